# Optimizing an MI355X kernel written in HIP

```python
import jax, jax.numpy as jnp
from jax import lax
import numpy as np

D_MODEL = 2048
BATCH = 4
SEQ = 2048
DEPTH = 1

HEAD_DIM = 128
MIX_WIDTH = D_MODEL
N_HEADS_NA = 8
N_HEADS_DIL = MIX_WIDTH // HEAD_DIM - N_HEADS_NA
WIDTH_NA = N_HEADS_NA * HEAD_DIM
WIDTH_DIL = N_HEADS_DIL * HEAD_DIM
GRID_W = 64
NA_ROWS = 8
NA_COLS = 16
DIL_PATTERNS = ((128, 1), (512, 4), (2048, 16))
DIL_QBLOCK = 64
T5_BUCKETS = 32
T5_MAX_DIST = 1024
N_EXPERTS = 32
TOP_K = 4
D_FF = D_MODEL
SWIGLU_LIMIT = 7.0
SWIGLU_ALPHA = 1.702
MOE_BLOCK = 256
EPS = 1e-6
NEG = -1e30

kernel_name = 'hybrid_na_dilated_moe_block'


def rms_norm(x, g):
    xf = x.astype(jnp.float32)
    y = xf * lax.rsqrt(jnp.mean(xf * xf, axis=-1, keepdims=True) + EPS)
    return (y * g.astype(jnp.float32)).astype(x.dtype)


def _t5_bucket(rel):
    nb = T5_BUCKETS // 2
    max_exact = nb // 2
    ret = (rel > 0).astype(np.int32) * nb
    n = np.abs(rel)
    large = max_exact + (np.log(np.maximum(n, 1) / max_exact) / np.log(T5_MAX_DIST / max_exact)
                         * (nb - max_exact)).astype(np.int32)
    large = np.minimum(large, nb - 1)
    return (ret + np.where(n < max_exact, n, large)).astype(np.int32)


def neighbourhood_attention(q, k, v, rpb):
    b, s, h, dh = q.shape
    rows = s // GRID_W
    kr = min(NA_ROWS, rows)
    r = np.arange(rows)
    row_start = np.clip(r - kr // 2, 0, rows - kr)
    row_idx = row_start[:, None] + np.arange(kr)[None, :]
    cidx = np.arange(GRID_W)
    col_start = np.clip(cidx - NA_COLS // 2, 0, GRID_W - NA_COLS)
    col_ok = (cidx[None, :] >= col_start[:, None]) & (cidx[None, :] < col_start[:, None] + NA_COLS)
    dr = row_idx - r[:, None] + NA_ROWS - 1
    dc = np.clip(cidx[None, :] - cidx[:, None] + NA_COLS - 1, 0, 2 * NA_COLS - 2)

    def to_grid(t):
        return t.reshape(b, rows, GRID_W, h, dh).transpose(0, 3, 1, 2, 4)

    qg, kg, vg = to_grid(q), to_grid(k), to_grid(v)
    k_rows = kg[:, :, row_idx]
    v_rows = vg[:, :, row_idx]
    logits = jnp.einsum('bhrqd,bhrkcd->bhrqkc', qg, k_rows).astype(jnp.float32) * (dh ** -0.5)
    bias = rpb[:, dr[:, None, :, None], dc[None, :, None, :]]
    logits = logits + bias.astype(jnp.float32)[None]
    logits = jnp.where(col_ok[None, None, None, :, None, :], logits, NEG)
    probs = jax.nn.softmax(logits.reshape(b, h, rows, GRID_W, kr * GRID_W), axis=-1)
    probs = probs.reshape(logits.shape).astype(v.dtype)
    out = jnp.einsum('bhrqkc,bhrkcd->bhrqd', probs, v_rows)
    return out.transpose(0, 2, 3, 1, 4).reshape(b, s, h * dh)


def _to_sub(t, sub_len, dil):
    b, h, s, dh = t.shape
    return t.reshape(b, h, sub_len, dil, dh).transpose(0, 1, 3, 2, 4)


def dilated_attention(q, k, v, t5_table):
    b, s, h, dh = q.shape
    qh, kh, vh = (t.transpose(0, 2, 1, 3) for t in (q, k, v))
    outs, lses = [], []
    for window, dil in DIL_PATTERNS:
        half = window // (2 * dil)
        sub_len = s // dil
        nblk = -(-sub_len // DIL_QBLOCK)
        lp = nblk * DIL_QBLOCK
        kw = DIL_QBLOCK + 2 * half
        qs = jnp.pad(_to_sub(qh, sub_len, dil), ((0, 0),) * 3 + ((0, lp - sub_len), (0, 0)))
        qs = qs.reshape(b, h, dil, nblk, DIL_QBLOCK, dh)
        pad_k = ((0, 0),) * 3 + ((half, lp - sub_len + half), (0, 0))
        ks = jnp.pad(_to_sub(kh, sub_len, dil), pad_k)
        vs = jnp.pad(_to_sub(vh, sub_len, dil), pad_k)
        kidx = np.arange(nblk)[:, None] * DIL_QBLOCK + np.arange(kw)[None, :]
        kb = ks[:, :, :, kidx]
        vb = vs[:, :, :, kidx]
        qi = np.arange(DIL_QBLOCK)
        kj = np.arange(kw)
        delta = kj[None, :] - half - qi[:, None]
        key_l = np.arange(nblk)[:, None] * DIL_QBLOCK + kj[None, :] - half
        valid = (np.abs(delta) <= half)[None] & ((key_l >= 0) & (key_l < sub_len))[:, None, :]
        bias = t5_table[_t5_bucket(delta * dil)].transpose(2, 0, 1).astype(jnp.float32)
        logits = jnp.einsum('bhrnqd,bhrnkd->bhrnqk', qs, kb).astype(jnp.float32) * (dh ** -0.5)
        logits = logits + bias[None, :, None, None]
        logits = jnp.where(valid[None, None, None], logits, NEG)
        m = jnp.max(logits, axis=-1, keepdims=True)
        p = jnp.exp(logits - m)
        den = jnp.sum(p, axis=-1, keepdims=True)
        o = jnp.einsum('bhrnqk,bhrnkd->bhrnqd', (p / den).astype(v.dtype), vb)
        lse = (m + jnp.log(den))[..., 0]
        o = o.reshape(b, h, dil, lp, dh)[:, :, :, :sub_len].transpose(0, 1, 3, 2, 4).reshape(b, h, s, dh)
        lse = lse.reshape(b, h, dil, lp)[..., :sub_len].transpose(0, 1, 3, 2).reshape(b, h, s)
        outs.append(o)
        lses.append(lse)
    wts = jax.nn.softmax(jnp.stack(lses, axis=0), axis=0)
    out = jnp.sum(wts[..., None] * jnp.stack(outs, axis=0).astype(jnp.float32), axis=0)
    return out.astype(q.dtype).transpose(0, 2, 1, 3).reshape(b, s, h * dh)


def moe_ffn(hid, w_router, b_router, w_e_in, b_e_in, w_e_out, b_e_out):
    t, d = hid.shape
    logits = hid.astype(jnp.float32) @ w_router.astype(jnp.float32) + b_router.astype(jnp.float32)
    top_val, top_idx = lax.top_k(logits, TOP_K)
    gates = jax.nn.softmax(top_val, axis=-1)
    n_assign = t * TOP_K
    e_flat = top_idx.reshape(n_assign).astype(jnp.int32)
    tok_flat = jnp.broadcast_to(jnp.arange(t, dtype=jnp.int32)[:, None], (t, TOP_K)).reshape(n_assign)
    g_flat = gates.reshape(n_assign)
    order = jnp.argsort(e_flat)
    e_sorted = e_flat[order]
    counts = jax.ops.segment_sum(jnp.ones((n_assign,), jnp.int32), e_flat, num_segments=N_EXPERTS)
    padded = (counts + MOE_BLOCK - 1) // MOE_BLOCK * MOE_BLOCK
    start = jnp.cumsum(counts) - counts
    pend = jnp.cumsum(padded)
    pstart = pend - padded
    dest = pstart[e_sorted] + jnp.arange(n_assign, dtype=jnp.int32) - start[e_sorted]
    n_slots = n_assign + N_EXPERTS * MOE_BLOCK
    nblk = n_slots // MOE_BLOCK
    slot_tok = jnp.full((n_slots,), t, jnp.int32).at[dest].set(tok_flat[order])
    slot_gate = jnp.zeros((n_slots,), jnp.float32).at[dest].set(g_flat[order])
    block_e = jnp.minimum(jnp.searchsorted(pend, jnp.arange(nblk, dtype=jnp.int32) * MOE_BLOCK, side='right'),
                          N_EXPERTS - 1)
    hid_pad = jnp.concatenate([hid, jnp.zeros((1, d), hid.dtype)], axis=0)

    def expert_block(args):
        tok, e = args
        z = hid_pad[tok] @ w_e_in[e] + b_e_in[e]
        gate = jnp.minimum(z[:, 0::2], SWIGLU_LIMIT)
        up = jnp.clip(z[:, 1::2], -SWIGLU_LIMIT, SWIGLU_LIMIT)
        glu = gate * jax.nn.sigmoid(SWIGLU_ALPHA * gate)
        return ((up + 1.0) * glu) @ w_e_out[e] + b_e_out[e]

    ys = lax.map(expert_block, (slot_tok.reshape(nblk, MOE_BLOCK), block_e))
    ys = ys.reshape(n_slots, d).astype(jnp.float32) * slot_gate[:, None]
    out = jax.ops.segment_sum(ys, slot_tok, num_segments=t + 1)[:t]
    return out.astype(hid.dtype)


def setup_inputs(seed: int = 0) -> dict:
    key = jax.random.key(seed)
    ks = jax.random.split(key, 21)
    f32 = jnp.float32
    d = D_MODEL

    def nrm(k, shape, scale):
        return jax.random.normal(k, shape, f32) * scale

    return {
        'x': nrm(ks[0], (BATCH, SEQ, d), 1.0),
        'c': nrm(ks[1], (BATCH, d), 1.0),
        'w_ada': nrm(ks[2], (DEPTH, d, 6 * d), 0.5 * d ** -0.5),
        'b_ada': nrm(ks[3], (DEPTH, 6 * d), 0.02),
        'g_pre_mix': 1.0 + nrm(ks[4], (DEPTH, d), 0.02),
        'g_post_mix': 1.0 + nrm(ks[5], (DEPTH, d), 0.02),
        'w_in': nrm(ks[6], (DEPTH, d, 3 * MIX_WIDTH), d ** -0.5),
        'rpb_na': nrm(ks[7], (DEPTH, N_HEADS_NA, 2 * NA_ROWS - 1, 2 * NA_COLS - 1), 0.1),
        't5_table': nrm(ks[8], (T5_BUCKETS, N_HEADS_DIL), 0.1),
        'g_out_na': 1.0 + nrm(ks[9], (DEPTH, WIDTH_NA), 0.02),
        'g_out_dil': 1.0 + nrm(ks[10], (DEPTH, WIDTH_DIL), 0.02),
        'w_o': nrm(ks[11], (DEPTH, MIX_WIDTH, d), MIX_WIDTH ** -0.5),
        'g_pre_ffn': 1.0 + nrm(ks[12], (DEPTH, d), 0.02),
        'g_post_ffn': 1.0 + nrm(ks[13], (DEPTH, d), 0.02),
        'w_router': nrm(ks[14], (DEPTH, d, N_EXPERTS), d ** -0.5),
        'b_router': nrm(ks[15], (DEPTH, N_EXPERTS), 0.01),
        'w_e_in': nrm(ks[16], (DEPTH, N_EXPERTS, d, 2 * D_FF), d ** -0.5),
        'b_e_in': nrm(ks[17], (DEPTH, N_EXPERTS, 2 * D_FF), 0.02),
        'w_e_out': nrm(ks[18], (DEPTH, N_EXPERTS, D_FF, d), D_FF ** -0.5),
        'b_e_out': nrm(ks[19], (DEPTH, N_EXPERTS, d), 0.02),
    }


def reference(x, c, w_ada, b_ada, g_pre_mix, g_post_mix, w_in, rpb_na, t5_table, g_out_na, g_out_dil,
              w_o, g_pre_ffn, g_post_ffn, w_router, b_router, w_e_in, b_e_in, w_e_out, b_e_out):
    b, s, d = x.shape
    for l in range(DEPTH):
        mod = jax.nn.silu(c) @ w_ada[l] + b_ada[l]
        sh1, sc1, gt1, sh2, sc2, gt2 = (m[:, None, :] for m in jnp.split(mod, 6, axis=-1))

        hmix = rms_norm(x, g_pre_mix[l]) * (1.0 + sc1) + sh1
        proj = hmix @ w_in[l]
        qa, ka, va = (t.reshape(b, s, N_HEADS_NA, HEAD_DIM)
                      for t in jnp.split(proj[..., :3 * WIDTH_NA], 3, axis=-1))
        qb, kb, vb = (t.reshape(b, s, N_HEADS_DIL, HEAD_DIM)
                      for t in jnp.split(proj[..., 3 * WIDTH_NA:], 3, axis=-1))
        out_na = neighbourhood_attention(qa, ka, va, rpb_na[l])
        out_dil = dilated_attention(qb, kb, vb, t5_table)
        mixed = jnp.concatenate([rms_norm(out_na, g_out_na[l]), rms_norm(out_dil, g_out_dil[l])], axis=-1) @ w_o[l]
        x = x + gt1 * rms_norm(mixed, g_post_mix[l])

        hffn = rms_norm(x, g_pre_ffn[l]) * (1.0 + sc2) + sh2
        y = moe_ffn(hffn.reshape(b * s, d), w_router[l], b_router[l], w_e_in[l], b_e_in[l],
                    w_e_out[l], b_e_out[l]).reshape(b, s, d)
        x = x + gt2 * rms_norm(y, g_post_ffn[l])
    return x
```

```cpp
#include <hip/hip_runtime.h>
#include <cstdio>
#include <cstdint>

#ifndef MK_N_LAUNCHES
#define MK_N_LAUNCHES 1
#endif

namespace pg8 {
#define PG8_LAS __attribute__((address_space(3)))
typedef unsigned short bf16_t;
typedef short bf16x8 __attribute__((ext_vector_type(8)));
typedef float f32x4 __attribute__((ext_vector_type(4)));
typedef unsigned u32x4 __attribute__((ext_vector_type(4)));
typedef unsigned u32x2 __attribute__((ext_vector_type(2)));
constexpr int BM = 256, BK = 64, HALF = 128, HTB = HALF * BK * 2  , STAGE_BYTES = 8 * HTB, NXCD = 8, WGM = 8;

__host__ __device__ __forceinline__ int lds_byte(int r, int c) { const int st = (r >> 4) * 2 + (c >> 5), rr = r & 15, cc = c & 31, ob = rr * 64 + cc * 2; return st * 1024 + (ob ^ (((ob >> 9) & 1) << 5)); }
__host__ __device__ __forceinline__ void stage_rc(int b, int& R, int& C) { const int st = b / 1024, sb = b % 1024, swz = sb ^ (((sb >> 9) & 1) << 5); R = (st >> 1) * 16 + swz / 64; C = (st & 1) * 32 + (swz % 64) / 2; }
__host__ __device__ __forceinline__ int perm32(int rho) { const int n = rho >> 4, i = rho & 15; return 8 * (i >> 2) + 4 * n + (i & 3); }

struct Unit { int pm, pn, bt, e; };
struct Gemm { const bf16_t* A; const bf16_t* Bt; int M, N, K; };

struct StaticOrder {
    int nM, nN, nwg, G, c;
    __host__ __device__ void init(int M, int N, int G_, int c_) { nM = M / BM; nN = N / BM; nwg = nM * nN; G = G_; c = c_; }
    __host__ __device__ bool next(int i, Unit& u) const {
        const long L = (long)i * G + c; if (L >= nwg) return false;
        int wgid = (int)L; { const int q = nwg / NXCD, r = nwg % NXCD, xcd = wgid % NXCD, off = wgid / NXCD; wgid = (xcd < r ? xcd * (q + 1) : r * (q + 1) + (xcd - r) * q) + off; }
        const int nig = WGM * nN, gid = wgid / nig, fm = gid * WGM, gsz = (nM - fm) < WGM ? (nM - fm) : WGM;
        u.pm = fm + ((wgid % nig) % gsz); u.pn = (wgid % nig) / gsz; u.bt = u.pn; u.e = 0; return true;
    }
    __device__ __forceinline__ void a_ready(const Unit&) const {}
    __device__ __forceinline__ void done(const Unit&) const {}
};
template <int NPN> struct MoeOrder {
    const PG8_LAS int* blk_e; int nb, G, c;
    __device__ __forceinline__ bool next(int i, Unit& u) const {
        int L = i * G + c;
        if (G == 256) L = ((i * 8 + (c & 7)) << 5) + (c >> 3);
        const int g = L >> 5, r = L & 31;
        int block, pn;
        if (NPN == 16) { block = 4 * (g >> 1) + (r & 3); pn = 8 * (g & 1) + (r >> 2); } else { block = 4 * g + (r & 3); pn = r >> 2; }
        if (block >= nb) return false;
        u.pm = block; u.pn = pn; u.e = blk_e[block]; u.bt = u.e * NPN + pn; return true;
    }
    __device__ __forceinline__ void a_ready(const Unit&) const {}
    __device__ __forceinline__ void done(const Unit&) const {}
};

__device__ __forceinline__ unsigned cvt_pk_bf16(float lo, float hi) { unsigned r; asm volatile("v_cvt_pk_bf16_f32 %0, %1, %2" : "=v"(r) : "v"(lo), "v"(hi)); return r; }

struct EpiF32 {
    static constexpr bool PERM = false, AFTER_DRAIN = false;
    float* C; int ldc;
    __device__ __forceinline__ void operator()(const f32x4 (&acc)[2][2][4][2], const Unit& u, int wr, int wc, int fr, int fq) const {
        const int row0 = u.pm * BM + wr * 64 + fr, col0 = u.pn * BM + wc * 32 + 4 * fq;
#pragma unroll
        for (int ai = 0; ai < 2; ++ai)
#pragma unroll
            for (int m = 0; m < 4; ++m) { float* rowp = C + (size_t)(row0 + ai * HALF + m * 16) * ldc + col0;
#pragma unroll
                for (int bj = 0; bj < 2; ++bj)
#pragma unroll
                    for (int n = 0; n < 2; ++n) *(f32x4*)(rowp + bj * HALF + n * 16) = acc[ai][bj][m][n]; }
    }
};
struct EpiBf16 {
    static constexpr bool PERM = true, AFTER_DRAIN = false;
    bf16_t* O; int ldc; const float* bias; int bias_estride;
    __device__ __forceinline__ void operator()(const f32x4 (&acc)[2][2][4][2], const Unit& u, int wr, int wc, int fr, int fq) const {
        const int row0 = u.pm * BM + wr * 64 + fr; const int col0 = u.pn * BM + wc * 32 + 8 * fq;
        f32x4 bv[2][2];
#pragma unroll
        for (int bj = 0; bj < 2; ++bj)
#pragma unroll
            for (int n = 0; n < 2; ++n) bv[bj][n] = bias ? *(const f32x4*)(bias + (size_t)u.e * bias_estride + col0 + bj * HALF + 4 * n) : (f32x4){0.f, 0.f, 0.f, 0.f};
#pragma unroll
        for (int ai = 0; ai < 2; ++ai)
#pragma unroll
            for (int m = 0; m < 4; ++m) { bf16_t* rowp = O + (size_t)(row0 + ai * HALF + m * 16) * ldc + col0;
#pragma unroll
                for (int bj = 0; bj < 2; ++bj) { const f32x4 v0 = acc[ai][bj][m][0] + bv[bj][0], v1 = acc[ai][bj][m][1] + bv[bj][1];
                    u32x4 w; w.x = cvt_pk_bf16(v0[0], v0[1]); w.y = cvt_pk_bf16(v0[2], v0[3]); w.z = cvt_pk_bf16(v1[0], v1[1]); w.w = cvt_pk_bf16(v1[2], v1[3]);
                    *(u32x4*)(rowp + bj * HALF) = w; } }
    }
};
__device__ __forceinline__ float swiglu1(float g, float u) {
    g = fminf(g, 7.0f); u = fminf(fmaxf(u, -7.0f), 7.0f);
    const float s = __builtin_amdgcn_rcpf(1.0f + __builtin_amdgcn_exp2f(g * (-1.702f * 1.44269504089f)));
    return (u + 1.0f) * (g * s);
}
struct EpiSwiglu {
    static constexpr bool PERM = true, AFTER_DRAIN = false;
    bf16_t* H; int ldh; const float* bias; int bias_estride;
    __device__ __forceinline__ void operator()(const f32x4 (&acc)[2][2][4][2], const Unit& u, int wr, int wc, int fr, int fq) const {
        const int row0 = u.pm * BM + wr * 64 + fr; const int col0 = u.pn * BM + wc * 32 + 8 * fq;
        f32x4 bv[2][2];
#pragma unroll
        for (int bj = 0; bj < 2; ++bj)
#pragma unroll
            for (int n = 0; n < 2; ++n) bv[bj][n] = *(const f32x4*)(bias + (size_t)u.e * bias_estride + col0 + bj * HALF + 4 * n);
#pragma unroll
        for (int ai = 0; ai < 2; ++ai)
#pragma unroll
            for (int m = 0; m < 4; ++m) { bf16_t* rowp = H + (size_t)(row0 + ai * HALF + m * 16) * ldh + (col0 >> 1);
#pragma unroll
                for (int bj = 0; bj < 2; ++bj) { const f32x4 v0 = acc[ai][bj][m][0] + bv[bj][0], v1 = acc[ai][bj][m][1] + bv[bj][1];
                    u32x2 w; w.x = cvt_pk_bf16(swiglu1(v0[0], v0[1]), swiglu1(v0[2], v0[3])); w.y = cvt_pk_bf16(swiglu1(v1[0], v1[1]), swiglu1(v1[2], v1[3]));
                    *(u32x2*)(rowp + bj * (HALF / 2)) = w; } }
    }
};

template <class Epi, class Sched, bool ALIGN_EPI = false, bool SP2 = false>
__device__ __forceinline__ void gemm_phase(PG8_LAS unsigned char* lds, const Gemm g, const Sched& S, const Epi& E) {
    const int tid = threadIdx.x, wid = __builtin_amdgcn_readfirstlane(tid >> 6), lane = tid & 63, wr = wid >> 2, wc = wid & 3, fr = lane & 15, fq = lane >> 4;
    const int K = g.K, nt = K / BK;
    unsigned voffA[2], voffB[2];
#pragma unroll
    for (int i = 0; i < 2; ++i) { int R, C; stage_rc(tid * 16 + i * 8192, R, C); const int Rb = Epi::PERM ? ((R & ~31) + perm32(R & 31)) : R;
        voffA[i] = (unsigned)(R * K + C) * 2u; voffB[i] = (unsigned)(Rb * K + C) * 2u; }
    const size_t kstep = (size_t)(BK * 2);
    const size_t hstep = (size_t)HALF * K * 2;
    const size_t tstep = 2 * hstep;
    const unsigned ldsw = (unsigned)wid * 1024u;
    const int aoff = lds_byte(wr * 64 + fr, fq * 8), boff = lds_byte(wc * 32 + fr, fq * 8);
#define PG8_SA(b, h) (((b) * 2 + (h)) * HTB)
#define PG8_SB(b, h) ((4 + (b) * 2 + (h)) * HTB)
#define PG8_STAGE(bufoff, gbase, voff) do { _Pragma("unroll") for (int _i = 0; _i < 2; ++_i) \
        __builtin_amdgcn_global_load_lds((const unsigned*)((const char*)(gbase) + (voff)[_i]), (PG8_LAS unsigned*)(lds + (bufoff) + ldsw + _i * 8192), 16, 0, 0); } while (0)
#define PG8_LDA(dst, b, h) do { _Pragma("unroll") for (int m = 0; m < 4; ++m) _Pragma("unroll") for (int k = 0; k < 2; ++k) dst[m][k] = *(const PG8_LAS bf16x8*)(lds + PG8_SA(b, h) + aoff + m * 2048 + k * 1024); } while (0)
#define PG8_LDB(dst, b, h) do { _Pragma("unroll") for (int n = 0; n < 2; ++n) _Pragma("unroll") for (int k = 0; k < 2; ++k) dst[n][k] = *(const PG8_LAS bf16x8*)(lds + PG8_SB(b, h) + boff + n * 2048 + k * 1024); } while (0)
#define PG8_MMA(ai, bj, At, Bt) do { __builtin_amdgcn_s_setprio(1); _Pragma("unroll") for (int m = 0; m < 4; ++m) _Pragma("unroll") for (int n = 0; n < 2; ++n) _Pragma("unroll") for (int k = 0; k < 2; ++k) \
        acc[ai][bj][m][n] = __builtin_amdgcn_mfma_f32_16x16x32_bf16(Bt[n][k], At[m][k], acc[ai][bj][m][n], 0, 0, 0); __builtin_amdgcn_s_setprio(0); } while (0)
#define PG8_WAIT_V(n) asm volatile("s_waitcnt vmcnt(" #n ")" ::: "memory")
#define PG8_WAIT_L(n) asm volatile("s_waitcnt lgkmcnt(" #n ")" ::: "memory")
#define PG8_BAR __builtin_amdgcn_s_barrier()
#define PG8_SCHED __builtin_amdgcn_sched_barrier(0)
    Unit cur, nxt; int ui = 0;
    if (!S.next(0, cur)) return;
    f32x4 acc[2][2][4][2];
#pragma unroll
    for (int a = 0; a < 2; ++a)
#pragma unroll
        for (int b = 0; b < 2; ++b)
#pragma unroll
            for (int m = 0; m < 4; ++m)
#pragma unroll
                for (int n = 0; n < 2; ++n) acc[a][b][m][n] = (f32x4){0.f, 0.f, 0.f, 0.f};
    bf16x8 At[4][2], B0[2][2], B1[2][2];
    const char* cA = (const char*)g.A + (size_t)cur.pm * tstep; const char* cB = (const char*)g.Bt + (size_t)cur.bt * tstep;
    S.a_ready(cur);
    if constexpr (SP2) {
        PG8_STAGE(PG8_SB(0, 0), cB, voffB); PG8_STAGE(PG8_SB(0, 1), cB + hstep, voffB); PG8_STAGE(PG8_SA(0, 0), cA, voffA); PG8_STAGE(PG8_SA(0, 1), cA + hstep, voffA);
        if (wr == 1) PG8_BAR;
        PG8_WAIT_V(2); PG8_BAR;
        PG8_STAGE(PG8_SB(1, 0), cB + kstep, voffB); PG8_STAGE(PG8_SA(1, 0), cA + kstep, voffA); PG8_STAGE(PG8_SB(1, 1), cB + hstep + kstep, voffB);
        PG8_WAIT_V(6); PG8_BAR;
    } else {
        PG8_STAGE(PG8_SB(0, 0), cB, voffB); PG8_STAGE(PG8_SA(0, 0), cA, voffA); PG8_STAGE(PG8_SB(0, 1), cB + hstep, voffB); PG8_STAGE(PG8_SA(0, 1), cA + hstep, voffA);
        if (wr == 1) PG8_BAR;
        PG8_WAIT_V(4); PG8_BAR;
        PG8_STAGE(PG8_SB(1, 0), cB + kstep, voffB); PG8_STAGE(PG8_SA(1, 0), cA + kstep, voffA); PG8_STAGE(PG8_SB(1, 1), cB + hstep + kstep, voffB);
        PG8_WAIT_V(6); PG8_BAR;
    }
    for (;;) {
        const bool has_next = S.next(ui + 1, nxt);
        const char* nA = has_next ? (const char*)g.A + (size_t)nxt.pm * tstep : cA; const char* nB = has_next ? (const char*)g.Bt + (size_t)nxt.bt * tstep : cB;
        for (int t = 0; t < nt; t += 2) {
            const bool last = (t == nt - 2);
            const char* a1 = cA + (size_t)(t + 1) * kstep;
            const char* a2 = last ? nA : cA + (size_t)(t + 2) * kstep; const char* b2 = last ? nB : cB + (size_t)(t + 2) * kstep;
            const char* a3 = a2 + kstep; const char* b3 = b2 + kstep;
            if (last && has_next) S.a_ready(nxt);
            if constexpr (SP2) {
            PG8_LDB(B0, 0, 0); PG8_LDB(B1, 0, 1); PG8_SCHED; PG8_LDA(At, 0, 0); PG8_STAGE(PG8_SA(1, 1), a1 + hstep, voffA);
            PG8_WAIT_V(8); PG8_WAIT_L(0); PG8_BAR; PG8_MMA(0, 0, At, B0); PG8_MMA(0, 1, At, B1); PG8_BAR; PG8_SCHED;
            PG8_LDA(At, 0, 1); PG8_STAGE(PG8_SB(0, 0), b2, voffB); PG8_STAGE(PG8_SB(0, 1), b2 + hstep, voffB); PG8_STAGE(PG8_SA(0, 0), a2, voffA);
            PG8_WAIT_V(8); PG8_WAIT_L(0); PG8_BAR; PG8_MMA(1, 0, At, B0); PG8_MMA(1, 1, At, B1); PG8_BAR; PG8_SCHED;
            PG8_LDB(B0, 1, 0); PG8_LDB(B1, 1, 1); PG8_SCHED; PG8_LDA(At, 1, 0); PG8_STAGE(PG8_SA(0, 1), a2 + hstep, voffA);
            PG8_WAIT_V(8); PG8_WAIT_L(0); PG8_BAR; PG8_MMA(0, 0, At, B0); PG8_MMA(0, 1, At, B1); PG8_BAR; PG8_SCHED;
            PG8_LDA(At, 1, 1); PG8_STAGE(PG8_SB(1, 0), b3, voffB); PG8_STAGE(PG8_SB(1, 1), b3 + hstep, voffB); PG8_STAGE(PG8_SA(1, 0), a3, voffA);
            PG8_WAIT_V(8); PG8_WAIT_L(0); PG8_BAR; PG8_MMA(1, 0, At, B0); PG8_MMA(1, 1, At, B1); PG8_BAR; PG8_SCHED;
            } else {
            PG8_LDB(B0, 0, 0); PG8_SCHED; PG8_LDA(At, 0, 0); PG8_STAGE(PG8_SA(1, 1), a1 + hstep, voffA);
            PG8_WAIT_L(8); PG8_BAR; PG8_WAIT_L(0); PG8_MMA(0, 0, At, B0); PG8_BAR; PG8_SCHED;
            PG8_LDB(B1, 0, 1); PG8_STAGE(PG8_SB(0, 0), b2, voffB);
            PG8_BAR; PG8_WAIT_L(0); PG8_MMA(0, 1, At, B1); PG8_BAR;
            PG8_LDA(At, 0, 1); PG8_STAGE(PG8_SA(0, 0), a2, voffA);
            PG8_BAR; PG8_WAIT_L(0); PG8_MMA(1, 0, At, B0); PG8_BAR; PG8_SCHED;
            PG8_STAGE(PG8_SB(0, 1), b2 + hstep, voffB);
            PG8_WAIT_V(6); PG8_BAR; PG8_MMA(1, 1, At, B1); PG8_BAR;
            PG8_LDB(B0, 1, 0); PG8_SCHED; PG8_LDA(At, 1, 0); PG8_STAGE(PG8_SA(0, 1), a2 + hstep, voffA);
            PG8_WAIT_L(8); PG8_BAR; PG8_WAIT_L(0); PG8_MMA(0, 0, At, B0); PG8_BAR; PG8_SCHED;
            PG8_LDB(B1, 1, 1); PG8_STAGE(PG8_SB(1, 0), b3, voffB);
            PG8_BAR; PG8_WAIT_L(0); PG8_MMA(0, 1, At, B1); PG8_BAR;
            PG8_LDA(At, 1, 1); PG8_STAGE(PG8_SA(1, 0), a3, voffA);
            PG8_BAR; PG8_WAIT_L(0); PG8_MMA(1, 0, At, B0); PG8_BAR; PG8_SCHED;
            PG8_STAGE(PG8_SB(1, 1), b3 + hstep, voffB);
            PG8_WAIT_V(6); PG8_BAR; PG8_MMA(1, 1, At, B1); PG8_BAR;
            }
        }
        if constexpr (ALIGN_EPI) { if (wr == 0) PG8_BAR; }
        if constexpr (!Epi::AFTER_DRAIN) { E(acc, cur, wr, wc, fr, fq); S.done(cur); }
        if (!has_next) break;
#pragma unroll
        for (int a = 0; a < 2; ++a)
#pragma unroll
            for (int b = 0; b < 2; ++b)
#pragma unroll
                for (int m = 0; m < 4; ++m)
#pragma unroll
                    for (int n = 0; n < 2; ++n) acc[a][b][m][n] = (f32x4){0.f, 0.f, 0.f, 0.f};
        cur = nxt; cA = nA; cB = nB; ++ui;
        if constexpr (ALIGN_EPI) { if (wr == 1) PG8_BAR; }
    }
    PG8_WAIT_V(0);
    if constexpr (!ALIGN_EPI) { if (wr == 0) PG8_BAR; }
    PG8_BAR;
    if constexpr (Epi::AFTER_DRAIN) { E.fused(acc, cur, wr, wc, fr, fq, lds, wid, lane); S.done(cur); }
#undef PG8_SA
#undef PG8_SB
#undef PG8_STAGE
#undef PG8_LDA
#undef PG8_LDB
#undef PG8_MMA
#undef PG8_WAIT_V
#undef PG8_WAIT_L
#undef PG8_BAR
#undef PG8_SCHED
}
}

constexpr int NWAVES = 8;
constexpr int NBATCH = 4, SEQ = 2048, T = NBATCH * SEQ, D = 2048, HD = 128, NHG = 8, GW = 1024, NQKV = 6144, NE = 32, TOPK = 4, FF = 2048, FF2 = 4096;
constexpr int MAXBLK = 160;
constexpr float EPS = 1e-6f;
constexpr int NPHASE = 11;

constexpr size_t MiB = 1u << 20;
constexpr size_t WS_CTL = 0, CTL_ZERO_BYTES = 1 * MiB;
constexpr size_t WS_MODP = 1 * MiB;
constexpr size_t WS_TOPI = 5 * MiB, WS_TOPG = WS_TOPI + 131072, WS_TSLOT = WS_TOPG + 131072;
constexpr size_t WS_LSE = 6 * MiB;
constexpr size_t WS_WIN_T = 8 * MiB;
constexpr size_t WS_WO_T = 32 * MiB;
constexpr size_t WS_HMIX = 40 * MiB;
constexpr size_t WS_AOUT = 72 * MiB;
constexpr size_t WS_PROJ = 104 * MiB;
constexpr size_t WS_ONA = 200 * MiB;
constexpr size_t WS_ODIL = 232 * MiB;
constexpr size_t WS_MIXED = 328 * MiB;
constexpr size_t WS_X1 = 392 * MiB;
constexpr size_t WS_HFFN = 456 * MiB;
constexpr size_t WS_XG = 492 * MiB;
constexpr size_t WS_HB = 652 * MiB;
constexpr size_t WS_YB = 812 * MiB;
constexpr size_t WS_WEI_T = 1024 * MiB;
constexpr size_t WS_WEO_T = 1536 * MiB;
constexpr size_t WS_END = 1792 * MiB;
constexpr int CW_TMO = 0, CW_CODE = 1, CW_CNT = 256, CW_CUR = 512, CW_BAR = 4096;

constexpr int RING_OFF = 0, RING_BYTES = 135168;
constexpr int MISC_OFF = RING_BYTES;
constexpr int LDS_BYTES = RING_BYTES + 1024;

#define GAS __attribute__((address_space(1)))
#define LAS __attribute__((address_space(3)))
typedef unsigned short bf16;
typedef unsigned v4u __attribute__((ext_vector_type(4)));
typedef unsigned v2u __attribute__((ext_vector_type(2)));
typedef float f32x4 __attribute__((ext_vector_type(4)));
typedef GAS unsigned gu32;
#define RLX_AGENT __ATOMIC_RELAXED, __HIP_MEMORY_SCOPE_AGENT
#define LDS_WAIT() asm volatile("s_waitcnt lgkmcnt(0)" ::: "memory")
#define VM_WAIT() asm volatile("s_waitcnt vmcnt(0)" ::: "memory")
__device__ __forceinline__ float bf2f(unsigned short h) { return __builtin_bit_cast(float, (unsigned)h << 16); }
__device__ __forceinline__ float bflo(unsigned w) { return __builtin_bit_cast(float, w << 16); }
__device__ __forceinline__ float bfhi(unsigned w) { return __builtin_bit_cast(float, w & 0xffff0000u); }
__device__ __forceinline__ unsigned pk2(float lo, float hi) { return pg8::cvt_pk_bf16(lo, hi); }

#define XB_TMO      128
#define XB_XCNT(j)  (256  + 64 * (j))
#define XB_XSUB(j)  (1280 + 64 * (j))
#define XB_XGEN(j)  (2304 + 64 * (j))
#define XB_TOP      3328
#define XB_TOPGEN   3392
#define XCD_BAR_WORDS 3456
#define XB_SPIN_CAP (1u << 18)
__device__ __forceinline__ unsigned xb_ld(unsigned* p)              { return __hip_atomic_load(p, __ATOMIC_RELAXED, __HIP_MEMORY_SCOPE_AGENT); }
__device__ __forceinline__ unsigned xb_add(unsigned* p, unsigned v) { return __hip_atomic_fetch_add(p, v, __ATOMIC_RELAXED, __HIP_MEMORY_SCOPE_AGENT); }
__device__ __forceinline__ unsigned xb_xcc_id() { return (unsigned)__builtin_amdgcn_s_getreg((3 << 11) | 20) & 0xFu; }
#define XB_SPIN(cond, bar) do { unsigned _sp = 0; while (cond) { __builtin_amdgcn_s_sleep(1); \
    if ((++_sp & 255u) == 0u) { if (xb_ld(&(bar)[XB_TMO])) break; if (_sp > XB_SPIN_CAP) { atomicAdd(&(bar)[XB_TMO], 1u); break; } } } } while (0)
struct XcdBarrier { unsigned* bar; unsigned x; volatile LAS unsigned* st; };
__device__ __forceinline__ XcdBarrier xcd_barrier_post(unsigned* bar, volatile LAS unsigned* st) {
    XcdBarrier b; b.bar = bar; b.x = xb_xcc_id(); b.st = st;
    if (threadIdx.x == 0) (void)xb_add(&bar[XB_XCNT(b.x)], 1u);
    return b;
}
__device__ __forceinline__ void xcd_barrier_complete(unsigned* bar, unsigned x, unsigned& nloc, unsigned& nx) {
    const unsigned G = gridDim.x * gridDim.y * gridDim.z;
    unsigned sum, cnt, mine, sp = 0u;
    for (;;) {
        sum = 0u; cnt = 0u; mine = 0u;
#pragma unroll
        for (unsigned j = 0; j < 16; ++j) { const unsigned c = xb_ld(&bar[XB_XCNT(j)]); sum += c; cnt += (c > 0u) ? 1u : 0u; mine = (j == x) ? c : mine; }
        if (sum == G) break;
        __builtin_amdgcn_s_sleep(1);
        if ((++sp & 255u) == 0u) { if (xb_ld(&bar[XB_TMO])) break; if (sp > XB_SPIN_CAP) { atomicAdd(&bar[XB_TMO], 1u); break; } }
    }
    nloc = mine > 0u ? mine : 1u; nx = cnt > 0u ? cnt : 1u;
}
__device__ __forceinline__ void xcd_barrier(const XcdBarrier& b) {
    asm volatile("s_waitcnt vmcnt(0)" ::: "memory");
    __syncthreads();
    if (threadIdx.x == 0) {
        unsigned* bar = b.bar;
        __builtin_amdgcn_s_waitcnt(0);
        unsigned nloc = b.st[0], nx = b.st[1];
        if (nloc == 0u) { xcd_barrier_complete(bar, b.x, nloc, nx); b.st[0] = nloc; b.st[1] = nx; }
        const unsigned old = xb_add(&bar[XB_XSUB(b.x)], 1u);
        const unsigned gen = old / nloc;
        if (old + 1u == (gen + 1u) * nloc) {
            __builtin_amdgcn_fence(__ATOMIC_RELEASE, "agent");
            asm volatile("s_waitcnt vmcnt(0)" ::: "memory");
            const unsigned og = xb_add(&bar[XB_TOP], 1u);
            const unsigned tg = og / nx;
            if (og + 1u == (tg + 1u) * nx) xb_add(&bar[XB_TOPGEN], 1u);
            else XB_SPIN(xb_ld(&bar[XB_TOPGEN]) == tg, bar);
            __builtin_amdgcn_fence(__ATOMIC_ACQUIRE, "agent");
            xb_add(&bar[XB_XGEN(b.x)], 1u);
            asm volatile("s_waitcnt vmcnt(0)" ::: "memory");
        } else {
            XB_SPIN(xb_ld(&bar[XB_XGEN(b.x)]) == gen, bar);
            __builtin_amdgcn_fence(__ATOMIC_ACQUIRE, "agent");
            asm volatile("s_waitcnt vmcnt(0)" ::: "memory");
        }
    }
    __syncthreads();
}

struct Frame {
    LAS unsigned char* lds;
    volatile LAS unsigned* MISC;
    unsigned* ctl;
    int tid, lane, wave, vcu, G;
    const float *x, *c, *w_ada, *b_ada, *g_pre_mix, *g_post_mix, *w_in, *rpb, *t5, *g_out_na, *g_out_dil, *w_o, *g_pre_ffn, *g_post_ffn, *w_router, *b_router, *w_e_in, *b_e_in, *w_e_out, *b_e_out;
    float* out;
    unsigned char* ws;
};
__device__ __forceinline__ float wave_sum(float v) {
#pragma unroll
    for (int o = 1; o < 64; o <<= 1) v += __shfl_xor(v, o);
    return v;
}
__device__ __forceinline__ float wave_max(float v) {
#pragma unroll
    for (int o = 1; o < 64; o <<= 1) v = fmaxf(v, __shfl_xor(v, o));
    return v;
}
__device__ __forceinline__ float mod_val(const Frame& F, int b, int idx) {
    const float* mp = (const float*)(F.ws + WS_MODP);
    float s = F.b_ada[idx];
#pragma unroll
    for (int ks = 0; ks < 16; ++ks) s += mp[(size_t)(ks * 4 + b) * (6 * D) + idx];
    return s;
}

__constant__ unsigned char T5B[3][132] = {
 {11,11,11,11,11,11,11,11,11,11,11,11,11,11,11,10,10,10,10,10,10,10,10,10,10,10,10,10,10,10,10,10,10,10,10,10,10,10,9,9,9,9,9,9,9,9,9,9,9,9,8,8,8,8,8,8,8,7,6,5,4,3,2,1,0,17,18,19,20,21,22,23,24,24,24,24,24,24,24,25,25,25,25,25,25,25,25,25,25,25,25,26,26,26,26,26,26,26,26,26,26,26,26,26,26,26,26,26,26,26,26,26,26,26,27,27,27,27,27,27,27,27,27,27,27,27,27,27,27,0,0,0},
 {13,13,13,13,13,13,13,13,13,13,13,13,13,13,13,13,13,13,13,13,13,13,13,12,12,12,12,12,12,12,12,12,12,12,12,12,12,12,12,12,12,12,11,11,11,11,11,11,11,11,11,11,10,10,10,10,10,10,9,9,9,8,8,4,0,20,24,24,25,25,25,26,26,26,26,26,26,27,27,27,27,27,27,27,27,27,27,28,28,28,28,28,28,28,28,28,28,28,28,28,28,28,28,28,28,28,29,29,29,29,29,29,29,29,29,29,29,29,29,29,29,29,29,29,29,29,29,29,29,0,0,0},
 {15,15,15,15,15,15,15,15,15,15,15,15,15,15,15,15,15,15,15,15,15,15,15,15,15,15,15,15,15,15,14,14,14,14,14,14,14,14,14,14,14,14,14,14,14,13,13,13,13,13,13,13,13,13,12,12,12,12,12,11,11,10,10,9,0,25,26,26,27,27,28,28,28,28,28,29,29,29,29,29,29,29,29,29,30,30,30,30,30,30,30,30,30,30,30,30,30,30,30,31,31,31,31,31,31,31,31,31,31,31,31,31,31,31,31,31,31,31,31,31,31,31,31,31,31,31,31,31,31,0,0,0}};

__device__ __forceinline__ void p0_mod_item(Frame& F, int j) {
    const int ks = j >> 4, cb = j & 15;
    LAS float* sc = (LAS float*)(F.lds + RING_OFF);
    LAS float* red = (LAS float*)(F.lds + RING_OFF + 4096);
    __syncthreads();
    { const int b = F.tid >> 7, k = F.tid & 127; const float cv = F.c[b * D + ks * 128 + k]; sc[F.tid] = cv / (1.0f + __expf(-cv)); }
    __syncthreads();
    const int cg = F.tid % 192, sub = F.tid / 192;
    f32x4 acc[4];
#pragma unroll
    for (int b = 0; b < 4; ++b) acc[b] = (f32x4){0.f, 0.f, 0.f, 0.f};
    if (sub < 2) {
        const float* wp = F.w_ada + (size_t)(ks * 128 + sub * 64) * (6 * D) + cb * 768 + 4 * cg;
#pragma unroll 8
        for (int i = 0; i < 64; ++i) {
            const f32x4 w = *(const f32x4*)(wp + (size_t)i * (6 * D));
#pragma unroll
            for (int b = 0; b < 4; ++b) { const float s = sc[b * 128 + sub * 64 + i]; acc[b] += w * s; }
        }
        if (sub == 1) {
#pragma unroll
            for (int b = 0; b < 4; ++b) *(LAS f32x4*)(red + cg * 16 + b * 4) = acc[b];
        }
    }
    __syncthreads();
    if (sub == 0) {
        float* mp = (float*)(F.ws + WS_MODP);
#pragma unroll
        for (int b = 0; b < 4; ++b) { const f32x4 o = acc[b] + *(LAS f32x4*)(red + cg * 16 + b * 4); *(f32x4*)(mp + (size_t)(ks * 4 + b) * (6 * D) + cb * 768 + 4 * cg) = o; }
    }
}
__device__ __forceinline__ void p0_transpose_item(const float* W, int K, int N, bf16* WT, LAS float* scr, int item, int lane) {
    const int nblk = N >> 6, kb = item / nblk, nb = item - kb * nblk, k0 = kb << 6, n0 = nb << 6;
    const float* src = W + (size_t)(k0 + (lane >> 4)) * N + n0 + 4 * (lane & 15);
    f32x4 v[16];
#pragma unroll
    for (int i = 0; i < 16; ++i) v[i] = *(const f32x4*)(src + (size_t)(4 * i) * N);
#pragma unroll
    for (int i = 0; i < 16; ++i) { LAS float* d = scr + (4 * i + (lane >> 4)) * 65 + 4 * (lane & 15); d[0] = v[i][0]; d[1] = v[i][1]; d[2] = v[i][2]; d[3] = v[i][3]; }
    LDS_WAIT();
    const int c = lane >> 3;
#pragma unroll
    for (int jn = 0; jn < 8; ++jn) { const int n = (lane & 7) + 8 * jn; const LAS float* s = scr + (8 * c) * 65 + n;
        v4u o; o.x = pk2(s[0 * 65], s[1 * 65]); o.y = pk2(s[2 * 65], s[3 * 65]); o.z = pk2(s[4 * 65], s[5 * 65]); o.w = pk2(s[6 * 65], s[7 * 65]);
        *(v4u*)(WT + (size_t)(n0 + n) * K + k0 + 8 * c) = o; }
    LDS_WAIT();
}
__device__ __forceinline__ void p0_prologue(Frame& F) {
    for (int j = F.vcu; j < 256; j += F.G) p0_mod_item(F, j);
    __syncthreads();
    LAS float* scr = (LAS float*)(F.lds + RING_OFF + F.wave * 16640);
    const int gw = F.vcu * NWAVES + F.wave, NGW = F.G * NWAVES;
    constexpr int I_IN = (D / 64) * (NQKV / 64), I_O = (D / 64) * (D / 64), I_EI1 = (D / 64) * (FF2 / 64), I_EO1 = (FF / 64) * (D / 64);
    constexpr int I_EI = NE * I_EI1, I_EO = NE * I_EO1, NITEMS = I_IN + I_O + I_EI + I_EO;
    for (int it = gw; it < NITEMS; it += NGW) {
        int r = it;
        if (r < I_IN) { p0_transpose_item(F.w_in, D, NQKV, (bf16*)(F.ws + WS_WIN_T), scr, r, F.lane); continue; } r -= I_IN;
        if (r < I_O) { p0_transpose_item(F.w_o, D, D, (bf16*)(F.ws + WS_WO_T), scr, r, F.lane); continue; } r -= I_O;
        if (r < I_EI) { const int e = r / I_EI1; p0_transpose_item(F.w_e_in + (size_t)e * D * FF2, D, FF2, (bf16*)(F.ws + WS_WEI_T) + (size_t)e * FF2 * D, scr, r - e * I_EI1, F.lane); continue; } r -= I_EI;
        { const int e = r / I_EO1; p0_transpose_item(F.w_e_out + (size_t)e * FF * D, FF, D, (bf16*)(F.ws + WS_WEO_T) + (size_t)e * D * FF, scr, r - e * I_EO1, F.lane); }
    }
}

__device__ __forceinline__ void p1_hmix(Frame& F) {
    LAS float* ta = (LAS float*)(F.lds + RING_OFF);
    LAS float* tb = ta + D;
    for (int rb = F.vcu; rb < T / 32; rb += F.G) {
        const int b = rb >> 6;
        __syncthreads();
        for (int col = F.tid; col < D; col += NWAVES * 64) { ta[col] = F.g_pre_mix[col] * (1.0f + mod_val(F, b, D + col)); tb[col] = mod_val(F, b, col); }
        __syncthreads();
        for (int rr = F.wave; rr < 32; rr += NWAVES) {
            const int row = rb * 32 + rr;
            const f32x4* xr = (const f32x4*)(F.x + (size_t)row * D) + F.lane;
            f32x4 v[8]; float ss = 0.f;
#pragma unroll
            for (int j = 0; j < 8; ++j) { v[j] = xr[64 * j]; ss += (v[j][0] * v[j][0] + v[j][1] * v[j][1]) + (v[j][2] * v[j][2] + v[j][3] * v[j][3]); }
            const float r = 1.0f / sqrtf(wave_sum(ss) * (1.0f / D) + EPS);
            v2u* o8 = (v2u*)((bf16*)(F.ws + WS_HMIX) + (size_t)row * D) + F.lane;
#pragma unroll
            for (int j = 0; j < 8; ++j) { const int col = 4 * F.lane + 256 * j; const f32x4 a = *(LAS f32x4*)(ta + col), s = *(LAS f32x4*)(tb + col);
                v2u w; w.x = pk2(v[j][0] * r * a[0] + s[0], v[j][1] * r * a[1] + s[1]); w.y = pk2(v[j][2] * r * a[2] + s[2], v[j][3] * r * a[3] + s[3]); o8[64 * j] = w; }
        }
    }
}

__device__ __forceinline__ float dot_qk(const LAS float* q, const bf16* krow) {
    float s = 0.f;
#pragma unroll
    for (int ch = 0; ch < 16; ++ch) { const v4u kv = *(const v4u*)(krow + 8 * ch); const LAS float* qq = q + 8 * ch;
        s += qq[0] * bflo(kv.x) + qq[1] * bfhi(kv.x) + qq[2] * bflo(kv.y) + qq[3] * bfhi(kv.y) + qq[4] * bflo(kv.z) + qq[5] * bfhi(kv.z) + qq[6] * bflo(kv.w) + qq[7] * bfhi(kv.w); }
    return s;
}
__device__ __forceinline__ void p3_attn_naive(Frame& F) {
    LAS float* lq = (LAS float*)(F.lds + RING_OFF + F.wave * 2048);
    LAS float* lp = lq + 128;
    const bf16* proj = (const bf16*)(F.ws + WS_PROJ);
    float* ona = (float*)(F.ws + WS_ONA); float* odil = (float*)(F.ws + WS_ODIL); float* lse = (float*)(F.ws + WS_LSE);
    const float scale = 0.08838834764831845f;
    const int gw = F.vcu * NWAVES + F.wave, NGW = F.G * NWAVES, lane = F.lane;
    for (int it = gw; it < T * 16; it += NGW) {
        const int tok = it >> 4, hh = it & 15, b = tok >> 11, pos = tok & 2047;
        const bf16* prow = proj + (size_t)tok * NQKV;
        if (hh < 8) {
            const int h = hh;
            { const unsigned qw = *(const unsigned*)(prow + h * HD + 2 * lane); LDS_WAIT(); lq[2 * lane] = bflo(qw); lq[2 * lane + 1] = bfhi(qw); LDS_WAIT(); }
            const int r = pos >> 6, c = pos & 63; const int rs = min(max(r - 4, 0), 24), cs = min(max(c - 8, 0), 48);
            float lg[2];
#pragma unroll
            for (int jj = 0; jj < 2; ++jj) { const int j = lane + 64 * jj, i = j >> 4, cc = cs + (j & 15), kpos = (rs + i) * 64 + cc;
                const float d = dot_qk(lq, proj + (size_t)(b * SEQ + kpos) * NQKV + GW + h * HD);
                lg[jj] = d * scale + F.rpb[(h * 15 + (rs + i - r + 7)) * 31 + (cc - c + 15)]; }
            const float m = wave_max(fmaxf(lg[0], lg[1]));
            const float p0 = __expf(lg[0] - m), p1 = __expf(lg[1] - m);
            const float inv = 1.0f / wave_sum(p0 + p1);
            lp[lane] = p0 * inv; lp[lane + 64] = p1 * inv; LDS_WAIT();
            float o0 = 0.f, o1 = 0.f;
            for (int j = 0; j < 128; ++j) { const int kpos = (rs + (j >> 4)) * 64 + cs + (j & 15);
                const unsigned vw = *(const unsigned*)(proj + (size_t)(b * SEQ + kpos) * NQKV + 2 * GW + h * HD + 2 * lane); const float p = lp[j]; o0 += p * bflo(vw); o1 += p * bfhi(vw); }
            *(float2*)(ona + (size_t)tok * GW + h * HD + 2 * lane) = make_float2(o0, o1);
        } else {
            const int h = hh - 8;
            { const unsigned qw = *(const unsigned*)(prow + 3 * GW + h * HD + 2 * lane); LDS_WAIT(); lq[2 * lane] = bflo(qw); lq[2 * lane + 1] = bfhi(qw); LDS_WAIT(); }
#pragma unroll
            for (int p = 0; p < 3; ++p) {
                const int dsh = 2 * p, dil = 1 << dsh, sub_len = SEQ >> dsh, rho = pos & (dil - 1), ql = pos >> dsh;
                float lg[3];
#pragma unroll
                for (int jj = 0; jj < 3; ++jj) { const int j = lane + 64 * jj; const int kl = ql + j - 64; const bool valid = (j < 129) && (kl >= 0) && (kl < sub_len);
                    const int kpos = rho + dil * min(max(kl, 0), sub_len - 1);
                    float d = -INFINITY;
                    if (valid) d = dot_qk(lq, proj + (size_t)(b * SEQ + kpos) * NQKV + 4 * GW + h * HD) * scale + F.t5[(int)T5B[p][j] * 8 + h];
                    lg[jj] = d; }
                const float m = wave_max(fmaxf(fmaxf(lg[0], lg[1]), lg[2]));
                const float p0 = __expf(lg[0] - m), p1 = __expf(lg[1] - m), p2 = __expf(lg[2] - m);
                const float den = wave_sum(p0 + p1 + p2), inv = 1.0f / den;
                LDS_WAIT(); lp[lane] = p0 * inv; lp[lane + 64] = p1 * inv; lp[lane + 128] = p2 * inv; LDS_WAIT();
                float o0 = 0.f, o1 = 0.f;
                for (int j = 0; j < 129; ++j) { const int kl = ql + j - 64; const int kpos = rho + dil * min(max(kl, 0), sub_len - 1);
                    const unsigned vw = *(const unsigned*)(proj + (size_t)(b * SEQ + kpos) * NQKV + 5 * GW + h * HD + 2 * lane); const float pp = lp[j]; o0 += pp * bflo(vw); o1 += pp * bfhi(vw); }
                *(float2*)(odil + ((size_t)p * T + tok) * GW + h * HD + 2 * lane) = make_float2(o0, o1);
                if (lane == 0) lse[((size_t)p * T + tok) * 8 + h] = m + __logf(den);
            }
        }
    }
}

__device__ __forceinline__ void p4_post(Frame& F) {
    const float* ona = (const float*)(F.ws + WS_ONA); const float* odil = (const float*)(F.ws + WS_ODIL); const float* lse = (const float*)(F.ws + WS_LSE);
    bf16* aout = (bf16*)(F.ws + WS_AOUT);
    const int gw = F.vcu * NWAVES + F.wave, NGW = F.G * NWAVES, lane = F.lane;
    for (int tok = gw; tok < T; tok += NGW) {
        f32x4 v[4]; float ss = 0.f;
#pragma unroll
        for (int j = 0; j < 4; ++j) { v[j] = *(const f32x4*)(ona + (size_t)tok * GW + 4 * lane + 256 * j); ss += (v[j][0] * v[j][0] + v[j][1] * v[j][1]) + (v[j][2] * v[j][2] + v[j][3] * v[j][3]); }
        float r = 1.0f / sqrtf(wave_sum(ss) * (1.0f / GW) + EPS);
#pragma unroll
        for (int j = 0; j < 4; ++j) { const int col = 4 * lane + 256 * j; const f32x4 g = *(const f32x4*)(F.g_out_na + col);
            v2u w; w.x = pk2(v[j][0] * r * g[0], v[j][1] * r * g[1]); w.y = pk2(v[j][2] * r * g[2], v[j][3] * r * g[3]); *(v2u*)(aout + (size_t)tok * D + col) = w; }
        ss = 0.f;
#pragma unroll
        for (int j = 0; j < 4; ++j) { const int col = 4 * lane + 256 * j, h = col >> 7;
            const float l0 = lse[((size_t)0 * T + tok) * 8 + h], l1 = lse[((size_t)1 * T + tok) * 8 + h], l2 = lse[((size_t)2 * T + tok) * 8 + h];
            const float mx = fmaxf(fmaxf(l0, l1), l2); const float e0 = __expf(l0 - mx), e1 = __expf(l1 - mx), e2 = __expf(l2 - mx); const float inv = 1.0f / (e0 + e1 + e2);
            const f32x4 a0 = *(const f32x4*)(odil + ((size_t)0 * T + tok) * GW + col), a1 = *(const f32x4*)(odil + ((size_t)1 * T + tok) * GW + col), a2 = *(const f32x4*)(odil + ((size_t)2 * T + tok) * GW + col);
            v[j] = a0 * (e0 * inv) + a1 * (e1 * inv) + a2 * (e2 * inv);
            ss += (v[j][0] * v[j][0] + v[j][1] * v[j][1]) + (v[j][2] * v[j][2] + v[j][3] * v[j][3]); }
        r = 1.0f / sqrtf(wave_sum(ss) * (1.0f / GW) + EPS);
#pragma unroll
        for (int j = 0; j < 4; ++j) { const int col = 4 * lane + 256 * j; const f32x4 g = *(const f32x4*)(F.g_out_dil + col);
            v2u w; w.x = pk2(v[j][0] * r * g[0], v[j][1] * r * g[1]); w.y = pk2(v[j][2] * r * g[2], v[j][3] * r * g[3]); *(v2u*)(aout + (size_t)tok * D + GW + col) = w; }
    }
}

__device__ __forceinline__ void p6_rows(Frame& F) {
    LAS float* t1 = (LAS float*)(F.lds + RING_OFF);
    LAS float* t2 = t1 + D;
    LAS float* t3 = t2 + D;
    LAS float* hrow = t3 + D + F.wave * D;
    const float* mixed = (const float*)(F.ws + WS_MIXED); float* x1 = (float*)(F.ws + WS_X1); bf16* hffn = (bf16*)(F.ws + WS_HFFN);
    int* topi = (int*)(F.ws + WS_TOPI); float* topg = (float*)(F.ws + WS_TOPG);
    const int lane = F.lane;
    for (int rb = F.vcu; rb < T / 32; rb += F.G) {
        const int b = rb >> 6;
        __syncthreads();
        for (int col = F.tid; col < D; col += NWAVES * 64) { t1[col] = F.g_post_mix[col] * mod_val(F, b, 2 * D + col); t2[col] = F.g_pre_ffn[col] * (1.0f + mod_val(F, b, 4 * D + col)); t3[col] = mod_val(F, b, 3 * D + col); }
        __syncthreads();
        for (int rr = F.wave; rr < 32; rr += NWAVES) {
            const int row = rb * 32 + rr;
            f32x4 v[8]; float ss = 0.f;
#pragma unroll
            for (int j = 0; j < 8; ++j) { v[j] = *(const f32x4*)(mixed + (size_t)row * D + 4 * lane + 256 * j); ss += (v[j][0] * v[j][0] + v[j][1] * v[j][1]) + (v[j][2] * v[j][2] + v[j][3] * v[j][3]); }
            float r = 1.0f / sqrtf(wave_sum(ss) * (1.0f / D) + EPS);
            ss = 0.f;
#pragma unroll
            for (int j = 0; j < 8; ++j) { const int col = 4 * lane + 256 * j; const f32x4 xv = *(const f32x4*)(F.x + (size_t)row * D + col); const f32x4 a = *(LAS f32x4*)(t1 + col);
                v[j] = xv + a * (v[j] * r); *(f32x4*)(x1 + (size_t)row * D + col) = v[j];
                ss += (v[j][0] * v[j][0] + v[j][1] * v[j][1]) + (v[j][2] * v[j][2] + v[j][3] * v[j][3]); }
            r = 1.0f / sqrtf(wave_sum(ss) * (1.0f / D) + EPS);
            LDS_WAIT();
#pragma unroll
            for (int j = 0; j < 8; ++j) { const int col = 4 * lane + 256 * j; const f32x4 a = *(LAS f32x4*)(t2 + col), s = *(LAS f32x4*)(t3 + col);
                const f32x4 hv = v[j] * r * a + s; *(LAS f32x4*)(hrow + col) = hv;
                v2u w; w.x = pk2(hv[0], hv[1]); w.y = pk2(hv[2], hv[3]); *(v2u*)(hffn + (size_t)row * D + col) = w; }
            LDS_WAIT();
            const int e = lane & 31, half = lane >> 5;
            float acc = 0.f;
            const float* wr = F.w_router + (size_t)(half * 1024) * NE + e; const LAS float* hr = hrow + half * 1024;
#pragma unroll 8
            for (int k = 0; k < 1024; ++k) acc += hr[k] * wr[(size_t)k * NE];
            acc += __shfl_xor(acc, 32);
            float lg = (lane < 32) ? acc + F.b_router[e] : -INFINITY;
            int sel[4]; float val[4];
#pragma unroll
            for (int k = 0; k < 4; ++k) { const float mx = wave_max(lg); const unsigned long long bal = __ballot(lg == mx); const int idx = __ffsll((long long)bal) - 1; sel[k] = idx; val[k] = mx; if (lane == idx) lg = -INFINITY; }
            const float e1 = __expf(val[1] - val[0]), e2 = __expf(val[2] - val[0]), e3 = __expf(val[3] - val[0]); const float inv = 1.0f / (1.0f + e1 + e2 + e3);
            if (lane == 0) {
                *(int4*)(topi + (size_t)row * 4) = make_int4(sel[0], sel[1], sel[2], sel[3]);
                *(float4*)(topg + (size_t)row * 4) = make_float4(inv, e1 * inv, e2 * inv, e3 * inv);
#pragma unroll
                for (int k = 0; k < 4; ++k) xb_add(F.ctl + CW_CNT + sel[k], 1u);
            }
        }
    }
}

__device__ __forceinline__ void moe_tables(Frame& F) {
    __syncthreads();
    if (F.tid == 0) { int nb = 0;
        for (int e = 0; e < NE; ++e) { const int cnt = (int)xb_ld(F.ctl + CW_CNT + e); const int k = (cnt + 255) >> 8; F.MISC[32 + e] = (unsigned)(nb * 256); for (int j = 0; j < k && nb < MAXBLK; ++j) F.MISC[64 + nb++] = (unsigned)e; }
        F.MISC[16] = (unsigned)nb; }
    __syncthreads();
}
__device__ __forceinline__ void p7_slots(Frame& F) {
    moe_tables(F);
    const int* topi = (const int*)(F.ws + WS_TOPI); int* tslot = (int*)(F.ws + WS_TSLOT);
    const bf16* hffn = (const bf16*)(F.ws + WS_HFFN); bf16* xg = (bf16*)(F.ws + WS_XG);
    const int gw = F.vcu * NWAVES + F.wave, NGW = F.G * NWAVES, lane = F.lane;
    for (int pid = gw; pid < T * TOPK; pid += NGW) {
        const int t = pid >> 2; const int e = topi[pid];
        int rank = 0; if (lane == 0) rank = (int)xb_add(F.ctl + CW_CUR + e, 1u);
        rank = __builtin_amdgcn_readfirstlane(rank);
        const int slot = (int)F.MISC[32 + e] + rank;
        if (lane == 0) tslot[pid] = slot;
        const v4u* s = (const v4u*)(hffn + (size_t)t * D) + lane; v4u* d = (v4u*)(xg + (size_t)slot * D) + lane;
#pragma unroll
        for (int j = 0; j < 4; ++j) d[64 * j] = s[64 * j];
    }
}

__device__ __forceinline__ void p10_final(Frame& F) {
    LAS float* t1 = (LAS float*)(F.lds + RING_OFF);
    const float* x1 = (const float*)(F.ws + WS_X1); const bf16* yb = (const bf16*)(F.ws + WS_YB);
    const int* tslot = (const int*)(F.ws + WS_TSLOT); const float* topg = (const float*)(F.ws + WS_TOPG);
    const int lane = F.lane;
    for (int rb = F.vcu; rb < T / 32; rb += F.G) {
        const int b = rb >> 6;
        __syncthreads();
        for (int col = F.tid; col < D; col += NWAVES * 64) t1[col] = F.g_post_ffn[col] * mod_val(F, b, 5 * D + col);
        __syncthreads();
        for (int rr = F.wave; rr < 32; rr += NWAVES) {
            const int row = rb * 32 + rr;
            const int4 sl = *(const int4*)(tslot + (size_t)row * 4); const float4 gt = *(const float4*)(topg + (size_t)row * 4);
            const int sls[4] = {sl.x, sl.y, sl.z, sl.w}; const float gts[4] = {gt.x, gt.y, gt.z, gt.w};
            float y[4][8]; float ss = 0.f;
#pragma unroll
            for (int j = 0; j < 4; ++j) {
#pragma unroll
                for (int i = 0; i < 8; ++i) y[j][i] = 0.f;
#pragma unroll
                for (int k = 0; k < 4; ++k) { const v4u w = *(const v4u*)(yb + (size_t)sls[k] * D + 8 * lane + 512 * j); const float g = gts[k];
                    y[j][0] += g * bflo(w.x); y[j][1] += g * bfhi(w.x); y[j][2] += g * bflo(w.y); y[j][3] += g * bfhi(w.y); y[j][4] += g * bflo(w.z); y[j][5] += g * bfhi(w.z); y[j][6] += g * bflo(w.w); y[j][7] += g * bfhi(w.w); }
#pragma unroll
                for (int i = 0; i < 8; ++i) ss += y[j][i] * y[j][i];
            }
            const float r = 1.0f / sqrtf(wave_sum(ss) * (1.0f / D) + EPS);
#pragma unroll
            for (int j = 0; j < 4; ++j) { const int col = 8 * lane + 512 * j;
#pragma unroll
                for (int hh = 0; hh < 2; ++hh) { const f32x4 xv = *(const f32x4*)(x1 + (size_t)row * D + col + 4 * hh); const f32x4 a = *(LAS f32x4*)(t1 + col + 4 * hh);
                    f32x4 o; o[0] = xv[0] + a[0] * y[j][4 * hh + 0] * r; o[1] = xv[1] + a[1] * y[j][4 * hh + 1] * r; o[2] = xv[2] + a[2] * y[j][4 * hh + 2] * r; o[3] = xv[3] + a[3] * y[j][4 * hh + 3] * r;
                    *(f32x4*)(F.out + (size_t)row * D + col + 4 * hh) = o; } }
        }
    }
}

struct Args { const float* in[20]; float* out; unsigned char* ws; int ph_lo, ph_hi; };
__global__ void __launch_bounds__(NWAVES * 64, 2) fwd_kernel(Args args) {
    extern __shared__ __attribute__((aligned(16))) unsigned char lds[];
    Frame F;
    F.lds = (LAS unsigned char*)lds;
    F.MISC = (volatile LAS unsigned*)(F.lds + MISC_OFF);
    F.tid = threadIdx.x; F.lane = F.tid & 63; F.wave = __builtin_amdgcn_readfirstlane(F.tid >> 6);
    F.G = gridDim.x; { const int bx = blockIdx.x; F.vcu = (F.G % 8 == 0) ? (bx % 8) * (F.G / 8) + bx / 8 : bx; }
    F.ws = args.ws; F.ctl = (unsigned*)(args.ws + WS_CTL); F.out = args.out;
    F.x = args.in[0]; F.c = args.in[1]; F.w_ada = args.in[2]; F.b_ada = args.in[3]; F.g_pre_mix = args.in[4]; F.g_post_mix = args.in[5]; F.w_in = args.in[6]; F.rpb = args.in[7]; F.t5 = args.in[8];
    F.g_out_na = args.in[9]; F.g_out_dil = args.in[10]; F.w_o = args.in[11]; F.g_pre_ffn = args.in[12]; F.g_post_ffn = args.in[13]; F.w_router = args.in[14]; F.b_router = args.in[15];
    F.w_e_in = args.in[16]; F.b_e_in = args.in[17]; F.w_e_out = args.in[18]; F.b_e_out = args.in[19];
    for (int u = F.tid; u < 256; u += NWAVES * 64) F.MISC[u] = 0u;
    __syncthreads();
    XcdBarrier bar; bar.bar = F.ctl + CW_BAR; bar.x = 0; bar.st = nullptr;
    if (MK_N_LAUNCHES == 1) bar = xcd_barrier_post(F.ctl + CW_BAR, F.MISC + 8);
    const int lo = args.ph_lo, hi = args.ph_hi;
#define IN(k) (lo <= (k) && (k) < hi)
#define SEAM(k) do { if (IN(k) && IN((k) + 1)) xcd_barrier(bar); } while (0)

    if (IN(0)) { p0_prologue(F); } SEAM(0);
    if (IN(1)) { p1_hmix(F); } SEAM(1);
    if (IN(2)) {
        pg8::Gemm g{(const bf16*)(F.ws + WS_HMIX), (const bf16*)(F.ws + WS_WIN_T), T, NQKV, D}; pg8::StaticOrder S; S.init(T, NQKV, F.G, (int)blockIdx.x);
        pg8::EpiBf16 E{(bf16*)(F.ws + WS_PROJ), NQKV, nullptr, 0};
        __syncthreads();
        pg8::gemm_phase<pg8::EpiBf16, pg8::StaticOrder, true, true>(F.lds + RING_OFF, g, S, E);
    } SEAM(2);
    if (IN(3)) { p3_attn_naive(F); } SEAM(3);
    if (IN(4)) { p4_post(F); } SEAM(4);
    if (IN(5)) {
        pg8::Gemm g{(const bf16*)(F.ws + WS_AOUT), (const bf16*)(F.ws + WS_WO_T), T, D, D}; pg8::StaticOrder S; S.init(T, D, F.G, (int)blockIdx.x);
        pg8::EpiF32 E{(float*)(F.ws + WS_MIXED), D};
        __syncthreads();
        pg8::gemm_phase<pg8::EpiF32, pg8::StaticOrder, true, true>(F.lds + RING_OFF, g, S, E);
    } SEAM(5);
    if (IN(6)) { p6_rows(F); } SEAM(6);
    if (IN(7)) { p7_slots(F); } SEAM(7);
    if (IN(8)) {
        moe_tables(F);
        pg8::Gemm g{(const bf16*)(F.ws + WS_XG), (const bf16*)(F.ws + WS_WEI_T), MAXBLK * 256, FF2, D};
        pg8::MoeOrder<16> S{(const LAS int*)(F.lds + MISC_OFF + 64 * 4), (int)F.MISC[16], F.G, (int)blockIdx.x};
        pg8::EpiSwiglu E{(bf16*)(F.ws + WS_HB), FF, F.b_e_in, FF2};
        pg8::gemm_phase<pg8::EpiSwiglu, pg8::MoeOrder<16>, true, true>(F.lds + RING_OFF, g, S, E);
    } SEAM(8);
    if (IN(9)) {
        moe_tables(F);
        pg8::Gemm g{(const bf16*)(F.ws + WS_HB), (const bf16*)(F.ws + WS_WEO_T), MAXBLK * 256, D, FF};
        pg8::MoeOrder<8> S{(const LAS int*)(F.lds + MISC_OFF + 64 * 4), (int)F.MISC[16], F.G, (int)blockIdx.x};
        pg8::EpiBf16 E{(bf16*)(F.ws + WS_YB), D, F.b_e_out, D};
        pg8::gemm_phase<pg8::EpiBf16, pg8::MoeOrder<8>, true, true>(F.lds + RING_OFF, g, S, E);
    } SEAM(9);
    if (IN(10)) { p10_final(F); }
#undef IN
#undef SEAM
}

extern "C" void kernel_launch(void* const* d_in, const int* in_sizes, int n_in, void* d_out, int out_size, void* d_ws, size_t ws_size, hipStream_t stream) {
    static int grid = 0;
    if (grid == 0) {
        if (n_in != 20 || out_size != T * D || ws_size < WS_END) { fprintf(stderr, "kernel_launch: unexpected problem (n_in %d, out %d, ws %zu)\n", n_in, out_size, ws_size); grid = -1; return; }
        int dev = 0, cus = 0, per_cu = 0;
        if (hipGetDevice(&dev) != hipSuccess || hipDeviceGetAttribute(&cus, hipDeviceAttributeMultiprocessorCount, dev) != hipSuccess) { grid = -1; return; }
        if (hipFuncSetAttribute((const void*)fwd_kernel, hipFuncAttributeMaxDynamicSharedMemorySize, LDS_BYTES) != hipSuccess) { fprintf(stderr, "kernel_launch: hipFuncSetAttribute failed\n"); grid = -1; return; }
        if (hipOccupancyMaxActiveBlocksPerMultiprocessor(&per_cu, (const void*)fwd_kernel, NWAVES * 64, LDS_BYTES) != hipSuccess || per_cu < 1) { fprintf(stderr, "kernel_launch: occupancy query reports %d\n", per_cu); }
        (void)hipGetLastError();
        grid = cus;
    }
    if (grid < 0) return;
    if (hipMemsetAsync((char*)d_ws + WS_CTL, 0, CTL_ZERO_BYTES, stream) != hipSuccess) return;
    Args a{};
    for (int i = 0; i < 20; ++i) a.in[i] = (const float*)d_in[i];
    a.out = (float*)d_out; a.ws = (unsigned char*)d_ws;
    if (MK_N_LAUNCHES == 1) {
        a.ph_lo = 0; a.ph_hi = NPHASE;
        hipLaunchKernelGGL(fwd_kernel, dim3(grid), dim3(NWAVES * 64), LDS_BYTES, stream, a);
    } else {
        for (int p = 0; p < NPHASE; ++p) { a.ph_lo = p; a.ph_hi = p + 1; hipLaunchKernelGGL(fwd_kernel, dim3(grid), dim3(NWAVES * 64), LDS_BYTES, stream, a); }
    }
}
```

```cpp
#include <hip/hip_runtime.h>
#include <cstdio>
#include <cstdint>

#ifndef MK_N_LAUNCHES
#define MK_N_LAUNCHES 1
#endif

namespace pg8 {
#define PG8_LAS __attribute__((address_space(3)))
typedef unsigned short bf16_t;
typedef short bf16x8 __attribute__((ext_vector_type(8)));
typedef float f32x4 __attribute__((ext_vector_type(4)));
typedef unsigned u32x4 __attribute__((ext_vector_type(4)));
typedef unsigned u32x2 __attribute__((ext_vector_type(2)));
constexpr int BM = 256, BK = 64, HALF = 128, HTB = HALF * BK * 2  , STAGE_BYTES = 8 * HTB, NXCD = 8, WGM = 8;

__host__ __device__ __forceinline__ int lds_byte(int r, int c) { const int st = (r >> 4) * 2 + (c >> 5), rr = r & 15, cc = c & 31, ob = rr * 64 + cc * 2; return st * 1024 + (ob ^ (((ob >> 9) & 1) << 5)); }
__host__ __device__ __forceinline__ void stage_rc(int b, int& R, int& C) { const int st = b / 1024, sb = b % 1024, swz = sb ^ (((sb >> 9) & 1) << 5); R = (st >> 1) * 16 + swz / 64; C = (st & 1) * 32 + (swz % 64) / 2; }
__host__ __device__ __forceinline__ int perm32(int rho) { const int n = rho >> 4, i = rho & 15; return 8 * (i >> 2) + 4 * n + (i & 3); }

struct Unit { int pm, pn, bt, e; };
struct Gemm { const bf16_t* A; const bf16_t* Bt; int M, N, K; };

struct StaticOrder {
    int nM, nN, nwg, G, c;
    __host__ __device__ void init(int M, int N, int G_, int c_) { nM = M / BM; nN = N / BM; nwg = nM * nN; G = G_; c = c_; }
    __host__ __device__ bool next(int i, Unit& u) const {
        const long L = (long)i * G + c; if (L >= nwg) return false;
        int wgid = (int)L; { const int q = nwg / NXCD, r = nwg % NXCD, xcd = wgid % NXCD, off = wgid / NXCD; wgid = (xcd < r ? xcd * (q + 1) : r * (q + 1) + (xcd - r) * q) + off; }
        const int nig = WGM * nN, gid = wgid / nig, fm = gid * WGM, gsz = (nM - fm) < WGM ? (nM - fm) : WGM;
        u.pm = fm + ((wgid % nig) % gsz); u.pn = (wgid % nig) / gsz; u.bt = u.pn; u.e = 0; return true;
    }
    __device__ __forceinline__ void a_ready(const Unit&) const {}
    __device__ __forceinline__ void done(const Unit&) const {}
};
template <int NPN> struct MoeOrder {
    const PG8_LAS int* blk_e; int nb, G, c;
    __device__ __forceinline__ bool next(int i, Unit& u) const {
        int L = i * G + c;
        if (G == 256) L = ((i * 8 + (c & 7)) << 5) + (c >> 3);
        const int g = L >> 5, r = L & 31;
        int block, pn;
        if (NPN == 16) { block = 4 * (g >> 1) + (r & 3); pn = 8 * (g & 1) + (r >> 2); } else { block = 4 * g + (r & 3); pn = r >> 2; }
        if (block >= nb) return false;
        u.pm = block; u.pn = pn; u.e = blk_e[block]; u.bt = u.e * NPN + pn; return true;
    }
    __device__ __forceinline__ void a_ready(const Unit&) const {}
    __device__ __forceinline__ void done(const Unit&) const {}
};

__device__ __forceinline__ unsigned cvt_pk_bf16(float lo, float hi) { unsigned r; asm volatile("v_cvt_pk_bf16_f32 %0, %1, %2" : "=v"(r) : "v"(lo), "v"(hi)); return r; }

struct EpiF32 {
    static constexpr bool PERM = false, AFTER_DRAIN = false;
    float* C; int ldc;
    __device__ __forceinline__ void operator()(const f32x4 (&acc)[2][2][4][2], const Unit& u, int wr, int wc, int fr, int fq) const {
        const int row0 = u.pm * BM + wr * 64 + fr, col0 = u.pn * BM + wc * 32 + 4 * fq;
#pragma unroll
        for (int ai = 0; ai < 2; ++ai)
#pragma unroll
            for (int m = 0; m < 4; ++m) { float* rowp = C + (size_t)(row0 + ai * HALF + m * 16) * ldc + col0;
#pragma unroll
                for (int bj = 0; bj < 2; ++bj)
#pragma unroll
                    for (int n = 0; n < 2; ++n) *(f32x4*)(rowp + bj * HALF + n * 16) = acc[ai][bj][m][n]; }
    }
};
struct EpiBf16 {
    static constexpr bool PERM = true, AFTER_DRAIN = false;
    bf16_t* O; int ldc; const float* bias; int bias_estride;
    __device__ __forceinline__ void operator()(const f32x4 (&acc)[2][2][4][2], const Unit& u, int wr, int wc, int fr, int fq) const {
        const int row0 = u.pm * BM + wr * 64 + fr; const int col0 = u.pn * BM + wc * 32 + 8 * fq;
        f32x4 bv[2][2];
#pragma unroll
        for (int bj = 0; bj < 2; ++bj)
#pragma unroll
            for (int n = 0; n < 2; ++n) bv[bj][n] = bias ? *(const f32x4*)(bias + (size_t)u.e * bias_estride + col0 + bj * HALF + 4 * n) : (f32x4){0.f, 0.f, 0.f, 0.f};
#pragma unroll
        for (int ai = 0; ai < 2; ++ai)
#pragma unroll
            for (int m = 0; m < 4; ++m) { bf16_t* rowp = O + (size_t)(row0 + ai * HALF + m * 16) * ldc + col0;
#pragma unroll
                for (int bj = 0; bj < 2; ++bj) { const f32x4 v0 = acc[ai][bj][m][0] + bv[bj][0], v1 = acc[ai][bj][m][1] + bv[bj][1];
                    u32x4 w; w.x = cvt_pk_bf16(v0[0], v0[1]); w.y = cvt_pk_bf16(v0[2], v0[3]); w.z = cvt_pk_bf16(v1[0], v1[1]); w.w = cvt_pk_bf16(v1[2], v1[3]);
                    *(u32x4*)(rowp + bj * HALF) = w; } }
    }
};
__device__ __forceinline__ float swiglu1(float g, float u) {
    g = fminf(g, 7.0f); u = fminf(fmaxf(u, -7.0f), 7.0f);
    const float s = __builtin_amdgcn_rcpf(1.0f + __builtin_amdgcn_exp2f(g * (-1.702f * 1.44269504089f)));
    return (u + 1.0f) * (g * s);
}
struct EpiSwiglu {
    static constexpr bool PERM = true, AFTER_DRAIN = false;
    bf16_t* H; int ldh; const float* bias; int bias_estride;
    __device__ __forceinline__ void operator()(const f32x4 (&acc)[2][2][4][2], const Unit& u, int wr, int wc, int fr, int fq) const {
        const int row0 = u.pm * BM + wr * 64 + fr; const int col0 = u.pn * BM + wc * 32 + 8 * fq;
        f32x4 bv[2][2];
#pragma unroll
        for (int bj = 0; bj < 2; ++bj)
#pragma unroll
            for (int n = 0; n < 2; ++n) bv[bj][n] = *(const f32x4*)(bias + (size_t)u.e * bias_estride + col0 + bj * HALF + 4 * n);
#pragma unroll
        for (int ai = 0; ai < 2; ++ai)
#pragma unroll
            for (int m = 0; m < 4; ++m) { bf16_t* rowp = H + (size_t)(row0 + ai * HALF + m * 16) * ldh + (col0 >> 1);
#pragma unroll
                for (int bj = 0; bj < 2; ++bj) { const f32x4 v0 = acc[ai][bj][m][0] + bv[bj][0], v1 = acc[ai][bj][m][1] + bv[bj][1];
                    u32x2 w; w.x = cvt_pk_bf16(swiglu1(v0[0], v0[1]), swiglu1(v0[2], v0[3])); w.y = cvt_pk_bf16(swiglu1(v1[0], v1[1]), swiglu1(v1[2], v1[3]));
                    *(u32x2*)(rowp + bj * (HALF / 2)) = w; } }
    }
};

template <class Epi, class Sched, bool ALIGN_EPI = false, bool SP2 = false>
__device__ __forceinline__ void gemm_phase(PG8_LAS unsigned char* lds, const Gemm g, const Sched& S, const Epi& E) {
    const int tid = threadIdx.x, wid = __builtin_amdgcn_readfirstlane(tid >> 6), lane = tid & 63, wr = wid >> 2, wc = wid & 3, fr = lane & 15, fq = lane >> 4;
    const int K = g.K, nt = K / BK;
    unsigned voffA[2], voffB[2];
#pragma unroll
    for (int i = 0; i < 2; ++i) { int R, C; stage_rc(tid * 16 + i * 8192, R, C); const int Rb = Epi::PERM ? ((R & ~31) + perm32(R & 31)) : R;
        voffA[i] = (unsigned)(R * K + C) * 2u; voffB[i] = (unsigned)(Rb * K + C) * 2u; }
    const size_t kstep = (size_t)(BK * 2);
    const size_t hstep = (size_t)HALF * K * 2;
    const size_t tstep = 2 * hstep;
    const unsigned ldsw = (unsigned)wid * 1024u;
    const int aoff = lds_byte(wr * 64 + fr, fq * 8), boff = lds_byte(wc * 32 + fr, fq * 8);
#define PG8_SA(b, h) (((b) * 2 + (h)) * HTB)
#define PG8_SB(b, h) ((4 + (b) * 2 + (h)) * HTB)
#define PG8_STAGE(bufoff, gbase, voff) do { _Pragma("unroll") for (int _i = 0; _i < 2; ++_i) \
        __builtin_amdgcn_global_load_lds((const unsigned*)((const char*)(gbase) + (voff)[_i]), (PG8_LAS unsigned*)(lds + (bufoff) + ldsw + _i * 8192), 16, 0, 0); } while (0)
#define PG8_LDA(dst, b, h) do { _Pragma("unroll") for (int m = 0; m < 4; ++m) _Pragma("unroll") for (int k = 0; k < 2; ++k) dst[m][k] = *(const PG8_LAS bf16x8*)(lds + PG8_SA(b, h) + aoff + m * 2048 + k * 1024); } while (0)
#define PG8_LDB(dst, b, h) do { _Pragma("unroll") for (int n = 0; n < 2; ++n) _Pragma("unroll") for (int k = 0; k < 2; ++k) dst[n][k] = *(const PG8_LAS bf16x8*)(lds + PG8_SB(b, h) + boff + n * 2048 + k * 1024); } while (0)
#define PG8_MMA(ai, bj, At, Bt) do { __builtin_amdgcn_s_setprio(1); _Pragma("unroll") for (int m = 0; m < 4; ++m) _Pragma("unroll") for (int n = 0; n < 2; ++n) _Pragma("unroll") for (int k = 0; k < 2; ++k) \
        acc[ai][bj][m][n] = __builtin_amdgcn_mfma_f32_16x16x32_bf16(Bt[n][k], At[m][k], acc[ai][bj][m][n], 0, 0, 0); __builtin_amdgcn_s_setprio(0); } while (0)
#define PG8_WAIT_V(n) asm volatile("s_waitcnt vmcnt(" #n ")" ::: "memory")
#define PG8_WAIT_L(n) asm volatile("s_waitcnt lgkmcnt(" #n ")" ::: "memory")
#define PG8_BAR __builtin_amdgcn_s_barrier()
#define PG8_SCHED __builtin_amdgcn_sched_barrier(0)
    Unit cur, nxt; int ui = 0;
    if (!S.next(0, cur)) return;
    f32x4 acc[2][2][4][2];
#pragma unroll
    for (int a = 0; a < 2; ++a)
#pragma unroll
        for (int b = 0; b < 2; ++b)
#pragma unroll
            for (int m = 0; m < 4; ++m)
#pragma unroll
                for (int n = 0; n < 2; ++n) acc[a][b][m][n] = (f32x4){0.f, 0.f, 0.f, 0.f};
    bf16x8 At[4][2], B0[2][2], B1[2][2];
    const char* cA = (const char*)g.A + (size_t)cur.pm * tstep; const char* cB = (const char*)g.Bt + (size_t)cur.bt * tstep;
    S.a_ready(cur);
    if constexpr (SP2) {
        PG8_STAGE(PG8_SB(0, 0), cB, voffB); PG8_STAGE(PG8_SB(0, 1), cB + hstep, voffB); PG8_STAGE(PG8_SA(0, 0), cA, voffA); PG8_STAGE(PG8_SA(0, 1), cA + hstep, voffA);
        if (wr == 1) PG8_BAR;
        PG8_WAIT_V(2); PG8_BAR;
        PG8_STAGE(PG8_SB(1, 0), cB + kstep, voffB); PG8_STAGE(PG8_SA(1, 0), cA + kstep, voffA); PG8_STAGE(PG8_SB(1, 1), cB + hstep + kstep, voffB);
        PG8_WAIT_V(6); PG8_BAR;
    } else {
        PG8_STAGE(PG8_SB(0, 0), cB, voffB); PG8_STAGE(PG8_SA(0, 0), cA, voffA); PG8_STAGE(PG8_SB(0, 1), cB + hstep, voffB); PG8_STAGE(PG8_SA(0, 1), cA + hstep, voffA);
        if (wr == 1) PG8_BAR;
        PG8_WAIT_V(4); PG8_BAR;
        PG8_STAGE(PG8_SB(1, 0), cB + kstep, voffB); PG8_STAGE(PG8_SA(1, 0), cA + kstep, voffA); PG8_STAGE(PG8_SB(1, 1), cB + hstep + kstep, voffB);
        PG8_WAIT_V(6); PG8_BAR;
    }
    for (;;) {
        const bool has_next = S.next(ui + 1, nxt);
        const char* nA = has_next ? (const char*)g.A + (size_t)nxt.pm * tstep : cA; const char* nB = has_next ? (const char*)g.Bt + (size_t)nxt.bt * tstep : cB;
        for (int t = 0; t < nt; t += 2) {
            const bool last = (t == nt - 2);
            const char* a1 = cA + (size_t)(t + 1) * kstep;
            const char* a2 = last ? nA : cA + (size_t)(t + 2) * kstep; const char* b2 = last ? nB : cB + (size_t)(t + 2) * kstep;
            const char* a3 = a2 + kstep; const char* b3 = b2 + kstep;
            if (last && has_next) S.a_ready(nxt);
            if constexpr (SP2) {
            PG8_LDB(B0, 0, 0); PG8_LDB(B1, 0, 1); PG8_SCHED; PG8_LDA(At, 0, 0); PG8_STAGE(PG8_SA(1, 1), a1 + hstep, voffA);
            PG8_WAIT_V(8); PG8_WAIT_L(0); PG8_BAR; PG8_MMA(0, 0, At, B0); PG8_MMA(0, 1, At, B1); PG8_BAR; PG8_SCHED;
            PG8_LDA(At, 0, 1); PG8_STAGE(PG8_SB(0, 0), b2, voffB); PG8_STAGE(PG8_SB(0, 1), b2 + hstep, voffB); PG8_STAGE(PG8_SA(0, 0), a2, voffA);
            PG8_WAIT_V(8); PG8_WAIT_L(0); PG8_BAR; PG8_MMA(1, 0, At, B0); PG8_MMA(1, 1, At, B1); PG8_BAR; PG8_SCHED;
            PG8_LDB(B0, 1, 0); PG8_LDB(B1, 1, 1); PG8_SCHED; PG8_LDA(At, 1, 0); PG8_STAGE(PG8_SA(0, 1), a2 + hstep, voffA);
            PG8_WAIT_V(8); PG8_WAIT_L(0); PG8_BAR; PG8_MMA(0, 0, At, B0); PG8_MMA(0, 1, At, B1); PG8_BAR; PG8_SCHED;
            PG8_LDA(At, 1, 1); PG8_STAGE(PG8_SB(1, 0), b3, voffB); PG8_STAGE(PG8_SB(1, 1), b3 + hstep, voffB); PG8_STAGE(PG8_SA(1, 0), a3, voffA);
            PG8_WAIT_V(8); PG8_WAIT_L(0); PG8_BAR; PG8_MMA(1, 0, At, B0); PG8_MMA(1, 1, At, B1); PG8_BAR; PG8_SCHED;
            } else {
            PG8_LDB(B0, 0, 0); PG8_SCHED; PG8_LDA(At, 0, 0); PG8_STAGE(PG8_SA(1, 1), a1 + hstep, voffA);
            PG8_WAIT_L(8); PG8_BAR; PG8_WAIT_L(0); PG8_MMA(0, 0, At, B0); PG8_BAR; PG8_SCHED;
            PG8_LDB(B1, 0, 1); PG8_STAGE(PG8_SB(0, 0), b2, voffB);
            PG8_BAR; PG8_WAIT_L(0); PG8_MMA(0, 1, At, B1); PG8_BAR;
            PG8_LDA(At, 0, 1); PG8_STAGE(PG8_SA(0, 0), a2, voffA);
            PG8_BAR; PG8_WAIT_L(0); PG8_MMA(1, 0, At, B0); PG8_BAR; PG8_SCHED;
            PG8_STAGE(PG8_SB(0, 1), b2 + hstep, voffB);
            PG8_WAIT_V(6); PG8_BAR; PG8_MMA(1, 1, At, B1); PG8_BAR;
            PG8_LDB(B0, 1, 0); PG8_SCHED; PG8_LDA(At, 1, 0); PG8_STAGE(PG8_SA(0, 1), a2 + hstep, voffA);
            PG8_WAIT_L(8); PG8_BAR; PG8_WAIT_L(0); PG8_MMA(0, 0, At, B0); PG8_BAR; PG8_SCHED;
            PG8_LDB(B1, 1, 1); PG8_STAGE(PG8_SB(1, 0), b3, voffB);
            PG8_BAR; PG8_WAIT_L(0); PG8_MMA(0, 1, At, B1); PG8_BAR;
            PG8_LDA(At, 1, 1); PG8_STAGE(PG8_SA(1, 0), a3, voffA);
            PG8_BAR; PG8_WAIT_L(0); PG8_MMA(1, 0, At, B0); PG8_BAR; PG8_SCHED;
            PG8_STAGE(PG8_SB(1, 1), b3 + hstep, voffB);
            PG8_WAIT_V(6); PG8_BAR; PG8_MMA(1, 1, At, B1); PG8_BAR;
            }
        }
        if constexpr (ALIGN_EPI) { if (wr == 0) PG8_BAR; }
        if constexpr (!Epi::AFTER_DRAIN) { E(acc, cur, wr, wc, fr, fq); S.done(cur); }
        if (!has_next) break;
#pragma unroll
        for (int a = 0; a < 2; ++a)
#pragma unroll
            for (int b = 0; b < 2; ++b)
#pragma unroll
                for (int m = 0; m < 4; ++m)
#pragma unroll
                    for (int n = 0; n < 2; ++n) acc[a][b][m][n] = (f32x4){0.f, 0.f, 0.f, 0.f};
        cur = nxt; cA = nA; cB = nB; ++ui;
        if constexpr (ALIGN_EPI) { if (wr == 1) PG8_BAR; }
    }
    PG8_WAIT_V(0);
    if constexpr (!ALIGN_EPI) { if (wr == 0) PG8_BAR; }
    PG8_BAR;
    if constexpr (Epi::AFTER_DRAIN) { E.fused(acc, cur, wr, wc, fr, fq, lds, wid, lane); S.done(cur); }
#undef PG8_SA
#undef PG8_SB
#undef PG8_STAGE
#undef PG8_LDA
#undef PG8_LDB
#undef PG8_MMA
#undef PG8_WAIT_V
#undef PG8_WAIT_L
#undef PG8_BAR
#undef PG8_SCHED
}
}

constexpr int NWAVES = 8;
constexpr int NBATCH = 4, SEQ = 2048, T = NBATCH * SEQ, D = 2048, HD = 128, NHG = 8, GW = 1024, NQKV = 6144, NE = 32, TOPK = 4, FF = 2048, FF2 = 4096;
constexpr int MAXBLK = 160;
constexpr float EPS = 1e-6f;
constexpr int NPHASE = 11;

constexpr size_t MiB = 1u << 20;
constexpr size_t WS_CTL = 0, CTL_ZERO_BYTES = 1 * MiB;
constexpr size_t WS_MODP = 1 * MiB;
constexpr size_t WS_TOPI = 5 * MiB, WS_TOPG = WS_TOPI + 131072, WS_TSLOT = WS_TOPG + 131072;
constexpr size_t WS_LSE = 6 * MiB;
constexpr size_t WS_WIN_T = 8 * MiB;
constexpr size_t WS_WO_T = 32 * MiB;
constexpr size_t WS_HMIX = 40 * MiB;
constexpr size_t WS_AOUT = 72 * MiB;
constexpr size_t WS_PROJ = 104 * MiB;
constexpr size_t WS_ONA = 200 * MiB;
constexpr size_t WS_ODIL = 232 * MiB;
constexpr size_t WS_MIXED = 328 * MiB;
constexpr size_t WS_X1 = 392 * MiB;
constexpr size_t WS_HFFN = 456 * MiB;
constexpr size_t WS_XG = 492 * MiB;
constexpr size_t WS_HB = 652 * MiB;
constexpr size_t WS_YB = 812 * MiB;
constexpr size_t WS_WEI_T = 1024 * MiB;
constexpr size_t WS_WEO_T = 1536 * MiB;
constexpr size_t WS_END = 1792 * MiB;
constexpr int CW_TMO = 0, CW_CODE = 1, CW_CNT = 256, CW_CUR = 512, CW_BAR = 4096;

constexpr int RING_OFF = 0, RING_BYTES = 135168;
constexpr int MISC_OFF = RING_BYTES;
constexpr int LDS_BYTES = RING_BYTES + 1024;

#define GAS __attribute__((address_space(1)))
#define LAS __attribute__((address_space(3)))
typedef unsigned short bf16;
typedef unsigned v4u __attribute__((ext_vector_type(4)));
typedef unsigned v2u __attribute__((ext_vector_type(2)));
typedef float f32x4 __attribute__((ext_vector_type(4)));
typedef GAS unsigned gu32;
#define RLX_AGENT __ATOMIC_RELAXED, __HIP_MEMORY_SCOPE_AGENT
#define LDS_WAIT() asm volatile("s_waitcnt lgkmcnt(0)" ::: "memory")
#define VM_WAIT() asm volatile("s_waitcnt vmcnt(0)" ::: "memory")
__device__ __forceinline__ float bf2f(unsigned short h) { return __builtin_bit_cast(float, (unsigned)h << 16); }
__device__ __forceinline__ float bflo(unsigned w) { return __builtin_bit_cast(float, w << 16); }
__device__ __forceinline__ float bfhi(unsigned w) { return __builtin_bit_cast(float, w & 0xffff0000u); }
__device__ __forceinline__ unsigned pk2(float lo, float hi) { return pg8::cvt_pk_bf16(lo, hi); }

#define XB_TMO      128
#define XB_XCNT(j)  (256  + 64 * (j))
#define XB_XSUB(j)  (1280 + 64 * (j))
#define XB_XGEN(j)  (2304 + 64 * (j))
#define XB_TOP      3328
#define XB_TOPGEN   3392
#define XCD_BAR_WORDS 3456
#define XB_SPIN_CAP (1u << 18)
__device__ __forceinline__ unsigned xb_ld(unsigned* p)              { return __hip_atomic_load(p, __ATOMIC_RELAXED, __HIP_MEMORY_SCOPE_AGENT); }
__device__ __forceinline__ unsigned xb_add(unsigned* p, unsigned v) { return __hip_atomic_fetch_add(p, v, __ATOMIC_RELAXED, __HIP_MEMORY_SCOPE_AGENT); }
__device__ __forceinline__ unsigned xb_xcc_id() { return (unsigned)__builtin_amdgcn_s_getreg((3 << 11) | 20) & 0xFu; }
#define XB_SPIN(cond, bar) do { unsigned _sp = 0; while (cond) { __builtin_amdgcn_s_sleep(1); \
    if ((++_sp & 255u) == 0u) { if (xb_ld(&(bar)[XB_TMO])) break; if (_sp > XB_SPIN_CAP) { atomicAdd(&(bar)[XB_TMO], 1u); break; } } } } while (0)
struct XcdBarrier { unsigned* bar; unsigned x; volatile LAS unsigned* st; };
__device__ __forceinline__ XcdBarrier xcd_barrier_post(unsigned* bar, volatile LAS unsigned* st) {
    XcdBarrier b; b.bar = bar; b.x = xb_xcc_id(); b.st = st;
    if (threadIdx.x == 0) (void)xb_add(&bar[XB_XCNT(b.x)], 1u);
    return b;
}
__device__ __forceinline__ void xcd_barrier_complete(unsigned* bar, unsigned x, unsigned& nloc, unsigned& nx) {
    const unsigned G = gridDim.x * gridDim.y * gridDim.z;
    unsigned sum, cnt, mine, sp = 0u;
    for (;;) {
        sum = 0u; cnt = 0u; mine = 0u;
#pragma unroll
        for (unsigned j = 0; j < 16; ++j) { const unsigned c = xb_ld(&bar[XB_XCNT(j)]); sum += c; cnt += (c > 0u) ? 1u : 0u; mine = (j == x) ? c : mine; }
        if (sum == G) break;
        __builtin_amdgcn_s_sleep(1);
        if ((++sp & 255u) == 0u) { if (xb_ld(&bar[XB_TMO])) break; if (sp > XB_SPIN_CAP) { atomicAdd(&bar[XB_TMO], 1u); break; } }
    }
    nloc = mine > 0u ? mine : 1u; nx = cnt > 0u ? cnt : 1u;
}
__device__ __forceinline__ void xcd_barrier(const XcdBarrier& b) {
    asm volatile("s_waitcnt vmcnt(0)" ::: "memory");
    __syncthreads();
    if (threadIdx.x == 0) {
        unsigned* bar = b.bar;
        __builtin_amdgcn_s_waitcnt(0);
        unsigned nloc = b.st[0], nx = b.st[1];
        if (nloc == 0u) { xcd_barrier_complete(bar, b.x, nloc, nx); b.st[0] = nloc; b.st[1] = nx; }
        const unsigned old = xb_add(&bar[XB_XSUB(b.x)], 1u);
        const unsigned gen = old / nloc;
        if (old + 1u == (gen + 1u) * nloc) {
            __builtin_amdgcn_fence(__ATOMIC_RELEASE, "agent");
            asm volatile("s_waitcnt vmcnt(0)" ::: "memory");
            const unsigned og = xb_add(&bar[XB_TOP], 1u);
            const unsigned tg = og / nx;
            if (og + 1u == (tg + 1u) * nx) xb_add(&bar[XB_TOPGEN], 1u);
            else XB_SPIN(xb_ld(&bar[XB_TOPGEN]) == tg, bar);
            __builtin_amdgcn_fence(__ATOMIC_ACQUIRE, "agent");
            xb_add(&bar[XB_XGEN(b.x)], 1u);
            asm volatile("s_waitcnt vmcnt(0)" ::: "memory");
        } else {
            XB_SPIN(xb_ld(&bar[XB_XGEN(b.x)]) == gen, bar);
            __builtin_amdgcn_fence(__ATOMIC_ACQUIRE, "agent");
            asm volatile("s_waitcnt vmcnt(0)" ::: "memory");
        }
    }
    __syncthreads();
}

struct Frame {
    LAS unsigned char* lds;
    volatile LAS unsigned* MISC;
    unsigned* ctl;
    int tid, lane, wave, vcu, G;
    const float *x, *c, *w_ada, *b_ada, *g_pre_mix, *g_post_mix, *w_in, *rpb, *t5, *g_out_na, *g_out_dil, *w_o, *g_pre_ffn, *g_post_ffn, *w_router, *b_router, *w_e_in, *b_e_in, *w_e_out, *b_e_out;
    float* out;
    unsigned char* ws;
};
__device__ __forceinline__ float wave_sum(float v) {
#pragma unroll
    for (int o = 1; o < 64; o <<= 1) v += __shfl_xor(v, o);
    return v;
}
__device__ __forceinline__ float wave_max(float v) {
#pragma unroll
    for (int o = 1; o < 64; o <<= 1) v = fmaxf(v, __shfl_xor(v, o));
    return v;
}
__device__ __forceinline__ float mod_val(const Frame& F, int b, int idx) {
    const float* mp = (const float*)(F.ws + WS_MODP);
    float s = F.b_ada[idx];
#pragma unroll
    for (int ks = 0; ks < 16; ++ks) s += mp[(size_t)(ks * 4 + b) * (6 * D) + idx];
    return s;
}

__constant__ unsigned char T5B[3][132] = {
 {11,11,11,11,11,11,11,11,11,11,11,11,11,11,11,10,10,10,10,10,10,10,10,10,10,10,10,10,10,10,10,10,10,10,10,10,10,10,9,9,9,9,9,9,9,9,9,9,9,9,8,8,8,8,8,8,8,7,6,5,4,3,2,1,0,17,18,19,20,21,22,23,24,24,24,24,24,24,24,25,25,25,25,25,25,25,25,25,25,25,25,26,26,26,26,26,26,26,26,26,26,26,26,26,26,26,26,26,26,26,26,26,26,26,27,27,27,27,27,27,27,27,27,27,27,27,27,27,27,0,0,0},
 {13,13,13,13,13,13,13,13,13,13,13,13,13,13,13,13,13,13,13,13,13,13,13,12,12,12,12,12,12,12,12,12,12,12,12,12,12,12,12,12,12,12,11,11,11,11,11,11,11,11,11,11,10,10,10,10,10,10,9,9,9,8,8,4,0,20,24,24,25,25,25,26,26,26,26,26,26,27,27,27,27,27,27,27,27,27,27,28,28,28,28,28,28,28,28,28,28,28,28,28,28,28,28,28,28,28,29,29,29,29,29,29,29,29,29,29,29,29,29,29,29,29,29,29,29,29,29,29,29,0,0,0},
 {15,15,15,15,15,15,15,15,15,15,15,15,15,15,15,15,15,15,15,15,15,15,15,15,15,15,15,15,15,15,14,14,14,14,14,14,14,14,14,14,14,14,14,14,14,13,13,13,13,13,13,13,13,13,12,12,12,12,12,11,11,10,10,9,0,25,26,26,27,27,28,28,28,28,28,29,29,29,29,29,29,29,29,29,30,30,30,30,30,30,30,30,30,30,30,30,30,30,30,31,31,31,31,31,31,31,31,31,31,31,31,31,31,31,31,31,31,31,31,31,31,31,31,31,31,31,31,31,31,0,0,0}};

__device__ __forceinline__ void p0_mod_item(Frame& F, int j) {
    const int ks = j >> 4, cb = j & 15;
    LAS float* sc = (LAS float*)(F.lds + RING_OFF);
    LAS float* red = (LAS float*)(F.lds + RING_OFF + 4096);
    __syncthreads();
    { const int b = F.tid >> 7, k = F.tid & 127; const float cv = F.c[b * D + ks * 128 + k]; sc[F.tid] = cv / (1.0f + __expf(-cv)); }
    __syncthreads();
    const int cg = F.tid % 192, sub = F.tid / 192;
    f32x4 acc[4];
#pragma unroll
    for (int b = 0; b < 4; ++b) acc[b] = (f32x4){0.f, 0.f, 0.f, 0.f};
    if (sub < 2) {
        const float* wp = F.w_ada + (size_t)(ks * 128 + sub * 64) * (6 * D) + cb * 768 + 4 * cg;
#pragma unroll 8
        for (int i = 0; i < 64; ++i) {
            const f32x4 w = *(const f32x4*)(wp + (size_t)i * (6 * D));
#pragma unroll
            for (int b = 0; b < 4; ++b) { const float s = sc[b * 128 + sub * 64 + i]; acc[b] += w * s; }
        }
        if (sub == 1) {
#pragma unroll
            for (int b = 0; b < 4; ++b) *(LAS f32x4*)(red + cg * 16 + b * 4) = acc[b];
        }
    }
    __syncthreads();
    if (sub == 0) {
        float* mp = (float*)(F.ws + WS_MODP);
#pragma unroll
        for (int b = 0; b < 4; ++b) { const f32x4 o = acc[b] + *(LAS f32x4*)(red + cg * 16 + b * 4); *(f32x4*)(mp + (size_t)(ks * 4 + b) * (6 * D) + cb * 768 + 4 * cg) = o; }
    }
}
__device__ __forceinline__ void p0_transpose_item(const float* W, int K, int N, bf16* WT, LAS float* scr, int item, int lane) {
    const int nblk = N >> 6, kb = item / nblk, nb = item - kb * nblk, k0 = kb << 6, n0 = nb << 6;
    const float* src = W + (size_t)(k0 + (lane >> 4)) * N + n0 + 4 * (lane & 15);
    f32x4 v[16];
#pragma unroll
    for (int i = 0; i < 16; ++i) v[i] = *(const f32x4*)(src + (size_t)(4 * i) * N);
#pragma unroll
    for (int i = 0; i < 16; ++i) { LAS float* d = scr + (4 * i + (lane >> 4)) * 65 + 4 * (lane & 15); d[0] = v[i][0]; d[1] = v[i][1]; d[2] = v[i][2]; d[3] = v[i][3]; }
    LDS_WAIT();
    const int c = lane >> 3;
#pragma unroll
    for (int jn = 0; jn < 8; ++jn) { const int n = (lane & 7) + 8 * jn; const LAS float* s = scr + (8 * c) * 65 + n;
        v4u o; o.x = pk2(s[0 * 65], s[1 * 65]); o.y = pk2(s[2 * 65], s[3 * 65]); o.z = pk2(s[4 * 65], s[5 * 65]); o.w = pk2(s[6 * 65], s[7 * 65]);
        *(v4u*)(WT + (size_t)(n0 + n) * K + k0 + 8 * c) = o; }
    LDS_WAIT();
}
__device__ __forceinline__ void p0_prologue(Frame& F) {
    for (int j = F.vcu; j < 256; j += F.G) p0_mod_item(F, j);
    __syncthreads();
    LAS float* scr = (LAS float*)(F.lds + RING_OFF + F.wave * 16640);
    const int gw = F.vcu * NWAVES + F.wave, NGW = F.G * NWAVES;
    constexpr int I_IN = (D / 64) * (NQKV / 64), I_O = (D / 64) * (D / 64), I_EI1 = (D / 64) * (FF2 / 64), I_EO1 = (FF / 64) * (D / 64);
    constexpr int I_EI = NE * I_EI1, I_EO = NE * I_EO1, NITEMS = I_IN + I_O + I_EI + I_EO;
    for (int it = gw; it < NITEMS; it += NGW) {
        int r = it;
        if (r < I_IN) { p0_transpose_item(F.w_in, D, NQKV, (bf16*)(F.ws + WS_WIN_T), scr, r, F.lane); continue; } r -= I_IN;
        if (r < I_O) { p0_transpose_item(F.w_o, D, D, (bf16*)(F.ws + WS_WO_T), scr, r, F.lane); continue; } r -= I_O;
        if (r < I_EI) { const int e = r / I_EI1; p0_transpose_item(F.w_e_in + (size_t)e * D * FF2, D, FF2, (bf16*)(F.ws + WS_WEI_T) + (size_t)e * FF2 * D, scr, r - e * I_EI1, F.lane); continue; } r -= I_EI;
        { const int e = r / I_EO1; p0_transpose_item(F.w_e_out + (size_t)e * FF * D, FF, D, (bf16*)(F.ws + WS_WEO_T) + (size_t)e * D * FF, scr, r - e * I_EO1, F.lane); }
    }
}

__device__ __forceinline__ void p1_hmix(Frame& F) {
    LAS float* ta = (LAS float*)(F.lds + RING_OFF);
    LAS float* tb = ta + D;
    for (int rb = F.vcu; rb < T / 32; rb += F.G) {
        const int b = rb >> 6;
        __syncthreads();
        for (int col = F.tid; col < D; col += NWAVES * 64) { ta[col] = F.g_pre_mix[col] * (1.0f + mod_val(F, b, D + col)); tb[col] = mod_val(F, b, col); }
        __syncthreads();
        for (int rr = F.wave; rr < 32; rr += NWAVES) {
            const int row = rb * 32 + rr;
            const f32x4* xr = (const f32x4*)(F.x + (size_t)row * D) + F.lane;
            f32x4 v[8]; float ss = 0.f;
#pragma unroll
            for (int j = 0; j < 8; ++j) { v[j] = xr[64 * j]; ss += (v[j][0] * v[j][0] + v[j][1] * v[j][1]) + (v[j][2] * v[j][2] + v[j][3] * v[j][3]); }
            const float r = 1.0f / sqrtf(wave_sum(ss) * (1.0f / D) + EPS);
            v2u* o8 = (v2u*)((bf16*)(F.ws + WS_HMIX) + (size_t)row * D) + F.lane;
#pragma unroll
            for (int j = 0; j < 8; ++j) { const int col = 4 * F.lane + 256 * j; const f32x4 a = *(LAS f32x4*)(ta + col), s = *(LAS f32x4*)(tb + col);
                v2u w; w.x = pk2(v[j][0] * r * a[0] + s[0], v[j][1] * r * a[1] + s[1]); w.y = pk2(v[j][2] * r * a[2] + s[2], v[j][3] * r * a[3] + s[3]); o8[64 * j] = w; }
        }
    }
}

__device__ __forceinline__ float dot_qk(const LAS float* q, const bf16* krow) {
    float s = 0.f;
#pragma unroll
    for (int ch = 0; ch < 16; ++ch) { const v4u kv = *(const v4u*)(krow + 8 * ch); const LAS float* qq = q + 8 * ch;
        s += qq[0] * bflo(kv.x) + qq[1] * bfhi(kv.x) + qq[2] * bflo(kv.y) + qq[3] * bfhi(kv.y) + qq[4] * bflo(kv.z) + qq[5] * bfhi(kv.z) + qq[6] * bflo(kv.w) + qq[7] * bfhi(kv.w); }
    return s;
}
__device__ __forceinline__ void p3_attn_naive(Frame& F) {
    LAS float* lq = (LAS float*)(F.lds + RING_OFF + F.wave * 2048);
    LAS float* lp = lq + 128;
    const bf16* proj = (const bf16*)(F.ws + WS_PROJ);
    float* ona = (float*)(F.ws + WS_ONA); float* odil = (float*)(F.ws + WS_ODIL); float* lse = (float*)(F.ws + WS_LSE);
    const float scale = 0.08838834764831845f;
    const int gw = F.vcu * NWAVES + F.wave, NGW = F.G * NWAVES, lane = F.lane;
    for (int it = gw; it < T * 16; it += NGW) {
        const int tok = it >> 4, hh = it & 15, b = tok >> 11, pos = tok & 2047;
        const bf16* prow = proj + (size_t)tok * NQKV;
        if (hh < 8) {
            const int h = hh;
            { const unsigned qw = *(const unsigned*)(prow + h * HD + 2 * lane); LDS_WAIT(); lq[2 * lane] = bflo(qw); lq[2 * lane + 1] = bfhi(qw); LDS_WAIT(); }
            const int r = pos >> 6, c = pos & 63; const int rs = min(max(r - 4, 0), 24), cs = min(max(c - 8, 0), 48);
            float lg[2];
#pragma unroll
            for (int jj = 0; jj < 2; ++jj) { const int j = lane + 64 * jj, i = j >> 4, cc = cs + (j & 15), kpos = (rs + i) * 64 + cc;
                const float d = dot_qk(lq, proj + (size_t)(b * SEQ + kpos) * NQKV + GW + h * HD);
                lg[jj] = d * scale + F.rpb[(h * 15 + (rs + i - r + 7)) * 31 + (cc - c + 15)]; }
            const float m = wave_max(fmaxf(lg[0], lg[1]));
            const float p0 = __expf(lg[0] - m), p1 = __expf(lg[1] - m);
            const float inv = 1.0f / wave_sum(p0 + p1);
            lp[lane] = p0 * inv; lp[lane + 64] = p1 * inv; LDS_WAIT();
            float o0 = 0.f, o1 = 0.f;
            for (int j = 0; j < 128; ++j) { const int kpos = (rs + (j >> 4)) * 64 + cs + (j & 15);
                const unsigned vw = *(const unsigned*)(proj + (size_t)(b * SEQ + kpos) * NQKV + 2 * GW + h * HD + 2 * lane); const float p = lp[j]; o0 += p * bflo(vw); o1 += p * bfhi(vw); }
            *(float2*)(ona + (size_t)tok * GW + h * HD + 2 * lane) = make_float2(o0, o1);
        } else {
            const int h = hh - 8;
            { const unsigned qw = *(const unsigned*)(prow + 3 * GW + h * HD + 2 * lane); LDS_WAIT(); lq[2 * lane] = bflo(qw); lq[2 * lane + 1] = bfhi(qw); LDS_WAIT(); }
#pragma unroll
            for (int p = 0; p < 3; ++p) {
                const int dsh = 2 * p, dil = 1 << dsh, sub_len = SEQ >> dsh, rho = pos & (dil - 1), ql = pos >> dsh;
                float lg[3];
#pragma unroll
                for (int jj = 0; jj < 3; ++jj) { const int j = lane + 64 * jj; const int kl = ql + j - 64; const bool valid = (j < 129) && (kl >= 0) && (kl < sub_len);
                    const int kpos = rho + dil * min(max(kl, 0), sub_len - 1);
                    float d = -INFINITY;
                    if (valid) d = dot_qk(lq, proj + (size_t)(b * SEQ + kpos) * NQKV + 4 * GW + h * HD) * scale + F.t5[(int)T5B[p][j] * 8 + h];
                    lg[jj] = d; }
                const float m = wave_max(fmaxf(fmaxf(lg[0], lg[1]), lg[2]));
                const float p0 = __expf(lg[0] - m), p1 = __expf(lg[1] - m), p2 = __expf(lg[2] - m);
                const float den = wave_sum(p0 + p1 + p2), inv = 1.0f / den;
                LDS_WAIT(); lp[lane] = p0 * inv; lp[lane + 64] = p1 * inv; lp[lane + 128] = p2 * inv; LDS_WAIT();
                float o0 = 0.f, o1 = 0.f;
                for (int j = 0; j < 129; ++j) { const int kl = ql + j - 64; const int kpos = rho + dil * min(max(kl, 0), sub_len - 1);
                    const unsigned vw = *(const unsigned*)(proj + (size_t)(b * SEQ + kpos) * NQKV + 5 * GW + h * HD + 2 * lane); const float pp = lp[j]; o0 += pp * bflo(vw); o1 += pp * bfhi(vw); }
                *(float2*)(odil + ((size_t)p * T + tok) * GW + h * HD + 2 * lane) = make_float2(o0, o1);
                if (lane == 0) lse[((size_t)p * T + tok) * 8 + h] = m + __logf(den);
            }
        }
    }
}


typedef short bf16x8v __attribute__((ext_vector_type(8)));
typedef short s16x4v __attribute__((ext_vector_type(4)));
typedef int v4i16_t_ __attribute__((ext_vector_type(2)));
__device__ __forceinline__ unsigned vimg_off(unsigned row, unsigned ch) { return 256u * row + 16u * (ch ^ (((row & 3u) << 2) | ((row >> 2) & 3u))); }
__device__ __forceinline__ s16x4v tr_read16(const LAS unsigned char* p) {
    typedef short v4i16 __attribute__((ext_vector_type(4)));
    return __builtin_bit_cast(s16x4v, __builtin_amdgcn_ds_read_tr16_b64_v4i16((LAS v4i16*)p));
}
struct GeoNA {
    int tok0, qbase, kbase, r, rs, c0, kc0; const float* rpb_h;
    static constexpr int QCOL = 0, KCOL = GW, VCOL = 2 * GW;
    __device__ __forceinline__ int qtok(int n16) const { return qbase + n16; }
    __device__ __forceinline__ int ktok(int c, int slot) const { return kbase + c * 64 + slot; }
    __device__ __forceinline__ float bias(int c, int slot, int n16) const {
        const int qc = c0 + n16, kc = kc0 + slot, cs = min(max(qc - 8, 0), 48);
        const bool valid = (kc >= cs) && (kc < cs + 16);
        const int dc = min(max(kc - qc + 15, 0), 30);
        const float bv = rpb_h[(rs + c - r + 7) * 31 + dc];
        return valid ? bv : -INFINITY;
    }
};
struct GeoDil {
    int tok0, rho, dsh, sub_len, l0, p, h; const float* t5;
    static constexpr int QCOL = 3 * GW, KCOL = 4 * GW, VCOL = 5 * GW;
    __device__ __forceinline__ int qtok(int n16) const { return tok0 + rho + ((l0 + n16) << dsh); }
    __device__ __forceinline__ int ktok(int c, int slot) const { const int l = min(max(l0 - 64 + 32 * c + slot, 0), sub_len - 1); return tok0 + rho + (l << dsh); }
    __device__ __forceinline__ float bias(int c, int slot, int n16) const {
        const int kk = 32 * c + slot, delta = kk - 64 - n16, l = l0 - 64 + kk;
        const bool valid = (delta >= -64) && (delta <= 64) && (l >= 0) && (l < sub_len);
        const int di = min(max(delta + 64, 0), 128);
        const float bv = t5[(int)T5B[p][di] * 8 + h];
        return valid ? bv : -INFINITY;
    }
};
template <int NCH, class Geo>
__device__ __forceinline__ void attn_item(const Geo& G, const bf16* proj, int hcol, LAS unsigned char* vimg, float* out, float* lse_out, int lane) {
    const int n16 = lane & 15, g = lane >> 4;
    const float scale_l2 = 0.08838834764831845f * 1.44269504089f;
    bf16x8v qf[4];
    { const bf16* qp = proj + (size_t)G.qtok(n16) * NQKV + Geo::QCOL + hcol + 8 * g;
#pragma unroll
      for (int s = 0; s < 4; ++s) qf[s] = *(const bf16x8v*)(qp + 32 * s); }
    f32x4 st[NCH][2];
#pragma unroll
    for (int c = 0; c < NCH; ++c)
#pragma unroll
        for (int t2 = 0; t2 < 2; ++t2) {
            const int slot = 8 * (n16 >> 2) + 4 * t2 + (n16 & 3);
            const bf16* kp = proj + (size_t)G.ktok(c, slot) * NQKV + Geo::KCOL + hcol + 8 * g;
            f32x4 acc = (f32x4){0.f, 0.f, 0.f, 0.f};
#pragma unroll
            for (int s = 0; s < 4; ++s) { const bf16x8v kf = *(const bf16x8v*)(kp + 32 * s); acc = __builtin_amdgcn_mfma_f32_16x16x32_bf16(kf, qf[s], acc, 0, 0, 0); }
            st[c][t2] = acc;
        }
    float mx = -INFINITY;
#pragma unroll
    for (int c = 0; c < NCH; ++c)
#pragma unroll
        for (int t2 = 0; t2 < 2; ++t2)
#pragma unroll
            for (int r = 0; r < 4; ++r) { const float bv = G.bias(c, 8 * g + 4 * t2 + r, n16); const float x = st[c][t2][r] * scale_l2 + bv * 1.44269504089f; st[c][t2][r] = x; mx = fmaxf(mx, x); }
    mx = fmaxf(mx, __shfl_xor(mx, 16)); mx = fmaxf(mx, __shfl_xor(mx, 32));
    float sum = 0.f;
    bf16x8v pf[NCH];
#pragma unroll
    for (int c = 0; c < NCH; ++c) {
        float pv[8];
#pragma unroll
        for (int t2 = 0; t2 < 2; ++t2)
#pragma unroll
            for (int r = 0; r < 4; ++r) { const float p = __builtin_amdgcn_exp2f(st[c][t2][r] - mx); pv[4 * t2 + r] = p; sum += p; }
        v4u w; w.x = pk2(pv[0], pv[1]); w.y = pk2(pv[2], pv[3]); w.z = pk2(pv[4], pv[5]); w.w = pk2(pv[6], pv[7]);
        pf[c] = __builtin_bit_cast(bf16x8v, w);
    }
    sum += __shfl_xor(sum, 16); sum += __shfl_xor(sum, 32);
    f32x4 oacc[8];
#pragma unroll
    for (int dt = 0; dt < 8; ++dt) oacc[dt] = (f32x4){0.f, 0.f, 0.f, 0.f};
    const int vr_row = lane >> 4, vr_ch = lane & 15;
    v4u vr[8];
#pragma unroll
    for (int i = 0; i < 8; ++i) vr[i] = *(const v4u*)(proj + (size_t)G.ktok(0, 4 * i + vr_row) * NQKV + Geo::VCOL + hcol + 8 * vr_ch);
    const unsigned q4 = (unsigned)(lane & 15) >> 2, pp = (unsigned)lane & 3u;
#pragma unroll
    for (int c = 0; c < NCH; ++c) {
        asm volatile("" ::: "memory");
#pragma unroll
        for (int i = 0; i < 8; ++i) *(LAS v4u*)(vimg + vimg_off((unsigned)(4 * i + vr_row), (unsigned)vr_ch)) = vr[i];
        asm volatile("" ::: "memory");
        if (c + 1 < NCH) {
#pragma unroll
            for (int i = 0; i < 8; ++i) vr[i] = *(const v4u*)(proj + (size_t)G.ktok(c + 1, 4 * i + vr_row) * NQKV + Geo::VCOL + hcol + 8 * vr_ch);
        }
#pragma unroll
        for (int dt = 0; dt < 8; ++dt) {
            const s16x4v lo = tr_read16(vimg + vimg_off((unsigned)(8 * g) + q4, (unsigned)(2 * dt) + (pp >> 1)) + 8u * (pp & 1u));
            const s16x4v hi = tr_read16(vimg + vimg_off((unsigned)(8 * g + 4) + q4, (unsigned)(2 * dt) + (pp >> 1)) + 8u * (pp & 1u));
            bf16x8v vf; vf[0] = lo[0]; vf[1] = lo[1]; vf[2] = lo[2]; vf[3] = lo[3]; vf[4] = hi[0]; vf[5] = hi[1]; vf[6] = hi[2]; vf[7] = hi[3];
            oacc[dt] = __builtin_amdgcn_mfma_f32_16x16x32_bf16(vf, pf[c], oacc[dt], 0, 0, 0);
        }
        asm volatile("" ::: "memory");
    }
    const float inv = 1.0f / sum;
    float* op = out + (size_t)G.qtok(n16) * GW + hcol + 4 * g;
#pragma unroll
    for (int dt = 0; dt < 8; ++dt) *(f32x4*)(op + 16 * dt) = oacc[dt] * inv;
    if (lse_out != nullptr && g == 0) lse_out[(size_t)G.qtok(n16) * 8 + (hcol >> 7)] = (mx + __builtin_amdgcn_logf(sum)) * 0.69314718056f;
}
__device__ __forceinline__ void p3_attn_mfma(Frame& F) {
    LAS unsigned char* vimg = F.lds + RING_OFF + F.wave * 8192;
    const bf16* proj = (const bf16*)(F.ws + WS_PROJ);
    float* ona = (float*)(F.ws + WS_ONA); float* odil = (float*)(F.ws + WS_ODIL); float* lse = (float*)(F.ws + WS_LSE);
    const int gw = F.vcu * NWAVES + F.wave, NGW = F.G * NWAVES, lane = F.lane;
    for (int it = gw * 2; it < NBATCH * 32 * 8 * 4; it += NGW * 2) {
#pragma unroll 1
        for (int k = 0; k < 2; ++k) {
            const int id = it + k, qt = id & 3, h = (id >> 2) & 7, r = (id >> 5) & 31, b = id >> 10;
            GeoNA G; G.tok0 = b * SEQ; G.r = r; G.rs = min(max(r - 4, 0), 24); G.c0 = 16 * qt; G.kc0 = (qt == 0) ? 0 : (qt == 1) ? 8 : (qt == 2) ? 24 : 32;
            G.qbase = G.tok0 + r * 64 + G.c0; G.kbase = G.tok0 + G.rs * 64 + G.kc0; G.rpb_h = F.rpb + h * (15 * 31);
            attn_item<8, GeoNA>(G, proj, h * HD, vimg, ona, nullptr, lane);
        }
    }
    for (int it = gw * 6; it < 3 * NBATCH * 8 * 128; it += NGW * 6) {
#pragma unroll 1
        for (int k = 0; k < 6; ++k) {
            const int id = it + k, tile = id & 127, h = (id >> 7) & 7, b = (id >> 10) & 3, p = id >> 12;
            GeoDil G; G.dsh = 2 * p; G.sub_len = SEQ >> G.dsh; const int tpc = G.sub_len >> 4;
            G.rho = tile / tpc; G.l0 = (tile - G.rho * tpc) * 16; G.tok0 = b * SEQ; G.p = p; G.h = h; G.t5 = F.t5;
            attn_item<5, GeoDil>(G, proj, h * HD, vimg, odil + (size_t)p * T * GW, lse + (size_t)p * T * 8, lane);
        }
    }
}

__device__ __forceinline__ void p4_post(Frame& F) {
    const float* ona = (const float*)(F.ws + WS_ONA); const float* odil = (const float*)(F.ws + WS_ODIL); const float* lse = (const float*)(F.ws + WS_LSE);
    bf16* aout = (bf16*)(F.ws + WS_AOUT);
    const int gw = F.vcu * NWAVES + F.wave, NGW = F.G * NWAVES, lane = F.lane;
    for (int tok = gw; tok < T; tok += NGW) {
        f32x4 v[4]; float ss = 0.f;
#pragma unroll
        for (int j = 0; j < 4; ++j) { v[j] = *(const f32x4*)(ona + (size_t)tok * GW + 4 * lane + 256 * j); ss += (v[j][0] * v[j][0] + v[j][1] * v[j][1]) + (v[j][2] * v[j][2] + v[j][3] * v[j][3]); }
        float r = 1.0f / sqrtf(wave_sum(ss) * (1.0f / GW) + EPS);
#pragma unroll
        for (int j = 0; j < 4; ++j) { const int col = 4 * lane + 256 * j; const f32x4 g = *(const f32x4*)(F.g_out_na + col);
            v2u w; w.x = pk2(v[j][0] * r * g[0], v[j][1] * r * g[1]); w.y = pk2(v[j][2] * r * g[2], v[j][3] * r * g[3]); *(v2u*)(aout + (size_t)tok * D + col) = w; }
        ss = 0.f;
#pragma unroll
        for (int j = 0; j < 4; ++j) { const int col = 4 * lane + 256 * j, h = col >> 7;
            const float l0 = lse[((size_t)0 * T + tok) * 8 + h], l1 = lse[((size_t)1 * T + tok) * 8 + h], l2 = lse[((size_t)2 * T + tok) * 8 + h];
            const float mx = fmaxf(fmaxf(l0, l1), l2); const float e0 = __expf(l0 - mx), e1 = __expf(l1 - mx), e2 = __expf(l2 - mx); const float inv = 1.0f / (e0 + e1 + e2);
            const f32x4 a0 = *(const f32x4*)(odil + ((size_t)0 * T + tok) * GW + col), a1 = *(const f32x4*)(odil + ((size_t)1 * T + tok) * GW + col), a2 = *(const f32x4*)(odil + ((size_t)2 * T + tok) * GW + col);
            v[j] = a0 * (e0 * inv) + a1 * (e1 * inv) + a2 * (e2 * inv);
            ss += (v[j][0] * v[j][0] + v[j][1] * v[j][1]) + (v[j][2] * v[j][2] + v[j][3] * v[j][3]); }
        r = 1.0f / sqrtf(wave_sum(ss) * (1.0f / GW) + EPS);
#pragma unroll
        for (int j = 0; j < 4; ++j) { const int col = 4 * lane + 256 * j; const f32x4 g = *(const f32x4*)(F.g_out_dil + col);
            v2u w; w.x = pk2(v[j][0] * r * g[0], v[j][1] * r * g[1]); w.y = pk2(v[j][2] * r * g[2], v[j][3] * r * g[3]); *(v2u*)(aout + (size_t)tok * D + GW + col) = w; }
    }
}

__device__ __forceinline__ void p6_rows(Frame& F) {
    LAS float* t1 = (LAS float*)(F.lds + RING_OFF);
    LAS float* t2 = t1 + D;
    LAS float* t3 = t2 + D;
    LAS float* hrow = t3 + D + F.wave * D;
    const float* mixed = (const float*)(F.ws + WS_MIXED); float* x1 = (float*)(F.ws + WS_X1); bf16* hffn = (bf16*)(F.ws + WS_HFFN);
    int* topi = (int*)(F.ws + WS_TOPI); float* topg = (float*)(F.ws + WS_TOPG);
    const int lane = F.lane;
    for (int rb = F.vcu; rb < T / 32; rb += F.G) {
        const int b = rb >> 6;
        __syncthreads();
        for (int col = F.tid; col < D; col += NWAVES * 64) { t1[col] = F.g_post_mix[col] * mod_val(F, b, 2 * D + col); t2[col] = F.g_pre_ffn[col] * (1.0f + mod_val(F, b, 4 * D + col)); t3[col] = mod_val(F, b, 3 * D + col); }
        __syncthreads();
        for (int rr = F.wave; rr < 32; rr += NWAVES) {
            const int row = rb * 32 + rr;
            f32x4 v[8]; float ss = 0.f;
#pragma unroll
            for (int j = 0; j < 8; ++j) { v[j] = *(const f32x4*)(mixed + (size_t)row * D + 4 * lane + 256 * j); ss += (v[j][0] * v[j][0] + v[j][1] * v[j][1]) + (v[j][2] * v[j][2] + v[j][3] * v[j][3]); }
            float r = 1.0f / sqrtf(wave_sum(ss) * (1.0f / D) + EPS);
            ss = 0.f;
#pragma unroll
            for (int j = 0; j < 8; ++j) { const int col = 4 * lane + 256 * j; const f32x4 xv = *(const f32x4*)(F.x + (size_t)row * D + col); const f32x4 a = *(LAS f32x4*)(t1 + col);
                v[j] = xv + a * (v[j] * r); *(f32x4*)(x1 + (size_t)row * D + col) = v[j];
                ss += (v[j][0] * v[j][0] + v[j][1] * v[j][1]) + (v[j][2] * v[j][2] + v[j][3] * v[j][3]); }
            r = 1.0f / sqrtf(wave_sum(ss) * (1.0f / D) + EPS);
            LDS_WAIT();
#pragma unroll
            for (int j = 0; j < 8; ++j) { const int col = 4 * lane + 256 * j; const f32x4 a = *(LAS f32x4*)(t2 + col), s = *(LAS f32x4*)(t3 + col);
                const f32x4 hv = v[j] * r * a + s; *(LAS f32x4*)(hrow + col) = hv;
                v2u w; w.x = pk2(hv[0], hv[1]); w.y = pk2(hv[2], hv[3]); *(v2u*)(hffn + (size_t)row * D + col) = w; }
            LDS_WAIT();
            const int e = lane & 31, half = lane >> 5;
            float acc = 0.f;
            const float* wr = F.w_router + (size_t)(half * 1024) * NE + e; const LAS float* hr = hrow + half * 1024;
#pragma unroll 8
            for (int k = 0; k < 1024; ++k) acc += hr[k] * wr[(size_t)k * NE];
            acc += __shfl_xor(acc, 32);
            float lg = (lane < 32) ? acc + F.b_router[e] : -INFINITY;
            int sel[4]; float val[4];
#pragma unroll
            for (int k = 0; k < 4; ++k) { const float mx = wave_max(lg); const unsigned long long bal = __ballot(lg == mx); const int idx = __ffsll((long long)bal) - 1; sel[k] = idx; val[k] = mx; if (lane == idx) lg = -INFINITY; }
            const float e1 = __expf(val[1] - val[0]), e2 = __expf(val[2] - val[0]), e3 = __expf(val[3] - val[0]); const float inv = 1.0f / (1.0f + e1 + e2 + e3);
            if (lane == 0) {
                *(int4*)(topi + (size_t)row * 4) = make_int4(sel[0], sel[1], sel[2], sel[3]);
                *(float4*)(topg + (size_t)row * 4) = make_float4(inv, e1 * inv, e2 * inv, e3 * inv);
#pragma unroll
                for (int k = 0; k < 4; ++k) xb_add(F.ctl + CW_CNT + sel[k], 1u);
            }
        }
    }
}

__device__ __forceinline__ void moe_tables(Frame& F) {
    __syncthreads();
    if (F.tid == 0) { int nb = 0;
        for (int e = 0; e < NE; ++e) { const int cnt = (int)xb_ld(F.ctl + CW_CNT + e); const int k = (cnt + 255) >> 8; F.MISC[32 + e] = (unsigned)(nb * 256); for (int j = 0; j < k && nb < MAXBLK; ++j) F.MISC[64 + nb++] = (unsigned)e; }
        F.MISC[16] = (unsigned)nb; }
    __syncthreads();
}
__device__ __forceinline__ void p7_slots(Frame& F) {
    moe_tables(F);
    const int* topi = (const int*)(F.ws + WS_TOPI); int* tslot = (int*)(F.ws + WS_TSLOT);
    const bf16* hffn = (const bf16*)(F.ws + WS_HFFN); bf16* xg = (bf16*)(F.ws + WS_XG);
    const int gw = F.vcu * NWAVES + F.wave, NGW = F.G * NWAVES, lane = F.lane;
    for (int pid = gw; pid < T * TOPK; pid += NGW) {
        const int t = pid >> 2; const int e = topi[pid];
        int rank = 0; if (lane == 0) rank = (int)xb_add(F.ctl + CW_CUR + e, 1u);
        rank = __builtin_amdgcn_readfirstlane(rank);
        const int slot = (int)F.MISC[32 + e] + rank;
        if (lane == 0) tslot[pid] = slot;
        const v4u* s = (const v4u*)(hffn + (size_t)t * D) + lane; v4u* d = (v4u*)(xg + (size_t)slot * D) + lane;
#pragma unroll
        for (int j = 0; j < 4; ++j) d[64 * j] = s[64 * j];
    }
}

__device__ __forceinline__ void p10_final(Frame& F) {
    LAS float* t1 = (LAS float*)(F.lds + RING_OFF);
    const float* x1 = (const float*)(F.ws + WS_X1); const bf16* yb = (const bf16*)(F.ws + WS_YB);
    const int* tslot = (const int*)(F.ws + WS_TSLOT); const float* topg = (const float*)(F.ws + WS_TOPG);
    const int lane = F.lane;
    for (int rb = F.vcu; rb < T / 32; rb += F.G) {
        const int b = rb >> 6;
        __syncthreads();
        for (int col = F.tid; col < D; col += NWAVES * 64) t1[col] = F.g_post_ffn[col] * mod_val(F, b, 5 * D + col);
        __syncthreads();
        for (int rr = F.wave; rr < 32; rr += NWAVES) {
            const int row = rb * 32 + rr;
            const int4 sl = *(const int4*)(tslot + (size_t)row * 4); const float4 gt = *(const float4*)(topg + (size_t)row * 4);
            const int sls[4] = {sl.x, sl.y, sl.z, sl.w}; const float gts[4] = {gt.x, gt.y, gt.z, gt.w};
            float y[4][8]; float ss = 0.f;
#pragma unroll
            for (int j = 0; j < 4; ++j) {
#pragma unroll
                for (int i = 0; i < 8; ++i) y[j][i] = 0.f;
#pragma unroll
                for (int k = 0; k < 4; ++k) { const v4u w = *(const v4u*)(yb + (size_t)sls[k] * D + 8 * lane + 512 * j); const float g = gts[k];
                    y[j][0] += g * bflo(w.x); y[j][1] += g * bfhi(w.x); y[j][2] += g * bflo(w.y); y[j][3] += g * bfhi(w.y); y[j][4] += g * bflo(w.z); y[j][5] += g * bfhi(w.z); y[j][6] += g * bflo(w.w); y[j][7] += g * bfhi(w.w); }
#pragma unroll
                for (int i = 0; i < 8; ++i) ss += y[j][i] * y[j][i];
            }
            const float r = 1.0f / sqrtf(wave_sum(ss) * (1.0f / D) + EPS);
#pragma unroll
            for (int j = 0; j < 4; ++j) { const int col = 8 * lane + 512 * j;
#pragma unroll
                for (int hh = 0; hh < 2; ++hh) { const f32x4 xv = *(const f32x4*)(x1 + (size_t)row * D + col + 4 * hh); const f32x4 a = *(LAS f32x4*)(t1 + col + 4 * hh);
                    f32x4 o; o[0] = xv[0] + a[0] * y[j][4 * hh + 0] * r; o[1] = xv[1] + a[1] * y[j][4 * hh + 1] * r; o[2] = xv[2] + a[2] * y[j][4 * hh + 2] * r; o[3] = xv[3] + a[3] * y[j][4 * hh + 3] * r;
                    *(f32x4*)(F.out + (size_t)row * D + col + 4 * hh) = o; } }
        }
    }
}

struct Args { const float* in[20]; float* out; unsigned char* ws; int ph_lo, ph_hi; };
__global__ void __launch_bounds__(NWAVES * 64, 2) fwd_kernel(Args args) {
    extern __shared__ __attribute__((aligned(16))) unsigned char lds[];
    Frame F;
    F.lds = (LAS unsigned char*)lds;
    F.MISC = (volatile LAS unsigned*)(F.lds + MISC_OFF);
    F.tid = threadIdx.x; F.lane = F.tid & 63; F.wave = __builtin_amdgcn_readfirstlane(F.tid >> 6);
    F.G = gridDim.x; { const int bx = blockIdx.x; F.vcu = (F.G % 8 == 0) ? (bx % 8) * (F.G / 8) + bx / 8 : bx; }
    F.ws = args.ws; F.ctl = (unsigned*)(args.ws + WS_CTL); F.out = args.out;
    F.x = args.in[0]; F.c = args.in[1]; F.w_ada = args.in[2]; F.b_ada = args.in[3]; F.g_pre_mix = args.in[4]; F.g_post_mix = args.in[5]; F.w_in = args.in[6]; F.rpb = args.in[7]; F.t5 = args.in[8];
    F.g_out_na = args.in[9]; F.g_out_dil = args.in[10]; F.w_o = args.in[11]; F.g_pre_ffn = args.in[12]; F.g_post_ffn = args.in[13]; F.w_router = args.in[14]; F.b_router = args.in[15];
    F.w_e_in = args.in[16]; F.b_e_in = args.in[17]; F.w_e_out = args.in[18]; F.b_e_out = args.in[19];
    for (int u = F.tid; u < 256; u += NWAVES * 64) F.MISC[u] = 0u;
    __syncthreads();
    XcdBarrier bar; bar.bar = F.ctl + CW_BAR; bar.x = 0; bar.st = nullptr;
    if (MK_N_LAUNCHES == 1) bar = xcd_barrier_post(F.ctl + CW_BAR, F.MISC + 8);
    const int lo = args.ph_lo, hi = args.ph_hi;
#define IN(k) (lo <= (k) && (k) < hi)
#define SEAM(k) do { if (IN(k) && IN((k) + 1)) xcd_barrier(bar); } while (0)

    if (IN(0)) { p0_prologue(F); } SEAM(0);
    if (IN(1)) { p1_hmix(F); } SEAM(1);
    if (IN(2)) {
        pg8::Gemm g{(const bf16*)(F.ws + WS_HMIX), (const bf16*)(F.ws + WS_WIN_T), T, NQKV, D}; pg8::StaticOrder S; S.init(T, NQKV, F.G, (int)blockIdx.x);
        pg8::EpiBf16 E{(bf16*)(F.ws + WS_PROJ), NQKV, nullptr, 0};
        __syncthreads();
        pg8::gemm_phase<pg8::EpiBf16, pg8::StaticOrder, true, true>(F.lds + RING_OFF, g, S, E);
    } SEAM(2);
    #ifdef ATTN_NAIVE
    if (IN(3)) { p3_attn_naive(F); } SEAM(3);
#else
    if (IN(3)) { __syncthreads(); p3_attn_mfma(F); } SEAM(3);
#endif
    if (IN(4)) { p4_post(F); } SEAM(4);
    if (IN(5)) {
        pg8::Gemm g{(const bf16*)(F.ws + WS_AOUT), (const bf16*)(F.ws + WS_WO_T), T, D, D}; pg8::StaticOrder S; S.init(T, D, F.G, (int)blockIdx.x);
        pg8::EpiF32 E{(float*)(F.ws + WS_MIXED), D};
        __syncthreads();
        pg8::gemm_phase<pg8::EpiF32, pg8::StaticOrder, true, true>(F.lds + RING_OFF, g, S, E);
    } SEAM(5);
    if (IN(6)) { p6_rows(F); } SEAM(6);
    if (IN(7)) { p7_slots(F); } SEAM(7);
    if (IN(8)) {
        moe_tables(F);
        pg8::Gemm g{(const bf16*)(F.ws + WS_XG), (const bf16*)(F.ws + WS_WEI_T), MAXBLK * 256, FF2, D};
        pg8::MoeOrder<16> S{(const LAS int*)(F.lds + MISC_OFF + 64 * 4), (int)F.MISC[16], F.G, (int)blockIdx.x};
        pg8::EpiSwiglu E{(bf16*)(F.ws + WS_HB), FF, F.b_e_in, FF2};
        pg8::gemm_phase<pg8::EpiSwiglu, pg8::MoeOrder<16>, true, true>(F.lds + RING_OFF, g, S, E);
    } SEAM(8);
    if (IN(9)) {
        moe_tables(F);
        pg8::Gemm g{(const bf16*)(F.ws + WS_HB), (const bf16*)(F.ws + WS_WEO_T), MAXBLK * 256, D, FF};
        pg8::MoeOrder<8> S{(const LAS int*)(F.lds + MISC_OFF + 64 * 4), (int)F.MISC[16], F.G, (int)blockIdx.x};
        pg8::EpiBf16 E{(bf16*)(F.ws + WS_YB), D, F.b_e_out, D};
        pg8::gemm_phase<pg8::EpiBf16, pg8::MoeOrder<8>, true, true>(F.lds + RING_OFF, g, S, E);
    } SEAM(9);
    if (IN(10)) { p10_final(F); }
#undef IN
#undef SEAM
}

extern "C" void kernel_launch(void* const* d_in, const int* in_sizes, int n_in, void* d_out, int out_size, void* d_ws, size_t ws_size, hipStream_t stream) {
    static int grid = 0;
    if (grid == 0) {
        if (n_in != 20 || out_size != T * D || ws_size < WS_END) { fprintf(stderr, "kernel_launch: unexpected problem (n_in %d, out %d, ws %zu)\n", n_in, out_size, ws_size); grid = -1; return; }
        int dev = 0, cus = 0, per_cu = 0;
        if (hipGetDevice(&dev) != hipSuccess || hipDeviceGetAttribute(&cus, hipDeviceAttributeMultiprocessorCount, dev) != hipSuccess) { grid = -1; return; }
        if (hipFuncSetAttribute((const void*)fwd_kernel, hipFuncAttributeMaxDynamicSharedMemorySize, LDS_BYTES) != hipSuccess) { fprintf(stderr, "kernel_launch: hipFuncSetAttribute failed\n"); grid = -1; return; }
        if (hipOccupancyMaxActiveBlocksPerMultiprocessor(&per_cu, (const void*)fwd_kernel, NWAVES * 64, LDS_BYTES) != hipSuccess || per_cu < 1) { fprintf(stderr, "kernel_launch: occupancy query reports %d\n", per_cu); }
        (void)hipGetLastError();
        grid = cus;
    }
    if (grid < 0) return;
    if (hipMemsetAsync((char*)d_ws + WS_CTL, 0, CTL_ZERO_BYTES, stream) != hipSuccess) return;
    Args a{};
    for (int i = 0; i < 20; ++i) a.in[i] = (const float*)d_in[i];
    a.out = (float*)d_out; a.ws = (unsigned char*)d_ws;
    if (MK_N_LAUNCHES == 1) {
        a.ph_lo = 0; a.ph_hi = NPHASE;
        hipLaunchKernelGGL(fwd_kernel, dim3(grid), dim3(NWAVES * 64), LDS_BYTES, stream, a);
    } else {
        for (int p = 0; p < NPHASE; ++p) { a.ph_lo = p; a.ph_hi = p + 1; hipLaunchKernelGGL(fwd_kernel, dim3(grid), dim3(NWAVES * 64), LDS_BYTES, stream, a); }
    }
}
```

```cpp
#include <hip/hip_runtime.h>
#include <cstdio>
#include <cstdint>

#ifndef MK_N_LAUNCHES
#define MK_N_LAUNCHES 1
#endif

namespace pg8 {
#define PG8_LAS __attribute__((address_space(3)))
typedef unsigned short bf16_t;
typedef short bf16x8 __attribute__((ext_vector_type(8)));
typedef float f32x4 __attribute__((ext_vector_type(4)));
typedef unsigned u32x4 __attribute__((ext_vector_type(4)));
typedef unsigned u32x2 __attribute__((ext_vector_type(2)));
constexpr int BM = 256, BK = 64, HALF = 128, HTB = HALF * BK * 2  , STAGE_BYTES = 8 * HTB, NXCD = 8, WGM = 8;

__host__ __device__ __forceinline__ int lds_byte(int r, int c) { const int st = (r >> 4) * 2 + (c >> 5), rr = r & 15, cc = c & 31, ob = rr * 64 + cc * 2; return st * 1024 + (ob ^ (((ob >> 9) & 1) << 5)); }
__host__ __device__ __forceinline__ void stage_rc(int b, int& R, int& C) { const int st = b / 1024, sb = b % 1024, swz = sb ^ (((sb >> 9) & 1) << 5); R = (st >> 1) * 16 + swz / 64; C = (st & 1) * 32 + (swz % 64) / 2; }
__host__ __device__ __forceinline__ int perm32(int rho) { const int n = rho >> 4, i = rho & 15; return 8 * (i >> 2) + 4 * n + (i & 3); }

struct Unit { int pm, pn, bt, e; };
struct Gemm { const bf16_t* A; const bf16_t* Bt; int M, N, K; };

struct StaticOrder {
    int nM, nN, nwg, G, c;
    __host__ __device__ void init(int M, int N, int G_, int c_) { nM = M / BM; nN = N / BM; nwg = nM * nN; G = G_; c = c_; }
    __host__ __device__ bool next(int i, Unit& u) const {
        const long L = (long)i * G + c; if (L >= nwg) return false;
        int wgid = (int)L; { const int q = nwg / NXCD, r = nwg % NXCD, xcd = wgid % NXCD, off = wgid / NXCD; wgid = (xcd < r ? xcd * (q + 1) : r * (q + 1) + (xcd - r) * q) + off; }
        const int nig = WGM * nN, gid = wgid / nig, fm = gid * WGM, gsz = (nM - fm) < WGM ? (nM - fm) : WGM;
        u.pm = fm + ((wgid % nig) % gsz); u.pn = (wgid % nig) / gsz; u.bt = u.pn; u.e = 0; return true;
    }
    __device__ __forceinline__ void a_ready(const Unit&) const {}
    __device__ __forceinline__ void done(const Unit&) const {}
};
template <int NPN> struct MoeOrder {
    const PG8_LAS int* blk_e; int nb, G, c;
    __device__ __forceinline__ bool next(int i, Unit& u) const {
        int L = i * G + c;
        if (G == 256) L = ((i * 8 + (c & 7)) << 5) + (c >> 3);
        const int g = L >> 5, r = L & 31;
        int block, pn;
        if (NPN == 16) { block = 4 * (g >> 1) + (r & 3); pn = 8 * (g & 1) + (r >> 2); } else { block = 4 * g + (r & 3); pn = r >> 2; }
        if (block >= nb) return false;
        u.pm = block; u.pn = pn; u.e = blk_e[block]; u.bt = u.e * NPN + pn; return true;
    }
    __device__ __forceinline__ void a_ready(const Unit&) const {}
    __device__ __forceinline__ void done(const Unit&) const {}
};

__device__ __forceinline__ unsigned cvt_pk_bf16(float lo, float hi) { unsigned r; asm volatile("v_cvt_pk_bf16_f32 %0, %1, %2" : "=v"(r) : "v"(lo), "v"(hi)); return r; }

struct EpiF32 {
    static constexpr bool PERM = false, AFTER_DRAIN = false;
    float* C; int ldc;
    __device__ __forceinline__ void operator()(const f32x4 (&acc)[2][2][4][2], const Unit& u, int wr, int wc, int fr, int fq) const {
        const int row0 = u.pm * BM + wr * 64 + fr, col0 = u.pn * BM + wc * 32 + 4 * fq;
#pragma unroll
        for (int ai = 0; ai < 2; ++ai)
#pragma unroll
            for (int m = 0; m < 4; ++m) { float* rowp = C + (size_t)(row0 + ai * HALF + m * 16) * ldc + col0;
#pragma unroll
                for (int bj = 0; bj < 2; ++bj)
#pragma unroll
                    for (int n = 0; n < 2; ++n) *(f32x4*)(rowp + bj * HALF + n * 16) = acc[ai][bj][m][n]; }
    }
};
struct EpiBf16 {
    static constexpr bool PERM = true, AFTER_DRAIN = false;
    bf16_t* O; int ldc; const float* bias; int bias_estride;
    __device__ __forceinline__ void operator()(const f32x4 (&acc)[2][2][4][2], const Unit& u, int wr, int wc, int fr, int fq) const {
        const int row0 = u.pm * BM + wr * 64 + fr; const int col0 = u.pn * BM + wc * 32 + 8 * fq;
        f32x4 bv[2][2];
#pragma unroll
        for (int bj = 0; bj < 2; ++bj)
#pragma unroll
            for (int n = 0; n < 2; ++n) bv[bj][n] = bias ? *(const f32x4*)(bias + (size_t)u.e * bias_estride + col0 + bj * HALF + 4 * n) : (f32x4){0.f, 0.f, 0.f, 0.f};
#pragma unroll
        for (int ai = 0; ai < 2; ++ai)
#pragma unroll
            for (int m = 0; m < 4; ++m) { bf16_t* rowp = O + (size_t)(row0 + ai * HALF + m * 16) * ldc + col0;
#pragma unroll
                for (int bj = 0; bj < 2; ++bj) { const f32x4 v0 = acc[ai][bj][m][0] + bv[bj][0], v1 = acc[ai][bj][m][1] + bv[bj][1];
                    u32x4 w; w.x = cvt_pk_bf16(v0[0], v0[1]); w.y = cvt_pk_bf16(v0[2], v0[3]); w.z = cvt_pk_bf16(v1[0], v1[1]); w.w = cvt_pk_bf16(v1[2], v1[3]);
                    *(u32x4*)(rowp + bj * HALF) = w; } }
    }
};
__device__ __forceinline__ float swiglu1(float g, float u) {
    g = fminf(g, 7.0f); u = fminf(fmaxf(u, -7.0f), 7.0f);
    const float s = __builtin_amdgcn_rcpf(1.0f + __builtin_amdgcn_exp2f(g * (-1.702f * 1.44269504089f)));
    return (u + 1.0f) * (g * s);
}
struct EpiSwiglu {
    static constexpr bool PERM = true, AFTER_DRAIN = false;
    bf16_t* H; int ldh; const float* bias; int bias_estride;
    __device__ __forceinline__ void operator()(const f32x4 (&acc)[2][2][4][2], const Unit& u, int wr, int wc, int fr, int fq) const {
        const int row0 = u.pm * BM + wr * 64 + fr; const int col0 = u.pn * BM + wc * 32 + 8 * fq;
        f32x4 bv[2][2];
#pragma unroll
        for (int bj = 0; bj < 2; ++bj)
#pragma unroll
            for (int n = 0; n < 2; ++n) bv[bj][n] = *(const f32x4*)(bias + (size_t)u.e * bias_estride + col0 + bj * HALF + 4 * n);
#pragma unroll
        for (int ai = 0; ai < 2; ++ai)
#pragma unroll
            for (int m = 0; m < 4; ++m) { bf16_t* rowp = H + (size_t)(row0 + ai * HALF + m * 16) * ldh + (col0 >> 1);
#pragma unroll
                for (int bj = 0; bj < 2; ++bj) { const f32x4 v0 = acc[ai][bj][m][0] + bv[bj][0], v1 = acc[ai][bj][m][1] + bv[bj][1];
                    u32x2 w; w.x = cvt_pk_bf16(swiglu1(v0[0], v0[1]), swiglu1(v0[2], v0[3])); w.y = cvt_pk_bf16(swiglu1(v1[0], v1[1]), swiglu1(v1[2], v1[3]));
                    *(u32x2*)(rowp + bj * (HALF / 2)) = w; } }
    }
};

template <class Epi, class Sched, bool ALIGN_EPI = false, bool SP2 = false>
__device__ __forceinline__ void gemm_phase(PG8_LAS unsigned char* lds, const Gemm g, const Sched& S, const Epi& E) {
    const int tid = threadIdx.x, wid = __builtin_amdgcn_readfirstlane(tid >> 6), lane = tid & 63, wr = wid >> 2, wc = wid & 3, fr = lane & 15, fq = lane >> 4;
    const int K = g.K, nt = K / BK;
    unsigned voffA[2], voffB[2];
#pragma unroll
    for (int i = 0; i < 2; ++i) { int R, C; stage_rc(tid * 16 + i * 8192, R, C); const int Rb = Epi::PERM ? ((R & ~31) + perm32(R & 31)) : R;
        voffA[i] = (unsigned)(R * K + C) * 2u; voffB[i] = (unsigned)(Rb * K + C) * 2u; }
    const size_t kstep = (size_t)(BK * 2);
    const size_t hstep = (size_t)HALF * K * 2;
    const size_t tstep = 2 * hstep;
    const unsigned ldsw = (unsigned)wid * 1024u;
    const int aoff = lds_byte(wr * 64 + fr, fq * 8), boff = lds_byte(wc * 32 + fr, fq * 8);
#define PG8_SA(b, h) (((b) * 2 + (h)) * HTB)
#define PG8_SB(b, h) ((4 + (b) * 2 + (h)) * HTB)
#define PG8_STAGE(bufoff, gbase, voff) do { _Pragma("unroll") for (int _i = 0; _i < 2; ++_i) \
        __builtin_amdgcn_global_load_lds((const unsigned*)((const char*)(gbase) + (voff)[_i]), (PG8_LAS unsigned*)(lds + (bufoff) + ldsw + _i * 8192), 16, 0, 0); } while (0)
#define PG8_LDA(dst, b, h) do { _Pragma("unroll") for (int m = 0; m < 4; ++m) _Pragma("unroll") for (int k = 0; k < 2; ++k) dst[m][k] = *(const PG8_LAS bf16x8*)(lds + PG8_SA(b, h) + aoff + m * 2048 + k * 1024); } while (0)
#define PG8_LDB(dst, b, h) do { _Pragma("unroll") for (int n = 0; n < 2; ++n) _Pragma("unroll") for (int k = 0; k < 2; ++k) dst[n][k] = *(const PG8_LAS bf16x8*)(lds + PG8_SB(b, h) + boff + n * 2048 + k * 1024); } while (0)
#define PG8_MMA(ai, bj, At, Bt) do { __builtin_amdgcn_s_setprio(1); _Pragma("unroll") for (int m = 0; m < 4; ++m) _Pragma("unroll") for (int n = 0; n < 2; ++n) _Pragma("unroll") for (int k = 0; k < 2; ++k) \
        acc[ai][bj][m][n] = __builtin_amdgcn_mfma_f32_16x16x32_bf16(Bt[n][k], At[m][k], acc[ai][bj][m][n], 0, 0, 0); __builtin_amdgcn_s_setprio(0); } while (0)
#define PG8_WAIT_V(n) asm volatile("s_waitcnt vmcnt(" #n ")" ::: "memory")
#define PG8_WAIT_L(n) asm volatile("s_waitcnt lgkmcnt(" #n ")" ::: "memory")
#define PG8_BAR __builtin_amdgcn_s_barrier()
#define PG8_SCHED __builtin_amdgcn_sched_barrier(0)
    Unit cur, nxt; int ui = 0;
    if (!S.next(0, cur)) return;
    f32x4 acc[2][2][4][2];
#pragma unroll
    for (int a = 0; a < 2; ++a)
#pragma unroll
        for (int b = 0; b < 2; ++b)
#pragma unroll
            for (int m = 0; m < 4; ++m)
#pragma unroll
                for (int n = 0; n < 2; ++n) acc[a][b][m][n] = (f32x4){0.f, 0.f, 0.f, 0.f};
    bf16x8 At[4][2], B0[2][2], B1[2][2];
    const char* cA = (const char*)g.A + (size_t)cur.pm * tstep; const char* cB = (const char*)g.Bt + (size_t)cur.bt * tstep;
    S.a_ready(cur);
    if constexpr (SP2) {
        PG8_STAGE(PG8_SB(0, 0), cB, voffB); PG8_STAGE(PG8_SB(0, 1), cB + hstep, voffB); PG8_STAGE(PG8_SA(0, 0), cA, voffA); PG8_STAGE(PG8_SA(0, 1), cA + hstep, voffA);
        if (wr == 1) PG8_BAR;
        PG8_WAIT_V(2); PG8_BAR;
        PG8_STAGE(PG8_SB(1, 0), cB + kstep, voffB); PG8_STAGE(PG8_SA(1, 0), cA + kstep, voffA); PG8_STAGE(PG8_SB(1, 1), cB + hstep + kstep, voffB);
        PG8_WAIT_V(6); PG8_BAR;
    } else {
        PG8_STAGE(PG8_SB(0, 0), cB, voffB); PG8_STAGE(PG8_SA(0, 0), cA, voffA); PG8_STAGE(PG8_SB(0, 1), cB + hstep, voffB); PG8_STAGE(PG8_SA(0, 1), cA + hstep, voffA);
        if (wr == 1) PG8_BAR;
        PG8_WAIT_V(4); PG8_BAR;
        PG8_STAGE(PG8_SB(1, 0), cB + kstep, voffB); PG8_STAGE(PG8_SA(1, 0), cA + kstep, voffA); PG8_STAGE(PG8_SB(1, 1), cB + hstep + kstep, voffB);
        PG8_WAIT_V(6); PG8_BAR;
    }
    for (;;) {
        const bool has_next = S.next(ui + 1, nxt);
        const char* nA = has_next ? (const char*)g.A + (size_t)nxt.pm * tstep : cA; const char* nB = has_next ? (const char*)g.Bt + (size_t)nxt.bt * tstep : cB;
        for (int t = 0; t < nt; t += 2) {
            const bool last = (t == nt - 2);
            const char* a1 = cA + (size_t)(t + 1) * kstep;
            const char* a2 = last ? nA : cA + (size_t)(t + 2) * kstep; const char* b2 = last ? nB : cB + (size_t)(t + 2) * kstep;
            const char* a3 = a2 + kstep; const char* b3 = b2 + kstep;
            if (last && has_next) S.a_ready(nxt);
            if constexpr (SP2) {
            PG8_LDB(B0, 0, 0); PG8_LDB(B1, 0, 1); PG8_SCHED; PG8_LDA(At, 0, 0); PG8_STAGE(PG8_SA(1, 1), a1 + hstep, voffA);
            PG8_WAIT_V(8); PG8_WAIT_L(0); PG8_BAR; PG8_MMA(0, 0, At, B0); PG8_MMA(0, 1, At, B1); PG8_BAR; PG8_SCHED;
            PG8_LDA(At, 0, 1); PG8_STAGE(PG8_SB(0, 0), b2, voffB); PG8_STAGE(PG8_SB(0, 1), b2 + hstep, voffB); PG8_STAGE(PG8_SA(0, 0), a2, voffA);
            PG8_WAIT_V(8); PG8_WAIT_L(0); PG8_BAR; PG8_MMA(1, 0, At, B0); PG8_MMA(1, 1, At, B1); PG8_BAR; PG8_SCHED;
            PG8_LDB(B0, 1, 0); PG8_LDB(B1, 1, 1); PG8_SCHED; PG8_LDA(At, 1, 0); PG8_STAGE(PG8_SA(0, 1), a2 + hstep, voffA);
            PG8_WAIT_V(8); PG8_WAIT_L(0); PG8_BAR; PG8_MMA(0, 0, At, B0); PG8_MMA(0, 1, At, B1); PG8_BAR; PG8_SCHED;
            PG8_LDA(At, 1, 1); PG8_STAGE(PG8_SB(1, 0), b3, voffB); PG8_STAGE(PG8_SB(1, 1), b3 + hstep, voffB); PG8_STAGE(PG8_SA(1, 0), a3, voffA);
            PG8_WAIT_V(8); PG8_WAIT_L(0); PG8_BAR; PG8_MMA(1, 0, At, B0); PG8_MMA(1, 1, At, B1); PG8_BAR; PG8_SCHED;
            } else {
            PG8_LDB(B0, 0, 0); PG8_SCHED; PG8_LDA(At, 0, 0); PG8_STAGE(PG8_SA(1, 1), a1 + hstep, voffA);
            PG8_WAIT_L(8); PG8_BAR; PG8_WAIT_L(0); PG8_MMA(0, 0, At, B0); PG8_BAR; PG8_SCHED;
            PG8_LDB(B1, 0, 1); PG8_STAGE(PG8_SB(0, 0), b2, voffB);
            PG8_BAR; PG8_WAIT_L(0); PG8_MMA(0, 1, At, B1); PG8_BAR;
            PG8_LDA(At, 0, 1); PG8_STAGE(PG8_SA(0, 0), a2, voffA);
            PG8_BAR; PG8_WAIT_L(0); PG8_MMA(1, 0, At, B0); PG8_BAR; PG8_SCHED;
            PG8_STAGE(PG8_SB(0, 1), b2 + hstep, voffB);
            PG8_WAIT_V(6); PG8_BAR; PG8_MMA(1, 1, At, B1); PG8_BAR;
            PG8_LDB(B0, 1, 0); PG8_SCHED; PG8_LDA(At, 1, 0); PG8_STAGE(PG8_SA(0, 1), a2 + hstep, voffA);
            PG8_WAIT_L(8); PG8_BAR; PG8_WAIT_L(0); PG8_MMA(0, 0, At, B0); PG8_BAR; PG8_SCHED;
            PG8_LDB(B1, 1, 1); PG8_STAGE(PG8_SB(1, 0), b3, voffB);
            PG8_BAR; PG8_WAIT_L(0); PG8_MMA(0, 1, At, B1); PG8_BAR;
            PG8_LDA(At, 1, 1); PG8_STAGE(PG8_SA(1, 0), a3, voffA);
            PG8_BAR; PG8_WAIT_L(0); PG8_MMA(1, 0, At, B0); PG8_BAR; PG8_SCHED;
            PG8_STAGE(PG8_SB(1, 1), b3 + hstep, voffB);
            PG8_WAIT_V(6); PG8_BAR; PG8_MMA(1, 1, At, B1); PG8_BAR;
            }
        }
        if constexpr (ALIGN_EPI) { if (wr == 0) PG8_BAR; }
        if constexpr (!Epi::AFTER_DRAIN) { E(acc, cur, wr, wc, fr, fq); S.done(cur); }
        if (!has_next) break;
#pragma unroll
        for (int a = 0; a < 2; ++a)
#pragma unroll
            for (int b = 0; b < 2; ++b)
#pragma unroll
                for (int m = 0; m < 4; ++m)
#pragma unroll
                    for (int n = 0; n < 2; ++n) acc[a][b][m][n] = (f32x4){0.f, 0.f, 0.f, 0.f};
        cur = nxt; cA = nA; cB = nB; ++ui;
        if constexpr (ALIGN_EPI) { if (wr == 1) PG8_BAR; }
    }
    PG8_WAIT_V(0);
    if constexpr (!ALIGN_EPI) { if (wr == 0) PG8_BAR; }
    PG8_BAR;
    if constexpr (Epi::AFTER_DRAIN) { E.fused(acc, cur, wr, wc, fr, fq, lds, wid, lane); S.done(cur); }
#undef PG8_SA
#undef PG8_SB
#undef PG8_STAGE
#undef PG8_LDA
#undef PG8_LDB
#undef PG8_MMA
#undef PG8_WAIT_V
#undef PG8_WAIT_L
#undef PG8_BAR
#undef PG8_SCHED
}
}

constexpr int NWAVES = 8;
constexpr int NBATCH = 4, SEQ = 2048, T = NBATCH * SEQ, D = 2048, HD = 128, NHG = 8, GW = 1024, NQKV = 6144, NE = 32, TOPK = 4, FF = 2048, FF2 = 4096;
constexpr int MAXBLK = 160;
constexpr float EPS = 1e-6f;
constexpr int NPHASE = 11;

constexpr size_t MiB = 1u << 20;
constexpr size_t WS_CTL = 0, CTL_ZERO_BYTES = 1 * MiB;
constexpr size_t WS_MODP = 1 * MiB;
constexpr size_t WS_TOPI = 5 * MiB, WS_TOPG = WS_TOPI + 131072, WS_TSLOT = WS_TOPG + 131072;
constexpr size_t WS_LSE = 6 * MiB;
constexpr size_t WS_WIN_T = 8 * MiB;
constexpr size_t WS_WO_T = 32 * MiB;
constexpr size_t WS_HMIX = 40 * MiB;
constexpr size_t WS_AOUT = 72 * MiB;
constexpr size_t WS_PROJ = 104 * MiB;
constexpr size_t WS_ONA = 200 * MiB;
constexpr size_t WS_ODIL = 232 * MiB;
constexpr size_t WS_MIXED = 328 * MiB;
constexpr size_t WS_X1 = 392 * MiB;
constexpr size_t WS_HFFN = 456 * MiB;
constexpr size_t WS_XG = 492 * MiB;
constexpr size_t WS_HB = 652 * MiB;
constexpr size_t WS_YB = 812 * MiB;
constexpr size_t WS_WEI_T = 1024 * MiB;
constexpr size_t WS_WEO_T = 1536 * MiB;
constexpr size_t WS_END = 1792 * MiB;
constexpr int CW_TMO = 0, CW_CODE = 1, CW_CNT = 256, CW_CUR = 512, CW_BAR = 4096;

constexpr int RING_OFF = 0, RING_BYTES = 155648;
constexpr int MISC_OFF = RING_BYTES;
constexpr int LDS_BYTES = RING_BYTES + 1024;

#define GAS __attribute__((address_space(1)))
#define LAS __attribute__((address_space(3)))
typedef unsigned short bf16;
typedef unsigned v4u __attribute__((ext_vector_type(4)));
typedef unsigned v2u __attribute__((ext_vector_type(2)));
typedef float f32x4 __attribute__((ext_vector_type(4)));
typedef GAS unsigned gu32;
#define RLX_AGENT __ATOMIC_RELAXED, __HIP_MEMORY_SCOPE_AGENT
#define LDS_WAIT() asm volatile("s_waitcnt lgkmcnt(0)" ::: "memory")
#define VM_WAIT() asm volatile("s_waitcnt vmcnt(0)" ::: "memory")
__device__ __forceinline__ float bf2f(unsigned short h) { return __builtin_bit_cast(float, (unsigned)h << 16); }
__device__ __forceinline__ float bflo(unsigned w) { return __builtin_bit_cast(float, w << 16); }
__device__ __forceinline__ float bfhi(unsigned w) { return __builtin_bit_cast(float, w & 0xffff0000u); }
__device__ __forceinline__ unsigned pk2(float lo, float hi) { return pg8::cvt_pk_bf16(lo, hi); }

#define XB_TMO      128
#define XB_XCNT(j)  (256  + 64 * (j))
#define XB_XSUB(j)  (1280 + 64 * (j))
#define XB_XGEN(j)  (2304 + 64 * (j))
#define XB_TOP      3328
#define XB_TOPGEN   3392
#define XCD_BAR_WORDS 3456
#define XB_SPIN_CAP (1u << 18)
__device__ __forceinline__ unsigned xb_ld(unsigned* p)              { return __hip_atomic_load(p, __ATOMIC_RELAXED, __HIP_MEMORY_SCOPE_AGENT); }
__device__ __forceinline__ unsigned xb_add(unsigned* p, unsigned v) { return __hip_atomic_fetch_add(p, v, __ATOMIC_RELAXED, __HIP_MEMORY_SCOPE_AGENT); }
__device__ __forceinline__ unsigned xb_xcc_id() { return (unsigned)__builtin_amdgcn_s_getreg((3 << 11) | 20) & 0xFu; }
#define XB_SPIN(cond, bar) do { unsigned _sp = 0; while (cond) { __builtin_amdgcn_s_sleep(1); \
    if ((++_sp & 255u) == 0u) { if (xb_ld(&(bar)[XB_TMO])) break; if (_sp > XB_SPIN_CAP) { atomicAdd(&(bar)[XB_TMO], 1u); break; } } } } while (0)
struct XcdBarrier { unsigned* bar; unsigned x; volatile LAS unsigned* st; };
__device__ __forceinline__ XcdBarrier xcd_barrier_post(unsigned* bar, volatile LAS unsigned* st) {
    XcdBarrier b; b.bar = bar; b.x = xb_xcc_id(); b.st = st;
    if (threadIdx.x == 0) (void)xb_add(&bar[XB_XCNT(b.x)], 1u);
    return b;
}
__device__ __forceinline__ void xcd_barrier_complete(unsigned* bar, unsigned x, unsigned& nloc, unsigned& nx) {
    const unsigned G = gridDim.x * gridDim.y * gridDim.z;
    unsigned sum, cnt, mine, sp = 0u;
    for (;;) {
        sum = 0u; cnt = 0u; mine = 0u;
#pragma unroll
        for (unsigned j = 0; j < 16; ++j) { const unsigned c = xb_ld(&bar[XB_XCNT(j)]); sum += c; cnt += (c > 0u) ? 1u : 0u; mine = (j == x) ? c : mine; }
        if (sum == G) break;
        __builtin_amdgcn_s_sleep(1);
        if ((++sp & 255u) == 0u) { if (xb_ld(&bar[XB_TMO])) break; if (sp > XB_SPIN_CAP) { atomicAdd(&bar[XB_TMO], 1u); break; } }
    }
    nloc = mine > 0u ? mine : 1u; nx = cnt > 0u ? cnt : 1u;
}
__device__ __forceinline__ void xcd_barrier(const XcdBarrier& b) {
    asm volatile("s_waitcnt vmcnt(0)" ::: "memory");
    __syncthreads();
    if (threadIdx.x == 0) {
        unsigned* bar = b.bar;
        __builtin_amdgcn_s_waitcnt(0);
        unsigned nloc = b.st[0], nx = b.st[1];
        if (nloc == 0u) { xcd_barrier_complete(bar, b.x, nloc, nx); b.st[0] = nloc; b.st[1] = nx; }
        const unsigned old = xb_add(&bar[XB_XSUB(b.x)], 1u);
        const unsigned gen = old / nloc;
        if (old + 1u == (gen + 1u) * nloc) {
            __builtin_amdgcn_fence(__ATOMIC_RELEASE, "agent");
            asm volatile("s_waitcnt vmcnt(0)" ::: "memory");
            const unsigned og = xb_add(&bar[XB_TOP], 1u);
            const unsigned tg = og / nx;
            if (og + 1u == (tg + 1u) * nx) xb_add(&bar[XB_TOPGEN], 1u);
            else XB_SPIN(xb_ld(&bar[XB_TOPGEN]) == tg, bar);
            __builtin_amdgcn_fence(__ATOMIC_ACQUIRE, "agent");
            xb_add(&bar[XB_XGEN(b.x)], 1u);
            asm volatile("s_waitcnt vmcnt(0)" ::: "memory");
        } else {
            XB_SPIN(xb_ld(&bar[XB_XGEN(b.x)]) == gen, bar);
            __builtin_amdgcn_fence(__ATOMIC_ACQUIRE, "agent");
            asm volatile("s_waitcnt vmcnt(0)" ::: "memory");
        }
    }
    __syncthreads();
}

struct Frame {
    LAS unsigned char* lds;
    volatile LAS unsigned* MISC;
    unsigned* ctl;
    int tid, lane, wave, vcu, G;
    const float *x, *c, *w_ada, *b_ada, *g_pre_mix, *g_post_mix, *w_in, *rpb, *t5, *g_out_na, *g_out_dil, *w_o, *g_pre_ffn, *g_post_ffn, *w_router, *b_router, *w_e_in, *b_e_in, *w_e_out, *b_e_out;
    float* out;
    unsigned char* ws;
};
__device__ __forceinline__ float wave_sum(float v) {
#pragma unroll
    for (int o = 1; o < 64; o <<= 1) v += __shfl_xor(v, o);
    return v;
}
__device__ __forceinline__ float wave_max(float v) {
#pragma unroll
    for (int o = 1; o < 64; o <<= 1) v = fmaxf(v, __shfl_xor(v, o));
    return v;
}
__device__ __forceinline__ float mod_val(const Frame& F, int b, int idx) {
    const float* mp = (const float*)(F.ws + WS_MODP);
    float s = F.b_ada[idx];
#pragma unroll
    for (int ks = 0; ks < 16; ++ks) s += mp[(size_t)(ks * 4 + b) * (6 * D) + idx];
    return s;
}

__constant__ unsigned char T5B[3][132] = {
 {11,11,11,11,11,11,11,11,11,11,11,11,11,11,11,10,10,10,10,10,10,10,10,10,10,10,10,10,10,10,10,10,10,10,10,10,10,10,9,9,9,9,9,9,9,9,9,9,9,9,8,8,8,8,8,8,8,7,6,5,4,3,2,1,0,17,18,19,20,21,22,23,24,24,24,24,24,24,24,25,25,25,25,25,25,25,25,25,25,25,25,26,26,26,26,26,26,26,26,26,26,26,26,26,26,26,26,26,26,26,26,26,26,26,27,27,27,27,27,27,27,27,27,27,27,27,27,27,27,0,0,0},
 {13,13,13,13,13,13,13,13,13,13,13,13,13,13,13,13,13,13,13,13,13,13,13,12,12,12,12,12,12,12,12,12,12,12,12,12,12,12,12,12,12,12,11,11,11,11,11,11,11,11,11,11,10,10,10,10,10,10,9,9,9,8,8,4,0,20,24,24,25,25,25,26,26,26,26,26,26,27,27,27,27,27,27,27,27,27,27,28,28,28,28,28,28,28,28,28,28,28,28,28,28,28,28,28,28,28,29,29,29,29,29,29,29,29,29,29,29,29,29,29,29,29,29,29,29,29,29,29,29,0,0,0},
 {15,15,15,15,15,15,15,15,15,15,15,15,15,15,15,15,15,15,15,15,15,15,15,15,15,15,15,15,15,15,14,14,14,14,14,14,14,14,14,14,14,14,14,14,14,13,13,13,13,13,13,13,13,13,12,12,12,12,12,11,11,10,10,9,0,25,26,26,27,27,28,28,28,28,28,29,29,29,29,29,29,29,29,29,30,30,30,30,30,30,30,30,30,30,30,30,30,30,30,31,31,31,31,31,31,31,31,31,31,31,31,31,31,31,31,31,31,31,31,31,31,31,31,31,31,31,31,31,31,0,0,0}};

__device__ __forceinline__ void p0_mod_item(Frame& F, int j) {
    const int ks = j >> 4, cb = j & 15;
    LAS float* sc = (LAS float*)(F.lds + RING_OFF);
    LAS float* red = (LAS float*)(F.lds + RING_OFF + 4096);
    __syncthreads();
    { const int b = F.tid >> 7, k = F.tid & 127; const float cv = F.c[b * D + ks * 128 + k]; sc[F.tid] = cv / (1.0f + __expf(-cv)); }
    __syncthreads();
    const int cg = F.tid % 192, sub = F.tid / 192;
    f32x4 acc[4];
#pragma unroll
    for (int b = 0; b < 4; ++b) acc[b] = (f32x4){0.f, 0.f, 0.f, 0.f};
    if (sub < 2) {
        const float* wp = F.w_ada + (size_t)(ks * 128 + sub * 64) * (6 * D) + cb * 768 + 4 * cg;
#pragma unroll 8
        for (int i = 0; i < 64; ++i) {
            const f32x4 w = *(const f32x4*)(wp + (size_t)i * (6 * D));
#pragma unroll
            for (int b = 0; b < 4; ++b) { const float s = sc[b * 128 + sub * 64 + i]; acc[b] += w * s; }
        }
        if (sub == 1) {
#pragma unroll
            for (int b = 0; b < 4; ++b) *(LAS f32x4*)(red + cg * 16 + b * 4) = acc[b];
        }
    }
    __syncthreads();
    if (sub == 0) {
        float* mp = (float*)(F.ws + WS_MODP);
#pragma unroll
        for (int b = 0; b < 4; ++b) { const f32x4 o = acc[b] + *(LAS f32x4*)(red + cg * 16 + b * 4); *(f32x4*)(mp + (size_t)(ks * 4 + b) * (6 * D) + cb * 768 + 4 * cg) = o; }
    }
}
__device__ __forceinline__ void p0_transpose_item(const float* W, int K, int N, bf16* WT, LAS float* scr, int item, int lane) {
    const int nblk = N >> 6, kb = item / nblk, nb = item - kb * nblk, k0 = kb << 6, n0 = nb << 6;
    const float* src = W + (size_t)(k0 + (lane >> 4)) * N + n0 + 4 * (lane & 15);
    f32x4 v[16];
#pragma unroll
    for (int i = 0; i < 16; ++i) v[i] = *(const f32x4*)(src + (size_t)(4 * i) * N);
#pragma unroll
    for (int i = 0; i < 16; ++i) { LAS float* d = scr + (4 * i + (lane >> 4)) * 65 + 4 * (lane & 15); d[0] = v[i][0]; d[1] = v[i][1]; d[2] = v[i][2]; d[3] = v[i][3]; }
    LDS_WAIT();
    const int c = lane >> 3;
#pragma unroll
    for (int jn = 0; jn < 8; ++jn) { const int n = (lane & 7) + 8 * jn; const LAS float* s = scr + (8 * c) * 65 + n;
        v4u o; o.x = pk2(s[0 * 65], s[1 * 65]); o.y = pk2(s[2 * 65], s[3 * 65]); o.z = pk2(s[4 * 65], s[5 * 65]); o.w = pk2(s[6 * 65], s[7 * 65]);
        *(v4u*)(WT + (size_t)(n0 + n) * K + k0 + 8 * c) = o; }
    LDS_WAIT();
}
__device__ __forceinline__ void p0_prologue(Frame& F) {
    for (int j = F.vcu; j < 256; j += F.G) p0_mod_item(F, j);
    __syncthreads();
    LAS float* scr = (LAS float*)(F.lds + RING_OFF + F.wave * 16640);
    const int gw = F.vcu * NWAVES + F.wave, NGW = F.G * NWAVES;
    constexpr int I_IN = (D / 64) * (NQKV / 64), I_O = (D / 64) * (D / 64), I_EI1 = (D / 64) * (FF2 / 64), I_EO1 = (FF / 64) * (D / 64);
    constexpr int I_EI = NE * I_EI1, I_EO = NE * I_EO1, NITEMS = I_IN + I_O + I_EI + I_EO;
    for (int it = gw; it < NITEMS; it += NGW) {
        int r = it;
        if (r < I_IN) { p0_transpose_item(F.w_in, D, NQKV, (bf16*)(F.ws + WS_WIN_T), scr, r, F.lane); continue; } r -= I_IN;
        if (r < I_O) { p0_transpose_item(F.w_o, D, D, (bf16*)(F.ws + WS_WO_T), scr, r, F.lane); continue; } r -= I_O;
        if (r < I_EI) { const int e = r / I_EI1; p0_transpose_item(F.w_e_in + (size_t)e * D * FF2, D, FF2, (bf16*)(F.ws + WS_WEI_T) + (size_t)e * FF2 * D, scr, r - e * I_EI1, F.lane); continue; } r -= I_EI;
        { const int e = r / I_EO1; p0_transpose_item(F.w_e_out + (size_t)e * FF * D, FF, D, (bf16*)(F.ws + WS_WEO_T) + (size_t)e * D * FF, scr, r - e * I_EO1, F.lane); }
    }
}

__device__ __forceinline__ void p1_hmix(Frame& F) {
    LAS float* ta = (LAS float*)(F.lds + RING_OFF);
    LAS float* tb = ta + D;
    for (int rb = F.vcu; rb < T / 32; rb += F.G) {
        const int b = rb >> 6;
        __syncthreads();
        for (int col = F.tid; col < D; col += NWAVES * 64) { ta[col] = F.g_pre_mix[col] * (1.0f + mod_val(F, b, D + col)); tb[col] = mod_val(F, b, col); }
        __syncthreads();
        for (int rr = F.wave; rr < 32; rr += NWAVES) {
            const int row = rb * 32 + rr;
            const f32x4* xr = (const f32x4*)(F.x + (size_t)row * D) + F.lane;
            f32x4 v[8]; float ss = 0.f;
#pragma unroll
            for (int j = 0; j < 8; ++j) { v[j] = xr[64 * j]; ss += (v[j][0] * v[j][0] + v[j][1] * v[j][1]) + (v[j][2] * v[j][2] + v[j][3] * v[j][3]); }
            const float r = 1.0f / sqrtf(wave_sum(ss) * (1.0f / D) + EPS);
            v2u* o8 = (v2u*)((bf16*)(F.ws + WS_HMIX) + (size_t)row * D) + F.lane;
#pragma unroll
            for (int j = 0; j < 8; ++j) { const int col = 4 * F.lane + 256 * j; const f32x4 a = *(LAS f32x4*)(ta + col), s = *(LAS f32x4*)(tb + col);
                v2u w; w.x = pk2(v[j][0] * r * a[0] + s[0], v[j][1] * r * a[1] + s[1]); w.y = pk2(v[j][2] * r * a[2] + s[2], v[j][3] * r * a[3] + s[3]); o8[64 * j] = w; }
        }
    }
}

__device__ __forceinline__ float dot_qk(const LAS float* q, const bf16* krow) {
    float s = 0.f;
#pragma unroll
    for (int ch = 0; ch < 16; ++ch) { const v4u kv = *(const v4u*)(krow + 8 * ch); const LAS float* qq = q + 8 * ch;
        s += qq[0] * bflo(kv.x) + qq[1] * bfhi(kv.x) + qq[2] * bflo(kv.y) + qq[3] * bfhi(kv.y) + qq[4] * bflo(kv.z) + qq[5] * bfhi(kv.z) + qq[6] * bflo(kv.w) + qq[7] * bfhi(kv.w); }
    return s;
}
__device__ __forceinline__ void p3_attn_naive(Frame& F) {
    LAS float* lq = (LAS float*)(F.lds + RING_OFF + F.wave * 2048);
    LAS float* lp = lq + 128;
    const bf16* proj = (const bf16*)(F.ws + WS_PROJ);
    float* ona = (float*)(F.ws + WS_ONA); float* odil = (float*)(F.ws + WS_ODIL); float* lse = (float*)(F.ws + WS_LSE);
    const float scale = 0.08838834764831845f;
    const int gw = F.vcu * NWAVES + F.wave, NGW = F.G * NWAVES, lane = F.lane;
    for (int it = gw; it < T * 16; it += NGW) {
        const int tok = it >> 4, hh = it & 15, b = tok >> 11, pos = tok & 2047;
        const bf16* prow = proj + (size_t)tok * NQKV;
        if (hh < 8) {
            const int h = hh;
            { const unsigned qw = *(const unsigned*)(prow + h * HD + 2 * lane); LDS_WAIT(); lq[2 * lane] = bflo(qw); lq[2 * lane + 1] = bfhi(qw); LDS_WAIT(); }
            const int r = pos >> 6, c = pos & 63; const int rs = min(max(r - 4, 0), 24), cs = min(max(c - 8, 0), 48);
            float lg[2];
#pragma unroll
            for (int jj = 0; jj < 2; ++jj) { const int j = lane + 64 * jj, i = j >> 4, cc = cs + (j & 15), kpos = (rs + i) * 64 + cc;
                const float d = dot_qk(lq, proj + (size_t)(b * SEQ + kpos) * NQKV + GW + h * HD);
                lg[jj] = d * scale + F.rpb[(h * 15 + (rs + i - r + 7)) * 31 + (cc - c + 15)]; }
            const float m = wave_max(fmaxf(lg[0], lg[1]));
            const float p0 = __expf(lg[0] - m), p1 = __expf(lg[1] - m);
            const float inv = 1.0f / wave_sum(p0 + p1);
            lp[lane] = p0 * inv; lp[lane + 64] = p1 * inv; LDS_WAIT();
            float o0 = 0.f, o1 = 0.f;
            for (int j = 0; j < 128; ++j) { const int kpos = (rs + (j >> 4)) * 64 + cs + (j & 15);
                const unsigned vw = *(const unsigned*)(proj + (size_t)(b * SEQ + kpos) * NQKV + 2 * GW + h * HD + 2 * lane); const float p = lp[j]; o0 += p * bflo(vw); o1 += p * bfhi(vw); }
            *(float2*)(ona + (size_t)tok * GW + h * HD + 2 * lane) = make_float2(o0, o1);
        } else {
            const int h = hh - 8;
            { const unsigned qw = *(const unsigned*)(prow + 3 * GW + h * HD + 2 * lane); LDS_WAIT(); lq[2 * lane] = bflo(qw); lq[2 * lane + 1] = bfhi(qw); LDS_WAIT(); }
#pragma unroll
            for (int p = 0; p < 3; ++p) {
                const int dsh = 2 * p, dil = 1 << dsh, sub_len = SEQ >> dsh, rho = pos & (dil - 1), ql = pos >> dsh;
                float lg[3];
#pragma unroll
                for (int jj = 0; jj < 3; ++jj) { const int j = lane + 64 * jj; const int kl = ql + j - 64; const bool valid = (j < 129) && (kl >= 0) && (kl < sub_len);
                    const int kpos = rho + dil * min(max(kl, 0), sub_len - 1);
                    float d = -INFINITY;
                    if (valid) d = dot_qk(lq, proj + (size_t)(b * SEQ + kpos) * NQKV + 4 * GW + h * HD) * scale + F.t5[(int)T5B[p][j] * 8 + h];
                    lg[jj] = d; }
                const float m = wave_max(fmaxf(fmaxf(lg[0], lg[1]), lg[2]));
                const float p0 = __expf(lg[0] - m), p1 = __expf(lg[1] - m), p2 = __expf(lg[2] - m);
                const float den = wave_sum(p0 + p1 + p2), inv = 1.0f / den;
                LDS_WAIT(); lp[lane] = p0 * inv; lp[lane + 64] = p1 * inv; lp[lane + 128] = p2 * inv; LDS_WAIT();
                float o0 = 0.f, o1 = 0.f;
                for (int j = 0; j < 129; ++j) { const int kl = ql + j - 64; const int kpos = rho + dil * min(max(kl, 0), sub_len - 1);
                    const unsigned vw = *(const unsigned*)(proj + (size_t)(b * SEQ + kpos) * NQKV + 5 * GW + h * HD + 2 * lane); const float pp = lp[j]; o0 += pp * bflo(vw); o1 += pp * bfhi(vw); }
                *(float2*)(odil + ((size_t)p * T + tok) * GW + h * HD + 2 * lane) = make_float2(o0, o1);
                if (lane == 0) lse[((size_t)p * T + tok) * 8 + h] = m + __logf(den);
            }
        }
    }
}


typedef short bf16x8v __attribute__((ext_vector_type(8)));
typedef short s16x4v __attribute__((ext_vector_type(4)));
typedef int v4i16_t_ __attribute__((ext_vector_type(2)));
__device__ __forceinline__ unsigned vimg_off(unsigned row, unsigned ch) { return 256u * row + 16u * (ch ^ (((row & 3u) << 2) | ((row >> 2) & 3u))); }
__device__ __forceinline__ s16x4v tr_read16(const LAS unsigned char* p) {
    typedef short v4i16 __attribute__((ext_vector_type(4)));
    return __builtin_bit_cast(s16x4v, __builtin_amdgcn_ds_read_tr16_b64_v4i16((LAS v4i16*)p));
}
struct GeoNA {
    int tok0, qbase, kbase, r, rs, c0, kc0; const float* rpb_h;
    static constexpr int QCOL = 0, KCOL = GW, VCOL = 2 * GW;
    __device__ __forceinline__ int qtok(int n16) const { return qbase + n16; }
    __device__ __forceinline__ int ktok(int c, int slot) const { return kbase + c * 64 + slot; }
    __device__ __forceinline__ float bias(int c, int slot, int n16) const {
        const int qc = c0 + n16, kc = kc0 + slot, cs = min(max(qc - 8, 0), 48);
        const bool valid = (kc >= cs) && (kc < cs + 16);
        const int dc = min(max(kc - qc + 15, 0), 30);
        const float bv = rpb_h[(rs + c - r + 7) * 31 + dc];
        return valid ? bv : -INFINITY;
    }
};
struct GeoDil {
    int tok0, rho, dsh, sub_len, l0, p, h; const float* t5;
    static constexpr int QCOL = 3 * GW, KCOL = 4 * GW, VCOL = 5 * GW;
    __device__ __forceinline__ int qtok(int n16) const { return tok0 + rho + ((l0 + n16) << dsh); }
    __device__ __forceinline__ int ktok(int c, int slot) const { const int l = min(max(l0 - 64 + 32 * c + slot, 0), sub_len - 1); return tok0 + rho + (l << dsh); }
    __device__ __forceinline__ float bias(int c, int slot, int n16) const {
        const int kk = 32 * c + slot, delta = kk - 64 - n16, l = l0 - 64 + kk;
        const bool valid = (delta >= -64) && (delta <= 64) && (l >= 0) && (l < sub_len);
        const int di = min(max(delta + 64, 0), 128);
        const float bv = t5[(int)T5B[p][di] * 8 + h];
        return valid ? bv : -INFINITY;
    }
};
template <int NCH, class Geo>
__device__ __forceinline__ void attn_item(const Geo& G, const bf16* proj, int hcol, LAS unsigned char* vimg, float* out, float* lse_out, int lane) {
    const int n16 = lane & 15, g = lane >> 4;
    const float scale_l2 = 0.08838834764831845f * 1.44269504089f;
    bf16x8v qf[4];
    { const bf16* qp = proj + (size_t)G.qtok(n16) * NQKV + Geo::QCOL + hcol + 8 * g;
#pragma unroll
      for (int s = 0; s < 4; ++s) qf[s] = *(const bf16x8v*)(qp + 32 * s); }
    f32x4 st[NCH][2];
#pragma unroll
    for (int c = 0; c < NCH; ++c)
#pragma unroll
        for (int t2 = 0; t2 < 2; ++t2) {
            const int slot = 8 * (n16 >> 2) + 4 * t2 + (n16 & 3);
            const bf16* kp = proj + (size_t)G.ktok(c, slot) * NQKV + Geo::KCOL + hcol + 8 * g;
            f32x4 acc = (f32x4){0.f, 0.f, 0.f, 0.f};
#pragma unroll
            for (int s = 0; s < 4; ++s) { const bf16x8v kf = *(const bf16x8v*)(kp + 32 * s); acc = __builtin_amdgcn_mfma_f32_16x16x32_bf16(kf, qf[s], acc, 0, 0, 0); }
            st[c][t2] = acc;
        }
    float mx = -INFINITY;
#pragma unroll
    for (int c = 0; c < NCH; ++c)
#pragma unroll
        for (int t2 = 0; t2 < 2; ++t2)
#pragma unroll
            for (int r = 0; r < 4; ++r) { const float bv = G.bias(c, 8 * g + 4 * t2 + r, n16); const float x = st[c][t2][r] * scale_l2 + bv * 1.44269504089f; st[c][t2][r] = x; mx = fmaxf(mx, x); }
    mx = fmaxf(mx, __shfl_xor(mx, 16)); mx = fmaxf(mx, __shfl_xor(mx, 32));
    float sum = 0.f;
    bf16x8v pf[NCH];
#pragma unroll
    for (int c = 0; c < NCH; ++c) {
        float pv[8];
#pragma unroll
        for (int t2 = 0; t2 < 2; ++t2)
#pragma unroll
            for (int r = 0; r < 4; ++r) { const float p = __builtin_amdgcn_exp2f(st[c][t2][r] - mx); pv[4 * t2 + r] = p; sum += p; }
        v4u w; w.x = pk2(pv[0], pv[1]); w.y = pk2(pv[2], pv[3]); w.z = pk2(pv[4], pv[5]); w.w = pk2(pv[6], pv[7]);
        pf[c] = __builtin_bit_cast(bf16x8v, w);
    }
    sum += __shfl_xor(sum, 16); sum += __shfl_xor(sum, 32);
    f32x4 oacc[8];
#pragma unroll
    for (int dt = 0; dt < 8; ++dt) oacc[dt] = (f32x4){0.f, 0.f, 0.f, 0.f};
    const int vr_row = lane >> 4, vr_ch = lane & 15;
    v4u vr[8];
#pragma unroll
    for (int i = 0; i < 8; ++i) vr[i] = *(const v4u*)(proj + (size_t)G.ktok(0, 4 * i + vr_row) * NQKV + Geo::VCOL + hcol + 8 * vr_ch);
    const unsigned q4 = (unsigned)(lane & 15) >> 2, pp = (unsigned)lane & 3u;
#pragma unroll
    for (int c = 0; c < NCH; ++c) {
        asm volatile("" ::: "memory");
#pragma unroll
        for (int i = 0; i < 8; ++i) *(LAS v4u*)(vimg + vimg_off((unsigned)(4 * i + vr_row), (unsigned)vr_ch)) = vr[i];
        asm volatile("" ::: "memory");
        if (c + 1 < NCH) {
#pragma unroll
            for (int i = 0; i < 8; ++i) vr[i] = *(const v4u*)(proj + (size_t)G.ktok(c + 1, 4 * i + vr_row) * NQKV + Geo::VCOL + hcol + 8 * vr_ch);
        }
#pragma unroll
        for (int dt = 0; dt < 8; ++dt) {
            const s16x4v lo = tr_read16(vimg + vimg_off((unsigned)(8 * g) + q4, (unsigned)(2 * dt) + (pp >> 1)) + 8u * (pp & 1u));
            const s16x4v hi = tr_read16(vimg + vimg_off((unsigned)(8 * g + 4) + q4, (unsigned)(2 * dt) + (pp >> 1)) + 8u * (pp & 1u));
            bf16x8v vf; vf[0] = lo[0]; vf[1] = lo[1]; vf[2] = lo[2]; vf[3] = lo[3]; vf[4] = hi[0]; vf[5] = hi[1]; vf[6] = hi[2]; vf[7] = hi[3];
            oacc[dt] = __builtin_amdgcn_mfma_f32_16x16x32_bf16(vf, pf[c], oacc[dt], 0, 0, 0);
        }
        asm volatile("" ::: "memory");
    }
    const float inv = 1.0f / sum;
    float* op = out + (size_t)G.qtok(n16) * GW + hcol + 4 * g;
#pragma unroll
    for (int dt = 0; dt < 8; ++dt) *(f32x4*)(op + 16 * dt) = oacc[dt] * inv;
    if (lse_out != nullptr && g == 0) lse_out[(size_t)G.qtok(n16) * 8 + (hcol >> 7)] = (mx + __builtin_amdgcn_logf(sum)) * 0.69314718056f;
}
__device__ __forceinline__ void p3_attn_mfma(Frame& F) {
    LAS unsigned char* vimg = F.lds + RING_OFF + F.wave * 8192;
    const bf16* proj = (const bf16*)(F.ws + WS_PROJ);
    float* ona = (float*)(F.ws + WS_ONA); float* odil = (float*)(F.ws + WS_ODIL); float* lse = (float*)(F.ws + WS_LSE);
    const int gw = F.vcu * NWAVES + F.wave, NGW = F.G * NWAVES, lane = F.lane;
    for (int it = gw * 2; it < NBATCH * 32 * 8 * 4; it += NGW * 2) {
#pragma unroll 1
        for (int k = 0; k < 2; ++k) {
            const int id = it + k, qt = id & 3, h = (id >> 2) & 7, r = (id >> 5) & 31, b = id >> 10;
            GeoNA G; G.tok0 = b * SEQ; G.r = r; G.rs = min(max(r - 4, 0), 24); G.c0 = 16 * qt; G.kc0 = (qt == 0) ? 0 : (qt == 1) ? 8 : (qt == 2) ? 24 : 32;
            G.qbase = G.tok0 + r * 64 + G.c0; G.kbase = G.tok0 + G.rs * 64 + G.kc0; G.rpb_h = F.rpb + h * (15 * 31);
            attn_item<8, GeoNA>(G, proj, h * HD, vimg, ona, nullptr, lane);
        }
    }
    for (int it = gw * 6; it < 3 * NBATCH * 8 * 128; it += NGW * 6) {
#pragma unroll 1
        for (int k = 0; k < 6; ++k) {
            const int id = it + k, tile = id & 127, h = (id >> 7) & 7, b = (id >> 10) & 3, p = id >> 12;
            GeoDil G; G.dsh = 2 * p; G.sub_len = SEQ >> G.dsh; const int tpc = G.sub_len >> 4;
            G.rho = tile / tpc; G.l0 = (tile - G.rho * tpc) * 16; G.tok0 = b * SEQ; G.p = p; G.h = h; G.t5 = F.t5;
            attn_item<5, GeoDil>(G, proj, h * HD, vimg, odil + (size_t)p * T * GW, lse + (size_t)p * T * 8, lane);
        }
    }
}

__device__ __forceinline__ void p4_post(Frame& F) {
    const float* ona = (const float*)(F.ws + WS_ONA); const float* odil = (const float*)(F.ws + WS_ODIL); const float* lse = (const float*)(F.ws + WS_LSE);
    bf16* aout = (bf16*)(F.ws + WS_AOUT);
    const int gw = F.vcu * NWAVES + F.wave, NGW = F.G * NWAVES, lane = F.lane;
    for (int tok = gw; tok < T; tok += NGW) {
        f32x4 v[4]; float ss = 0.f;
#pragma unroll
        for (int j = 0; j < 4; ++j) { v[j] = *(const f32x4*)(ona + (size_t)tok * GW + 4 * lane + 256 * j); ss += (v[j][0] * v[j][0] + v[j][1] * v[j][1]) + (v[j][2] * v[j][2] + v[j][3] * v[j][3]); }
        float r = 1.0f / sqrtf(wave_sum(ss) * (1.0f / GW) + EPS);
#pragma unroll
        for (int j = 0; j < 4; ++j) { const int col = 4 * lane + 256 * j; const f32x4 g = *(const f32x4*)(F.g_out_na + col);
            v2u w; w.x = pk2(v[j][0] * r * g[0], v[j][1] * r * g[1]); w.y = pk2(v[j][2] * r * g[2], v[j][3] * r * g[3]); *(v2u*)(aout + (size_t)tok * D + col) = w; }
        ss = 0.f;
#pragma unroll
        for (int j = 0; j < 4; ++j) { const int col = 4 * lane + 256 * j, h = col >> 7;
            const float l0 = lse[((size_t)0 * T + tok) * 8 + h], l1 = lse[((size_t)1 * T + tok) * 8 + h], l2 = lse[((size_t)2 * T + tok) * 8 + h];
            const float mx = fmaxf(fmaxf(l0, l1), l2); const float e0 = __expf(l0 - mx), e1 = __expf(l1 - mx), e2 = __expf(l2 - mx); const float inv = 1.0f / (e0 + e1 + e2);
            const f32x4 a0 = *(const f32x4*)(odil + ((size_t)0 * T + tok) * GW + col), a1 = *(const f32x4*)(odil + ((size_t)1 * T + tok) * GW + col), a2 = *(const f32x4*)(odil + ((size_t)2 * T + tok) * GW + col);
            v[j] = a0 * (e0 * inv) + a1 * (e1 * inv) + a2 * (e2 * inv);
            ss += (v[j][0] * v[j][0] + v[j][1] * v[j][1]) + (v[j][2] * v[j][2] + v[j][3] * v[j][3]); }
        r = 1.0f / sqrtf(wave_sum(ss) * (1.0f / GW) + EPS);
#pragma unroll
        for (int j = 0; j < 4; ++j) { const int col = 4 * lane + 256 * j; const f32x4 g = *(const f32x4*)(F.g_out_dil + col);
            v2u w; w.x = pk2(v[j][0] * r * g[0], v[j][1] * r * g[1]); w.y = pk2(v[j][2] * r * g[2], v[j][3] * r * g[3]); *(v2u*)(aout + (size_t)tok * D + GW + col) = w; }
    }
}

__device__ __forceinline__ void p6_rows(Frame& F, bool do_count) {
    LAS float* t1 = (LAS float*)(F.lds + RING_OFF);
    LAS float* t2 = t1 + D;
    LAS float* t3 = t2 + D;
    LAS unsigned* hb = (LAS unsigned*)(F.lds + RING_OFF + 3 * D * 4) + F.wave * (4 * D / 2);
    const float* mixed = (const float*)(F.ws + WS_MIXED); float* x1 = (float*)(F.ws + WS_X1); bf16* hffn = (bf16*)(F.ws + WS_HFFN);
    int* topi = (int*)(F.ws + WS_TOPI); float* topg = (float*)(F.ws + WS_TOPG);
    const int lane = F.lane;
    for (int rb = F.vcu; rb < T / 32; rb += F.G) {
        const int b = rb >> 6;
        __syncthreads();
        for (int col = F.tid; col < D; col += NWAVES * 64) { t1[col] = F.g_post_mix[col] * mod_val(F, b, 2 * D + col); t2[col] = F.g_pre_ffn[col] * (1.0f + mod_val(F, b, 4 * D + col)); t3[col] = mod_val(F, b, 3 * D + col); }
        __syncthreads();
#pragma unroll 1
        for (int rr = 0; rr < 4; ++rr) {
            const int row = rb * 32 + F.wave * 4 + rr;
            f32x4 v[8]; float ss = 0.f;
#pragma unroll
            for (int j = 0; j < 8; ++j) { v[j] = *(const f32x4*)(mixed + (size_t)row * D + 4 * lane + 256 * j); ss += (v[j][0] * v[j][0] + v[j][1] * v[j][1]) + (v[j][2] * v[j][2] + v[j][3] * v[j][3]); }
            float r = 1.0f / sqrtf(wave_sum(ss) * (1.0f / D) + EPS);
            ss = 0.f;
#pragma unroll
            for (int j = 0; j < 8; ++j) { const int col = 4 * lane + 256 * j; const f32x4 xv = *(const f32x4*)(F.x + (size_t)row * D + col); const f32x4 a = *(LAS f32x4*)(t1 + col);
                v[j] = xv + a * (v[j] * r); *(f32x4*)(x1 + (size_t)row * D + col) = v[j];
                ss += (v[j][0] * v[j][0] + v[j][1] * v[j][1]) + (v[j][2] * v[j][2] + v[j][3] * v[j][3]); }
            r = 1.0f / sqrtf(wave_sum(ss) * (1.0f / D) + EPS);
#pragma unroll
            for (int j = 0; j < 8; ++j) { const int col = 4 * lane + 256 * j; const f32x4 a = *(LAS f32x4*)(t2 + col), s = *(LAS f32x4*)(t3 + col);
                const f32x4 hv = v[j] * r * a + s;
                v2u w; w.x = pk2(hv[0], hv[1]); w.y = pk2(hv[2], hv[3]); *(v2u*)(hffn + (size_t)row * D + col) = w; *(LAS v2u*)(hb + rr * (D / 2) + (col >> 1)) = w; }
        }
        LDS_WAIT();
        const int e = lane & 31, half = lane >> 5;
        float acc[4] = {0.f, 0.f, 0.f, 0.f};
        { const float* wr = F.w_router + (size_t)(half * 1024) * NE + e; const LAS unsigned* hr = hb + half * 512;
#pragma unroll 8
          for (int kp = 0; kp < 512; ++kp) { const float w0 = wr[(size_t)(2 * kp) * NE], w1 = wr[(size_t)(2 * kp + 1) * NE];
#pragma unroll
              for (int rr = 0; rr < 4; ++rr) { const unsigned hw = hr[rr * (D / 2) + kp]; acc[rr] += bflo(hw) * w0 + bfhi(hw) * w1; } } }
        const float br = F.b_router[e];
#pragma unroll
        for (int rr = 0; rr < 4; ++rr) {
            const int row = rb * 32 + F.wave * 4 + rr;
            float a = acc[rr]; a += __shfl_xor(a, 32);
            float lg = (lane < 32) ? a + br : -INFINITY;
            int sel[4]; float val[4];
#pragma unroll
            for (int k = 0; k < 4; ++k) { const float mx = wave_max(lg); const unsigned long long bal = __ballot(lg == mx); const int idx = __ffsll((long long)bal) - 1; sel[k] = idx; val[k] = mx; if (lane == idx) lg = -INFINITY; }
            const float e1 = __expf(val[1] - val[0]), e2 = __expf(val[2] - val[0]), e3 = __expf(val[3] - val[0]); const float inv = 1.0f / (1.0f + e1 + e2 + e3);
            if (lane == 0) {
                *(int4*)(topi + (size_t)row * 4) = make_int4(sel[0], sel[1], sel[2], sel[3]);
                *(float4*)(topg + (size_t)row * 4) = make_float4(inv, e1 * inv, e2 * inv, e3 * inv);
#pragma unroll
                for (int k = 0; k < 4; ++k) if (do_count) xb_add(F.ctl + CW_CNT + sel[k], 1u);
            }
        }
    }
}

__device__ __forceinline__ void moe_tables(Frame& F) {
    __syncthreads();
    if (F.tid == 0) { int nb = 0;
        for (int e = 0; e < NE; ++e) { const int cnt = (int)xb_ld(F.ctl + CW_CNT + e); const int k = (cnt + 255) >> 8; F.MISC[32 + e] = (unsigned)(nb * 256); for (int j = 0; j < k && nb < MAXBLK; ++j) F.MISC[64 + nb++] = (unsigned)e; }
        F.MISC[16] = (unsigned)nb; }
    __syncthreads();
}
__device__ __forceinline__ void p7_slots(Frame& F) {
    moe_tables(F);
    const int* topi = (const int*)(F.ws + WS_TOPI); int* tslot = (int*)(F.ws + WS_TSLOT);
    const bf16* hffn = (const bf16*)(F.ws + WS_HFFN); bf16* xg = (bf16*)(F.ws + WS_XG);
    const int gw = F.vcu * NWAVES + F.wave, NGW = F.G * NWAVES, lane = F.lane;
    for (int pid = gw; pid < T * TOPK; pid += NGW) {
        const int t = pid >> 2; const int e = topi[pid];
        int rank = 0; if (lane == 0) rank = (int)xb_add(F.ctl + CW_CUR + e, 1u);
        rank = __builtin_amdgcn_readfirstlane(rank);
        const int slot = (int)F.MISC[32 + e] + rank;
        if (lane == 0) tslot[pid] = slot;
        const v4u* s = (const v4u*)(hffn + (size_t)t * D) + lane; v4u* d = (v4u*)(xg + (size_t)slot * D) + lane;
#pragma unroll
        for (int j = 0; j < 4; ++j) d[64 * j] = s[64 * j];
    }
}

__device__ __forceinline__ void p10_final(Frame& F) {
    LAS float* t1 = (LAS float*)(F.lds + RING_OFF);
    const float* x1 = (const float*)(F.ws + WS_X1); const bf16* yb = (const bf16*)(F.ws + WS_YB);
    const int* tslot = (const int*)(F.ws + WS_TSLOT); const float* topg = (const float*)(F.ws + WS_TOPG);
    const int lane = F.lane;
    for (int rb = F.vcu; rb < T / 32; rb += F.G) {
        const int b = rb >> 6;
        __syncthreads();
        for (int col = F.tid; col < D; col += NWAVES * 64) t1[col] = F.g_post_ffn[col] * mod_val(F, b, 5 * D + col);
        __syncthreads();
        for (int rr = F.wave; rr < 32; rr += NWAVES) {
            const int row = rb * 32 + rr;
            const int4 sl = *(const int4*)(tslot + (size_t)row * 4); const float4 gt = *(const float4*)(topg + (size_t)row * 4);
            const int sls[4] = {sl.x, sl.y, sl.z, sl.w}; const float gts[4] = {gt.x, gt.y, gt.z, gt.w};
            float y[4][8]; float ss = 0.f;
#pragma unroll
            for (int j = 0; j < 4; ++j) {
#pragma unroll
                for (int i = 0; i < 8; ++i) y[j][i] = 0.f;
#pragma unroll
                for (int k = 0; k < 4; ++k) { const v4u w = *(const v4u*)(yb + (size_t)sls[k] * D + 8 * lane + 512 * j); const float g = gts[k];
                    y[j][0] += g * bflo(w.x); y[j][1] += g * bfhi(w.x); y[j][2] += g * bflo(w.y); y[j][3] += g * bfhi(w.y); y[j][4] += g * bflo(w.z); y[j][5] += g * bfhi(w.z); y[j][6] += g * bflo(w.w); y[j][7] += g * bfhi(w.w); }
#pragma unroll
                for (int i = 0; i < 8; ++i) ss += y[j][i] * y[j][i];
            }
            const float r = 1.0f / sqrtf(wave_sum(ss) * (1.0f / D) + EPS);
#pragma unroll
            for (int j = 0; j < 4; ++j) { const int col = 8 * lane + 512 * j;
#pragma unroll
                for (int hh = 0; hh < 2; ++hh) { const f32x4 xv = *(const f32x4*)(x1 + (size_t)row * D + col + 4 * hh); const f32x4 a = *(LAS f32x4*)(t1 + col + 4 * hh);
                    f32x4 o; o[0] = xv[0] + a[0] * y[j][4 * hh + 0] * r; o[1] = xv[1] + a[1] * y[j][4 * hh + 1] * r; o[2] = xv[2] + a[2] * y[j][4 * hh + 2] * r; o[3] = xv[3] + a[3] * y[j][4 * hh + 3] * r;
                    *(f32x4*)(F.out + (size_t)row * D + col + 4 * hh) = o; } }
        }
    }
}

struct Args { const float* in[20]; float* out; unsigned char* ws; int ph_lo, ph_hi; };
__global__ void __launch_bounds__(NWAVES * 64, 2) fwd_kernel(Args args) {
    extern __shared__ __attribute__((aligned(16))) unsigned char lds[];
    Frame F;
    F.lds = (LAS unsigned char*)lds;
    F.MISC = (volatile LAS unsigned*)(F.lds + MISC_OFF);
    F.tid = threadIdx.x; F.lane = F.tid & 63; F.wave = __builtin_amdgcn_readfirstlane(F.tid >> 6);
    F.G = gridDim.x; { const int bx = blockIdx.x; F.vcu = (F.G % 8 == 0) ? (bx % 8) * (F.G / 8) + bx / 8 : bx; }
    F.ws = args.ws; F.ctl = (unsigned*)(args.ws + WS_CTL); F.out = args.out;
    F.x = args.in[0]; F.c = args.in[1]; F.w_ada = args.in[2]; F.b_ada = args.in[3]; F.g_pre_mix = args.in[4]; F.g_post_mix = args.in[5]; F.w_in = args.in[6]; F.rpb = args.in[7]; F.t5 = args.in[8];
    F.g_out_na = args.in[9]; F.g_out_dil = args.in[10]; F.w_o = args.in[11]; F.g_pre_ffn = args.in[12]; F.g_post_ffn = args.in[13]; F.w_router = args.in[14]; F.b_router = args.in[15];
    F.w_e_in = args.in[16]; F.b_e_in = args.in[17]; F.w_e_out = args.in[18]; F.b_e_out = args.in[19];
    for (int u = F.tid; u < 256; u += NWAVES * 64) F.MISC[u] = 0u;
    __syncthreads();
    XcdBarrier bar; bar.bar = F.ctl + CW_BAR; bar.x = 0; bar.st = nullptr;
    if (MK_N_LAUNCHES == 1) bar = xcd_barrier_post(F.ctl + CW_BAR, F.MISC + 8);
    const int lo = args.ph_lo, hi = args.ph_hi;
#define IN(k) (lo <= (k) && (k) < hi)
#ifndef PROBE_REPEAT
#define PROBE_REPEAT -1
#endif
#define REP(k) ((PROBE_REPEAT == (k)) ? 2 : 1)
#define SEAM(k) do { if (IN(k) && IN((k) + 1)) xcd_barrier(bar); } while (0)

    if (IN(0)) { for (int rep = 0; rep < REP(0); ++rep) p0_prologue(F); } SEAM(0);
    if (IN(1)) { p1_hmix(F); } SEAM(1);
    if (IN(2)) {
        pg8::Gemm g{(const bf16*)(F.ws + WS_HMIX), (const bf16*)(F.ws + WS_WIN_T), T, NQKV, D}; pg8::StaticOrder S; S.init(T, NQKV, F.G, (int)blockIdx.x);
        pg8::EpiBf16 E{(bf16*)(F.ws + WS_PROJ), NQKV, nullptr, 0};
        __syncthreads();
        pg8::gemm_phase<pg8::EpiBf16, pg8::StaticOrder, true, true>(F.lds + RING_OFF, g, S, E);
    } SEAM(2);
    #ifdef ATTN_NAIVE
    if (IN(3)) { p3_attn_naive(F); } SEAM(3);
#else
    if (IN(3)) { for (int rep = 0; rep < REP(3); ++rep) { __syncthreads(); p3_attn_mfma(F); } } SEAM(3);
#endif
    if (IN(4)) { p4_post(F); } SEAM(4);
    if (IN(5)) {
        pg8::Gemm g{(const bf16*)(F.ws + WS_AOUT), (const bf16*)(F.ws + WS_WO_T), T, D, D}; pg8::StaticOrder S; S.init(T, D, F.G, (int)blockIdx.x);
        pg8::EpiF32 E{(float*)(F.ws + WS_MIXED), D};
        __syncthreads();
        pg8::gemm_phase<pg8::EpiF32, pg8::StaticOrder, true, true>(F.lds + RING_OFF, g, S, E);
    } SEAM(5);
    if (IN(6)) { for (int rep = 0; rep < REP(6); ++rep) p6_rows(F, rep == 0); } SEAM(6);
    if (IN(7)) { p7_slots(F); } SEAM(7);
    if (IN(8)) {
        moe_tables(F);
        pg8::Gemm g{(const bf16*)(F.ws + WS_XG), (const bf16*)(F.ws + WS_WEI_T), MAXBLK * 256, FF2, D};
        pg8::MoeOrder<16> S{(const LAS int*)(F.lds + MISC_OFF + 64 * 4), (int)F.MISC[16], F.G, (int)blockIdx.x};
        pg8::EpiSwiglu E{(bf16*)(F.ws + WS_HB), FF, F.b_e_in, FF2};
        pg8::gemm_phase<pg8::EpiSwiglu, pg8::MoeOrder<16>, true, true>(F.lds + RING_OFF, g, S, E);
    } SEAM(8);
    if (IN(9)) {
        moe_tables(F);
        pg8::Gemm g{(const bf16*)(F.ws + WS_HB), (const bf16*)(F.ws + WS_WEO_T), MAXBLK * 256, D, FF};
        pg8::MoeOrder<8> S{(const LAS int*)(F.lds + MISC_OFF + 64 * 4), (int)F.MISC[16], F.G, (int)blockIdx.x};
        pg8::EpiBf16 E{(bf16*)(F.ws + WS_YB), D, F.b_e_out, D};
        pg8::gemm_phase<pg8::EpiBf16, pg8::MoeOrder<8>, true, true>(F.lds + RING_OFF, g, S, E);
    } SEAM(9);
    if (IN(10)) { p10_final(F); }
#undef IN
#undef SEAM
}

extern "C" void kernel_launch(void* const* d_in, const int* in_sizes, int n_in, void* d_out, int out_size, void* d_ws, size_t ws_size, hipStream_t stream) {
    static int grid = 0;
    if (grid == 0) {
        if (n_in != 20 || out_size != T * D || ws_size < WS_END) { fprintf(stderr, "kernel_launch: unexpected problem (n_in %d, out %d, ws %zu)\n", n_in, out_size, ws_size); grid = -1; return; }
        int dev = 0, cus = 0, per_cu = 0;
        if (hipGetDevice(&dev) != hipSuccess || hipDeviceGetAttribute(&cus, hipDeviceAttributeMultiprocessorCount, dev) != hipSuccess) { grid = -1; return; }
        if (hipFuncSetAttribute((const void*)fwd_kernel, hipFuncAttributeMaxDynamicSharedMemorySize, LDS_BYTES) != hipSuccess) { fprintf(stderr, "kernel_launch: hipFuncSetAttribute failed\n"); grid = -1; return; }
        if (hipOccupancyMaxActiveBlocksPerMultiprocessor(&per_cu, (const void*)fwd_kernel, NWAVES * 64, LDS_BYTES) != hipSuccess || per_cu < 1) { fprintf(stderr, "kernel_launch: occupancy query reports %d\n", per_cu); }
        (void)hipGetLastError();
        grid = cus;
    }
    if (grid < 0) return;
    if (hipMemsetAsync((char*)d_ws + WS_CTL, 0, CTL_ZERO_BYTES, stream) != hipSuccess) return;
    Args a{};
    for (int i = 0; i < 20; ++i) a.in[i] = (const float*)d_in[i];
    a.out = (float*)d_out; a.ws = (unsigned char*)d_ws;
    if (MK_N_LAUNCHES == 1) {
        a.ph_lo = 0; a.ph_hi = NPHASE;
        hipLaunchKernelGGL(fwd_kernel, dim3(grid), dim3(NWAVES * 64), LDS_BYTES, stream, a);
    } else {
        for (int p = 0; p < NPHASE; ++p) { a.ph_lo = p; a.ph_hi = p + 1; hipLaunchKernelGGL(fwd_kernel, dim3(grid), dim3(NWAVES * 64), LDS_BYTES, stream, a); }
    }
}
```

```cpp
#include <hip/hip_runtime.h>
#include <cstdio>
#include <cstdint>

#ifndef MK_N_LAUNCHES
#define MK_N_LAUNCHES 1
#endif

namespace pg8 {
#define PG8_LAS __attribute__((address_space(3)))
typedef unsigned short bf16_t;
typedef short bf16x8 __attribute__((ext_vector_type(8)));
typedef float f32x4 __attribute__((ext_vector_type(4)));
typedef unsigned u32x4 __attribute__((ext_vector_type(4)));
typedef unsigned u32x2 __attribute__((ext_vector_type(2)));
constexpr int BM = 256, BK = 64, HALF = 128, HTB = HALF * BK * 2  , STAGE_BYTES = 8 * HTB, NXCD = 8, WGM = 8;

__host__ __device__ __forceinline__ int lds_byte(int r, int c) { const int st = (r >> 4) * 2 + (c >> 5), rr = r & 15, cc = c & 31, ob = rr * 64 + cc * 2; return st * 1024 + (ob ^ (((ob >> 9) & 1) << 5)); }
__host__ __device__ __forceinline__ void stage_rc(int b, int& R, int& C) { const int st = b / 1024, sb = b % 1024, swz = sb ^ (((sb >> 9) & 1) << 5); R = (st >> 1) * 16 + swz / 64; C = (st & 1) * 32 + (swz % 64) / 2; }
__host__ __device__ __forceinline__ int perm32(int rho) { const int n = rho >> 4, i = rho & 15; return 8 * (i >> 2) + 4 * n + (i & 3); }

struct Unit { int pm, pn, bt, e; };
struct Gemm { const bf16_t* A; const bf16_t* Bt; int M, N, K; };

struct StaticOrder {
    int nM, nN, nwg, G, c;
    __host__ __device__ void init(int M, int N, int G_, int c_) { nM = M / BM; nN = N / BM; nwg = nM * nN; G = G_; c = c_; }
    __host__ __device__ bool next(int i, Unit& u) const {
        const long L = (long)i * G + c; if (L >= nwg) return false;
        int wgid = (int)L; { const int q = nwg / NXCD, r = nwg % NXCD, xcd = wgid % NXCD, off = wgid / NXCD; wgid = (xcd < r ? xcd * (q + 1) : r * (q + 1) + (xcd - r) * q) + off; }
        const int nig = WGM * nN, gid = wgid / nig, fm = gid * WGM, gsz = (nM - fm) < WGM ? (nM - fm) : WGM;
        u.pm = fm + ((wgid % nig) % gsz); u.pn = (wgid % nig) / gsz; u.bt = u.pn; u.e = 0; return true;
    }
    __device__ __forceinline__ void a_ready(const Unit&) const {}
    __device__ __forceinline__ void done(const Unit&) const {}
};
template <int NPN> struct MoeOrder {
    const PG8_LAS int* blk_e; int nb, G, c;
    __device__ __forceinline__ bool next(int i, Unit& u) const {
        int L = i * G + c;
        if (G == 256) L = ((i * 8 + (c & 7)) << 5) + (c >> 3);
        const int g = L >> 5, r = L & 31;
        int block, pn;
        if (NPN == 16) { block = 4 * (g >> 1) + (r & 3); pn = 8 * (g & 1) + (r >> 2); } else { block = 4 * g + (r & 3); pn = r >> 2; }
        if (block >= nb) return false;
        u.pm = block; u.pn = pn; u.e = blk_e[block]; u.bt = u.e * NPN + pn; return true;
    }
    __device__ __forceinline__ void a_ready(const Unit&) const {}
    __device__ __forceinline__ void done(const Unit&) const {}
};

__device__ __forceinline__ unsigned cvt_pk_bf16(float lo, float hi) { unsigned r; asm volatile("v_cvt_pk_bf16_f32 %0, %1, %2" : "=v"(r) : "v"(lo), "v"(hi)); return r; }

struct EpiF32 {
    static constexpr bool PERM = false, AFTER_DRAIN = false;
    float* C; int ldc;
    __device__ __forceinline__ void operator()(const f32x4 (&acc)[2][2][4][2], const Unit& u, int wr, int wc, int fr, int fq) const {
        const int row0 = u.pm * BM + wr * 64 + fr, col0 = u.pn * BM + wc * 32 + 4 * fq;
#pragma unroll
        for (int ai = 0; ai < 2; ++ai)
#pragma unroll
            for (int m = 0; m < 4; ++m) { float* rowp = C + (size_t)(row0 + ai * HALF + m * 16) * ldc + col0;
#pragma unroll
                for (int bj = 0; bj < 2; ++bj)
#pragma unroll
                    for (int n = 0; n < 2; ++n) *(f32x4*)(rowp + bj * HALF + n * 16) = acc[ai][bj][m][n]; }
    }
};
struct EpiBf16 {
    static constexpr bool PERM = true, AFTER_DRAIN = false;
    bf16_t* O; int ldc; const float* bias; int bias_estride;
    __device__ __forceinline__ void operator()(const f32x4 (&acc)[2][2][4][2], const Unit& u, int wr, int wc, int fr, int fq) const {
        const int row0 = u.pm * BM + wr * 64 + fr; const int col0 = u.pn * BM + wc * 32 + 8 * fq;
        f32x4 bv[2][2];
#pragma unroll
        for (int bj = 0; bj < 2; ++bj)
#pragma unroll
            for (int n = 0; n < 2; ++n) bv[bj][n] = bias ? *(const f32x4*)(bias + (size_t)u.e * bias_estride + col0 + bj * HALF + 4 * n) : (f32x4){0.f, 0.f, 0.f, 0.f};
#pragma unroll
        for (int ai = 0; ai < 2; ++ai)
#pragma unroll
            for (int m = 0; m < 4; ++m) { bf16_t* rowp = O + (size_t)(row0 + ai * HALF + m * 16) * ldc + col0;
#pragma unroll
                for (int bj = 0; bj < 2; ++bj) { const f32x4 v0 = acc[ai][bj][m][0] + bv[bj][0], v1 = acc[ai][bj][m][1] + bv[bj][1];
                    u32x4 w; w.x = cvt_pk_bf16(v0[0], v0[1]); w.y = cvt_pk_bf16(v0[2], v0[3]); w.z = cvt_pk_bf16(v1[0], v1[1]); w.w = cvt_pk_bf16(v1[2], v1[3]);
                    *(u32x4*)(rowp + bj * HALF) = w; } }
    }
};
__device__ __forceinline__ float swiglu1(float g, float u) {
    g = fminf(g, 7.0f); u = fminf(fmaxf(u, -7.0f), 7.0f);
    const float s = __builtin_amdgcn_rcpf(1.0f + __builtin_amdgcn_exp2f(g * (-1.702f * 1.44269504089f)));
    return (u + 1.0f) * (g * s);
}
struct EpiSwiglu {
    static constexpr bool PERM = true, AFTER_DRAIN = false;
    bf16_t* H; int ldh; const float* bias; int bias_estride;
    __device__ __forceinline__ void operator()(const f32x4 (&acc)[2][2][4][2], const Unit& u, int wr, int wc, int fr, int fq) const {
        const int row0 = u.pm * BM + wr * 64 + fr; const int col0 = u.pn * BM + wc * 32 + 8 * fq;
        f32x4 bv[2][2];
#pragma unroll
        for (int bj = 0; bj < 2; ++bj)
#pragma unroll
            for (int n = 0; n < 2; ++n) bv[bj][n] = *(const f32x4*)(bias + (size_t)u.e * bias_estride + col0 + bj * HALF + 4 * n);
#pragma unroll
        for (int ai = 0; ai < 2; ++ai)
#pragma unroll
            for (int m = 0; m < 4; ++m) { bf16_t* rowp = H + (size_t)(row0 + ai * HALF + m * 16) * ldh + (col0 >> 1);
#pragma unroll
                for (int bj = 0; bj < 2; ++bj) { const f32x4 v0 = acc[ai][bj][m][0] + bv[bj][0], v1 = acc[ai][bj][m][1] + bv[bj][1];
                    u32x2 w; w.x = cvt_pk_bf16(swiglu1(v0[0], v0[1]), swiglu1(v0[2], v0[3])); w.y = cvt_pk_bf16(swiglu1(v1[0], v1[1]), swiglu1(v1[2], v1[3]));
                    *(u32x2*)(rowp + bj * (HALF / 2)) = w; } }
    }
};

template <class Epi, class Sched, bool ALIGN_EPI = false, bool SP2 = false>
__device__ __forceinline__ void gemm_phase(PG8_LAS unsigned char* lds, const Gemm g, const Sched& S, const Epi& E) {
    const int tid = threadIdx.x, wid = __builtin_amdgcn_readfirstlane(tid >> 6), lane = tid & 63, wr = wid >> 2, wc = wid & 3, fr = lane & 15, fq = lane >> 4;
    const int K = g.K, nt = K / BK;
    unsigned voffA[2], voffB[2];
#pragma unroll
    for (int i = 0; i < 2; ++i) { int R, C; stage_rc(tid * 16 + i * 8192, R, C); const int Rb = Epi::PERM ? ((R & ~31) + perm32(R & 31)) : R;
        voffA[i] = (unsigned)(R * K + C) * 2u; voffB[i] = (unsigned)(Rb * K + C) * 2u; }
    const size_t kstep = (size_t)(BK * 2);
    const size_t hstep = (size_t)HALF * K * 2;
    const size_t tstep = 2 * hstep;
    const unsigned ldsw = (unsigned)wid * 1024u;
    const int aoff = lds_byte(wr * 64 + fr, fq * 8), boff = lds_byte(wc * 32 + fr, fq * 8);
#define PG8_SA(b, h) (((b) * 2 + (h)) * HTB)
#define PG8_SB(b, h) ((4 + (b) * 2 + (h)) * HTB)
#define PG8_STAGE(bufoff, gbase, voff) do { _Pragma("unroll") for (int _i = 0; _i < 2; ++_i) \
        __builtin_amdgcn_global_load_lds((const unsigned*)((const char*)(gbase) + (voff)[_i]), (PG8_LAS unsigned*)(lds + (bufoff) + ldsw + _i * 8192), 16, 0, 0); } while (0)
#define PG8_LDA(dst, b, h) do { _Pragma("unroll") for (int m = 0; m < 4; ++m) _Pragma("unroll") for (int k = 0; k < 2; ++k) dst[m][k] = *(const PG8_LAS bf16x8*)(lds + PG8_SA(b, h) + aoff + m * 2048 + k * 1024); } while (0)
#define PG8_LDB(dst, b, h) do { _Pragma("unroll") for (int n = 0; n < 2; ++n) _Pragma("unroll") for (int k = 0; k < 2; ++k) dst[n][k] = *(const PG8_LAS bf16x8*)(lds + PG8_SB(b, h) + boff + n * 2048 + k * 1024); } while (0)
#define PG8_MMA(ai, bj, At, Bt) do { __builtin_amdgcn_s_setprio(1); _Pragma("unroll") for (int m = 0; m < 4; ++m) _Pragma("unroll") for (int n = 0; n < 2; ++n) _Pragma("unroll") for (int k = 0; k < 2; ++k) \
        acc[ai][bj][m][n] = __builtin_amdgcn_mfma_f32_16x16x32_bf16(Bt[n][k], At[m][k], acc[ai][bj][m][n], 0, 0, 0); __builtin_amdgcn_s_setprio(0); } while (0)
#define PG8_WAIT_V(n) asm volatile("s_waitcnt vmcnt(" #n ")" ::: "memory")
#define PG8_WAIT_L(n) asm volatile("s_waitcnt lgkmcnt(" #n ")" ::: "memory")
#define PG8_BAR __builtin_amdgcn_s_barrier()
#define PG8_SCHED __builtin_amdgcn_sched_barrier(0)
    Unit cur, nxt; int ui = 0;
    if (!S.next(0, cur)) return;
    f32x4 acc[2][2][4][2];
#pragma unroll
    for (int a = 0; a < 2; ++a)
#pragma unroll
        for (int b = 0; b < 2; ++b)
#pragma unroll
            for (int m = 0; m < 4; ++m)
#pragma unroll
                for (int n = 0; n < 2; ++n) acc[a][b][m][n] = (f32x4){0.f, 0.f, 0.f, 0.f};
    bf16x8 At[4][2], B0[2][2], B1[2][2];
    const char* cA = (const char*)g.A + (size_t)cur.pm * tstep; const char* cB = (const char*)g.Bt + (size_t)cur.bt * tstep;
    S.a_ready(cur);
    if constexpr (SP2) {
        PG8_STAGE(PG8_SB(0, 0), cB, voffB); PG8_STAGE(PG8_SB(0, 1), cB + hstep, voffB); PG8_STAGE(PG8_SA(0, 0), cA, voffA); PG8_STAGE(PG8_SA(0, 1), cA + hstep, voffA);
        if (wr == 1) PG8_BAR;
        PG8_WAIT_V(2); PG8_BAR;
        PG8_STAGE(PG8_SB(1, 0), cB + kstep, voffB); PG8_STAGE(PG8_SA(1, 0), cA + kstep, voffA); PG8_STAGE(PG8_SB(1, 1), cB + hstep + kstep, voffB);
        PG8_WAIT_V(6); PG8_BAR;
    } else {
        PG8_STAGE(PG8_SB(0, 0), cB, voffB); PG8_STAGE(PG8_SA(0, 0), cA, voffA); PG8_STAGE(PG8_SB(0, 1), cB + hstep, voffB); PG8_STAGE(PG8_SA(0, 1), cA + hstep, voffA);
        if (wr == 1) PG8_BAR;
        PG8_WAIT_V(4); PG8_BAR;
        PG8_STAGE(PG8_SB(1, 0), cB + kstep, voffB); PG8_STAGE(PG8_SA(1, 0), cA + kstep, voffA); PG8_STAGE(PG8_SB(1, 1), cB + hstep + kstep, voffB);
        PG8_WAIT_V(6); PG8_BAR;
    }
    for (;;) {
        const bool has_next = S.next(ui + 1, nxt);
        const char* nA = has_next ? (const char*)g.A + (size_t)nxt.pm * tstep : cA; const char* nB = has_next ? (const char*)g.Bt + (size_t)nxt.bt * tstep : cB;
        for (int t = 0; t < nt; t += 2) {
            const bool last = (t == nt - 2);
            const char* a1 = cA + (size_t)(t + 1) * kstep;
            const char* a2 = last ? nA : cA + (size_t)(t + 2) * kstep; const char* b2 = last ? nB : cB + (size_t)(t + 2) * kstep;
            const char* a3 = a2 + kstep; const char* b3 = b2 + kstep;
            if (last && has_next) S.a_ready(nxt);
            if constexpr (SP2) {
            PG8_LDB(B0, 0, 0); PG8_LDB(B1, 0, 1); PG8_SCHED; PG8_LDA(At, 0, 0); PG8_STAGE(PG8_SA(1, 1), a1 + hstep, voffA);
            PG8_WAIT_V(8); PG8_WAIT_L(0); PG8_BAR; PG8_MMA(0, 0, At, B0); PG8_MMA(0, 1, At, B1); PG8_BAR; PG8_SCHED;
            PG8_LDA(At, 0, 1); PG8_STAGE(PG8_SB(0, 0), b2, voffB); PG8_STAGE(PG8_SB(0, 1), b2 + hstep, voffB); PG8_STAGE(PG8_SA(0, 0), a2, voffA);
            PG8_WAIT_V(8); PG8_WAIT_L(0); PG8_BAR; PG8_MMA(1, 0, At, B0); PG8_MMA(1, 1, At, B1); PG8_BAR; PG8_SCHED;
            PG8_LDB(B0, 1, 0); PG8_LDB(B1, 1, 1); PG8_SCHED; PG8_LDA(At, 1, 0); PG8_STAGE(PG8_SA(0, 1), a2 + hstep, voffA);
            PG8_WAIT_V(8); PG8_WAIT_L(0); PG8_BAR; PG8_MMA(0, 0, At, B0); PG8_MMA(0, 1, At, B1); PG8_BAR; PG8_SCHED;
            PG8_LDA(At, 1, 1); PG8_STAGE(PG8_SB(1, 0), b3, voffB); PG8_STAGE(PG8_SB(1, 1), b3 + hstep, voffB); PG8_STAGE(PG8_SA(1, 0), a3, voffA);
            PG8_WAIT_V(8); PG8_WAIT_L(0); PG8_BAR; PG8_MMA(1, 0, At, B0); PG8_MMA(1, 1, At, B1); PG8_BAR; PG8_SCHED;
            } else {
            PG8_LDB(B0, 0, 0); PG8_SCHED; PG8_LDA(At, 0, 0); PG8_STAGE(PG8_SA(1, 1), a1 + hstep, voffA);
            PG8_WAIT_L(8); PG8_BAR; PG8_WAIT_L(0); PG8_MMA(0, 0, At, B0); PG8_BAR; PG8_SCHED;
            PG8_LDB(B1, 0, 1); PG8_STAGE(PG8_SB(0, 0), b2, voffB);
            PG8_BAR; PG8_WAIT_L(0); PG8_MMA(0, 1, At, B1); PG8_BAR;
            PG8_LDA(At, 0, 1); PG8_STAGE(PG8_SA(0, 0), a2, voffA);
            PG8_BAR; PG8_WAIT_L(0); PG8_MMA(1, 0, At, B0); PG8_BAR; PG8_SCHED;
            PG8_STAGE(PG8_SB(0, 1), b2 + hstep, voffB);
            PG8_WAIT_V(6); PG8_BAR; PG8_MMA(1, 1, At, B1); PG8_BAR;
            PG8_LDB(B0, 1, 0); PG8_SCHED; PG8_LDA(At, 1, 0); PG8_STAGE(PG8_SA(0, 1), a2 + hstep, voffA);
            PG8_WAIT_L(8); PG8_BAR; PG8_WAIT_L(0); PG8_MMA(0, 0, At, B0); PG8_BAR; PG8_SCHED;
            PG8_LDB(B1, 1, 1); PG8_STAGE(PG8_SB(1, 0), b3, voffB);
            PG8_BAR; PG8_WAIT_L(0); PG8_MMA(0, 1, At, B1); PG8_BAR;
            PG8_LDA(At, 1, 1); PG8_STAGE(PG8_SA(1, 0), a3, voffA);
            PG8_BAR; PG8_WAIT_L(0); PG8_MMA(1, 0, At, B0); PG8_BAR; PG8_SCHED;
            PG8_STAGE(PG8_SB(1, 1), b3 + hstep, voffB);
            PG8_WAIT_V(6); PG8_BAR; PG8_MMA(1, 1, At, B1); PG8_BAR;
            }
        }
        if constexpr (ALIGN_EPI) { if (wr == 0) PG8_BAR; }
        if constexpr (!Epi::AFTER_DRAIN) { E(acc, cur, wr, wc, fr, fq); S.done(cur); }
        if (!has_next) break;
#pragma unroll
        for (int a = 0; a < 2; ++a)
#pragma unroll
            for (int b = 0; b < 2; ++b)
#pragma unroll
                for (int m = 0; m < 4; ++m)
#pragma unroll
                    for (int n = 0; n < 2; ++n) acc[a][b][m][n] = (f32x4){0.f, 0.f, 0.f, 0.f};
        cur = nxt; cA = nA; cB = nB; ++ui;
        if constexpr (ALIGN_EPI) { if (wr == 1) PG8_BAR; }
    }
    PG8_WAIT_V(0);
    if constexpr (!ALIGN_EPI) { if (wr == 0) PG8_BAR; }
    PG8_BAR;
    if constexpr (Epi::AFTER_DRAIN) { E.fused(acc, cur, wr, wc, fr, fq, lds, wid, lane); S.done(cur); }
#undef PG8_SA
#undef PG8_SB
#undef PG8_STAGE
#undef PG8_LDA
#undef PG8_LDB
#undef PG8_MMA
#undef PG8_WAIT_V
#undef PG8_WAIT_L
#undef PG8_BAR
#undef PG8_SCHED
}
}

constexpr int NWAVES = 8;
constexpr int NBATCH = 4, SEQ = 2048, T = NBATCH * SEQ, D = 2048, HD = 128, NHG = 8, GW = 1024, NQKV = 6144, NE = 32, TOPK = 4, FF = 2048, FF2 = 4096;
constexpr int MAXBLK = 160;
constexpr float EPS = 1e-6f;
constexpr int NPHASE = 11;

constexpr size_t MiB = 1u << 20;
constexpr size_t WS_CTL = 0, CTL_ZERO_BYTES = 1 * MiB;
constexpr size_t WS_MODP = 1 * MiB;
constexpr size_t WS_TOPI = 5 * MiB, WS_TOPG = WS_TOPI + 131072, WS_TSLOT = WS_TOPG + 131072;
constexpr size_t WS_TRANK = WS_TSLOT + 131072, WS_HIST = WS_TRANK + 131072;
constexpr size_t WS_LSE = 6 * MiB;
constexpr size_t WS_WIN_T = 8 * MiB;
constexpr size_t WS_WO_T = 32 * MiB;
constexpr size_t WS_HMIX = 40 * MiB;
constexpr size_t WS_AOUT = 72 * MiB;
constexpr size_t WS_PROJ = 104 * MiB;
constexpr size_t WS_ONA = 200 * MiB;
constexpr size_t WS_ODIL = 232 * MiB;
constexpr size_t WS_MIXED = 328 * MiB;
constexpr size_t WS_X1 = 392 * MiB;
constexpr size_t WS_HFFN = 456 * MiB;
constexpr size_t WS_XG = 492 * MiB;
constexpr size_t WS_HB = 652 * MiB;
constexpr size_t WS_YB = 812 * MiB;
constexpr size_t WS_WEI_T = 1024 * MiB;
constexpr size_t WS_WEO_T = 1536 * MiB;
constexpr size_t WS_END = 1792 * MiB;
constexpr int CW_TMO = 0, CW_CODE = 1, CW_CNT = 256, CW_CUR = 512, CW_BAR = 4096;

constexpr int RING_OFF = 0, RING_BYTES = 155648;
constexpr int MISC_OFF = RING_BYTES;
constexpr int LDS_BYTES = RING_BYTES + 1024;

#define GAS __attribute__((address_space(1)))
#define LAS __attribute__((address_space(3)))
typedef unsigned short bf16;
typedef unsigned v4u __attribute__((ext_vector_type(4)));
typedef unsigned v2u __attribute__((ext_vector_type(2)));
typedef float f32x4 __attribute__((ext_vector_type(4)));
typedef GAS unsigned gu32;
#define RLX_AGENT __ATOMIC_RELAXED, __HIP_MEMORY_SCOPE_AGENT
#define LDS_WAIT() asm volatile("s_waitcnt lgkmcnt(0)" ::: "memory")
#define VM_WAIT() asm volatile("s_waitcnt vmcnt(0)" ::: "memory")
__device__ __forceinline__ float bf2f(unsigned short h) { return __builtin_bit_cast(float, (unsigned)h << 16); }
__device__ __forceinline__ float bflo(unsigned w) { return __builtin_bit_cast(float, w << 16); }
__device__ __forceinline__ float bfhi(unsigned w) { return __builtin_bit_cast(float, w & 0xffff0000u); }
__device__ __forceinline__ unsigned pk2(float lo, float hi) { return pg8::cvt_pk_bf16(lo, hi); }

#define XB_TMO      128
#define XB_XCNT(j)  (256  + 64 * (j))
#define XB_XSUB(j)  (1280 + 64 * (j))
#define XB_XGEN(j)  (2304 + 64 * (j))
#define XB_TOP      3328
#define XB_TOPGEN   3392
#define XCD_BAR_WORDS 3456
#define XB_SPIN_CAP (1u << 18)
__device__ __forceinline__ unsigned xb_ld(unsigned* p)              { return __hip_atomic_load(p, __ATOMIC_RELAXED, __HIP_MEMORY_SCOPE_AGENT); }
__device__ __forceinline__ unsigned xb_add(unsigned* p, unsigned v) { return __hip_atomic_fetch_add(p, v, __ATOMIC_RELAXED, __HIP_MEMORY_SCOPE_AGENT); }
__device__ __forceinline__ unsigned xb_xcc_id() { return (unsigned)__builtin_amdgcn_s_getreg((3 << 11) | 20) & 0xFu; }
#define XB_SPIN(cond, bar) do { unsigned _sp = 0; while (cond) { __builtin_amdgcn_s_sleep(1); \
    if ((++_sp & 255u) == 0u) { if (xb_ld(&(bar)[XB_TMO])) break; if (_sp > XB_SPIN_CAP) { atomicAdd(&(bar)[XB_TMO], 1u); break; } } } } while (0)
struct XcdBarrier { unsigned* bar; unsigned x; volatile LAS unsigned* st; };
__device__ __forceinline__ XcdBarrier xcd_barrier_post(unsigned* bar, volatile LAS unsigned* st) {
    XcdBarrier b; b.bar = bar; b.x = xb_xcc_id(); b.st = st;
    if (threadIdx.x == 0) (void)xb_add(&bar[XB_XCNT(b.x)], 1u);
    return b;
}
__device__ __forceinline__ void xcd_barrier_complete(unsigned* bar, unsigned x, unsigned& nloc, unsigned& nx) {
    const unsigned G = gridDim.x * gridDim.y * gridDim.z;
    unsigned sum, cnt, mine, sp = 0u;
    for (;;) {
        sum = 0u; cnt = 0u; mine = 0u;
#pragma unroll
        for (unsigned j = 0; j < 16; ++j) { const unsigned c = xb_ld(&bar[XB_XCNT(j)]); sum += c; cnt += (c > 0u) ? 1u : 0u; mine = (j == x) ? c : mine; }
        if (sum == G) break;
        __builtin_amdgcn_s_sleep(1);
        if ((++sp & 255u) == 0u) { if (xb_ld(&bar[XB_TMO])) break; if (sp > XB_SPIN_CAP) { atomicAdd(&bar[XB_TMO], 1u); break; } }
    }
    nloc = mine > 0u ? mine : 1u; nx = cnt > 0u ? cnt : 1u;
}
__device__ __forceinline__ void xcd_barrier(const XcdBarrier& b) {
    asm volatile("s_waitcnt vmcnt(0)" ::: "memory");
    __syncthreads();
    if (threadIdx.x == 0) {
        unsigned* bar = b.bar;
        __builtin_amdgcn_s_waitcnt(0);
        unsigned nloc = b.st[0], nx = b.st[1];
        if (nloc == 0u) { xcd_barrier_complete(bar, b.x, nloc, nx); b.st[0] = nloc; b.st[1] = nx; }
        const unsigned old = xb_add(&bar[XB_XSUB(b.x)], 1u);
        const unsigned gen = old / nloc;
        if (old + 1u == (gen + 1u) * nloc) {
            __builtin_amdgcn_fence(__ATOMIC_RELEASE, "agent");
            asm volatile("s_waitcnt vmcnt(0)" ::: "memory");
            const unsigned og = xb_add(&bar[XB_TOP], 1u);
            const unsigned tg = og / nx;
            if (og + 1u == (tg + 1u) * nx) xb_add(&bar[XB_TOPGEN], 1u);
            else XB_SPIN(xb_ld(&bar[XB_TOPGEN]) == tg, bar);
            __builtin_amdgcn_fence(__ATOMIC_ACQUIRE, "agent");
            xb_add(&bar[XB_XGEN(b.x)], 1u);
            asm volatile("s_waitcnt vmcnt(0)" ::: "memory");
        } else {
            XB_SPIN(xb_ld(&bar[XB_XGEN(b.x)]) == gen, bar);
            __builtin_amdgcn_fence(__ATOMIC_ACQUIRE, "agent");
            asm volatile("s_waitcnt vmcnt(0)" ::: "memory");
        }
    }
    __syncthreads();
}

struct Frame {
    LAS unsigned char* lds;
    volatile LAS unsigned* MISC;
    unsigned* ctl;
    int tid, lane, wave, vcu, G;
    const float *x, *c, *w_ada, *b_ada, *g_pre_mix, *g_post_mix, *w_in, *rpb, *t5, *g_out_na, *g_out_dil, *w_o, *g_pre_ffn, *g_post_ffn, *w_router, *b_router, *w_e_in, *b_e_in, *w_e_out, *b_e_out;
    float* out;
    unsigned char* ws;
};
__device__ __forceinline__ float wave_sum(float v) {
#pragma unroll
    for (int o = 1; o < 64; o <<= 1) v += __shfl_xor(v, o);
    return v;
}
__device__ __forceinline__ float wave_max(float v) {
#pragma unroll
    for (int o = 1; o < 64; o <<= 1) v = fmaxf(v, __shfl_xor(v, o));
    return v;
}
__device__ __forceinline__ float mod_val(const Frame& F, int b, int idx) {
    const float* mp = (const float*)(F.ws + WS_MODP);
    float s = F.b_ada[idx];
#pragma unroll
    for (int ks = 0; ks < 16; ++ks) s += mp[(size_t)(ks * 4 + b) * (6 * D) + idx];
    return s;
}

__constant__ unsigned char T5B[3][132] = {
 {11,11,11,11,11,11,11,11,11,11,11,11,11,11,11,10,10,10,10,10,10,10,10,10,10,10,10,10,10,10,10,10,10,10,10,10,10,10,9,9,9,9,9,9,9,9,9,9,9,9,8,8,8,8,8,8,8,7,6,5,4,3,2,1,0,17,18,19,20,21,22,23,24,24,24,24,24,24,24,25,25,25,25,25,25,25,25,25,25,25,25,26,26,26,26,26,26,26,26,26,26,26,26,26,26,26,26,26,26,26,26,26,26,26,27,27,27,27,27,27,27,27,27,27,27,27,27,27,27,0,0,0},
 {13,13,13,13,13,13,13,13,13,13,13,13,13,13,13,13,13,13,13,13,13,13,13,12,12,12,12,12,12,12,12,12,12,12,12,12,12,12,12,12,12,12,11,11,11,11,11,11,11,11,11,11,10,10,10,10,10,10,9,9,9,8,8,4,0,20,24,24,25,25,25,26,26,26,26,26,26,27,27,27,27,27,27,27,27,27,27,28,28,28,28,28,28,28,28,28,28,28,28,28,28,28,28,28,28,28,29,29,29,29,29,29,29,29,29,29,29,29,29,29,29,29,29,29,29,29,29,29,29,0,0,0},
 {15,15,15,15,15,15,15,15,15,15,15,15,15,15,15,15,15,15,15,15,15,15,15,15,15,15,15,15,15,15,14,14,14,14,14,14,14,14,14,14,14,14,14,14,14,13,13,13,13,13,13,13,13,13,12,12,12,12,12,11,11,10,10,9,0,25,26,26,27,27,28,28,28,28,28,29,29,29,29,29,29,29,29,29,30,30,30,30,30,30,30,30,30,30,30,30,30,30,30,31,31,31,31,31,31,31,31,31,31,31,31,31,31,31,31,31,31,31,31,31,31,31,31,31,31,31,31,31,31,0,0,0}};

__device__ __forceinline__ void p0_mod_item(Frame& F, int j) {
    const int ks = j >> 4, cb = j & 15;
    LAS float* sc = (LAS float*)(F.lds + RING_OFF);
    LAS float* red = (LAS float*)(F.lds + RING_OFF + 4096);
    __syncthreads();
    { const int b = F.tid >> 7, k = F.tid & 127; const float cv = F.c[b * D + ks * 128 + k]; sc[F.tid] = cv / (1.0f + __expf(-cv)); }
    __syncthreads();
    const int cg = F.tid % 192, sub = F.tid / 192;
    f32x4 acc[4];
#pragma unroll
    for (int b = 0; b < 4; ++b) acc[b] = (f32x4){0.f, 0.f, 0.f, 0.f};
    if (sub < 2) {
        const float* wp = F.w_ada + (size_t)(ks * 128 + sub * 64) * (6 * D) + cb * 768 + 4 * cg;
#pragma unroll 8
        for (int i = 0; i < 64; ++i) {
            const f32x4 w = *(const f32x4*)(wp + (size_t)i * (6 * D));
#pragma unroll
            for (int b = 0; b < 4; ++b) { const float s = sc[b * 128 + sub * 64 + i]; acc[b] += w * s; }
        }
        if (sub == 1) {
#pragma unroll
            for (int b = 0; b < 4; ++b) *(LAS f32x4*)(red + cg * 16 + b * 4) = acc[b];
        }
    }
    __syncthreads();
    if (sub == 0) {
        float* mp = (float*)(F.ws + WS_MODP);
#pragma unroll
        for (int b = 0; b < 4; ++b) { const f32x4 o = acc[b] + *(LAS f32x4*)(red + cg * 16 + b * 4); *(f32x4*)(mp + (size_t)(ks * 4 + b) * (6 * D) + cb * 768 + 4 * cg) = o; }
    }
}
__device__ __forceinline__ void p0_transpose_item(const float* W, int K, int N, bf16* WT, LAS float* scr, int item, int lane) {
    const int nblk = N >> 6, kb = item / nblk, nb = item - kb * nblk, k0 = kb << 6, n0 = nb << 6;
    const float* src = W + (size_t)(k0 + (lane >> 4)) * N + n0 + 4 * (lane & 15);
    f32x4 v[16];
#pragma unroll
    for (int i = 0; i < 16; ++i) v[i] = *(const f32x4*)(src + (size_t)(4 * i) * N);
#pragma unroll
    for (int i = 0; i < 16; ++i) { LAS float* d = scr + (4 * i + (lane >> 4)) * 65 + 4 * (lane & 15); d[0] = v[i][0]; d[1] = v[i][1]; d[2] = v[i][2]; d[3] = v[i][3]; }
    LDS_WAIT();
    const int c = lane >> 3;
#pragma unroll
    for (int jn = 0; jn < 8; ++jn) { const int n = (lane & 7) + 8 * jn; const LAS float* s = scr + (8 * c) * 65 + n;
        v4u o; o.x = pk2(s[0 * 65], s[1 * 65]); o.y = pk2(s[2 * 65], s[3 * 65]); o.z = pk2(s[4 * 65], s[5 * 65]); o.w = pk2(s[6 * 65], s[7 * 65]);
        *(v4u*)(WT + (size_t)(n0 + n) * K + k0 + 8 * c) = o; }
    LDS_WAIT();
}
__device__ __forceinline__ void p0_prologue(Frame& F) {
    for (int j = F.vcu; j < 256; j += F.G) p0_mod_item(F, j);
    __syncthreads();
    LAS float* scr = (LAS float*)(F.lds + RING_OFF + F.wave * 16640);
    const int gw = F.vcu * NWAVES + F.wave, NGW = F.G * NWAVES;
    constexpr int I_IN = (D / 64) * (NQKV / 64), I_O = (D / 64) * (D / 64), I_EI1 = (D / 64) * (FF2 / 64), I_EO1 = (FF / 64) * (D / 64);
    constexpr int I_EI = NE * I_EI1, I_EO = NE * I_EO1, NITEMS = I_IN + I_O + I_EI + I_EO;
    for (int it = gw; it < NITEMS; it += NGW) {
        int r = it;
        if (r < I_IN) { p0_transpose_item(F.w_in, D, NQKV, (bf16*)(F.ws + WS_WIN_T), scr, r, F.lane); continue; } r -= I_IN;
        if (r < I_O) { p0_transpose_item(F.w_o, D, D, (bf16*)(F.ws + WS_WO_T), scr, r, F.lane); continue; } r -= I_O;
        if (r < I_EI) { const int e = r / I_EI1; p0_transpose_item(F.w_e_in + (size_t)e * D * FF2, D, FF2, (bf16*)(F.ws + WS_WEI_T) + (size_t)e * FF2 * D, scr, r - e * I_EI1, F.lane); continue; } r -= I_EI;
        { const int e = r / I_EO1; p0_transpose_item(F.w_e_out + (size_t)e * FF * D, FF, D, (bf16*)(F.ws + WS_WEO_T) + (size_t)e * D * FF, scr, r - e * I_EO1, F.lane); }
    }
}

__device__ __forceinline__ void p1_hmix(Frame& F) {
    LAS float* ta = (LAS float*)(F.lds + RING_OFF);
    LAS float* tb = ta + D;
    for (int rb = F.vcu; rb < T / 32; rb += F.G) {
        const int b = rb >> 6;
        __syncthreads();
        for (int col = F.tid; col < D; col += NWAVES * 64) { ta[col] = F.g_pre_mix[col] * (1.0f + mod_val(F, b, D + col)); tb[col] = mod_val(F, b, col); }
        __syncthreads();
        for (int rr = F.wave; rr < 32; rr += NWAVES) {
            const int row = rb * 32 + rr;
            const f32x4* xr = (const f32x4*)(F.x + (size_t)row * D) + F.lane;
            f32x4 v[8]; float ss = 0.f;
#pragma unroll
            for (int j = 0; j < 8; ++j) { v[j] = xr[64 * j]; ss += (v[j][0] * v[j][0] + v[j][1] * v[j][1]) + (v[j][2] * v[j][2] + v[j][3] * v[j][3]); }
            const float r = 1.0f / sqrtf(wave_sum(ss) * (1.0f / D) + EPS);
            v2u* o8 = (v2u*)((bf16*)(F.ws + WS_HMIX) + (size_t)row * D) + F.lane;
#pragma unroll
            for (int j = 0; j < 8; ++j) { const int col = 4 * F.lane + 256 * j; const f32x4 a = *(LAS f32x4*)(ta + col), s = *(LAS f32x4*)(tb + col);
                v2u w; w.x = pk2(v[j][0] * r * a[0] + s[0], v[j][1] * r * a[1] + s[1]); w.y = pk2(v[j][2] * r * a[2] + s[2], v[j][3] * r * a[3] + s[3]); o8[64 * j] = w; }
        }
    }
}

__device__ __forceinline__ float dot_qk(const LAS float* q, const bf16* krow) {
    float s = 0.f;
#pragma unroll
    for (int ch = 0; ch < 16; ++ch) { const v4u kv = *(const v4u*)(krow + 8 * ch); const LAS float* qq = q + 8 * ch;
        s += qq[0] * bflo(kv.x) + qq[1] * bfhi(kv.x) + qq[2] * bflo(kv.y) + qq[3] * bfhi(kv.y) + qq[4] * bflo(kv.z) + qq[5] * bfhi(kv.z) + qq[6] * bflo(kv.w) + qq[7] * bfhi(kv.w); }
    return s;
}
__device__ __forceinline__ void p3_attn_naive(Frame& F) {
    LAS float* lq = (LAS float*)(F.lds + RING_OFF + F.wave * 2048);
    LAS float* lp = lq + 128;
    const bf16* proj = (const bf16*)(F.ws + WS_PROJ);
    float* ona = (float*)(F.ws + WS_ONA); float* odil = (float*)(F.ws + WS_ODIL); float* lse = (float*)(F.ws + WS_LSE);
    const float scale = 0.08838834764831845f;
    const int gw = F.vcu * NWAVES + F.wave, NGW = F.G * NWAVES, lane = F.lane;
    for (int it = gw; it < T * 16; it += NGW) {
        const int tok = it >> 4, hh = it & 15, b = tok >> 11, pos = tok & 2047;
        const bf16* prow = proj + (size_t)tok * NQKV;
        if (hh < 8) {
            const int h = hh;
            { const unsigned qw = *(const unsigned*)(prow + h * HD + 2 * lane); LDS_WAIT(); lq[2 * lane] = bflo(qw); lq[2 * lane + 1] = bfhi(qw); LDS_WAIT(); }
            const int r = pos >> 6, c = pos & 63; const int rs = min(max(r - 4, 0), 24), cs = min(max(c - 8, 0), 48);
            float lg[2];
#pragma unroll
            for (int jj = 0; jj < 2; ++jj) { const int j = lane + 64 * jj, i = j >> 4, cc = cs + (j & 15), kpos = (rs + i) * 64 + cc;
                const float d = dot_qk(lq, proj + (size_t)(b * SEQ + kpos) * NQKV + GW + h * HD);
                lg[jj] = d * scale + F.rpb[(h * 15 + (rs + i - r + 7)) * 31 + (cc - c + 15)]; }
            const float m = wave_max(fmaxf(lg[0], lg[1]));
            const float p0 = __expf(lg[0] - m), p1 = __expf(lg[1] - m);
            const float inv = 1.0f / wave_sum(p0 + p1);
            lp[lane] = p0 * inv; lp[lane + 64] = p1 * inv; LDS_WAIT();
            float o0 = 0.f, o1 = 0.f;
            for (int j = 0; j < 128; ++j) { const int kpos = (rs + (j >> 4)) * 64 + cs + (j & 15);
                const unsigned vw = *(const unsigned*)(proj + (size_t)(b * SEQ + kpos) * NQKV + 2 * GW + h * HD + 2 * lane); const float p = lp[j]; o0 += p * bflo(vw); o1 += p * bfhi(vw); }
            *(float2*)(ona + (size_t)tok * GW + h * HD + 2 * lane) = make_float2(o0, o1);
        } else {
            const int h = hh - 8;
            { const unsigned qw = *(const unsigned*)(prow + 3 * GW + h * HD + 2 * lane); LDS_WAIT(); lq[2 * lane] = bflo(qw); lq[2 * lane + 1] = bfhi(qw); LDS_WAIT(); }
#pragma unroll
            for (int p = 0; p < 3; ++p) {
                const int dsh = 2 * p, dil = 1 << dsh, sub_len = SEQ >> dsh, rho = pos & (dil - 1), ql = pos >> dsh;
                float lg[3];
#pragma unroll
                for (int jj = 0; jj < 3; ++jj) { const int j = lane + 64 * jj; const int kl = ql + j - 64; const bool valid = (j < 129) && (kl >= 0) && (kl < sub_len);
                    const int kpos = rho + dil * min(max(kl, 0), sub_len - 1);
                    float d = -INFINITY;
                    if (valid) d = dot_qk(lq, proj + (size_t)(b * SEQ + kpos) * NQKV + 4 * GW + h * HD) * scale + F.t5[(int)T5B[p][j] * 8 + h];
                    lg[jj] = d; }
                const float m = wave_max(fmaxf(fmaxf(lg[0], lg[1]), lg[2]));
                const float p0 = __expf(lg[0] - m), p1 = __expf(lg[1] - m), p2 = __expf(lg[2] - m);
                const float den = wave_sum(p0 + p1 + p2), inv = 1.0f / den;
                LDS_WAIT(); lp[lane] = p0 * inv; lp[lane + 64] = p1 * inv; lp[lane + 128] = p2 * inv; LDS_WAIT();
                float o0 = 0.f, o1 = 0.f;
                for (int j = 0; j < 129; ++j) { const int kl = ql + j - 64; const int kpos = rho + dil * min(max(kl, 0), sub_len - 1);
                    const unsigned vw = *(const unsigned*)(proj + (size_t)(b * SEQ + kpos) * NQKV + 5 * GW + h * HD + 2 * lane); const float pp = lp[j]; o0 += pp * bflo(vw); o1 += pp * bfhi(vw); }
                *(float2*)(odil + ((size_t)p * T + tok) * GW + h * HD + 2 * lane) = make_float2(o0, o1);
                if (lane == 0) lse[((size_t)p * T + tok) * 8 + h] = m + __logf(den);
            }
        }
    }
}


typedef short bf16x8v __attribute__((ext_vector_type(8)));
typedef short s16x4v __attribute__((ext_vector_type(4)));
typedef int v4i16_t_ __attribute__((ext_vector_type(2)));
__device__ __forceinline__ unsigned vimg_off(unsigned row, unsigned ch) { return 256u * row + 16u * (ch ^ (((row & 3u) << 2) | ((row >> 2) & 3u))); }
__device__ __forceinline__ s16x4v tr_read16(const LAS unsigned char* p) {
    typedef short v4i16 __attribute__((ext_vector_type(4)));
    return __builtin_bit_cast(s16x4v, __builtin_amdgcn_ds_read_tr16_b64_v4i16((LAS v4i16*)p));
}
struct GeoNA {
    int tok0, qbase, kbase, r, rs, c0, kc0; const float* rpb_h;
    static constexpr int QCOL = 0, KCOL = GW, VCOL = 2 * GW;
    __device__ __forceinline__ int qtok(int n16) const { return qbase + n16; }
    __device__ __forceinline__ int ktok(int c, int slot) const { return kbase + c * 64 + slot; }
    __device__ __forceinline__ float bias(int c, int slot, int n16) const {
        const int qc = c0 + n16, kc = kc0 + slot, cs = min(max(qc - 8, 0), 48);
        const bool valid = (kc >= cs) && (kc < cs + 16);
        const int dc = min(max(kc - qc + 15, 0), 30);
        const float bv = rpb_h[(rs + c - r + 7) * 31 + dc];
        return valid ? bv : -INFINITY;
    }
};
struct GeoDil {
    int tok0, rho, dsh, sub_len, l0, p, h; const float* t5;
    static constexpr int QCOL = 3 * GW, KCOL = 4 * GW, VCOL = 5 * GW;
    __device__ __forceinline__ int qtok(int n16) const { return tok0 + rho + ((l0 + n16) << dsh); }
    __device__ __forceinline__ int ktok(int c, int slot) const { const int l = min(max(l0 - 64 + 32 * c + slot, 0), sub_len - 1); return tok0 + rho + (l << dsh); }
    __device__ __forceinline__ float bias(int c, int slot, int n16) const {
        const int kk = 32 * c + slot, delta = kk - 64 - n16, l = l0 - 64 + kk;
        const bool valid = (delta >= -64) && (delta <= 64) && (l >= 0) && (l < sub_len);
        const int di = min(max(delta + 64, 0), 128);
        const float bv = t5[(int)T5B[p][di] * 8 + h];
        return valid ? bv : -INFINITY;
    }
};
template <int NCH, class Geo>
__device__ __forceinline__ void attn_item(const Geo& G, const bf16* proj, int hcol, LAS unsigned char* vimg, float* out, float* lse_out, int lane) {
    const int n16 = lane & 15, g = lane >> 4;
    const float scale_l2 = 0.08838834764831845f * 1.44269504089f;
    bf16x8v qf[4];
    { const bf16* qp = proj + (size_t)G.qtok(n16) * NQKV + Geo::QCOL + hcol + 8 * g;
#pragma unroll
      for (int s = 0; s < 4; ++s) qf[s] = *(const bf16x8v*)(qp + 32 * s); }
    f32x4 st[NCH][2];
#pragma unroll
    for (int c = 0; c < NCH; ++c)
#pragma unroll
        for (int t2 = 0; t2 < 2; ++t2) {
            const int slot = 8 * (n16 >> 2) + 4 * t2 + (n16 & 3);
            const bf16* kp = proj + (size_t)G.ktok(c, slot) * NQKV + Geo::KCOL + hcol + 8 * g;
            f32x4 acc = (f32x4){0.f, 0.f, 0.f, 0.f};
#pragma unroll
            for (int s = 0; s < 4; ++s) { const bf16x8v kf = *(const bf16x8v*)(kp + 32 * s); acc = __builtin_amdgcn_mfma_f32_16x16x32_bf16(kf, qf[s], acc, 0, 0, 0); }
            st[c][t2] = acc;
        }
    float mx = -INFINITY;
#pragma unroll
    for (int c = 0; c < NCH; ++c)
#pragma unroll
        for (int t2 = 0; t2 < 2; ++t2)
#pragma unroll
            for (int r = 0; r < 4; ++r) { const float bv = G.bias(c, 8 * g + 4 * t2 + r, n16); const float x = st[c][t2][r] * scale_l2 + bv * 1.44269504089f; st[c][t2][r] = x; mx = fmaxf(mx, x); }
    mx = fmaxf(mx, __shfl_xor(mx, 16)); mx = fmaxf(mx, __shfl_xor(mx, 32));
    float sum = 0.f;
    bf16x8v pf[NCH];
#pragma unroll
    for (int c = 0; c < NCH; ++c) {
        float pv[8];
#pragma unroll
        for (int t2 = 0; t2 < 2; ++t2)
#pragma unroll
            for (int r = 0; r < 4; ++r) { const float p = __builtin_amdgcn_exp2f(st[c][t2][r] - mx); pv[4 * t2 + r] = p; sum += p; }
        v4u w; w.x = pk2(pv[0], pv[1]); w.y = pk2(pv[2], pv[3]); w.z = pk2(pv[4], pv[5]); w.w = pk2(pv[6], pv[7]);
        pf[c] = __builtin_bit_cast(bf16x8v, w);
    }
    sum += __shfl_xor(sum, 16); sum += __shfl_xor(sum, 32);
    f32x4 oacc[8];
#pragma unroll
    for (int dt = 0; dt < 8; ++dt) oacc[dt] = (f32x4){0.f, 0.f, 0.f, 0.f};
    const int vr_row = lane >> 4, vr_ch = lane & 15;
    v4u vr[8];
#pragma unroll
    for (int i = 0; i < 8; ++i) vr[i] = *(const v4u*)(proj + (size_t)G.ktok(0, 4 * i + vr_row) * NQKV + Geo::VCOL + hcol + 8 * vr_ch);
    const unsigned q4 = (unsigned)(lane & 15) >> 2, pp = (unsigned)lane & 3u;
#pragma unroll
    for (int c = 0; c < NCH; ++c) {
        asm volatile("" ::: "memory");
#pragma unroll
        for (int i = 0; i < 8; ++i) *(LAS v4u*)(vimg + vimg_off((unsigned)(4 * i + vr_row), (unsigned)vr_ch)) = vr[i];
        asm volatile("" ::: "memory");
        if (c + 1 < NCH) {
#pragma unroll
            for (int i = 0; i < 8; ++i) vr[i] = *(const v4u*)(proj + (size_t)G.ktok(c + 1, 4 * i + vr_row) * NQKV + Geo::VCOL + hcol + 8 * vr_ch);
        }
#pragma unroll
        for (int dt = 0; dt < 8; ++dt) {
            const s16x4v lo = tr_read16(vimg + vimg_off((unsigned)(8 * g) + q4, (unsigned)(2 * dt) + (pp >> 1)) + 8u * (pp & 1u));
            const s16x4v hi = tr_read16(vimg + vimg_off((unsigned)(8 * g + 4) + q4, (unsigned)(2 * dt) + (pp >> 1)) + 8u * (pp & 1u));
            bf16x8v vf; vf[0] = lo[0]; vf[1] = lo[1]; vf[2] = lo[2]; vf[3] = lo[3]; vf[4] = hi[0]; vf[5] = hi[1]; vf[6] = hi[2]; vf[7] = hi[3];
            oacc[dt] = __builtin_amdgcn_mfma_f32_16x16x32_bf16(vf, pf[c], oacc[dt], 0, 0, 0);
        }
        asm volatile("" ::: "memory");
    }
    const float inv = 1.0f / sum;
    float* op = out + (size_t)G.qtok(n16) * GW + hcol + 4 * g;
#pragma unroll
    for (int dt = 0; dt < 8; ++dt) *(f32x4*)(op + 16 * dt) = oacc[dt] * inv;
    if (lse_out != nullptr && g == 0) lse_out[(size_t)G.qtok(n16) * 8 + (hcol >> 7)] = (mx + __builtin_amdgcn_logf(sum)) * 0.69314718056f;
}
__device__ __forceinline__ void p3_attn_mfma(Frame& F) {
    LAS unsigned char* vimg = F.lds + RING_OFF + F.wave * 8192;
    const bf16* proj = (const bf16*)(F.ws + WS_PROJ);
    float* ona = (float*)(F.ws + WS_ONA); float* odil = (float*)(F.ws + WS_ODIL); float* lse = (float*)(F.ws + WS_LSE);
    const int gw = F.vcu * NWAVES + F.wave, NGW = F.G * NWAVES, lane = F.lane;
    for (int it = gw * 2; it < NBATCH * 32 * 8 * 4; it += NGW * 2) {
#pragma unroll 1
        for (int k = 0; k < 2; ++k) {
            const int id = it + k, qt = id & 3, h = (id >> 2) & 7, r = (id >> 5) & 31, b = id >> 10;
            GeoNA G; G.tok0 = b * SEQ; G.r = r; G.rs = min(max(r - 4, 0), 24); G.c0 = 16 * qt; G.kc0 = (qt == 0) ? 0 : (qt == 1) ? 8 : (qt == 2) ? 24 : 32;
            G.qbase = G.tok0 + r * 64 + G.c0; G.kbase = G.tok0 + G.rs * 64 + G.kc0; G.rpb_h = F.rpb + h * (15 * 31);
            attn_item<8, GeoNA>(G, proj, h * HD, vimg, ona, nullptr, lane);
        }
    }
    for (int it = gw * 6; it < 3 * NBATCH * 8 * 128; it += NGW * 6) {
#pragma unroll 1
        for (int k = 0; k < 6; ++k) {
            const int id = it + k, tile = id & 127, h = (id >> 7) & 7, b = (id >> 10) & 3, p = id >> 12;
            GeoDil G; G.dsh = 2 * p; G.sub_len = SEQ >> G.dsh; const int tpc = G.sub_len >> 4;
            G.rho = tile / tpc; G.l0 = (tile - G.rho * tpc) * 16; G.tok0 = b * SEQ; G.p = p; G.h = h; G.t5 = F.t5;
            attn_item<5, GeoDil>(G, proj, h * HD, vimg, odil + (size_t)p * T * GW, lse + (size_t)p * T * 8, lane);
        }
    }
}

__device__ __forceinline__ void p4_post(Frame& F) {
    const float* ona = (const float*)(F.ws + WS_ONA); const float* odil = (const float*)(F.ws + WS_ODIL); const float* lse = (const float*)(F.ws + WS_LSE);
    bf16* aout = (bf16*)(F.ws + WS_AOUT);
    const int gw = F.vcu * NWAVES + F.wave, NGW = F.G * NWAVES, lane = F.lane;
    for (int tok = gw; tok < T; tok += NGW) {
        f32x4 v[4]; float ss = 0.f;
#pragma unroll
        for (int j = 0; j < 4; ++j) { v[j] = *(const f32x4*)(ona + (size_t)tok * GW + 4 * lane + 256 * j); ss += (v[j][0] * v[j][0] + v[j][1] * v[j][1]) + (v[j][2] * v[j][2] + v[j][3] * v[j][3]); }
        float r = 1.0f / sqrtf(wave_sum(ss) * (1.0f / GW) + EPS);
#pragma unroll
        for (int j = 0; j < 4; ++j) { const int col = 4 * lane + 256 * j; const f32x4 g = *(const f32x4*)(F.g_out_na + col);
            v2u w; w.x = pk2(v[j][0] * r * g[0], v[j][1] * r * g[1]); w.y = pk2(v[j][2] * r * g[2], v[j][3] * r * g[3]); *(v2u*)(aout + (size_t)tok * D + col) = w; }
        ss = 0.f;
#pragma unroll
        for (int j = 0; j < 4; ++j) { const int col = 4 * lane + 256 * j, h = col >> 7;
            const float l0 = lse[((size_t)0 * T + tok) * 8 + h], l1 = lse[((size_t)1 * T + tok) * 8 + h], l2 = lse[((size_t)2 * T + tok) * 8 + h];
            const float mx = fmaxf(fmaxf(l0, l1), l2); const float e0 = __expf(l0 - mx), e1 = __expf(l1 - mx), e2 = __expf(l2 - mx); const float inv = 1.0f / (e0 + e1 + e2);
            const f32x4 a0 = *(const f32x4*)(odil + ((size_t)0 * T + tok) * GW + col), a1 = *(const f32x4*)(odil + ((size_t)1 * T + tok) * GW + col), a2 = *(const f32x4*)(odil + ((size_t)2 * T + tok) * GW + col);
            v[j] = a0 * (e0 * inv) + a1 * (e1 * inv) + a2 * (e2 * inv);
            ss += (v[j][0] * v[j][0] + v[j][1] * v[j][1]) + (v[j][2] * v[j][2] + v[j][3] * v[j][3]); }
        r = 1.0f / sqrtf(wave_sum(ss) * (1.0f / GW) + EPS);
#pragma unroll
        for (int j = 0; j < 4; ++j) { const int col = 4 * lane + 256 * j; const f32x4 g = *(const f32x4*)(F.g_out_dil + col);
            v2u w; w.x = pk2(v[j][0] * r * g[0], v[j][1] * r * g[1]); w.y = pk2(v[j][2] * r * g[2], v[j][3] * r * g[3]); *(v2u*)(aout + (size_t)tok * D + GW + col) = w; }
    }
}

__device__ __forceinline__ void p6_rows(Frame& F) {
    LAS float* t1 = (LAS float*)(F.lds + RING_OFF);
    LAS float* t2 = t1 + D;
    LAS float* t3 = t2 + D;
    LAS unsigned* hb = (LAS unsigned*)(F.lds + RING_OFF + 3 * D * 4) + F.wave * (4 * D / 2);
    const float* mixed = (const float*)(F.ws + WS_MIXED); float* x1 = (float*)(F.ws + WS_X1); bf16* hffn = (bf16*)(F.ws + WS_HFFN);
    int* topi = (int*)(F.ws + WS_TOPI); float* topg = (float*)(F.ws + WS_TOPG); int* trank = (int*)(F.ws + WS_TRANK); unsigned* hist_g = (unsigned*)(F.ws + WS_HIST);
    LAS unsigned* hist = (LAS unsigned*)(F.lds + MISC_OFF) + 224;
    const int lane = F.lane;
    for (int rb = F.vcu; rb < T / 32; rb += F.G) {
        const int b = rb >> 6;
        __syncthreads();
        if (F.tid < 32) hist[F.tid] = 0u;
        for (int col = F.tid; col < D; col += NWAVES * 64) { t1[col] = F.g_post_mix[col] * mod_val(F, b, 2 * D + col); t2[col] = F.g_pre_ffn[col] * (1.0f + mod_val(F, b, 4 * D + col)); t3[col] = mod_val(F, b, 3 * D + col); }
        __syncthreads();
#pragma unroll 1
        for (int rr = 0; rr < 4; ++rr) {
            const int row = rb * 32 + F.wave * 4 + rr;
            f32x4 v[8]; float ss = 0.f;
#pragma unroll
            for (int j = 0; j < 8; ++j) { v[j] = *(const f32x4*)(mixed + (size_t)row * D + 4 * lane + 256 * j); ss += (v[j][0] * v[j][0] + v[j][1] * v[j][1]) + (v[j][2] * v[j][2] + v[j][3] * v[j][3]); }
            float r = 1.0f / sqrtf(wave_sum(ss) * (1.0f / D) + EPS);
            ss = 0.f;
#pragma unroll
            for (int j = 0; j < 8; ++j) { const int col = 4 * lane + 256 * j; const f32x4 xv = *(const f32x4*)(F.x + (size_t)row * D + col); const f32x4 a = *(LAS f32x4*)(t1 + col);
                v[j] = xv + a * (v[j] * r); *(f32x4*)(x1 + (size_t)row * D + col) = v[j];
                ss += (v[j][0] * v[j][0] + v[j][1] * v[j][1]) + (v[j][2] * v[j][2] + v[j][3] * v[j][3]); }
            r = 1.0f / sqrtf(wave_sum(ss) * (1.0f / D) + EPS);
#pragma unroll
            for (int j = 0; j < 8; ++j) { const int col = 4 * lane + 256 * j; const f32x4 a = *(LAS f32x4*)(t2 + col), s = *(LAS f32x4*)(t3 + col);
                const f32x4 hv = v[j] * r * a + s;
                v2u w; w.x = pk2(hv[0], hv[1]); w.y = pk2(hv[2], hv[3]); *(v2u*)(hffn + (size_t)row * D + col) = w; *(LAS v2u*)(hb + rr * (D / 2) + (col >> 1)) = w; }
        }
        LDS_WAIT();
        const int e = lane & 31, half = lane >> 5;
        float acc[4] = {0.f, 0.f, 0.f, 0.f};
        { const float* wr = F.w_router + (size_t)(half * 1024) * NE + e; const LAS unsigned* hr = hb + half * 512;
#pragma unroll 8
          for (int kp = 0; kp < 512; ++kp) { const float w0 = wr[(size_t)(2 * kp) * NE], w1 = wr[(size_t)(2 * kp + 1) * NE];
#pragma unroll
              for (int rr = 0; rr < 4; ++rr) { const unsigned hw = hr[rr * (D / 2) + kp]; acc[rr] += bflo(hw) * w0 + bfhi(hw) * w1; } } }
        const float br = F.b_router[e];
#pragma unroll
        for (int rr = 0; rr < 4; ++rr) {
            const int row = rb * 32 + F.wave * 4 + rr;
            float a = acc[rr]; a += __shfl_xor(a, 32);
            float lg = (lane < 32) ? a + br : -INFINITY;
            int sel[4]; float val[4];
#pragma unroll
            for (int k = 0; k < 4; ++k) { const float mx = wave_max(lg); const unsigned long long bal = __ballot(lg == mx); const int idx = __ffsll((long long)bal) - 1; sel[k] = idx; val[k] = mx; if (lane == idx) lg = -INFINITY; }
            const float e1 = __expf(val[1] - val[0]), e2 = __expf(val[2] - val[0]), e3 = __expf(val[3] - val[0]); const float inv = 1.0f / (1.0f + e1 + e2 + e3);
            if (lane == 0) {
                *(int4*)(topi + (size_t)row * 4) = make_int4(sel[0], sel[1], sel[2], sel[3]);
                *(float4*)(topg + (size_t)row * 4) = make_float4(inv, e1 * inv, e2 * inv, e3 * inv);
                int rk[4];
#pragma unroll
                for (int k = 0; k < 4; ++k) rk[k] = (int)__hip_atomic_fetch_add(hist + sel[k], 1u, __ATOMIC_RELAXED, __HIP_MEMORY_SCOPE_WORKGROUP);
                *(int4*)(trank + (size_t)row * 4) = make_int4(rk[0], rk[1], rk[2], rk[3]);
            }
        }
        __syncthreads();
        if (F.tid < 32) hist_g[rb * 32 + F.tid] = hist[F.tid];
    }
}

__device__ __forceinline__ void moe_tables(Frame& F, int rb) {
    const unsigned* hist_g = (const unsigned*)(F.ws + WS_HIST);
    LAS unsigned* red = (LAS unsigned*)(F.lds + RING_OFF);
    __syncthreads();
    { const int e = F.tid & 31, part = F.tid >> 5; unsigned tot = 0u, pre = 0u;
#pragma unroll
      for (int i = 0; i < 16; ++i) { const int r2 = part * 16 + i; const unsigned v = hist_g[r2 * 32 + e]; tot += v; pre += (r2 < rb) ? v : 0u; }
      red[(part * 32 + e) * 2] = tot; red[(part * 32 + e) * 2 + 1] = pre; }
    __syncthreads();
    if (F.tid < 32) { unsigned tot = 0u, pre = 0u;
#pragma unroll
        for (int part = 0; part < 16; ++part) { tot += red[(part * 32 + F.tid) * 2]; pre += red[(part * 32 + F.tid) * 2 + 1]; }
        F.MISC[224 + F.tid] = tot; F.MISC[32 + F.tid] = pre; }
    __syncthreads();
    if (F.tid == 0) { int nb = 0;
        for (int e = 0; e < NE; ++e) { const int cnt = (int)F.MISC[224 + e]; const int k = (cnt + 255) >> 8; F.MISC[32 + e] += (unsigned)(nb * 256); for (int j = 0; j < k && nb < MAXBLK; ++j) F.MISC[64 + nb++] = (unsigned)e; }
        F.MISC[16] = (unsigned)nb; }
    __syncthreads();
}
__device__ __forceinline__ void p7_slots(Frame& F) {
    const int* topi = (const int*)(F.ws + WS_TOPI); const int* trank = (const int*)(F.ws + WS_TRANK); int* tslot = (int*)(F.ws + WS_TSLOT);
    const bf16* hffn = (const bf16*)(F.ws + WS_HFFN); bf16* xg = (bf16*)(F.ws + WS_XG);
    const int lane = F.lane;
    for (int rb = F.vcu; rb < T / 32; rb += F.G) {
        moe_tables(F, rb);
#pragma unroll 4
        for (int i = 0; i < 16; ++i) {
            const int pid = rb * 128 + F.wave * 16 + i, t = pid >> 2; const int e = topi[pid];
            const int slot = (int)F.MISC[32 + e] + trank[pid];
            if (lane == 0) tslot[pid] = slot;
            const v4u* s = (const v4u*)(hffn + (size_t)t * D) + lane; v4u* d = (v4u*)(xg + (size_t)slot * D) + lane;
#pragma unroll
            for (int j = 0; j < 4; ++j) d[64 * j] = s[64 * j];
        }
    }
}

__device__ __forceinline__ void p10_final(Frame& F) {
    LAS float* t1 = (LAS float*)(F.lds + RING_OFF);
    const float* x1 = (const float*)(F.ws + WS_X1); const bf16* yb = (const bf16*)(F.ws + WS_YB);
    const int* tslot = (const int*)(F.ws + WS_TSLOT); const float* topg = (const float*)(F.ws + WS_TOPG);
    const int lane = F.lane;
    for (int rb = F.vcu; rb < T / 32; rb += F.G) {
        const int b = rb >> 6;
        __syncthreads();
        for (int col = F.tid; col < D; col += NWAVES * 64) t1[col] = F.g_post_ffn[col] * mod_val(F, b, 5 * D + col);
        __syncthreads();
        for (int rr = F.wave; rr < 32; rr += NWAVES) {
            const int row = rb * 32 + rr;
            const int4 sl = *(const int4*)(tslot + (size_t)row * 4); const float4 gt = *(const float4*)(topg + (size_t)row * 4);
            const int sls[4] = {sl.x, sl.y, sl.z, sl.w}; const float gts[4] = {gt.x, gt.y, gt.z, gt.w};
            float y[4][8]; float ss = 0.f;
#pragma unroll
            for (int j = 0; j < 4; ++j) {
#pragma unroll
                for (int i = 0; i < 8; ++i) y[j][i] = 0.f;
#pragma unroll
                for (int k = 0; k < 4; ++k) { const v4u w = *(const v4u*)(yb + (size_t)sls[k] * D + 8 * lane + 512 * j); const float g = gts[k];
                    y[j][0] += g * bflo(w.x); y[j][1] += g * bfhi(w.x); y[j][2] += g * bflo(w.y); y[j][3] += g * bfhi(w.y); y[j][4] += g * bflo(w.z); y[j][5] += g * bfhi(w.z); y[j][6] += g * bflo(w.w); y[j][7] += g * bfhi(w.w); }
#pragma unroll
                for (int i = 0; i < 8; ++i) ss += y[j][i] * y[j][i];
            }
            const float r = 1.0f / sqrtf(wave_sum(ss) * (1.0f / D) + EPS);
#pragma unroll
            for (int j = 0; j < 4; ++j) { const int col = 8 * lane + 512 * j;
#pragma unroll
                for (int hh = 0; hh < 2; ++hh) { const f32x4 xv = *(const f32x4*)(x1 + (size_t)row * D + col + 4 * hh); const f32x4 a = *(LAS f32x4*)(t1 + col + 4 * hh);
                    f32x4 o; o[0] = xv[0] + a[0] * y[j][4 * hh + 0] * r; o[1] = xv[1] + a[1] * y[j][4 * hh + 1] * r; o[2] = xv[2] + a[2] * y[j][4 * hh + 2] * r; o[3] = xv[3] + a[3] * y[j][4 * hh + 3] * r;
                    *(f32x4*)(F.out + (size_t)row * D + col + 4 * hh) = o; } }
        }
    }
}

struct Args { const float* in[20]; float* out; unsigned char* ws; int ph_lo, ph_hi; };
__global__ void __launch_bounds__(NWAVES * 64, 2) fwd_kernel(Args args) {
    extern __shared__ __attribute__((aligned(16))) unsigned char lds[];
    Frame F;
    F.lds = (LAS unsigned char*)lds;
    F.MISC = (volatile LAS unsigned*)(F.lds + MISC_OFF);
    F.tid = threadIdx.x; F.lane = F.tid & 63; F.wave = __builtin_amdgcn_readfirstlane(F.tid >> 6);
    F.G = gridDim.x; { const int bx = blockIdx.x; F.vcu = (F.G % 8 == 0) ? (bx % 8) * (F.G / 8) + bx / 8 : bx; }
    F.ws = args.ws; F.ctl = (unsigned*)(args.ws + WS_CTL); F.out = args.out;
    F.x = args.in[0]; F.c = args.in[1]; F.w_ada = args.in[2]; F.b_ada = args.in[3]; F.g_pre_mix = args.in[4]; F.g_post_mix = args.in[5]; F.w_in = args.in[6]; F.rpb = args.in[7]; F.t5 = args.in[8];
    F.g_out_na = args.in[9]; F.g_out_dil = args.in[10]; F.w_o = args.in[11]; F.g_pre_ffn = args.in[12]; F.g_post_ffn = args.in[13]; F.w_router = args.in[14]; F.b_router = args.in[15];
    F.w_e_in = args.in[16]; F.b_e_in = args.in[17]; F.w_e_out = args.in[18]; F.b_e_out = args.in[19];
    for (int u = F.tid; u < 256; u += NWAVES * 64) F.MISC[u] = 0u;
    __syncthreads();
    XcdBarrier bar; bar.bar = F.ctl + CW_BAR; bar.x = 0; bar.st = nullptr;
    if (MK_N_LAUNCHES == 1) bar = xcd_barrier_post(F.ctl + CW_BAR, F.MISC + 8);
    const int lo = args.ph_lo, hi = args.ph_hi;
#define IN(k) (lo <= (k) && (k) < hi)
#ifndef PROBE_REPEAT
#define PROBE_REPEAT -1
#endif
#define REP(k) ((PROBE_REPEAT == (k)) ? 2 : 1)
#define SEAM(k) do { if (IN(k) && IN((k) + 1)) xcd_barrier(bar); } while (0)

    if (IN(0)) { for (int rep = 0; rep < REP(0); ++rep) p0_prologue(F); } SEAM(0);
    if (IN(1)) { p1_hmix(F); } SEAM(1);
    if (IN(2)) {
        pg8::Gemm g{(const bf16*)(F.ws + WS_HMIX), (const bf16*)(F.ws + WS_WIN_T), T, NQKV, D}; pg8::StaticOrder S; S.init(T, NQKV, F.G, (int)blockIdx.x);
        pg8::EpiBf16 E{(bf16*)(F.ws + WS_PROJ), NQKV, nullptr, 0};
        __syncthreads();
        pg8::gemm_phase<pg8::EpiBf16, pg8::StaticOrder, true, true>(F.lds + RING_OFF, g, S, E);
    } SEAM(2);
    #ifdef ATTN_NAIVE
    if (IN(3)) { p3_attn_naive(F); } SEAM(3);
#else
    if (IN(3)) { for (int rep = 0; rep < REP(3); ++rep) { __syncthreads(); p3_attn_mfma(F); } } SEAM(3);
#endif
    if (IN(4)) { p4_post(F); } SEAM(4);
    if (IN(5)) {
        pg8::Gemm g{(const bf16*)(F.ws + WS_AOUT), (const bf16*)(F.ws + WS_WO_T), T, D, D}; pg8::StaticOrder S; S.init(T, D, F.G, (int)blockIdx.x);
        pg8::EpiF32 E{(float*)(F.ws + WS_MIXED), D};
        __syncthreads();
        pg8::gemm_phase<pg8::EpiF32, pg8::StaticOrder, true, true>(F.lds + RING_OFF, g, S, E);
    } SEAM(5);
    if (IN(6)) { for (int rep = 0; rep < REP(6); ++rep) p6_rows(F); } SEAM(6);
    if (IN(7)) { p7_slots(F); } SEAM(7);
    if (IN(8)) {
        moe_tables(F, -1);
        pg8::Gemm g{(const bf16*)(F.ws + WS_XG), (const bf16*)(F.ws + WS_WEI_T), MAXBLK * 256, FF2, D};
        pg8::MoeOrder<16> S{(const LAS int*)(F.lds + MISC_OFF + 64 * 4), (int)F.MISC[16], F.G, (int)blockIdx.x};
        pg8::EpiSwiglu E{(bf16*)(F.ws + WS_HB), FF, F.b_e_in, FF2};
        pg8::gemm_phase<pg8::EpiSwiglu, pg8::MoeOrder<16>, true, true>(F.lds + RING_OFF, g, S, E);
    } SEAM(8);
    if (IN(9)) {
        moe_tables(F, -1);
        pg8::Gemm g{(const bf16*)(F.ws + WS_HB), (const bf16*)(F.ws + WS_WEO_T), MAXBLK * 256, D, FF};
        pg8::MoeOrder<8> S{(const LAS int*)(F.lds + MISC_OFF + 64 * 4), (int)F.MISC[16], F.G, (int)blockIdx.x};
        pg8::EpiBf16 E{(bf16*)(F.ws + WS_YB), D, F.b_e_out, D};
        pg8::gemm_phase<pg8::EpiBf16, pg8::MoeOrder<8>, true, true>(F.lds + RING_OFF, g, S, E);
    } SEAM(9);
    if (IN(10)) { p10_final(F); }
#undef IN
#undef SEAM
}

extern "C" void kernel_launch(void* const* d_in, const int* in_sizes, int n_in, void* d_out, int out_size, void* d_ws, size_t ws_size, hipStream_t stream) {
    static int grid = 0;
    if (grid == 0) {
        if (n_in != 20 || out_size != T * D || ws_size < WS_END) { fprintf(stderr, "kernel_launch: unexpected problem (n_in %d, out %d, ws %zu)\n", n_in, out_size, ws_size); grid = -1; return; }
        int dev = 0, cus = 0, per_cu = 0;
        if (hipGetDevice(&dev) != hipSuccess || hipDeviceGetAttribute(&cus, hipDeviceAttributeMultiprocessorCount, dev) != hipSuccess) { grid = -1; return; }
        if (hipFuncSetAttribute((const void*)fwd_kernel, hipFuncAttributeMaxDynamicSharedMemorySize, LDS_BYTES) != hipSuccess) { fprintf(stderr, "kernel_launch: hipFuncSetAttribute failed\n"); grid = -1; return; }
        if (hipOccupancyMaxActiveBlocksPerMultiprocessor(&per_cu, (const void*)fwd_kernel, NWAVES * 64, LDS_BYTES) != hipSuccess || per_cu < 1) { fprintf(stderr, "kernel_launch: occupancy query reports %d\n", per_cu); }
        (void)hipGetLastError();
        grid = cus;
    }
    if (grid < 0) return;
    if (hipMemsetAsync((char*)d_ws + WS_CTL, 0, CTL_ZERO_BYTES, stream) != hipSuccess) return;
    Args a{};
    for (int i = 0; i < 20; ++i) a.in[i] = (const float*)d_in[i];
    a.out = (float*)d_out; a.ws = (unsigned char*)d_ws;
    if (MK_N_LAUNCHES == 1) {
        a.ph_lo = 0; a.ph_hi = NPHASE;
        hipLaunchKernelGGL(fwd_kernel, dim3(grid), dim3(NWAVES * 64), LDS_BYTES, stream, a);
    } else {
        for (int p = 0; p < NPHASE; ++p) { a.ph_lo = p; a.ph_hi = p + 1; hipLaunchKernelGGL(fwd_kernel, dim3(grid), dim3(NWAVES * 64), LDS_BYTES, stream, a); }
    }
}
```

```cpp
#include <hip/hip_runtime.h>
#include <cstdio>
#include <cstdint>
#include <type_traits>

#ifndef MK_N_LAUNCHES
#define MK_N_LAUNCHES 1
#endif

namespace pg8 {
#define PG8_LAS __attribute__((address_space(3)))
typedef unsigned short bf16_t;
typedef short bf16x8 __attribute__((ext_vector_type(8)));
typedef float f32x4 __attribute__((ext_vector_type(4)));
typedef unsigned u32x4 __attribute__((ext_vector_type(4)));
typedef unsigned u32x2 __attribute__((ext_vector_type(2)));
constexpr int BM = 256, BK = 64, HALF = 128, HTB = HALF * BK * 2  , STAGE_BYTES = 8 * HTB, NXCD = 8, WGM = 8;

__host__ __device__ __forceinline__ int lds_byte(int r, int c) { const int st = (r >> 4) * 2 + (c >> 5), rr = r & 15, cc = c & 31, ob = rr * 64 + cc * 2; return st * 1024 + (ob ^ (((ob >> 9) & 1) << 5)); }
__host__ __device__ __forceinline__ void stage_rc(int b, int& R, int& C) { const int st = b / 1024, sb = b % 1024, swz = sb ^ (((sb >> 9) & 1) << 5); R = (st >> 1) * 16 + swz / 64; C = (st & 1) * 32 + (swz % 64) / 2; }
__host__ __device__ __forceinline__ int perm32(int rho) { const int n = rho >> 4, i = rho & 15; return 8 * (i >> 2) + 4 * n + (i & 3); }

struct Unit { int pm, pn, bt, e; };
struct Gemm { const bf16_t* A; const bf16_t* Bt; int M, N, K; };

struct StaticOrder {
    int nM, nN, nwg, G, c;
    __host__ __device__ void init(int M, int N, int G_, int c_) { nM = M / BM; nN = N / BM; nwg = nM * nN; G = G_; c = c_; }
    __host__ __device__ bool next(int i, Unit& u) const {
        const long L = (long)i * G + c; if (L >= nwg) return false;
        int wgid = (int)L; { const int q = nwg / NXCD, r = nwg % NXCD, xcd = wgid % NXCD, off = wgid / NXCD; wgid = (xcd < r ? xcd * (q + 1) : r * (q + 1) + (xcd - r) * q) + off; }
        const int nig = WGM * nN, gid = wgid / nig, fm = gid * WGM, gsz = (nM - fm) < WGM ? (nM - fm) : WGM;
        u.pm = fm + ((wgid % nig) % gsz); u.pn = (wgid % nig) / gsz; u.bt = u.pn; u.e = 0; return true;
    }
    __device__ __forceinline__ void a_ready(const Unit&) const {}
    __device__ __forceinline__ void done(const Unit&) const {}
};
template <int NPN> struct MoeOrder {
    const PG8_LAS int* blk_e; int nb, G, c;
    __device__ __forceinline__ bool next(int i, Unit& u) const {
        int L = i * G + c;
        if (G == 256) L = ((i * 8 + (c & 7)) << 5) + (c >> 3);
        const int g = L >> 5, r = L & 31;
        int block, pn;
        if (NPN == 16) { block = 4 * (g >> 1) + (r & 3); pn = 8 * (g & 1) + (r >> 2); } else { block = 4 * g + (r & 3); pn = r >> 2; }
        if (block >= nb) return false;
        u.pm = block; u.pn = pn; u.e = blk_e[block]; u.bt = u.e * NPN + pn; return true;
    }
    __device__ __forceinline__ void a_ready(const Unit&) const {}
    __device__ __forceinline__ void done(const Unit&) const {}
};

__device__ __forceinline__ unsigned cvt_pk_bf16(float lo, float hi) { unsigned r; asm volatile("v_cvt_pk_bf16_f32 %0, %1, %2" : "=v"(r) : "v"(lo), "v"(hi)); return r; }

struct EpiF32 {
    static constexpr bool PERM = false, AFTER_DRAIN = false;
    float* C; int ldc;
    __device__ __forceinline__ void operator()(const f32x4 (&acc)[2][2][4][2], const Unit& u, int wr, int wc, int fr, int fq) const {
        const int row0 = u.pm * BM + wr * 64 + fr, col0 = u.pn * BM + wc * 32 + 4 * fq;
#pragma unroll
        for (int ai = 0; ai < 2; ++ai)
#pragma unroll
            for (int m = 0; m < 4; ++m) { float* rowp = C + (size_t)(row0 + ai * HALF + m * 16) * ldc + col0;
#pragma unroll
                for (int bj = 0; bj < 2; ++bj)
#pragma unroll
                    for (int n = 0; n < 2; ++n) *(f32x4*)(rowp + bj * HALF + n * 16) = acc[ai][bj][m][n]; }
    }
};
struct EpiBf16 {
    static constexpr bool PERM = true, AFTER_DRAIN = false;
    bf16_t* O; int ldc; const float* bias; int bias_estride;
    __device__ __forceinline__ void operator()(const f32x4 (&acc)[2][2][4][2], const Unit& u, int wr, int wc, int fr, int fq) const {
        const int row0 = u.pm * BM + wr * 64 + fr; const int col0 = u.pn * BM + wc * 32 + 8 * fq;
        f32x4 bv[2][2];
#pragma unroll
        for (int bj = 0; bj < 2; ++bj)
#pragma unroll
            for (int n = 0; n < 2; ++n) bv[bj][n] = bias ? *(const f32x4*)(bias + (size_t)u.e * bias_estride + col0 + bj * HALF + 4 * n) : (f32x4){0.f, 0.f, 0.f, 0.f};
#pragma unroll
        for (int ai = 0; ai < 2; ++ai)
#pragma unroll
            for (int m = 0; m < 4; ++m) { bf16_t* rowp = O + (size_t)(row0 + ai * HALF + m * 16) * ldc + col0;
#pragma unroll
                for (int bj = 0; bj < 2; ++bj) { const f32x4 v0 = acc[ai][bj][m][0] + bv[bj][0], v1 = acc[ai][bj][m][1] + bv[bj][1];
                    u32x4 w; w.x = cvt_pk_bf16(v0[0], v0[1]); w.y = cvt_pk_bf16(v0[2], v0[3]); w.z = cvt_pk_bf16(v1[0], v1[1]); w.w = cvt_pk_bf16(v1[2], v1[3]);
                    *(u32x4*)(rowp + bj * HALF) = w; } }
    }
};
__device__ __forceinline__ float swiglu1(float g, float u) {
    g = fminf(g, 7.0f); u = fminf(fmaxf(u, -7.0f), 7.0f);
    const float s = __builtin_amdgcn_rcpf(1.0f + __builtin_amdgcn_exp2f(g * (-1.702f * 1.44269504089f)));
    return (u + 1.0f) * (g * s);
}
struct EpiSwiglu {
    static constexpr bool PERM = true, AFTER_DRAIN = false;
    bf16_t* H; int ldh; const float* bias; int bias_estride;
    __device__ __forceinline__ void operator()(const f32x4 (&acc)[2][2][4][2], const Unit& u, int wr, int wc, int fr, int fq) const {
        const int row0 = u.pm * BM + wr * 64 + fr; const int col0 = u.pn * BM + wc * 32 + 8 * fq;
        f32x4 bv[2][2];
#pragma unroll
        for (int bj = 0; bj < 2; ++bj)
#pragma unroll
            for (int n = 0; n < 2; ++n) bv[bj][n] = *(const f32x4*)(bias + (size_t)u.e * bias_estride + col0 + bj * HALF + 4 * n);
#pragma unroll
        for (int ai = 0; ai < 2; ++ai)
#pragma unroll
            for (int m = 0; m < 4; ++m) { bf16_t* rowp = H + (size_t)(row0 + ai * HALF + m * 16) * ldh + (col0 >> 1);
#pragma unroll
                for (int bj = 0; bj < 2; ++bj) { const f32x4 v0 = acc[ai][bj][m][0] + bv[bj][0], v1 = acc[ai][bj][m][1] + bv[bj][1];
                    u32x2 w; w.x = cvt_pk_bf16(swiglu1(v0[0], v0[1]), swiglu1(v0[2], v0[3])); w.y = cvt_pk_bf16(swiglu1(v1[0], v1[1]), swiglu1(v1[2], v1[3]));
                    *(u32x2*)(rowp + bj * (HALF / 2)) = w; } }
    }
};

__device__ __forceinline__ unsigned cvt4_fp8(float a, float b, float c, float d) {
    int r = 0;
    r = __builtin_amdgcn_cvt_pk_fp8_f32(__builtin_amdgcn_fmed3f(a, -448.f, 448.f), __builtin_amdgcn_fmed3f(b, -448.f, 448.f), r, false);
    r = __builtin_amdgcn_cvt_pk_fp8_f32(__builtin_amdgcn_fmed3f(c, -448.f, 448.f), __builtin_amdgcn_fmed3f(d, -448.f, 448.f), r, true);
    return (unsigned)r;
}
struct EpiSwiglu8 {
    static constexpr bool PERM = true, AFTER_DRAIN = false;
    unsigned char* H; int ldh; const float* bias; int bias_estride; float ascale, hscale;
    __device__ __forceinline__ void operator()(const f32x4 (&acc)[2][2][4][2], const Unit& u, int wr, int wc, int fr, int fq) const {
        const int row0 = u.pm * BM + wr * 64 + fr; const int col0 = u.pn * BM + wc * 32 + 8 * fq;
        f32x4 bv[2][2];
#pragma unroll
        for (int bj = 0; bj < 2; ++bj)
#pragma unroll
            for (int n = 0; n < 2; ++n) bv[bj][n] = *(const f32x4*)(bias + (size_t)u.e * bias_estride + col0 + bj * HALF + 4 * n);
#pragma unroll
        for (int ai = 0; ai < 2; ++ai)
#pragma unroll
            for (int m = 0; m < 4; ++m) { unsigned char* rowp = H + (size_t)(row0 + ai * HALF + m * 16) * ldh + (col0 >> 1);
#pragma unroll
                for (int bj = 0; bj < 2; ++bj) { const f32x4 v0 = acc[ai][bj][m][0] * ascale + bv[bj][0], v1 = acc[ai][bj][m][1] * ascale + bv[bj][1];
                    *(unsigned*)(rowp + bj * (HALF / 2)) = cvt4_fp8(hscale * swiglu1(v0[0], v0[1]), hscale * swiglu1(v0[2], v0[3]), hscale * swiglu1(v1[0], v1[1]), hscale * swiglu1(v1[2], v1[3])); } }
    }
};
struct EpiBf16S {
    static constexpr bool PERM = true, AFTER_DRAIN = false;
    bf16_t* O; int ldc; const float* bias; int bias_estride; float ascale;
    __device__ __forceinline__ void operator()(const f32x4 (&acc)[2][2][4][2], const Unit& u, int wr, int wc, int fr, int fq) const {
        const int row0 = u.pm * BM + wr * 64 + fr; const int col0 = u.pn * BM + wc * 32 + 8 * fq;
        f32x4 bv[2][2];
#pragma unroll
        for (int bj = 0; bj < 2; ++bj)
#pragma unroll
            for (int n = 0; n < 2; ++n) bv[bj][n] = *(const f32x4*)(bias + (size_t)u.e * bias_estride + col0 + bj * HALF + 4 * n);
#pragma unroll
        for (int ai = 0; ai < 2; ++ai)
#pragma unroll
            for (int m = 0; m < 4; ++m) { bf16_t* rowp = O + (size_t)(row0 + ai * HALF + m * 16) * ldc + col0;
#pragma unroll
                for (int bj = 0; bj < 2; ++bj) { const f32x4 v0 = acc[ai][bj][m][0] * ascale + bv[bj][0], v1 = acc[ai][bj][m][1] * ascale + bv[bj][1];
                    u32x4 w; w.x = cvt_pk_bf16(v0[0], v0[1]); w.y = cvt_pk_bf16(v0[2], v0[3]); w.z = cvt_pk_bf16(v1[0], v1[1]); w.w = cvt_pk_bf16(v1[2], v1[3]);
                    *(u32x4*)(rowp + bj * HALF) = w; } }
    }
};

typedef int v8i32 __attribute__((ext_vector_type(8)));
typedef short bf16x16 __attribute__((ext_vector_type(16)));
template <class Epi, class Sched, bool ALIGN_EPI = false, bool SP2 = false, bool FP8 = false>
__device__ __forceinline__ void gemm_phase(PG8_LAS unsigned char* lds, const Gemm g, const Sched& S, const Epi& E) {
    const int tid = threadIdx.x, wid = __builtin_amdgcn_readfirstlane(tid >> 6), lane = tid & 63, wr = wid >> 2, wc = wid & 3, fr = lane & 15, fq = lane >> 4;
    const int K = g.K, nt = K / BK;
    unsigned voffA[2], voffB[2];
#pragma unroll
    for (int i = 0; i < 2; ++i) { int R, C; stage_rc(tid * 16 + i * 8192, R, C); const int Rb = Epi::PERM ? ((R & ~31) + perm32(R & 31)) : R;
        voffA[i] = (unsigned)(R * K + C) * 2u; voffB[i] = (unsigned)(Rb * K + C) * 2u; }
    const size_t kstep = (size_t)(BK * 2);
    const size_t hstep = (size_t)HALF * K * 2;
    const size_t tstep = 2 * hstep;
    const unsigned ldsw = (unsigned)wid * 1024u;
    const int fcol = FP8 ? (32 * (fq >> 1) + 16 * (fq & 1)) : fq * 8;
    const int aoff = lds_byte(wr * 64 + fr, fcol), boff = lds_byte(wc * 32 + fr, fcol);
    constexpr int KSTR = FP8 ? 16 : 1024;
#define PG8_SA(b, h) (((b) * 2 + (h)) * HTB)
#define PG8_SB(b, h) ((4 + (b) * 2 + (h)) * HTB)
#define PG8_STAGE(bufoff, gbase, voff) do { _Pragma("unroll") for (int _i = 0; _i < 2; ++_i) \
        __builtin_amdgcn_global_load_lds((const unsigned*)((const char*)(gbase) + (voff)[_i]), (PG8_LAS unsigned*)(lds + (bufoff) + ldsw + _i * 8192), 16, 0, 0); } while (0)
#define PG8_RD(dst, addr) do { if constexpr (FP8) { const u32x4 _lo = *(const PG8_LAS u32x4*)(addr), _hi = *(const PG8_LAS u32x4*)((addr) + 16); \
        (dst)[0] = (frag_t)__builtin_bit_cast(v8i32, __builtin_shufflevector(_lo, _hi, 0, 1, 2, 3, 4, 5, 6, 7)); } \
    else { (dst)[0] = (frag_t)*(const PG8_LAS bf16x8*)(addr); (dst)[NKF - 1] = (frag_t)*(const PG8_LAS bf16x8*)((addr) + 1024); } } while (0)
#define PG8_LDA(dst, b, h) do { _Pragma("unroll") for (int m = 0; m < 4; ++m) PG8_RD(dst[m], lds + PG8_SA(b, h) + aoff + m * 2048); } while (0)
#define PG8_LDB(dst, b, h) do { _Pragma("unroll") for (int n = 0; n < 2; ++n) PG8_RD(dst[n], lds + PG8_SB(b, h) + boff + n * 2048); } while (0)
#define PG8_MMA(ai, bj, At, Bt) do { __builtin_amdgcn_s_setprio(1); _Pragma("unroll") for (int m = 0; m < 4; ++m) _Pragma("unroll") for (int n = 0; n < 2; ++n) { \
        if constexpr (FP8) asm volatile("v_mfma_f32_16x16x128_f8f6f4 %0, %1, %2, %0" : "+v"(acc[ai][bj][m][n]) : "v"(Bt[n][0]), "v"(At[m][0])); \
        else { _Pragma("unroll") for (int k = 0; k < NKF; ++k) acc[ai][bj][m][n] = __builtin_amdgcn_mfma_f32_16x16x32_bf16((bf16x8)Bt[n][k], (bf16x8)At[m][k], acc[ai][bj][m][n], 0, 0, 0); } } \
        __builtin_amdgcn_s_setprio(0); } while (0)
#define PG8_WAIT_V(n) asm volatile("s_waitcnt vmcnt(" #n ")" ::: "memory")
#define PG8_WAIT_L(n) asm volatile("s_waitcnt lgkmcnt(" #n ")" ::: "memory")
#define PG8_BAR __builtin_amdgcn_s_barrier()
#define PG8_SCHED __builtin_amdgcn_sched_barrier(0)
    Unit cur, nxt; int ui = 0;
    if (!S.next(0, cur)) return;
    f32x4 acc[2][2][4][2];
#pragma unroll
    for (int a = 0; a < 2; ++a)
#pragma unroll
        for (int b = 0; b < 2; ++b)
#pragma unroll
            for (int m = 0; m < 4; ++m)
#pragma unroll
                for (int n = 0; n < 2; ++n) acc[a][b][m][n] = (f32x4){0.f, 0.f, 0.f, 0.f};
    typedef typename std::conditional<FP8, v8i32, bf16x8>::type frag_t; constexpr int NKF = FP8 ? 1 : 2;
    frag_t At[4][NKF], B0[2][NKF], B1[2][NKF];
    const char* cA = (const char*)g.A + (size_t)cur.pm * tstep; const char* cB = (const char*)g.Bt + (size_t)cur.bt * tstep;
    S.a_ready(cur);
    if constexpr (SP2) {
        PG8_STAGE(PG8_SB(0, 0), cB, voffB); PG8_STAGE(PG8_SB(0, 1), cB + hstep, voffB); PG8_STAGE(PG8_SA(0, 0), cA, voffA); PG8_STAGE(PG8_SA(0, 1), cA + hstep, voffA);
        if (wr == 1) PG8_BAR;
        PG8_WAIT_V(2); PG8_BAR;
        PG8_STAGE(PG8_SB(1, 0), cB + kstep, voffB); PG8_STAGE(PG8_SA(1, 0), cA + kstep, voffA); PG8_STAGE(PG8_SB(1, 1), cB + hstep + kstep, voffB);
        PG8_WAIT_V(6); PG8_BAR;
    } else {
        PG8_STAGE(PG8_SB(0, 0), cB, voffB); PG8_STAGE(PG8_SA(0, 0), cA, voffA); PG8_STAGE(PG8_SB(0, 1), cB + hstep, voffB); PG8_STAGE(PG8_SA(0, 1), cA + hstep, voffA);
        if (wr == 1) PG8_BAR;
        PG8_WAIT_V(4); PG8_BAR;
        PG8_STAGE(PG8_SB(1, 0), cB + kstep, voffB); PG8_STAGE(PG8_SA(1, 0), cA + kstep, voffA); PG8_STAGE(PG8_SB(1, 1), cB + hstep + kstep, voffB);
        PG8_WAIT_V(6); PG8_BAR;
    }
    for (;;) {
        const bool has_next = S.next(ui + 1, nxt);
        const char* nA = has_next ? (const char*)g.A + (size_t)nxt.pm * tstep : cA; const char* nB = has_next ? (const char*)g.Bt + (size_t)nxt.bt * tstep : cB;
        for (int t = 0; t < nt; t += 2) {
            const bool last = (t == nt - 2);
            const char* a1 = cA + (size_t)(t + 1) * kstep;
            const char* a2 = last ? nA : cA + (size_t)(t + 2) * kstep; const char* b2 = last ? nB : cB + (size_t)(t + 2) * kstep;
            const char* a3 = a2 + kstep; const char* b3 = b2 + kstep;
            if (last && has_next) S.a_ready(nxt);
            if constexpr (SP2) {
            PG8_LDB(B0, 0, 0); PG8_LDB(B1, 0, 1); PG8_SCHED; PG8_LDA(At, 0, 0); PG8_STAGE(PG8_SA(1, 1), a1 + hstep, voffA);
            PG8_WAIT_V(8); PG8_WAIT_L(0); PG8_BAR; PG8_MMA(0, 0, At, B0); PG8_MMA(0, 1, At, B1); PG8_BAR; PG8_SCHED;
            PG8_LDA(At, 0, 1); PG8_STAGE(PG8_SB(0, 0), b2, voffB); PG8_STAGE(PG8_SB(0, 1), b2 + hstep, voffB); PG8_STAGE(PG8_SA(0, 0), a2, voffA);
            PG8_WAIT_V(8); PG8_WAIT_L(0); PG8_BAR; PG8_MMA(1, 0, At, B0); PG8_MMA(1, 1, At, B1); PG8_BAR; PG8_SCHED;
            PG8_LDB(B0, 1, 0); PG8_LDB(B1, 1, 1); PG8_SCHED; PG8_LDA(At, 1, 0); PG8_STAGE(PG8_SA(0, 1), a2 + hstep, voffA);
            PG8_WAIT_V(8); PG8_WAIT_L(0); PG8_BAR; PG8_MMA(0, 0, At, B0); PG8_MMA(0, 1, At, B1); PG8_BAR; PG8_SCHED;
            PG8_LDA(At, 1, 1); PG8_STAGE(PG8_SB(1, 0), b3, voffB); PG8_STAGE(PG8_SB(1, 1), b3 + hstep, voffB); PG8_STAGE(PG8_SA(1, 0), a3, voffA);
            PG8_WAIT_V(8); PG8_WAIT_L(0); PG8_BAR; PG8_MMA(1, 0, At, B0); PG8_MMA(1, 1, At, B1); PG8_BAR; PG8_SCHED;
            } else {
            PG8_LDB(B0, 0, 0); PG8_SCHED; PG8_LDA(At, 0, 0); PG8_STAGE(PG8_SA(1, 1), a1 + hstep, voffA);
            PG8_WAIT_L(8); PG8_BAR; PG8_WAIT_L(0); PG8_MMA(0, 0, At, B0); PG8_BAR; PG8_SCHED;
            PG8_LDB(B1, 0, 1); PG8_STAGE(PG8_SB(0, 0), b2, voffB);
            PG8_BAR; PG8_WAIT_L(0); PG8_MMA(0, 1, At, B1); PG8_BAR;
            PG8_LDA(At, 0, 1); PG8_STAGE(PG8_SA(0, 0), a2, voffA);
            PG8_BAR; PG8_WAIT_L(0); PG8_MMA(1, 0, At, B0); PG8_BAR; PG8_SCHED;
            PG8_STAGE(PG8_SB(0, 1), b2 + hstep, voffB);
            PG8_WAIT_V(6); PG8_BAR; PG8_MMA(1, 1, At, B1); PG8_BAR;
            PG8_LDB(B0, 1, 0); PG8_SCHED; PG8_LDA(At, 1, 0); PG8_STAGE(PG8_SA(0, 1), a2 + hstep, voffA);
            PG8_WAIT_L(8); PG8_BAR; PG8_WAIT_L(0); PG8_MMA(0, 0, At, B0); PG8_BAR; PG8_SCHED;
            PG8_LDB(B1, 1, 1); PG8_STAGE(PG8_SB(1, 0), b3, voffB);
            PG8_BAR; PG8_WAIT_L(0); PG8_MMA(0, 1, At, B1); PG8_BAR;
            PG8_LDA(At, 1, 1); PG8_STAGE(PG8_SA(1, 0), a3, voffA);
            PG8_BAR; PG8_WAIT_L(0); PG8_MMA(1, 0, At, B0); PG8_BAR; PG8_SCHED;
            PG8_STAGE(PG8_SB(1, 1), b3 + hstep, voffB);
            PG8_WAIT_V(6); PG8_BAR; PG8_MMA(1, 1, At, B1); PG8_BAR;
            }
        }
        if constexpr (ALIGN_EPI) { if (wr == 0) PG8_BAR; }
        if constexpr (FP8) asm volatile("s_nop 15\n\ts_nop 15" ::: "memory");
        if constexpr (!Epi::AFTER_DRAIN) { E(acc, cur, wr, wc, fr, fq); S.done(cur); }
        if (!has_next) break;
#pragma unroll
        for (int a = 0; a < 2; ++a)
#pragma unroll
            for (int b = 0; b < 2; ++b)
#pragma unroll
                for (int m = 0; m < 4; ++m)
#pragma unroll
                    for (int n = 0; n < 2; ++n) acc[a][b][m][n] = (f32x4){0.f, 0.f, 0.f, 0.f};
        cur = nxt; cA = nA; cB = nB; ++ui;
        if constexpr (ALIGN_EPI) { if (wr == 1) PG8_BAR; }
    }
    PG8_WAIT_V(0);
    if constexpr (!ALIGN_EPI) { if (wr == 0) PG8_BAR; }
    PG8_BAR;
    if constexpr (Epi::AFTER_DRAIN) { E.fused(acc, cur, wr, wc, fr, fq, lds, wid, lane); S.done(cur); }
#undef PG8_SA
#undef PG8_SB
#undef PG8_STAGE
#undef PG8_LDA
#undef PG8_LDB
#undef PG8_MMA
#undef PG8_RD
#undef PG8_WAIT_V
#undef PG8_WAIT_L
#undef PG8_BAR
#undef PG8_SCHED
}
}

constexpr int NWAVES = 8;
constexpr int NBATCH = 4, SEQ = 2048, T = NBATCH * SEQ, D = 2048, HD = 128, NHG = 8, GW = 1024, NQKV = 6144, NE = 32, TOPK = 4, FF = 2048, FF2 = 4096;
constexpr int MAXBLK = 160;
constexpr float EPS = 1e-6f;
constexpr int NPHASE = 11;
constexpr float WSCALE = 512.0f, XSCALE = 16.0f, HSCALE = 4.0f;

constexpr size_t MiB = 1u << 20;
constexpr size_t WS_CTL = 0, CTL_ZERO_BYTES = 1 * MiB;
constexpr size_t WS_MODP = 1 * MiB;
constexpr size_t WS_TOPI = 5 * MiB, WS_TOPG = WS_TOPI + 131072, WS_TSLOT = WS_TOPG + 131072;
constexpr size_t WS_TRANK = WS_TSLOT + 131072, WS_HIST = WS_TRANK + 131072;
constexpr size_t WS_LSE = 6 * MiB;
constexpr size_t WS_WIN_T = 8 * MiB;
constexpr size_t WS_WO_T = 32 * MiB;
constexpr size_t WS_HMIX = 40 * MiB;
constexpr size_t WS_AOUT = 72 * MiB;
constexpr size_t WS_PROJ = 104 * MiB;
constexpr size_t WS_ONA = 200 * MiB;
constexpr size_t WS_ODIL = 232 * MiB;
constexpr size_t WS_MIXED = 328 * MiB;
constexpr size_t WS_X1 = 392 * MiB;
constexpr size_t WS_HFFN = 456 * MiB;
constexpr size_t WS_XG = 492 * MiB;
constexpr size_t WS_HB = 652 * MiB;
constexpr size_t WS_YB = 812 * MiB;
constexpr size_t WS_WEI_T = 1024 * MiB;
constexpr size_t WS_WEO_T = 1536 * MiB;
constexpr size_t WS_END = 1792 * MiB;
constexpr int CW_TMO = 0, CW_CODE = 1, CW_CNT = 256, CW_CUR = 512, CW_BAR = 4096;

constexpr int RING_OFF = 0, RING_BYTES = 155648;
constexpr int MISC_OFF = RING_BYTES;
constexpr int LDS_BYTES = RING_BYTES + 1024;

#define GAS __attribute__((address_space(1)))
#define LAS __attribute__((address_space(3)))
typedef unsigned short bf16;
typedef unsigned v4u __attribute__((ext_vector_type(4)));
typedef unsigned v2u __attribute__((ext_vector_type(2)));
typedef float f32x4 __attribute__((ext_vector_type(4)));
typedef GAS unsigned gu32;
#define RLX_AGENT __ATOMIC_RELAXED, __HIP_MEMORY_SCOPE_AGENT
#define LDS_WAIT() asm volatile("s_waitcnt lgkmcnt(0)" ::: "memory")
#define VM_WAIT() asm volatile("s_waitcnt vmcnt(0)" ::: "memory")
__device__ __forceinline__ float bf2f(unsigned short h) { return __builtin_bit_cast(float, (unsigned)h << 16); }
__device__ __forceinline__ float bflo(unsigned w) { return __builtin_bit_cast(float, w << 16); }
__device__ __forceinline__ float bfhi(unsigned w) { return __builtin_bit_cast(float, w & 0xffff0000u); }
__device__ __forceinline__ unsigned pk2(float lo, float hi) { return pg8::cvt_pk_bf16(lo, hi); }

#define XB_TMO      128
#define XB_XCNT(j)  (256  + 64 * (j))
#define XB_XSUB(j)  (1280 + 64 * (j))
#define XB_XGEN(j)  (2304 + 64 * (j))
#define XB_TOP      3328
#define XB_TOPGEN   3392
#define XCD_BAR_WORDS 3456
#define XB_SPIN_CAP (1u << 18)
__device__ __forceinline__ unsigned xb_ld(unsigned* p)              { return __hip_atomic_load(p, __ATOMIC_RELAXED, __HIP_MEMORY_SCOPE_AGENT); }
__device__ __forceinline__ unsigned xb_add(unsigned* p, unsigned v) { return __hip_atomic_fetch_add(p, v, __ATOMIC_RELAXED, __HIP_MEMORY_SCOPE_AGENT); }
__device__ __forceinline__ unsigned xb_xcc_id() { return (unsigned)__builtin_amdgcn_s_getreg((3 << 11) | 20) & 0xFu; }
#define XB_SPIN(cond, bar) do { unsigned _sp = 0; while (cond) { __builtin_amdgcn_s_sleep(1); \
    if ((++_sp & 255u) == 0u) { if (xb_ld(&(bar)[XB_TMO])) break; if (_sp > XB_SPIN_CAP) { atomicAdd(&(bar)[XB_TMO], 1u); break; } } } } while (0)
struct XcdBarrier { unsigned* bar; unsigned x; volatile LAS unsigned* st; };
__device__ __forceinline__ XcdBarrier xcd_barrier_post(unsigned* bar, volatile LAS unsigned* st) {
    XcdBarrier b; b.bar = bar; b.x = xb_xcc_id(); b.st = st;
    if (threadIdx.x == 0) (void)xb_add(&bar[XB_XCNT(b.x)], 1u);
    return b;
}
__device__ __forceinline__ void xcd_barrier_complete(unsigned* bar, unsigned x, unsigned& nloc, unsigned& nx) {
    const unsigned G = gridDim.x * gridDim.y * gridDim.z;
    unsigned sum, cnt, mine, sp = 0u;
    for (;;) {
        sum = 0u; cnt = 0u; mine = 0u;
#pragma unroll
        for (unsigned j = 0; j < 16; ++j) { const unsigned c = xb_ld(&bar[XB_XCNT(j)]); sum += c; cnt += (c > 0u) ? 1u : 0u; mine = (j == x) ? c : mine; }
        if (sum == G) break;
        __builtin_amdgcn_s_sleep(1);
        if ((++sp & 255u) == 0u) { if (xb_ld(&bar[XB_TMO])) break; if (sp > XB_SPIN_CAP) { atomicAdd(&bar[XB_TMO], 1u); break; } }
    }
    nloc = mine > 0u ? mine : 1u; nx = cnt > 0u ? cnt : 1u;
}
__device__ __forceinline__ void xcd_barrier(const XcdBarrier& b) {
    asm volatile("s_waitcnt vmcnt(0)" ::: "memory");
    __syncthreads();
    if (threadIdx.x == 0) {
        unsigned* bar = b.bar;
        __builtin_amdgcn_s_waitcnt(0);
        unsigned nloc = b.st[0], nx = b.st[1];
        if (nloc == 0u) { xcd_barrier_complete(bar, b.x, nloc, nx); b.st[0] = nloc; b.st[1] = nx; }
        const unsigned old = xb_add(&bar[XB_XSUB(b.x)], 1u);
        const unsigned gen = old / nloc;
        if (old + 1u == (gen + 1u) * nloc) {
            __builtin_amdgcn_fence(__ATOMIC_RELEASE, "agent");
            asm volatile("s_waitcnt vmcnt(0)" ::: "memory");
            const unsigned og = xb_add(&bar[XB_TOP], 1u);
            const unsigned tg = og / nx;
            if (og + 1u == (tg + 1u) * nx) xb_add(&bar[XB_TOPGEN], 1u);
            else XB_SPIN(xb_ld(&bar[XB_TOPGEN]) == tg, bar);
            __builtin_amdgcn_fence(__ATOMIC_ACQUIRE, "agent");
            xb_add(&bar[XB_XGEN(b.x)], 1u);
            asm volatile("s_waitcnt vmcnt(0)" ::: "memory");
        } else {
            XB_SPIN(xb_ld(&bar[XB_XGEN(b.x)]) == gen, bar);
            __builtin_amdgcn_fence(__ATOMIC_ACQUIRE, "agent");
            asm volatile("s_waitcnt vmcnt(0)" ::: "memory");
        }
    }
    __syncthreads();
}

struct Frame {
    LAS unsigned char* lds;
    volatile LAS unsigned* MISC;
    unsigned* ctl;
    int tid, lane, wave, vcu, G;
    const float *x, *c, *w_ada, *b_ada, *g_pre_mix, *g_post_mix, *w_in, *rpb, *t5, *g_out_na, *g_out_dil, *w_o, *g_pre_ffn, *g_post_ffn, *w_router, *b_router, *w_e_in, *b_e_in, *w_e_out, *b_e_out;
    float* out;
    unsigned char* ws;
};
__device__ __forceinline__ float wave_sum(float v) {
#pragma unroll
    for (int o = 1; o < 64; o <<= 1) v += __shfl_xor(v, o);
    return v;
}
__device__ __forceinline__ float wave_max(float v) {
#pragma unroll
    for (int o = 1; o < 64; o <<= 1) v = fmaxf(v, __shfl_xor(v, o));
    return v;
}
__device__ __forceinline__ float mod_val(const Frame& F, int b, int idx) {
    const float* mp = (const float*)(F.ws + WS_MODP);
    float s = F.b_ada[idx];
#pragma unroll
    for (int ks = 0; ks < 16; ++ks) s += mp[(size_t)(ks * 4 + b) * (6 * D) + idx];
    return s;
}

__constant__ unsigned char T5B[3][132] = {
 {11,11,11,11,11,11,11,11,11,11,11,11,11,11,11,10,10,10,10,10,10,10,10,10,10,10,10,10,10,10,10,10,10,10,10,10,10,10,9,9,9,9,9,9,9,9,9,9,9,9,8,8,8,8,8,8,8,7,6,5,4,3,2,1,0,17,18,19,20,21,22,23,24,24,24,24,24,24,24,25,25,25,25,25,25,25,25,25,25,25,25,26,26,26,26,26,26,26,26,26,26,26,26,26,26,26,26,26,26,26,26,26,26,26,27,27,27,27,27,27,27,27,27,27,27,27,27,27,27,0,0,0},
 {13,13,13,13,13,13,13,13,13,13,13,13,13,13,13,13,13,13,13,13,13,13,13,12,12,12,12,12,12,12,12,12,12,12,12,12,12,12,12,12,12,12,11,11,11,11,11,11,11,11,11,11,10,10,10,10,10,10,9,9,9,8,8,4,0,20,24,24,25,25,25,26,26,26,26,26,26,27,27,27,27,27,27,27,27,27,27,28,28,28,28,28,28,28,28,28,28,28,28,28,28,28,28,28,28,28,29,29,29,29,29,29,29,29,29,29,29,29,29,29,29,29,29,29,29,29,29,29,29,0,0,0},
 {15,15,15,15,15,15,15,15,15,15,15,15,15,15,15,15,15,15,15,15,15,15,15,15,15,15,15,15,15,15,14,14,14,14,14,14,14,14,14,14,14,14,14,14,14,13,13,13,13,13,13,13,13,13,12,12,12,12,12,11,11,10,10,9,0,25,26,26,27,27,28,28,28,28,28,29,29,29,29,29,29,29,29,29,30,30,30,30,30,30,30,30,30,30,30,30,30,30,30,31,31,31,31,31,31,31,31,31,31,31,31,31,31,31,31,31,31,31,31,31,31,31,31,31,31,31,31,31,31,0,0,0}};

__device__ __forceinline__ void p0_mod_item(Frame& F, int j) {
    const int ks = j >> 4, cb = j & 15;
    LAS float* sc = (LAS float*)(F.lds + RING_OFF);
    LAS float* red = (LAS float*)(F.lds + RING_OFF + 4096);
    __syncthreads();
    { const int b = F.tid >> 7, k = F.tid & 127; const float cv = F.c[b * D + ks * 128 + k]; sc[F.tid] = cv / (1.0f + __expf(-cv)); }
    __syncthreads();
    const int cg = F.tid % 192, sub = F.tid / 192;
    f32x4 acc[4];
#pragma unroll
    for (int b = 0; b < 4; ++b) acc[b] = (f32x4){0.f, 0.f, 0.f, 0.f};
    if (sub < 2) {
        const float* wp = F.w_ada + (size_t)(ks * 128 + sub * 64) * (6 * D) + cb * 768 + 4 * cg;
#pragma unroll 8
        for (int i = 0; i < 64; ++i) {
            const f32x4 w = *(const f32x4*)(wp + (size_t)i * (6 * D));
#pragma unroll
            for (int b = 0; b < 4; ++b) { const float s = sc[b * 128 + sub * 64 + i]; acc[b] += w * s; }
        }
        if (sub == 1) {
#pragma unroll
            for (int b = 0; b < 4; ++b) *(LAS f32x4*)(red + cg * 16 + b * 4) = acc[b];
        }
    }
    __syncthreads();
    if (sub == 0) {
        float* mp = (float*)(F.ws + WS_MODP);
#pragma unroll
        for (int b = 0; b < 4; ++b) { const f32x4 o = acc[b] + *(LAS f32x4*)(red + cg * 16 + b * 4); *(f32x4*)(mp + (size_t)(ks * 4 + b) * (6 * D) + cb * 768 + 4 * cg) = o; }
    }
}
__device__ __forceinline__ void p0_transpose_item(const float* W, int K, int N, bf16* WT, LAS float* scr, int item, int lane) {
    const int nblk = N >> 6, kb = item / nblk, nb = item - kb * nblk, k0 = kb << 6, n0 = nb << 6;
    const float* src = W + (size_t)(k0 + (lane >> 4)) * N + n0 + 4 * (lane & 15);
    f32x4 v[16];
#pragma unroll
    for (int i = 0; i < 16; ++i) v[i] = *(const f32x4*)(src + (size_t)(4 * i) * N);
#pragma unroll
    for (int i = 0; i < 16; ++i) { LAS float* d = scr + (4 * i + (lane >> 4)) * 65 + 4 * (lane & 15); d[0] = v[i][0]; d[1] = v[i][1]; d[2] = v[i][2]; d[3] = v[i][3]; }
    LDS_WAIT();
    const int c = lane >> 3;
#pragma unroll
    for (int jn = 0; jn < 8; ++jn) { const int n = (lane & 7) + 8 * jn; const LAS float* s = scr + (8 * c) * 65 + n;
        v4u o; o.x = pk2(s[0 * 65], s[1 * 65]); o.y = pk2(s[2 * 65], s[3 * 65]); o.z = pk2(s[4 * 65], s[5 * 65]); o.w = pk2(s[6 * 65], s[7 * 65]);
        *(v4u*)(WT + (size_t)(n0 + n) * K + k0 + 8 * c) = o; }
    LDS_WAIT();
}
__device__ __forceinline__ void p0_transpose8_item(const float* W, int K, int N, unsigned char* WT, LAS float* scr, int item, int lane, float scale) {
    const int nblk = N >> 5, kb = item / nblk, nb = item - kb * nblk, k0 = kb << 7, n0 = nb << 5;
    const float* src = W + (size_t)(k0 + (lane >> 3)) * N + n0 + 4 * (lane & 7);
    f32x4 v[16];
#pragma unroll
    for (int i = 0; i < 16; ++i) v[i] = *(const f32x4*)(src + (size_t)(8 * i) * N);
#pragma unroll
    for (int i = 0; i < 16; ++i) { LAS float* d = scr + (8 * i + (lane >> 3)) * 33 + 4 * (lane & 7); d[0] = v[i][0]; d[1] = v[i][1]; d[2] = v[i][2]; d[3] = v[i][3]; }
    LDS_WAIT();
#pragma unroll
    for (int jn = 0; jn < 2; ++jn)
#pragma unroll
        for (int jc = 0; jc < 2; ++jc) { const int n = (lane & 15) + 16 * jn, c = (lane >> 4) + 4 * jc; const LAS float* s = scr + (16 * c) * 33 + n;
            v4u o;
            o.x = pg8::cvt4_fp8(s[0 * 33] * scale, s[1 * 33] * scale, s[2 * 33] * scale, s[3 * 33] * scale);
            o.y = pg8::cvt4_fp8(s[4 * 33] * scale, s[5 * 33] * scale, s[6 * 33] * scale, s[7 * 33] * scale);
            o.z = pg8::cvt4_fp8(s[8 * 33] * scale, s[9 * 33] * scale, s[10 * 33] * scale, s[11 * 33] * scale);
            o.w = pg8::cvt4_fp8(s[12 * 33] * scale, s[13 * 33] * scale, s[14 * 33] * scale, s[15 * 33] * scale);
            *(v4u*)(WT + (size_t)(n0 + n) * K + k0 + 16 * c) = o; }
    LDS_WAIT();
}
__device__ __forceinline__ void p0_prologue(Frame& F) {
    for (int j = F.vcu; j < 256; j += F.G) p0_mod_item(F, j);
    __syncthreads();
    LAS float* scr = (LAS float*)(F.lds + RING_OFF + F.wave * 16896);
    const int gw = F.vcu * NWAVES + F.wave, NGW = F.G * NWAVES;
    constexpr int I_IN = (D / 64) * (NQKV / 64), I_O = (D / 64) * (D / 64), I_EI1 = (D / 128) * (FF2 / 32), I_EO1 = (FF / 128) * (D / 32);
    constexpr int I_EI = NE * I_EI1, I_EO = NE * I_EO1, NITEMS = I_IN + I_O + I_EI + I_EO;
    for (int it = gw; it < NITEMS; it += NGW) {
        int r = it;
        if (r < I_IN) { p0_transpose_item(F.w_in, D, NQKV, (bf16*)(F.ws + WS_WIN_T), scr, r, F.lane); continue; } r -= I_IN;
        if (r < I_O) { p0_transpose_item(F.w_o, D, D, (bf16*)(F.ws + WS_WO_T), scr, r, F.lane); continue; } r -= I_O;
        if (r < I_EI) { const int e = r / I_EI1; p0_transpose8_item(F.w_e_in + (size_t)e * D * FF2, D, FF2, F.ws + WS_WEI_T + (size_t)e * FF2 * D, scr, r - e * I_EI1, F.lane, WSCALE); continue; } r -= I_EI;
        { const int e = r / I_EO1; p0_transpose8_item(F.w_e_out + (size_t)e * FF * D, FF, D, F.ws + WS_WEO_T + (size_t)e * D * FF, scr, r - e * I_EO1, F.lane, WSCALE); }
    }
}

__device__ __forceinline__ void p1_hmix(Frame& F) {
    LAS float* ta = (LAS float*)(F.lds + RING_OFF);
    LAS float* tb = ta + D;
    for (int rb = F.vcu; rb < T / 32; rb += F.G) {
        const int b = rb >> 6;
        __syncthreads();
        for (int col = F.tid; col < D; col += NWAVES * 64) { ta[col] = F.g_pre_mix[col] * (1.0f + mod_val(F, b, D + col)); tb[col] = mod_val(F, b, col); }
        __syncthreads();
        for (int rr = F.wave; rr < 32; rr += NWAVES) {
            const int row = rb * 32 + rr;
            const f32x4* xr = (const f32x4*)(F.x + (size_t)row * D) + F.lane;
            f32x4 v[8]; float ss = 0.f;
#pragma unroll
            for (int j = 0; j < 8; ++j) { v[j] = xr[64 * j]; ss += (v[j][0] * v[j][0] + v[j][1] * v[j][1]) + (v[j][2] * v[j][2] + v[j][3] * v[j][3]); }
            const float r = 1.0f / sqrtf(wave_sum(ss) * (1.0f / D) + EPS);
            v2u* o8 = (v2u*)((bf16*)(F.ws + WS_HMIX) + (size_t)row * D) + F.lane;
#pragma unroll
            for (int j = 0; j < 8; ++j) { const int col = 4 * F.lane + 256 * j; const f32x4 a = *(LAS f32x4*)(ta + col), s = *(LAS f32x4*)(tb + col);
                v2u w; w.x = pk2(v[j][0] * r * a[0] + s[0], v[j][1] * r * a[1] + s[1]); w.y = pk2(v[j][2] * r * a[2] + s[2], v[j][3] * r * a[3] + s[3]); o8[64 * j] = w; }
        }
    }
}

__device__ __forceinline__ float dot_qk(const LAS float* q, const bf16* krow) {
    float s = 0.f;
#pragma unroll
    for (int ch = 0; ch < 16; ++ch) { const v4u kv = *(const v4u*)(krow + 8 * ch); const LAS float* qq = q + 8 * ch;
        s += qq[0] * bflo(kv.x) + qq[1] * bfhi(kv.x) + qq[2] * bflo(kv.y) + qq[3] * bfhi(kv.y) + qq[4] * bflo(kv.z) + qq[5] * bfhi(kv.z) + qq[6] * bflo(kv.w) + qq[7] * bfhi(kv.w); }
    return s;
}
__device__ __forceinline__ void p3_attn_naive(Frame& F) {
    LAS float* lq = (LAS float*)(F.lds + RING_OFF + F.wave * 2048);
    LAS float* lp = lq + 128;
    const bf16* proj = (const bf16*)(F.ws + WS_PROJ);
    float* ona = (float*)(F.ws + WS_ONA); float* odil = (float*)(F.ws + WS_ODIL); float* lse = (float*)(F.ws + WS_LSE);
    const float scale = 0.08838834764831845f;
    const int gw = F.vcu * NWAVES + F.wave, NGW = F.G * NWAVES, lane = F.lane;
    for (int it = gw; it < T * 16; it += NGW) {
        const int tok = it >> 4, hh = it & 15, b = tok >> 11, pos = tok & 2047;
        const bf16* prow = proj + (size_t)tok * NQKV;
        if (hh < 8) {
            const int h = hh;
            { const unsigned qw = *(const unsigned*)(prow + h * HD + 2 * lane); LDS_WAIT(); lq[2 * lane] = bflo(qw); lq[2 * lane + 1] = bfhi(qw); LDS_WAIT(); }
            const int r = pos >> 6, c = pos & 63; const int rs = min(max(r - 4, 0), 24), cs = min(max(c - 8, 0), 48);
            float lg[2];
#pragma unroll
            for (int jj = 0; jj < 2; ++jj) { const int j = lane + 64 * jj, i = j >> 4, cc = cs + (j & 15), kpos = (rs + i) * 64 + cc;
                const float d = dot_qk(lq, proj + (size_t)(b * SEQ + kpos) * NQKV + GW + h * HD);
                lg[jj] = d * scale + F.rpb[(h * 15 + (rs + i - r + 7)) * 31 + (cc - c + 15)]; }
            const float m = wave_max(fmaxf(lg[0], lg[1]));
            const float p0 = __expf(lg[0] - m), p1 = __expf(lg[1] - m);
            const float inv = 1.0f / wave_sum(p0 + p1);
            lp[lane] = p0 * inv; lp[lane + 64] = p1 * inv; LDS_WAIT();
            float o0 = 0.f, o1 = 0.f;
            for (int j = 0; j < 128; ++j) { const int kpos = (rs + (j >> 4)) * 64 + cs + (j & 15);
                const unsigned vw = *(const unsigned*)(proj + (size_t)(b * SEQ + kpos) * NQKV + 2 * GW + h * HD + 2 * lane); const float p = lp[j]; o0 += p * bflo(vw); o1 += p * bfhi(vw); }
            *(float2*)(ona + (size_t)tok * GW + h * HD + 2 * lane) = make_float2(o0, o1);
        } else {
            const int h = hh - 8;
            { const unsigned qw = *(const unsigned*)(prow + 3 * GW + h * HD + 2 * lane); LDS_WAIT(); lq[2 * lane] = bflo(qw); lq[2 * lane + 1] = bfhi(qw); LDS_WAIT(); }
#pragma unroll
            for (int p = 0; p < 3; ++p) {
                const int dsh = 2 * p, dil = 1 << dsh, sub_len = SEQ >> dsh, rho = pos & (dil - 1), ql = pos >> dsh;
                float lg[3];
#pragma unroll
                for (int jj = 0; jj < 3; ++jj) { const int j = lane + 64 * jj; const int kl = ql + j - 64; const bool valid = (j < 129) && (kl >= 0) && (kl < sub_len);
                    const int kpos = rho + dil * min(max(kl, 0), sub_len - 1);
                    float d = -INFINITY;
                    if (valid) d = dot_qk(lq, proj + (size_t)(b * SEQ + kpos) * NQKV + 4 * GW + h * HD) * scale + F.t5[(int)T5B[p][j] * 8 + h];
                    lg[jj] = d; }
                const float m = wave_max(fmaxf(fmaxf(lg[0], lg[1]), lg[2]));
                const float p0 = __expf(lg[0] - m), p1 = __expf(lg[1] - m), p2 = __expf(lg[2] - m);
                const float den = wave_sum(p0 + p1 + p2), inv = 1.0f / den;
                LDS_WAIT(); lp[lane] = p0 * inv; lp[lane + 64] = p1 * inv; lp[lane + 128] = p2 * inv; LDS_WAIT();
                float o0 = 0.f, o1 = 0.f;
                for (int j = 0; j < 129; ++j) { const int kl = ql + j - 64; const int kpos = rho + dil * min(max(kl, 0), sub_len - 1);
                    const unsigned vw = *(const unsigned*)(proj + (size_t)(b * SEQ + kpos) * NQKV + 5 * GW + h * HD + 2 * lane); const float pp = lp[j]; o0 += pp * bflo(vw); o1 += pp * bfhi(vw); }
                *(float2*)(odil + ((size_t)p * T + tok) * GW + h * HD + 2 * lane) = make_float2(o0, o1);
                if (lane == 0) lse[((size_t)p * T + tok) * 8 + h] = m + __logf(den);
            }
        }
    }
}


typedef short bf16x8v __attribute__((ext_vector_type(8)));
typedef short s16x4v __attribute__((ext_vector_type(4)));
typedef int v4i16_t_ __attribute__((ext_vector_type(2)));
__device__ __forceinline__ unsigned vimg_off(unsigned row, unsigned ch) { return 256u * row + 16u * (ch ^ (((row & 3u) << 2) | ((row >> 2) & 3u))); }
__device__ __forceinline__ s16x4v tr_read16(const LAS unsigned char* p) {
    typedef short v4i16 __attribute__((ext_vector_type(4)));
    return __builtin_bit_cast(s16x4v, __builtin_amdgcn_ds_read_tr16_b64_v4i16((LAS v4i16*)p));
}
struct GeoNA {
    int tok0, qbase, kbase, r, rs, c0, kc0; const float* rpb_h;
    static constexpr int QCOL = 0, KCOL = GW, VCOL = 2 * GW;
    __device__ __forceinline__ int qtok(int n16) const { return qbase + n16; }
    __device__ __forceinline__ int ktok(int c, int slot) const { return kbase + c * 64 + slot; }
    __device__ __forceinline__ float bias(int c, int slot, int n16) const {
        const int qc = c0 + n16, kc = kc0 + slot, cs = min(max(qc - 8, 0), 48);
        const bool valid = (kc >= cs) && (kc < cs + 16);
        const int dc = min(max(kc - qc + 15, 0), 30);
        const float bv = rpb_h[(rs + c - r + 7) * 31 + dc];
        return valid ? bv : -INFINITY;
    }
};
struct GeoDil {
    int tok0, rho, dsh, sub_len, l0, p, h; const float* t5;
    static constexpr int QCOL = 3 * GW, KCOL = 4 * GW, VCOL = 5 * GW;
    __device__ __forceinline__ int qtok(int n16) const { return tok0 + rho + ((l0 + n16) << dsh); }
    __device__ __forceinline__ int ktok(int c, int slot) const { const int l = min(max(l0 - 64 + 32 * c + slot, 0), sub_len - 1); return tok0 + rho + (l << dsh); }
    __device__ __forceinline__ float bias(int c, int slot, int n16) const {
        const int kk = 32 * c + slot, delta = kk - 64 - n16, l = l0 - 64 + kk;
        const bool valid = (delta >= -64) && (delta <= 64) && (l >= 0) && (l < sub_len);
        const int di = min(max(delta + 64, 0), 128);
        const float bv = t5[(int)T5B[p][di] * 8 + h];
        return valid ? bv : -INFINITY;
    }
};
template <int NCH, class Geo>
__device__ __forceinline__ void attn_item(const Geo& G, const bf16* proj, int hcol, LAS unsigned char* vimg, float* out, float* lse_out, int lane) {
    const int n16 = lane & 15, g = lane >> 4;
    const float scale_l2 = 0.08838834764831845f * 1.44269504089f;
    bf16x8v qf[4];
    { const bf16* qp = proj + (size_t)G.qtok(n16) * NQKV + Geo::QCOL + hcol + 8 * g;
#pragma unroll
      for (int s = 0; s < 4; ++s) qf[s] = *(const bf16x8v*)(qp + 32 * s); }
    f32x4 st[NCH][2];
#pragma unroll
    for (int c = 0; c < NCH; ++c)
#pragma unroll
        for (int t2 = 0; t2 < 2; ++t2) {
            const int slot = 8 * (n16 >> 2) + 4 * t2 + (n16 & 3);
            const bf16* kp = proj + (size_t)G.ktok(c, slot) * NQKV + Geo::KCOL + hcol + 8 * g;
            f32x4 acc = (f32x4){0.f, 0.f, 0.f, 0.f};
#pragma unroll
            for (int s = 0; s < 4; ++s) { const bf16x8v kf = *(const bf16x8v*)(kp + 32 * s); acc = __builtin_amdgcn_mfma_f32_16x16x32_bf16(kf, qf[s], acc, 0, 0, 0); }
            st[c][t2] = acc;
        }
    float mx = -INFINITY;
#pragma unroll
    for (int c = 0; c < NCH; ++c)
#pragma unroll
        for (int t2 = 0; t2 < 2; ++t2)
#pragma unroll
            for (int r = 0; r < 4; ++r) { const float bv = G.bias(c, 8 * g + 4 * t2 + r, n16); const float x = st[c][t2][r] * scale_l2 + bv * 1.44269504089f; st[c][t2][r] = x; mx = fmaxf(mx, x); }
    mx = fmaxf(mx, __shfl_xor(mx, 16)); mx = fmaxf(mx, __shfl_xor(mx, 32));
    float sum = 0.f;
    bf16x8v pf[NCH];
#pragma unroll
    for (int c = 0; c < NCH; ++c) {
        float pv[8];
#pragma unroll
        for (int t2 = 0; t2 < 2; ++t2)
#pragma unroll
            for (int r = 0; r < 4; ++r) { const float p = __builtin_amdgcn_exp2f(st[c][t2][r] - mx); pv[4 * t2 + r] = p; sum += p; }
        v4u w; w.x = pk2(pv[0], pv[1]); w.y = pk2(pv[2], pv[3]); w.z = pk2(pv[4], pv[5]); w.w = pk2(pv[6], pv[7]);
        pf[c] = __builtin_bit_cast(bf16x8v, w);
    }
    sum += __shfl_xor(sum, 16); sum += __shfl_xor(sum, 32);
    f32x4 oacc[8];
#pragma unroll
    for (int dt = 0; dt < 8; ++dt) oacc[dt] = (f32x4){0.f, 0.f, 0.f, 0.f};
    const int vr_row = lane >> 4, vr_ch = lane & 15;
    v4u vr[8];
#pragma unroll
    for (int i = 0; i < 8; ++i) vr[i] = *(const v4u*)(proj + (size_t)G.ktok(0, 4 * i + vr_row) * NQKV + Geo::VCOL + hcol + 8 * vr_ch);
    const unsigned q4 = (unsigned)(lane & 15) >> 2, pp = (unsigned)lane & 3u;
#pragma unroll
    for (int c = 0; c < NCH; ++c) {
        asm volatile("" ::: "memory");
#pragma unroll
        for (int i = 0; i < 8; ++i) *(LAS v4u*)(vimg + vimg_off((unsigned)(4 * i + vr_row), (unsigned)vr_ch)) = vr[i];
        asm volatile("" ::: "memory");
        if (c + 1 < NCH) {
#pragma unroll
            for (int i = 0; i < 8; ++i) vr[i] = *(const v4u*)(proj + (size_t)G.ktok(c + 1, 4 * i + vr_row) * NQKV + Geo::VCOL + hcol + 8 * vr_ch);
        }
#pragma unroll
        for (int dt = 0; dt < 8; ++dt) {
            const s16x4v lo = tr_read16(vimg + vimg_off((unsigned)(8 * g) + q4, (unsigned)(2 * dt) + (pp >> 1)) + 8u * (pp & 1u));
            const s16x4v hi = tr_read16(vimg + vimg_off((unsigned)(8 * g + 4) + q4, (unsigned)(2 * dt) + (pp >> 1)) + 8u * (pp & 1u));
            bf16x8v vf; vf[0] = lo[0]; vf[1] = lo[1]; vf[2] = lo[2]; vf[3] = lo[3]; vf[4] = hi[0]; vf[5] = hi[1]; vf[6] = hi[2]; vf[7] = hi[3];
            oacc[dt] = __builtin_amdgcn_mfma_f32_16x16x32_bf16(vf, pf[c], oacc[dt], 0, 0, 0);
        }
        asm volatile("" ::: "memory");
    }
    const float inv = 1.0f / sum;
    float* op = out + (size_t)G.qtok(n16) * GW + hcol + 4 * g;
#pragma unroll
    for (int dt = 0; dt < 8; ++dt) *(f32x4*)(op + 16 * dt) = oacc[dt] * inv;
    if (lse_out != nullptr && g == 0) lse_out[(size_t)G.qtok(n16) * 8 + (hcol >> 7)] = (mx + __builtin_amdgcn_logf(sum)) * 0.69314718056f;
}
__device__ __forceinline__ void p3_attn_mfma(Frame& F) {
    LAS unsigned char* vimg = F.lds + RING_OFF + F.wave * 8192;
    const bf16* proj = (const bf16*)(F.ws + WS_PROJ);
    float* ona = (float*)(F.ws + WS_ONA); float* odil = (float*)(F.ws + WS_ODIL); float* lse = (float*)(F.ws + WS_LSE);
    const int gw = F.vcu * NWAVES + F.wave, NGW = F.G * NWAVES, lane = F.lane;
    for (int it = gw * 2; it < NBATCH * 32 * 8 * 4; it += NGW * 2) {
#pragma unroll 1
        for (int k = 0; k < 2; ++k) {
            const int id = it + k, qt = id & 3, h = (id >> 2) & 7, r = (id >> 5) & 31, b = id >> 10;
            GeoNA G; G.tok0 = b * SEQ; G.r = r; G.rs = min(max(r - 4, 0), 24); G.c0 = 16 * qt; G.kc0 = (qt == 0) ? 0 : (qt == 1) ? 8 : (qt == 2) ? 24 : 32;
            G.qbase = G.tok0 + r * 64 + G.c0; G.kbase = G.tok0 + G.rs * 64 + G.kc0; G.rpb_h = F.rpb + h * (15 * 31);
            attn_item<8, GeoNA>(G, proj, h * HD, vimg, ona, nullptr, lane);
        }
    }
    for (int it = gw * 6; it < 3 * NBATCH * 8 * 128; it += NGW * 6) {
#pragma unroll 1
        for (int k = 0; k < 6; ++k) {
            const int id = it + k, tile = id & 127, h = (id >> 7) & 7, b = (id >> 10) & 3, p = id >> 12;
            GeoDil G; G.dsh = 2 * p; G.sub_len = SEQ >> G.dsh; const int tpc = G.sub_len >> 4;
            G.rho = tile / tpc; G.l0 = (tile - G.rho * tpc) * 16; G.tok0 = b * SEQ; G.p = p; G.h = h; G.t5 = F.t5;
            attn_item<5, GeoDil>(G, proj, h * HD, vimg, odil + (size_t)p * T * GW, lse + (size_t)p * T * 8, lane);
        }
    }
}

__device__ __forceinline__ void p4_post(Frame& F) {
    const float* ona = (const float*)(F.ws + WS_ONA); const float* odil = (const float*)(F.ws + WS_ODIL); const float* lse = (const float*)(F.ws + WS_LSE);
    bf16* aout = (bf16*)(F.ws + WS_AOUT);
    const int gw = F.vcu * NWAVES + F.wave, NGW = F.G * NWAVES, lane = F.lane;
    for (int tok = gw; tok < T; tok += NGW) {
        f32x4 v[4]; float ss = 0.f;
#pragma unroll
        for (int j = 0; j < 4; ++j) { v[j] = *(const f32x4*)(ona + (size_t)tok * GW + 4 * lane + 256 * j); ss += (v[j][0] * v[j][0] + v[j][1] * v[j][1]) + (v[j][2] * v[j][2] + v[j][3] * v[j][3]); }
        float r = 1.0f / sqrtf(wave_sum(ss) * (1.0f / GW) + EPS);
#pragma unroll
        for (int j = 0; j < 4; ++j) { const int col = 4 * lane + 256 * j; const f32x4 g = *(const f32x4*)(F.g_out_na + col);
            v2u w; w.x = pk2(v[j][0] * r * g[0], v[j][1] * r * g[1]); w.y = pk2(v[j][2] * r * g[2], v[j][3] * r * g[3]); *(v2u*)(aout + (size_t)tok * D + col) = w; }
        ss = 0.f;
#pragma unroll
        for (int j = 0; j < 4; ++j) { const int col = 4 * lane + 256 * j, h = col >> 7;
            const float l0 = lse[((size_t)0 * T + tok) * 8 + h], l1 = lse[((size_t)1 * T + tok) * 8 + h], l2 = lse[((size_t)2 * T + tok) * 8 + h];
            const float mx = fmaxf(fmaxf(l0, l1), l2); const float e0 = __expf(l0 - mx), e1 = __expf(l1 - mx), e2 = __expf(l2 - mx); const float inv = 1.0f / (e0 + e1 + e2);
            const f32x4 a0 = *(const f32x4*)(odil + ((size_t)0 * T + tok) * GW + col), a1 = *(const f32x4*)(odil + ((size_t)1 * T + tok) * GW + col), a2 = *(const f32x4*)(odil + ((size_t)2 * T + tok) * GW + col);
            v[j] = a0 * (e0 * inv) + a1 * (e1 * inv) + a2 * (e2 * inv);
            ss += (v[j][0] * v[j][0] + v[j][1] * v[j][1]) + (v[j][2] * v[j][2] + v[j][3] * v[j][3]); }
        r = 1.0f / sqrtf(wave_sum(ss) * (1.0f / GW) + EPS);
#pragma unroll
        for (int j = 0; j < 4; ++j) { const int col = 4 * lane + 256 * j; const f32x4 g = *(const f32x4*)(F.g_out_dil + col);
            v2u w; w.x = pk2(v[j][0] * r * g[0], v[j][1] * r * g[1]); w.y = pk2(v[j][2] * r * g[2], v[j][3] * r * g[3]); *(v2u*)(aout + (size_t)tok * D + GW + col) = w; }
    }
}

__device__ __forceinline__ void p6_rows(Frame& F) {
    LAS float* t1 = (LAS float*)(F.lds + RING_OFF);
    LAS float* t2 = t1 + D;
    LAS float* t3 = t2 + D;
    LAS unsigned* hb = (LAS unsigned*)(F.lds + RING_OFF + 3 * D * 4) + F.wave * (4 * D / 2);
    const float* mixed = (const float*)(F.ws + WS_MIXED); float* x1 = (float*)(F.ws + WS_X1); unsigned char* hffn8 = F.ws + WS_HFFN;
    int* topi = (int*)(F.ws + WS_TOPI); float* topg = (float*)(F.ws + WS_TOPG); int* trank = (int*)(F.ws + WS_TRANK); unsigned* hist_g = (unsigned*)(F.ws + WS_HIST);
    LAS unsigned* hist = (LAS unsigned*)(F.lds + MISC_OFF) + 224;
    const int lane = F.lane;
    for (int rb = F.vcu; rb < T / 32; rb += F.G) {
        const int b = rb >> 6;
        __syncthreads();
        if (F.tid < 32) hist[F.tid] = 0u;
        for (int col = F.tid; col < D; col += NWAVES * 64) { t1[col] = F.g_post_mix[col] * mod_val(F, b, 2 * D + col); t2[col] = F.g_pre_ffn[col] * (1.0f + mod_val(F, b, 4 * D + col)); t3[col] = mod_val(F, b, 3 * D + col); }
        __syncthreads();
#pragma unroll 1
        for (int rr = 0; rr < 4; ++rr) {
            const int row = rb * 32 + F.wave * 4 + rr;
            f32x4 v[8]; float ss = 0.f;
#pragma unroll
            for (int j = 0; j < 8; ++j) { v[j] = *(const f32x4*)(mixed + (size_t)row * D + 4 * lane + 256 * j); ss += (v[j][0] * v[j][0] + v[j][1] * v[j][1]) + (v[j][2] * v[j][2] + v[j][3] * v[j][3]); }
            float r = 1.0f / sqrtf(wave_sum(ss) * (1.0f / D) + EPS);
            ss = 0.f;
#pragma unroll
            for (int j = 0; j < 8; ++j) { const int col = 4 * lane + 256 * j; const f32x4 xv = *(const f32x4*)(F.x + (size_t)row * D + col); const f32x4 a = *(LAS f32x4*)(t1 + col);
                v[j] = xv + a * (v[j] * r); *(f32x4*)(x1 + (size_t)row * D + col) = v[j];
                ss += (v[j][0] * v[j][0] + v[j][1] * v[j][1]) + (v[j][2] * v[j][2] + v[j][3] * v[j][3]); }
            r = 1.0f / sqrtf(wave_sum(ss) * (1.0f / D) + EPS);
#pragma unroll
            for (int j = 0; j < 8; ++j) { const int col = 4 * lane + 256 * j; const f32x4 a = *(LAS f32x4*)(t2 + col), s = *(LAS f32x4*)(t3 + col);
                const f32x4 hv = v[j] * r * a + s;
                v2u w; w.x = pk2(hv[0], hv[1]); w.y = pk2(hv[2], hv[3]); *(LAS v2u*)(hb + rr * (D / 2) + (col >> 1)) = w;
                *(unsigned*)(hffn8 + (size_t)row * D + col) = pg8::cvt4_fp8(hv[0] * XSCALE, hv[1] * XSCALE, hv[2] * XSCALE, hv[3] * XSCALE); }
        }
        LDS_WAIT();
        const int e = lane & 31, half = lane >> 5;
        float acc[4] = {0.f, 0.f, 0.f, 0.f};
        { const float* wr = F.w_router + (size_t)(half * 1024) * NE + e; const LAS unsigned* hr = hb + half * 512;
#pragma unroll 8
          for (int kp = 0; kp < 512; ++kp) { const float w0 = wr[(size_t)(2 * kp) * NE], w1 = wr[(size_t)(2 * kp + 1) * NE];
#pragma unroll
              for (int rr = 0; rr < 4; ++rr) { const unsigned hw = hr[rr * (D / 2) + kp]; acc[rr] += bflo(hw) * w0 + bfhi(hw) * w1; } } }
        const float br = F.b_router[e];
#pragma unroll
        for (int rr = 0; rr < 4; ++rr) {
            const int row = rb * 32 + F.wave * 4 + rr;
            float a = acc[rr]; a += __shfl_xor(a, 32);
            float lg = (lane < 32) ? a + br : -INFINITY;
            int sel[4]; float val[4];
#pragma unroll
            for (int k = 0; k < 4; ++k) { const float mx = wave_max(lg); const unsigned long long bal = __ballot(lg == mx); const int idx = __ffsll((long long)bal) - 1; sel[k] = idx; val[k] = mx; if (lane == idx) lg = -INFINITY; }
            const float e1 = __expf(val[1] - val[0]), e2 = __expf(val[2] - val[0]), e3 = __expf(val[3] - val[0]); const float inv = 1.0f / (1.0f + e1 + e2 + e3);
            if (lane == 0) {
                *(int4*)(topi + (size_t)row * 4) = make_int4(sel[0], sel[1], sel[2], sel[3]);
                *(float4*)(topg + (size_t)row * 4) = make_float4(inv, e1 * inv, e2 * inv, e3 * inv);
                int rk[4];
#pragma unroll
                for (int k = 0; k < 4; ++k) rk[k] = (int)__hip_atomic_fetch_add(hist + sel[k], 1u, __ATOMIC_RELAXED, __HIP_MEMORY_SCOPE_WORKGROUP);
                *(int4*)(trank + (size_t)row * 4) = make_int4(rk[0], rk[1], rk[2], rk[3]);
            }
        }
        __syncthreads();
        if (F.tid < 32) hist_g[rb * 32 + F.tid] = hist[F.tid];
    }
}

__device__ __forceinline__ void moe_tables(Frame& F, int rb) {
    const unsigned* hist_g = (const unsigned*)(F.ws + WS_HIST);
    LAS unsigned* red = (LAS unsigned*)(F.lds + RING_OFF);
    __syncthreads();
    { const int e = F.tid & 31, part = F.tid >> 5; unsigned tot = 0u, pre = 0u;
#pragma unroll
      for (int i = 0; i < 16; ++i) { const int r2 = part * 16 + i; const unsigned v = hist_g[r2 * 32 + e]; tot += v; pre += (r2 < rb) ? v : 0u; }
      red[(part * 32 + e) * 2] = tot; red[(part * 32 + e) * 2 + 1] = pre; }
    __syncthreads();
    if (F.tid < 32) { unsigned tot = 0u, pre = 0u;
#pragma unroll
        for (int part = 0; part < 16; ++part) { tot += red[(part * 32 + F.tid) * 2]; pre += red[(part * 32 + F.tid) * 2 + 1]; }
        F.MISC[224 + F.tid] = tot; F.MISC[32 + F.tid] = pre; }
    __syncthreads();
    if (F.tid == 0) { int nb = 0;
        for (int e = 0; e < NE; ++e) { const int cnt = (int)F.MISC[224 + e]; const int k = (cnt + 255) >> 8; F.MISC[32 + e] += (unsigned)(nb * 256); for (int j = 0; j < k && nb < MAXBLK; ++j) F.MISC[64 + nb++] = (unsigned)e; }
        F.MISC[16] = (unsigned)nb; }
    __syncthreads();
}
__device__ __forceinline__ void p7_slots(Frame& F) {
    const int* topi = (const int*)(F.ws + WS_TOPI); const int* trank = (const int*)(F.ws + WS_TRANK); int* tslot = (int*)(F.ws + WS_TSLOT);
    const unsigned char* hffn8 = F.ws + WS_HFFN; unsigned char* xg8 = F.ws + WS_XG;
    const int lane = F.lane;
    for (int rb = F.vcu; rb < T / 32; rb += F.G) {
        moe_tables(F, rb);
#pragma unroll 4
        for (int i = 0; i < 16; ++i) {
            const int pid = rb * 128 + F.wave * 16 + i, t = pid >> 2; const int e = topi[pid];
            const int slot = (int)F.MISC[32 + e] + trank[pid];
            if (lane == 0) tslot[pid] = slot;
            const v4u* s = (const v4u*)(hffn8 + (size_t)t * D) + lane; v4u* d = (v4u*)(xg8 + (size_t)slot * D) + lane;
#pragma unroll
            for (int j = 0; j < 2; ++j) d[64 * j] = s[64 * j];
        }
    }
}

__device__ __forceinline__ void p10_final(Frame& F) {
    LAS float* t1 = (LAS float*)(F.lds + RING_OFF);
    const float* x1 = (const float*)(F.ws + WS_X1); const bf16* yb = (const bf16*)(F.ws + WS_YB);
    const int* tslot = (const int*)(F.ws + WS_TSLOT); const float* topg = (const float*)(F.ws + WS_TOPG);
    const int lane = F.lane;
    for (int rb = F.vcu; rb < T / 32; rb += F.G) {
        const int b = rb >> 6;
        __syncthreads();
        for (int col = F.tid; col < D; col += NWAVES * 64) t1[col] = F.g_post_ffn[col] * mod_val(F, b, 5 * D + col);
        __syncthreads();
        for (int rr = F.wave; rr < 32; rr += NWAVES) {
            const int row = rb * 32 + rr;
            const int4 sl = *(const int4*)(tslot + (size_t)row * 4); const float4 gt = *(const float4*)(topg + (size_t)row * 4);
            const int sls[4] = {sl.x, sl.y, sl.z, sl.w}; const float gts[4] = {gt.x, gt.y, gt.z, gt.w};
            float y[4][8]; float ss = 0.f;
#pragma unroll
            for (int j = 0; j < 4; ++j) {
#pragma unroll
                for (int i = 0; i < 8; ++i) y[j][i] = 0.f;
#pragma unroll
                for (int k = 0; k < 4; ++k) { const v4u w = *(const v4u*)(yb + (size_t)sls[k] * D + 8 * lane + 512 * j); const float g = gts[k];
                    y[j][0] += g * bflo(w.x); y[j][1] += g * bfhi(w.x); y[j][2] += g * bflo(w.y); y[j][3] += g * bfhi(w.y); y[j][4] += g * bflo(w.z); y[j][5] += g * bfhi(w.z); y[j][6] += g * bflo(w.w); y[j][7] += g * bfhi(w.w); }
#pragma unroll
                for (int i = 0; i < 8; ++i) ss += y[j][i] * y[j][i];
            }
            const float r = 1.0f / sqrtf(wave_sum(ss) * (1.0f / D) + EPS);
#pragma unroll
            for (int j = 0; j < 4; ++j) { const int col = 8 * lane + 512 * j;
#pragma unroll
                for (int hh = 0; hh < 2; ++hh) { const f32x4 xv = *(const f32x4*)(x1 + (size_t)row * D + col + 4 * hh); const f32x4 a = *(LAS f32x4*)(t1 + col + 4 * hh);
                    f32x4 o; o[0] = xv[0] + a[0] * y[j][4 * hh + 0] * r; o[1] = xv[1] + a[1] * y[j][4 * hh + 1] * r; o[2] = xv[2] + a[2] * y[j][4 * hh + 2] * r; o[3] = xv[3] + a[3] * y[j][4 * hh + 3] * r;
                    *(f32x4*)(F.out + (size_t)row * D + col + 4 * hh) = o; } }
        }
    }
}

struct Args { const float* in[20]; float* out; unsigned char* ws; int ph_lo, ph_hi; };
__global__ void __launch_bounds__(NWAVES * 64, 2) fwd_kernel(Args args) {
    extern __shared__ __attribute__((aligned(16))) unsigned char lds[];
    Frame F;
    F.lds = (LAS unsigned char*)lds;
    F.MISC = (volatile LAS unsigned*)(F.lds + MISC_OFF);
    F.tid = threadIdx.x; F.lane = F.tid & 63; F.wave = __builtin_amdgcn_readfirstlane(F.tid >> 6);
    F.G = gridDim.x; { const int bx = blockIdx.x; F.vcu = (F.G % 8 == 0) ? (bx % 8) * (F.G / 8) + bx / 8 : bx; }
    F.ws = args.ws; F.ctl = (unsigned*)(args.ws + WS_CTL); F.out = args.out;
    F.x = args.in[0]; F.c = args.in[1]; F.w_ada = args.in[2]; F.b_ada = args.in[3]; F.g_pre_mix = args.in[4]; F.g_post_mix = args.in[5]; F.w_in = args.in[6]; F.rpb = args.in[7]; F.t5 = args.in[8];
    F.g_out_na = args.in[9]; F.g_out_dil = args.in[10]; F.w_o = args.in[11]; F.g_pre_ffn = args.in[12]; F.g_post_ffn = args.in[13]; F.w_router = args.in[14]; F.b_router = args.in[15];
    F.w_e_in = args.in[16]; F.b_e_in = args.in[17]; F.w_e_out = args.in[18]; F.b_e_out = args.in[19];
    for (int u = F.tid; u < 256; u += NWAVES * 64) F.MISC[u] = 0u;
    __syncthreads();
    XcdBarrier bar; bar.bar = F.ctl + CW_BAR; bar.x = 0; bar.st = nullptr;
    if (MK_N_LAUNCHES == 1) bar = xcd_barrier_post(F.ctl + CW_BAR, F.MISC + 8);
    const int lo = args.ph_lo, hi = args.ph_hi;
#define IN(k) (lo <= (k) && (k) < hi)
#ifndef PROBE_REPEAT
#define PROBE_REPEAT -1
#endif
#define REP(k) ((PROBE_REPEAT == (k)) ? 2 : 1)
#define SEAM(k) do { if (IN(k) && IN((k) + 1)) xcd_barrier(bar); } while (0)

    if (IN(0)) { for (int rep = 0; rep < REP(0); ++rep) p0_prologue(F); } SEAM(0);
    if (IN(1)) { p1_hmix(F); } SEAM(1);
    if (IN(2)) {
        pg8::Gemm g{(const bf16*)(F.ws + WS_HMIX), (const bf16*)(F.ws + WS_WIN_T), T, NQKV, D}; pg8::StaticOrder S; S.init(T, NQKV, F.G, (int)blockIdx.x);
        pg8::EpiBf16 E{(bf16*)(F.ws + WS_PROJ), NQKV, nullptr, 0};
        __syncthreads();
        for (int rep = 0; rep < REP(2); ++rep) { __syncthreads(); pg8::gemm_phase<pg8::EpiBf16, pg8::StaticOrder, true, true>(F.lds + RING_OFF, g, S, E); }
    } SEAM(2);
    #ifdef ATTN_NAIVE
    if (IN(3)) { p3_attn_naive(F); } SEAM(3);
#else
    if (IN(3)) { for (int rep = 0; rep < REP(3); ++rep) { __syncthreads(); p3_attn_mfma(F); } } SEAM(3);
#endif
    if (IN(4)) { p4_post(F); } SEAM(4);
    if (IN(5)) {
        pg8::Gemm g{(const bf16*)(F.ws + WS_AOUT), (const bf16*)(F.ws + WS_WO_T), T, D, D}; pg8::StaticOrder S; S.init(T, D, F.G, (int)blockIdx.x);
        pg8::EpiF32 E{(float*)(F.ws + WS_MIXED), D};
        __syncthreads();
        pg8::gemm_phase<pg8::EpiF32, pg8::StaticOrder, true, true>(F.lds + RING_OFF, g, S, E);
    } SEAM(5);
    if (IN(6)) { for (int rep = 0; rep < REP(6); ++rep) p6_rows(F); } SEAM(6);
    if (IN(7)) { p7_slots(F); } SEAM(7);
    if (IN(8)) {
        moe_tables(F, -1);
        pg8::Gemm g{(const bf16*)(F.ws + WS_XG), (const bf16*)(F.ws + WS_WEI_T), MAXBLK * 256, FF2, D / 2};
        pg8::MoeOrder<16> S{(const LAS int*)(F.lds + MISC_OFF + 64 * 4), (int)F.MISC[16], F.G, (int)blockIdx.x};
        pg8::EpiSwiglu8 E{F.ws + WS_HB, FF, F.b_e_in, FF2, 1.0f / (WSCALE * XSCALE), HSCALE};
        for (int rep = 0; rep < REP(8); ++rep) { __syncthreads(); pg8::gemm_phase<pg8::EpiSwiglu8, pg8::MoeOrder<16>, true, true, true>(F.lds + RING_OFF, g, S, E); }
    } SEAM(8);
    if (IN(9)) {
        moe_tables(F, -1);
        pg8::Gemm g{(const bf16*)(F.ws + WS_HB), (const bf16*)(F.ws + WS_WEO_T), MAXBLK * 256, D, FF / 2};
        pg8::MoeOrder<8> S{(const LAS int*)(F.lds + MISC_OFF + 64 * 4), (int)F.MISC[16], F.G, (int)blockIdx.x};
        pg8::EpiBf16S E{(bf16*)(F.ws + WS_YB), D, F.b_e_out, D, 1.0f / (WSCALE * HSCALE)};
        for (int rep = 0; rep < REP(9); ++rep) { __syncthreads(); pg8::gemm_phase<pg8::EpiBf16S, pg8::MoeOrder<8>, true, true, true>(F.lds + RING_OFF, g, S, E); }
    } SEAM(9);
    if (IN(10)) { p10_final(F); }
#undef IN
#undef SEAM
}

extern "C" void kernel_launch(void* const* d_in, const int* in_sizes, int n_in, void* d_out, int out_size, void* d_ws, size_t ws_size, hipStream_t stream) {
    static int grid = 0;
    if (grid == 0) {
        if (n_in != 20 || out_size != T * D || ws_size < WS_END) { fprintf(stderr, "kernel_launch: unexpected problem (n_in %d, out %d, ws %zu)\n", n_in, out_size, ws_size); grid = -1; return; }
        int dev = 0, cus = 0, per_cu = 0;
        if (hipGetDevice(&dev) != hipSuccess || hipDeviceGetAttribute(&cus, hipDeviceAttributeMultiprocessorCount, dev) != hipSuccess) { grid = -1; return; }
        if (hipFuncSetAttribute((const void*)fwd_kernel, hipFuncAttributeMaxDynamicSharedMemorySize, LDS_BYTES) != hipSuccess) { fprintf(stderr, "kernel_launch: hipFuncSetAttribute failed\n"); grid = -1; return; }
        if (hipOccupancyMaxActiveBlocksPerMultiprocessor(&per_cu, (const void*)fwd_kernel, NWAVES * 64, LDS_BYTES) != hipSuccess || per_cu < 1) { fprintf(stderr, "kernel_launch: occupancy query reports %d\n", per_cu); }
        (void)hipGetLastError();
        grid = cus;
    }
    if (grid < 0) return;
    if (hipMemsetAsync((char*)d_ws + WS_CTL, 0, CTL_ZERO_BYTES, stream) != hipSuccess) return;
    Args a{};
    for (int i = 0; i < 20; ++i) a.in[i] = (const float*)d_in[i];
    a.out = (float*)d_out; a.ws = (unsigned char*)d_ws;
    if (MK_N_LAUNCHES == 1) {
        a.ph_lo = 0; a.ph_hi = NPHASE;
        hipLaunchKernelGGL(fwd_kernel, dim3(grid), dim3(NWAVES * 64), LDS_BYTES, stream, a);
    } else {
        for (int p = 0; p < NPHASE; ++p) { a.ph_lo = p; a.ph_hi = p + 1; hipLaunchKernelGGL(fwd_kernel, dim3(grid), dim3(NWAVES * 64), LDS_BYTES, stream, a); }
    }
}
```

```cpp
#include <hip/hip_runtime.h>
#include <cstdio>
#include <cstdint>
#include <type_traits>

#ifndef MK_N_LAUNCHES
#define MK_N_LAUNCHES 1
#endif

namespace pg8 {
#define PG8_LAS __attribute__((address_space(3)))
typedef unsigned short bf16_t;
typedef short bf16x8 __attribute__((ext_vector_type(8)));
typedef float f32x4 __attribute__((ext_vector_type(4)));
typedef unsigned u32x4 __attribute__((ext_vector_type(4)));
typedef unsigned u32x2 __attribute__((ext_vector_type(2)));
constexpr int BM = 256, BK = 64, HALF = 128, HTB = HALF * BK * 2  , STAGE_BYTES = 8 * HTB, NXCD = 8, WGM = 8;

__host__ __device__ __forceinline__ int lds_byte(int r, int c) { const int st = (r >> 4) * 2 + (c >> 5), rr = r & 15, cc = c & 31, ob = rr * 64 + cc * 2; return st * 1024 + (ob ^ (((ob >> 9) & 1) << 5)); }
__host__ __device__ __forceinline__ void stage_rc(int b, int& R, int& C) { const int st = b / 1024, sb = b % 1024, swz = sb ^ (((sb >> 9) & 1) << 5); R = (st >> 1) * 16 + swz / 64; C = (st & 1) * 32 + (swz % 64) / 2; }
__host__ __device__ __forceinline__ int perm32(int rho) { const int n = rho >> 4, i = rho & 15; return 8 * (i >> 2) + 4 * n + (i & 3); }

struct Unit { int pm, pn, bt, e; };
struct Gemm { const bf16_t* A; const bf16_t* Bt; int M, N, K; };

struct StaticOrder {
    int nM, nN, nwg, G, c;
    __host__ __device__ void init(int M, int N, int G_, int c_) { nM = M / BM; nN = N / BM; nwg = nM * nN; G = G_; c = c_; }
    __host__ __device__ bool next(int i, Unit& u) const {
        const long L = (long)i * G + c; if (L >= nwg) return false;
        int wgid = (int)L; { const int q = nwg / NXCD, r = nwg % NXCD, xcd = wgid % NXCD, off = wgid / NXCD; wgid = (xcd < r ? xcd * (q + 1) : r * (q + 1) + (xcd - r) * q) + off; }
        const int nig = WGM * nN, gid = wgid / nig, fm = gid * WGM, gsz = (nM - fm) < WGM ? (nM - fm) : WGM;
        u.pm = fm + ((wgid % nig) % gsz); u.pn = (wgid % nig) / gsz; u.bt = u.pn; u.e = 0; return true;
    }
    __device__ __forceinline__ void a_ready(const Unit&) const {}
    __device__ __forceinline__ void done(const Unit&) const {}
};
template <int NPN> struct MoeOrder {
    const PG8_LAS int* blk_e; int nb, G, c;
    __device__ __forceinline__ bool next(int i, Unit& u) const {
        int L = i * G + c;
        if (G == 256) L = ((i * 8 + (c & 7)) << 5) + (c >> 3);
        const int g = L >> 5, r = L & 31;
        int block, pn;
        if (NPN == 16) { block = 4 * (g >> 1) + (r & 3); pn = 8 * (g & 1) + (r >> 2); } else { block = 4 * g + (r & 3); pn = r >> 2; }
        if (block >= nb) return false;
        u.pm = block; u.pn = pn; u.e = blk_e[block]; u.bt = u.e * NPN + pn; return true;
    }
    __device__ __forceinline__ void a_ready(const Unit&) const {}
    __device__ __forceinline__ void done(const Unit&) const {}
};

__device__ __forceinline__ unsigned cvt_pk_bf16(float lo, float hi) { unsigned r; asm volatile("v_cvt_pk_bf16_f32 %0, %1, %2" : "=v"(r) : "v"(lo), "v"(hi)); return r; }

struct EpiF32 {
    static constexpr bool PERM = false, AFTER_DRAIN = false;
    float* C; int ldc;
    __device__ __forceinline__ void operator()(const f32x4 (&acc)[2][2][4][2], const Unit& u, int wr, int wc, int fr, int fq) const {
        const int row0 = u.pm * BM + wr * 64 + fr, col0 = u.pn * BM + wc * 32 + 4 * fq;
#pragma unroll
        for (int ai = 0; ai < 2; ++ai)
#pragma unroll
            for (int m = 0; m < 4; ++m) { float* rowp = C + (size_t)(row0 + ai * HALF + m * 16) * ldc + col0;
#pragma unroll
                for (int bj = 0; bj < 2; ++bj)
#pragma unroll
                    for (int n = 0; n < 2; ++n) *(f32x4*)(rowp + bj * HALF + n * 16) = acc[ai][bj][m][n]; }
    }
};
struct EpiBf16 {
    static constexpr bool PERM = true, AFTER_DRAIN = false;
    bf16_t* O; int ldc; const float* bias; int bias_estride;
    __device__ __forceinline__ void operator()(const f32x4 (&acc)[2][2][4][2], const Unit& u, int wr, int wc, int fr, int fq) const {
        const int row0 = u.pm * BM + wr * 64 + fr; const int col0 = u.pn * BM + wc * 32 + 8 * fq;
        f32x4 bv[2][2];
#pragma unroll
        for (int bj = 0; bj < 2; ++bj)
#pragma unroll
            for (int n = 0; n < 2; ++n) bv[bj][n] = bias ? *(const f32x4*)(bias + (size_t)u.e * bias_estride + col0 + bj * HALF + 4 * n) : (f32x4){0.f, 0.f, 0.f, 0.f};
#pragma unroll
        for (int ai = 0; ai < 2; ++ai)
#pragma unroll
            for (int m = 0; m < 4; ++m) { bf16_t* rowp = O + (size_t)(row0 + ai * HALF + m * 16) * ldc + col0;
#pragma unroll
                for (int bj = 0; bj < 2; ++bj) { const f32x4 v0 = acc[ai][bj][m][0] + bv[bj][0], v1 = acc[ai][bj][m][1] + bv[bj][1];
                    u32x4 w; w.x = cvt_pk_bf16(v0[0], v0[1]); w.y = cvt_pk_bf16(v0[2], v0[3]); w.z = cvt_pk_bf16(v1[0], v1[1]); w.w = cvt_pk_bf16(v1[2], v1[3]);
                    *(u32x4*)(rowp + bj * HALF) = w; } }
    }
};
__device__ __forceinline__ float swiglu1(float g, float u) {
    g = fminf(g, 7.0f); u = fminf(fmaxf(u, -7.0f), 7.0f);
    const float s = __builtin_amdgcn_rcpf(1.0f + __builtin_amdgcn_exp2f(g * (-1.702f * 1.44269504089f)));
    return (u + 1.0f) * (g * s);
}
struct EpiSwiglu {
    static constexpr bool PERM = true, AFTER_DRAIN = false;
    bf16_t* H; int ldh; const float* bias; int bias_estride;
    __device__ __forceinline__ void operator()(const f32x4 (&acc)[2][2][4][2], const Unit& u, int wr, int wc, int fr, int fq) const {
        const int row0 = u.pm * BM + wr * 64 + fr; const int col0 = u.pn * BM + wc * 32 + 8 * fq;
        f32x4 bv[2][2];
#pragma unroll
        for (int bj = 0; bj < 2; ++bj)
#pragma unroll
            for (int n = 0; n < 2; ++n) bv[bj][n] = *(const f32x4*)(bias + (size_t)u.e * bias_estride + col0 + bj * HALF + 4 * n);
#pragma unroll
        for (int ai = 0; ai < 2; ++ai)
#pragma unroll
            for (int m = 0; m < 4; ++m) { bf16_t* rowp = H + (size_t)(row0 + ai * HALF + m * 16) * ldh + (col0 >> 1);
#pragma unroll
                for (int bj = 0; bj < 2; ++bj) { const f32x4 v0 = acc[ai][bj][m][0] + bv[bj][0], v1 = acc[ai][bj][m][1] + bv[bj][1];
                    u32x2 w; w.x = cvt_pk_bf16(swiglu1(v0[0], v0[1]), swiglu1(v0[2], v0[3])); w.y = cvt_pk_bf16(swiglu1(v1[0], v1[1]), swiglu1(v1[2], v1[3]));
                    *(u32x2*)(rowp + bj * (HALF / 2)) = w; } }
    }
};

__device__ __forceinline__ unsigned cvt4_fp8(float a, float b, float c, float d) {
    int r = 0;
    r = __builtin_amdgcn_cvt_pk_fp8_f32(__builtin_amdgcn_fmed3f(a, -448.f, 448.f), __builtin_amdgcn_fmed3f(b, -448.f, 448.f), r, false);
    r = __builtin_amdgcn_cvt_pk_fp8_f32(__builtin_amdgcn_fmed3f(c, -448.f, 448.f), __builtin_amdgcn_fmed3f(d, -448.f, 448.f), r, true);
    return (unsigned)r;
}
struct EpiSwiglu8 {
    static constexpr bool PERM = true, AFTER_DRAIN = false;
    unsigned char* H; int ldh; const float* bias; int bias_estride; float ascale, hscale;
    __device__ __forceinline__ void operator()(const f32x4 (&acc)[2][2][4][2], const Unit& u, int wr, int wc, int fr, int fq) const {
        const int row0 = u.pm * BM + wr * 64 + fr; const int col0 = u.pn * BM + wc * 32 + 8 * fq;
        f32x4 bv[2][2];
#pragma unroll
        for (int bj = 0; bj < 2; ++bj)
#pragma unroll
            for (int n = 0; n < 2; ++n) bv[bj][n] = *(const f32x4*)(bias + (size_t)u.e * bias_estride + col0 + bj * HALF + 4 * n);
#pragma unroll
        for (int ai = 0; ai < 2; ++ai)
#pragma unroll
            for (int m = 0; m < 4; ++m) { unsigned char* rowp = H + (size_t)(row0 + ai * HALF + m * 16) * ldh + (col0 >> 1);
#pragma unroll
                for (int bj = 0; bj < 2; ++bj) { const f32x4 v0 = acc[ai][bj][m][0] * ascale + bv[bj][0], v1 = acc[ai][bj][m][1] * ascale + bv[bj][1];
                    *(unsigned*)(rowp + bj * (HALF / 2)) = cvt4_fp8(hscale * swiglu1(v0[0], v0[1]), hscale * swiglu1(v0[2], v0[3]), hscale * swiglu1(v1[0], v1[1]), hscale * swiglu1(v1[2], v1[3])); } }
    }
};
struct EpiBf16S {
    static constexpr bool PERM = true, AFTER_DRAIN = false;
    bf16_t* O; int ldc; const float* bias; int bias_estride; float ascale;
    __device__ __forceinline__ void operator()(const f32x4 (&acc)[2][2][4][2], const Unit& u, int wr, int wc, int fr, int fq) const {
        const int row0 = u.pm * BM + wr * 64 + fr; const int col0 = u.pn * BM + wc * 32 + 8 * fq;
        f32x4 bv[2][2];
#pragma unroll
        for (int bj = 0; bj < 2; ++bj)
#pragma unroll
            for (int n = 0; n < 2; ++n) bv[bj][n] = *(const f32x4*)(bias + (size_t)u.e * bias_estride + col0 + bj * HALF + 4 * n);
#pragma unroll
        for (int ai = 0; ai < 2; ++ai)
#pragma unroll
            for (int m = 0; m < 4; ++m) { bf16_t* rowp = O + (size_t)(row0 + ai * HALF + m * 16) * ldc + col0;
#pragma unroll
                for (int bj = 0; bj < 2; ++bj) { const f32x4 v0 = acc[ai][bj][m][0] * ascale + bv[bj][0], v1 = acc[ai][bj][m][1] * ascale + bv[bj][1];
                    u32x4 w; w.x = cvt_pk_bf16(v0[0], v0[1]); w.y = cvt_pk_bf16(v0[2], v0[3]); w.z = cvt_pk_bf16(v1[0], v1[1]); w.w = cvt_pk_bf16(v1[2], v1[3]);
                    *(u32x4*)(rowp + bj * HALF) = w; } }
    }
};

typedef int v8i32 __attribute__((ext_vector_type(8)));
typedef short bf16x16 __attribute__((ext_vector_type(16)));
template <class Epi, class Sched, bool ALIGN_EPI = false, bool SP2 = false, bool FP8 = false>
__device__ __forceinline__ void gemm_phase(PG8_LAS unsigned char* lds, const Gemm g, const Sched& S, const Epi& E) {
    const int tid = threadIdx.x, wid = __builtin_amdgcn_readfirstlane(tid >> 6), lane = tid & 63, wr = wid >> 2, wc = wid & 3, fr = lane & 15, fq = lane >> 4;
    const int K = g.K, nt = K / BK;
    unsigned voffA[2], voffB[2];
#pragma unroll
    for (int i = 0; i < 2; ++i) { int R, C; stage_rc(tid * 16 + i * 8192, R, C); const int Rb = Epi::PERM ? ((R & ~31) + perm32(R & 31)) : R;
        voffA[i] = (unsigned)(R * K + C) * 2u; voffB[i] = (unsigned)(Rb * K + C) * 2u; }
    const size_t kstep = (size_t)(BK * 2);
    const size_t hstep = (size_t)HALF * K * 2;
    const size_t tstep = 2 * hstep;
    const unsigned ldsw = (unsigned)wid * 1024u;
    const int fcol = FP8 ? (32 * (fq >> 1) + 16 * (fq & 1)) : fq * 8;
    const int aoff = lds_byte(wr * 64 + fr, fcol), boff = lds_byte(wc * 32 + fr, fcol);
    constexpr int KSTR = FP8 ? 16 : 1024;
#define PG8_SA(b, h) (((b) * 2 + (h)) * HTB)
#define PG8_SB(b, h) ((4 + (b) * 2 + (h)) * HTB)
#define PG8_STAGE(bufoff, gbase, voff) do { _Pragma("unroll") for (int _i = 0; _i < 2; ++_i) \
        __builtin_amdgcn_global_load_lds((const unsigned*)((const char*)(gbase) + (voff)[_i]), (PG8_LAS unsigned*)(lds + (bufoff) + ldsw + _i * 8192), 16, 0, 0); } while (0)
#define PG8_RD(dst, addr) do { if constexpr (FP8) { const u32x4 _lo = *(const PG8_LAS u32x4*)(addr), _hi = *(const PG8_LAS u32x4*)((addr) + 16); \
        (dst)[0] = (frag_t)__builtin_bit_cast(v8i32, __builtin_shufflevector(_lo, _hi, 0, 1, 2, 3, 4, 5, 6, 7)); } \
    else { (dst)[0] = (frag_t)*(const PG8_LAS bf16x8*)(addr); (dst)[NKF - 1] = (frag_t)*(const PG8_LAS bf16x8*)((addr) + 1024); } } while (0)
#define PG8_LDA(dst, b, h) do { _Pragma("unroll") for (int m = 0; m < 4; ++m) PG8_RD(dst[m], lds + PG8_SA(b, h) + aoff + m * 2048); } while (0)
#define PG8_LDB(dst, b, h) do { _Pragma("unroll") for (int n = 0; n < 2; ++n) PG8_RD(dst[n], lds + PG8_SB(b, h) + boff + n * 2048); } while (0)
#define PG8_MMA(ai, bj, At, Bt) do { __builtin_amdgcn_s_setprio(1); _Pragma("unroll") for (int m = 0; m < 4; ++m) _Pragma("unroll") for (int n = 0; n < 2; ++n) { \
        if constexpr (FP8) asm volatile("v_mfma_f32_16x16x128_f8f6f4 %0, %1, %2, %0" : "+v"(acc[ai][bj][m][n]) : "v"(Bt[n][0]), "v"(At[m][0])); \
        else { _Pragma("unroll") for (int k = 0; k < NKF; ++k) acc[ai][bj][m][n] = __builtin_amdgcn_mfma_f32_16x16x32_bf16((bf16x8)Bt[n][k], (bf16x8)At[m][k], acc[ai][bj][m][n], 0, 0, 0); } } \
        __builtin_amdgcn_s_setprio(0); } while (0)
#define PG8_WAIT_V(n) asm volatile("s_waitcnt vmcnt(" #n ")" ::: "memory")
#define PG8_WAIT_L(n) asm volatile("s_waitcnt lgkmcnt(" #n ")" ::: "memory")
#define PG8_BAR __builtin_amdgcn_s_barrier()
#define PG8_SCHED __builtin_amdgcn_sched_barrier(0)
    Unit cur, nxt; int ui = 0;
    if (!S.next(0, cur)) return;
    f32x4 acc[2][2][4][2];
#pragma unroll
    for (int a = 0; a < 2; ++a)
#pragma unroll
        for (int b = 0; b < 2; ++b)
#pragma unroll
            for (int m = 0; m < 4; ++m)
#pragma unroll
                for (int n = 0; n < 2; ++n) acc[a][b][m][n] = (f32x4){0.f, 0.f, 0.f, 0.f};
    typedef typename std::conditional<FP8, v8i32, bf16x8>::type frag_t; constexpr int NKF = FP8 ? 1 : 2;
    frag_t At[4][NKF], B0[2][NKF], B1[2][NKF];
    const char* cA = (const char*)g.A + (size_t)cur.pm * tstep; const char* cB = (const char*)g.Bt + (size_t)cur.bt * tstep;
    S.a_ready(cur);
    if constexpr (SP2) {
        PG8_STAGE(PG8_SB(0, 0), cB, voffB); PG8_STAGE(PG8_SB(0, 1), cB + hstep, voffB); PG8_STAGE(PG8_SA(0, 0), cA, voffA); PG8_STAGE(PG8_SA(0, 1), cA + hstep, voffA);
        if (wr == 1) PG8_BAR;
        PG8_WAIT_V(2); PG8_BAR;
        PG8_STAGE(PG8_SB(1, 0), cB + kstep, voffB); PG8_STAGE(PG8_SA(1, 0), cA + kstep, voffA); PG8_STAGE(PG8_SB(1, 1), cB + hstep + kstep, voffB);
        PG8_WAIT_V(6); PG8_BAR;
    } else {
        PG8_STAGE(PG8_SB(0, 0), cB, voffB); PG8_STAGE(PG8_SA(0, 0), cA, voffA); PG8_STAGE(PG8_SB(0, 1), cB + hstep, voffB); PG8_STAGE(PG8_SA(0, 1), cA + hstep, voffA);
        if (wr == 1) PG8_BAR;
        PG8_WAIT_V(4); PG8_BAR;
        PG8_STAGE(PG8_SB(1, 0), cB + kstep, voffB); PG8_STAGE(PG8_SA(1, 0), cA + kstep, voffA); PG8_STAGE(PG8_SB(1, 1), cB + hstep + kstep, voffB);
        PG8_WAIT_V(6); PG8_BAR;
    }
    for (;;) {
        const bool has_next = S.next(ui + 1, nxt);
        const char* nA = has_next ? (const char*)g.A + (size_t)nxt.pm * tstep : cA; const char* nB = has_next ? (const char*)g.Bt + (size_t)nxt.bt * tstep : cB;
        for (int t = 0; t < nt; t += 2) {
            const bool last = (t == nt - 2);
            const char* a1 = cA + (size_t)(t + 1) * kstep;
            const char* a2 = last ? nA : cA + (size_t)(t + 2) * kstep; const char* b2 = last ? nB : cB + (size_t)(t + 2) * kstep;
            const char* a3 = a2 + kstep; const char* b3 = b2 + kstep;
            if (last && has_next) S.a_ready(nxt);
            if constexpr (SP2) {
            PG8_LDB(B0, 0, 0); PG8_LDB(B1, 0, 1); PG8_SCHED; PG8_LDA(At, 0, 0); PG8_STAGE(PG8_SA(1, 1), a1 + hstep, voffA);
            PG8_WAIT_V(8); PG8_WAIT_L(0); PG8_BAR; PG8_MMA(0, 0, At, B0); PG8_MMA(0, 1, At, B1); PG8_BAR; PG8_SCHED;
            PG8_LDA(At, 0, 1); PG8_STAGE(PG8_SB(0, 0), b2, voffB); PG8_STAGE(PG8_SB(0, 1), b2 + hstep, voffB); PG8_STAGE(PG8_SA(0, 0), a2, voffA);
            PG8_WAIT_V(8); PG8_WAIT_L(0); PG8_BAR; PG8_MMA(1, 0, At, B0); PG8_MMA(1, 1, At, B1); PG8_BAR; PG8_SCHED;
            PG8_LDB(B0, 1, 0); PG8_LDB(B1, 1, 1); PG8_SCHED; PG8_LDA(At, 1, 0); PG8_STAGE(PG8_SA(0, 1), a2 + hstep, voffA);
            PG8_WAIT_V(8); PG8_WAIT_L(0); PG8_BAR; PG8_MMA(0, 0, At, B0); PG8_MMA(0, 1, At, B1); PG8_BAR; PG8_SCHED;
            PG8_LDA(At, 1, 1); PG8_STAGE(PG8_SB(1, 0), b3, voffB); PG8_STAGE(PG8_SB(1, 1), b3 + hstep, voffB); PG8_STAGE(PG8_SA(1, 0), a3, voffA);
            PG8_WAIT_V(8); PG8_WAIT_L(0); PG8_BAR; PG8_MMA(1, 0, At, B0); PG8_MMA(1, 1, At, B1); PG8_BAR; PG8_SCHED;
            } else {
            PG8_LDB(B0, 0, 0); PG8_SCHED; PG8_LDA(At, 0, 0); PG8_STAGE(PG8_SA(1, 1), a1 + hstep, voffA);
            PG8_WAIT_L(8); PG8_BAR; PG8_WAIT_L(0); PG8_MMA(0, 0, At, B0); PG8_BAR; PG8_SCHED;
            PG8_LDB(B1, 0, 1); PG8_STAGE(PG8_SB(0, 0), b2, voffB);
            PG8_BAR; PG8_WAIT_L(0); PG8_MMA(0, 1, At, B1); PG8_BAR;
            PG8_LDA(At, 0, 1); PG8_STAGE(PG8_SA(0, 0), a2, voffA);
            PG8_BAR; PG8_WAIT_L(0); PG8_MMA(1, 0, At, B0); PG8_BAR; PG8_SCHED;
            PG8_STAGE(PG8_SB(0, 1), b2 + hstep, voffB);
            PG8_WAIT_V(6); PG8_BAR; PG8_MMA(1, 1, At, B1); PG8_BAR;
            PG8_LDB(B0, 1, 0); PG8_SCHED; PG8_LDA(At, 1, 0); PG8_STAGE(PG8_SA(0, 1), a2 + hstep, voffA);
            PG8_WAIT_L(8); PG8_BAR; PG8_WAIT_L(0); PG8_MMA(0, 0, At, B0); PG8_BAR; PG8_SCHED;
            PG8_LDB(B1, 1, 1); PG8_STAGE(PG8_SB(1, 0), b3, voffB);
            PG8_BAR; PG8_WAIT_L(0); PG8_MMA(0, 1, At, B1); PG8_BAR;
            PG8_LDA(At, 1, 1); PG8_STAGE(PG8_SA(1, 0), a3, voffA);
            PG8_BAR; PG8_WAIT_L(0); PG8_MMA(1, 0, At, B0); PG8_BAR; PG8_SCHED;
            PG8_STAGE(PG8_SB(1, 1), b3 + hstep, voffB);
            PG8_WAIT_V(6); PG8_BAR; PG8_MMA(1, 1, At, B1); PG8_BAR;
            }
        }
        if constexpr (ALIGN_EPI) { if (wr == 0) PG8_BAR; }
        if constexpr (FP8) asm volatile("s_nop 15\n\ts_nop 15" ::: "memory");
        if constexpr (!Epi::AFTER_DRAIN) { E(acc, cur, wr, wc, fr, fq); S.done(cur); }
        if (!has_next) break;
#pragma unroll
        for (int a = 0; a < 2; ++a)
#pragma unroll
            for (int b = 0; b < 2; ++b)
#pragma unroll
                for (int m = 0; m < 4; ++m)
#pragma unroll
                    for (int n = 0; n < 2; ++n) acc[a][b][m][n] = (f32x4){0.f, 0.f, 0.f, 0.f};
        cur = nxt; cA = nA; cB = nB; ++ui;
        if constexpr (ALIGN_EPI) { if (wr == 1) PG8_BAR; }
    }
    PG8_WAIT_V(0);
    if constexpr (!ALIGN_EPI) { if (wr == 0) PG8_BAR; }
    PG8_BAR;
    if constexpr (Epi::AFTER_DRAIN) { E.fused(acc, cur, wr, wc, fr, fq, lds, wid, lane); S.done(cur); }
#undef PG8_SA
#undef PG8_SB
#undef PG8_STAGE
#undef PG8_LDA
#undef PG8_LDB
#undef PG8_MMA
#undef PG8_RD
#undef PG8_WAIT_V
#undef PG8_WAIT_L
#undef PG8_BAR
#undef PG8_SCHED
}
}

constexpr int NWAVES = 8;
constexpr int NBATCH = 4, SEQ = 2048, T = NBATCH * SEQ, D = 2048, HD = 128, NHG = 8, GW = 1024, NQKV = 6144, NE = 32, TOPK = 4, FF = 2048, FF2 = 4096;
constexpr int MAXBLK = 160;
constexpr float EPS = 1e-6f;
constexpr int NPHASE = 11;
constexpr float WSCALE = 512.0f, XSCALE = 16.0f, HSCALE = 4.0f;

constexpr size_t MiB = 1u << 20;
constexpr size_t WS_CTL = 0, CTL_ZERO_BYTES = 1 * MiB;
constexpr size_t WS_MODP = 1 * MiB;
constexpr size_t WS_TOPI = 5 * MiB, WS_TOPG = WS_TOPI + 131072, WS_TSLOT = WS_TOPG + 131072;
constexpr size_t WS_TRANK = WS_TSLOT + 131072, WS_HIST = WS_TRANK + 131072;
constexpr size_t WS_LSE = 6 * MiB;
constexpr size_t WS_WIN_T = 8 * MiB;
constexpr size_t WS_WO_T = 32 * MiB;
constexpr size_t WS_HMIX = 40 * MiB;
constexpr size_t WS_AOUT = 72 * MiB;
constexpr size_t WS_PROJ = 104 * MiB;
constexpr size_t WS_ONA = 200 * MiB;
constexpr size_t WS_ODIL = 232 * MiB;
constexpr size_t WS_MIXED = 328 * MiB;
constexpr size_t WS_X1 = 392 * MiB;
constexpr size_t WS_HFFN = 456 * MiB;
constexpr size_t WS_XG = 492 * MiB;
constexpr size_t WS_HB = 652 * MiB;
constexpr size_t WS_YB = 812 * MiB;
constexpr size_t WS_WEI_T = 1024 * MiB;
constexpr size_t WS_WEO_T = 1536 * MiB;
constexpr size_t WS_END = 1792 * MiB;
constexpr int CW_TMO = 0, CW_CODE = 1, CW_CNT = 256, CW_CUR = 512, CW_BAR = 4096;

constexpr int RING_OFF = 0, RING_BYTES = 155648;
constexpr int MISC_OFF = RING_BYTES;
constexpr int LDS_BYTES = RING_BYTES + 1024;

#define GAS __attribute__((address_space(1)))
#define LAS __attribute__((address_space(3)))
typedef unsigned short bf16;
typedef unsigned v4u __attribute__((ext_vector_type(4)));
typedef unsigned v2u __attribute__((ext_vector_type(2)));
typedef float f32x4 __attribute__((ext_vector_type(4)));
typedef GAS unsigned gu32;
#define RLX_AGENT __ATOMIC_RELAXED, __HIP_MEMORY_SCOPE_AGENT
#define LDS_WAIT() asm volatile("s_waitcnt lgkmcnt(0)" ::: "memory")
#define VM_WAIT() asm volatile("s_waitcnt vmcnt(0)" ::: "memory")
__device__ __forceinline__ float bf2f(unsigned short h) { return __builtin_bit_cast(float, (unsigned)h << 16); }
__device__ __forceinline__ float bflo(unsigned w) { return __builtin_bit_cast(float, w << 16); }
__device__ __forceinline__ float bfhi(unsigned w) { return __builtin_bit_cast(float, w & 0xffff0000u); }
__device__ __forceinline__ unsigned pk2(float lo, float hi) { return pg8::cvt_pk_bf16(lo, hi); }

#define XB_TMO      128
#define XB_XCNT(j)  (256  + 64 * (j))
#define XB_XSUB(j)  (1280 + 64 * (j))
#define XB_XGEN(j)  (2304 + 64 * (j))
#define XB_TOP      3328
#define XB_TOPGEN   3392
#define XCD_BAR_WORDS 3456
#define XB_SPIN_CAP (1u << 18)
__device__ __forceinline__ unsigned xb_ld(unsigned* p)              { return __hip_atomic_load(p, __ATOMIC_RELAXED, __HIP_MEMORY_SCOPE_AGENT); }
__device__ __forceinline__ unsigned xb_add(unsigned* p, unsigned v) { return __hip_atomic_fetch_add(p, v, __ATOMIC_RELAXED, __HIP_MEMORY_SCOPE_AGENT); }
__device__ __forceinline__ unsigned xb_xcc_id() { return (unsigned)__builtin_amdgcn_s_getreg((3 << 11) | 20) & 0xFu; }
#define XB_SPIN(cond, bar) do { unsigned _sp = 0; while (cond) { __builtin_amdgcn_s_sleep(1); \
    if ((++_sp & 255u) == 0u) { if (xb_ld(&(bar)[XB_TMO])) break; if (_sp > XB_SPIN_CAP) { atomicAdd(&(bar)[XB_TMO], 1u); break; } } } } while (0)
struct XcdBarrier { unsigned* bar; unsigned x; volatile LAS unsigned* st; };
__device__ __forceinline__ XcdBarrier xcd_barrier_post(unsigned* bar, volatile LAS unsigned* st) {
    XcdBarrier b; b.bar = bar; b.x = xb_xcc_id(); b.st = st;
    if (threadIdx.x == 0) (void)xb_add(&bar[XB_XCNT(b.x)], 1u);
    return b;
}
__device__ __forceinline__ void xcd_barrier_complete(unsigned* bar, unsigned x, unsigned& nloc, unsigned& nx) {
    const unsigned G = gridDim.x * gridDim.y * gridDim.z;
    unsigned sum, cnt, mine, sp = 0u;
    for (;;) {
        sum = 0u; cnt = 0u; mine = 0u;
#pragma unroll
        for (unsigned j = 0; j < 16; ++j) { const unsigned c = xb_ld(&bar[XB_XCNT(j)]); sum += c; cnt += (c > 0u) ? 1u : 0u; mine = (j == x) ? c : mine; }
        if (sum == G) break;
        __builtin_amdgcn_s_sleep(1);
        if ((++sp & 255u) == 0u) { if (xb_ld(&bar[XB_TMO])) break; if (sp > XB_SPIN_CAP) { atomicAdd(&bar[XB_TMO], 1u); break; } }
    }
    nloc = mine > 0u ? mine : 1u; nx = cnt > 0u ? cnt : 1u;
}
__device__ __forceinline__ void xcd_barrier(const XcdBarrier& b) {
    asm volatile("s_waitcnt vmcnt(0)" ::: "memory");
    __syncthreads();
    if (threadIdx.x == 0) {
        unsigned* bar = b.bar;
        __builtin_amdgcn_s_waitcnt(0);
        unsigned nloc = b.st[0], nx = b.st[1];
        if (nloc == 0u) { xcd_barrier_complete(bar, b.x, nloc, nx); b.st[0] = nloc; b.st[1] = nx; }
        const unsigned old = xb_add(&bar[XB_XSUB(b.x)], 1u);
        const unsigned gen = old / nloc;
        if (old + 1u == (gen + 1u) * nloc) {
            __builtin_amdgcn_fence(__ATOMIC_RELEASE, "agent");
            asm volatile("s_waitcnt vmcnt(0)" ::: "memory");
            const unsigned og = xb_add(&bar[XB_TOP], 1u);
            const unsigned tg = og / nx;
            if (og + 1u == (tg + 1u) * nx) xb_add(&bar[XB_TOPGEN], 1u);
            else XB_SPIN(xb_ld(&bar[XB_TOPGEN]) == tg, bar);
            __builtin_amdgcn_fence(__ATOMIC_ACQUIRE, "agent");
            xb_add(&bar[XB_XGEN(b.x)], 1u);
            asm volatile("s_waitcnt vmcnt(0)" ::: "memory");
        } else {
            XB_SPIN(xb_ld(&bar[XB_XGEN(b.x)]) == gen, bar);
            __builtin_amdgcn_fence(__ATOMIC_ACQUIRE, "agent");
            asm volatile("s_waitcnt vmcnt(0)" ::: "memory");
        }
    }
    __syncthreads();
}

struct Frame {
    LAS unsigned char* lds;
    volatile LAS unsigned* MISC;
    unsigned* ctl;
    int tid, lane, wave, vcu, G;
    const float *x, *c, *w_ada, *b_ada, *g_pre_mix, *g_post_mix, *w_in, *rpb, *t5, *g_out_na, *g_out_dil, *w_o, *g_pre_ffn, *g_post_ffn, *w_router, *b_router, *w_e_in, *b_e_in, *w_e_out, *b_e_out;
    float* out;
    unsigned char* ws;
};
__device__ __forceinline__ float wave_sum(float v) {
#pragma unroll
    for (int o = 1; o < 64; o <<= 1) v += __shfl_xor(v, o);
    return v;
}
__device__ __forceinline__ float wave_max(float v) {
#pragma unroll
    for (int o = 1; o < 64; o <<= 1) v = fmaxf(v, __shfl_xor(v, o));
    return v;
}
__device__ __forceinline__ float mod_val(const Frame& F, int b, int idx) {
    const float* mp = (const float*)(F.ws + WS_MODP);
    float s = F.b_ada[idx];
#pragma unroll
    for (int ks = 0; ks < 16; ++ks) s += mp[(size_t)(ks * 4 + b) * (6 * D) + idx];
    return s;
}

__constant__ unsigned char T5B[3][132] = {
 {11,11,11,11,11,11,11,11,11,11,11,11,11,11,11,10,10,10,10,10,10,10,10,10,10,10,10,10,10,10,10,10,10,10,10,10,10,10,9,9,9,9,9,9,9,9,9,9,9,9,8,8,8,8,8,8,8,7,6,5,4,3,2,1,0,17,18,19,20,21,22,23,24,24,24,24,24,24,24,25,25,25,25,25,25,25,25,25,25,25,25,26,26,26,26,26,26,26,26,26,26,26,26,26,26,26,26,26,26,26,26,26,26,26,27,27,27,27,27,27,27,27,27,27,27,27,27,27,27,0,0,0},
 {13,13,13,13,13,13,13,13,13,13,13,13,13,13,13,13,13,13,13,13,13,13,13,12,12,12,12,12,12,12,12,12,12,12,12,12,12,12,12,12,12,12,11,11,11,11,11,11,11,11,11,11,10,10,10,10,10,10,9,9,9,8,8,4,0,20,24,24,25,25,25,26,26,26,26,26,26,27,27,27,27,27,27,27,27,27,27,28,28,28,28,28,28,28,28,28,28,28,28,28,28,28,28,28,28,28,29,29,29,29,29,29,29,29,29,29,29,29,29,29,29,29,29,29,29,29,29,29,29,0,0,0},
 {15,15,15,15,15,15,15,15,15,15,15,15,15,15,15,15,15,15,15,15,15,15,15,15,15,15,15,15,15,15,14,14,14,14,14,14,14,14,14,14,14,14,14,14,14,13,13,13,13,13,13,13,13,13,12,12,12,12,12,11,11,10,10,9,0,25,26,26,27,27,28,28,28,28,28,29,29,29,29,29,29,29,29,29,30,30,30,30,30,30,30,30,30,30,30,30,30,30,30,31,31,31,31,31,31,31,31,31,31,31,31,31,31,31,31,31,31,31,31,31,31,31,31,31,31,31,31,31,31,0,0,0}};

__device__ __forceinline__ void p0_mod_item(Frame& F, int j) {
    const int ks = j >> 4, cb = j & 15;
    LAS float* sc = (LAS float*)(F.lds + RING_OFF);
    LAS float* red = (LAS float*)(F.lds + RING_OFF + 4096);
    __syncthreads();
    { const int b = F.tid >> 7, k = F.tid & 127; const float cv = F.c[b * D + ks * 128 + k]; sc[F.tid] = cv / (1.0f + __expf(-cv)); }
    __syncthreads();
    const int cg = F.tid % 192, sub = F.tid / 192;
    f32x4 acc[4];
#pragma unroll
    for (int b = 0; b < 4; ++b) acc[b] = (f32x4){0.f, 0.f, 0.f, 0.f};
    if (sub < 2) {
        const float* wp = F.w_ada + (size_t)(ks * 128 + sub * 64) * (6 * D) + cb * 768 + 4 * cg;
#pragma unroll 8
        for (int i = 0; i < 64; ++i) {
            const f32x4 w = *(const f32x4*)(wp + (size_t)i * (6 * D));
#pragma unroll
            for (int b = 0; b < 4; ++b) { const float s = sc[b * 128 + sub * 64 + i]; acc[b] += w * s; }
        }
        if (sub == 1) {
#pragma unroll
            for (int b = 0; b < 4; ++b) *(LAS f32x4*)(red + cg * 16 + b * 4) = acc[b];
        }
    }
    __syncthreads();
    if (sub == 0) {
        float* mp = (float*)(F.ws + WS_MODP);
#pragma unroll
        for (int b = 0; b < 4; ++b) { const f32x4 o = acc[b] + *(LAS f32x4*)(red + cg * 16 + b * 4); *(f32x4*)(mp + (size_t)(ks * 4 + b) * (6 * D) + cb * 768 + 4 * cg) = o; }
    }
}
__device__ __forceinline__ void p0_transpose_item(const float* W, int K, int N, bf16* WT, LAS float* scr, int item, int lane) {
    const int nblk = N >> 6, kb = item / nblk, nb = item - kb * nblk, k0 = kb << 6, n0 = nb << 6;
    const float* src = W + (size_t)(k0 + (lane >> 4)) * N + n0 + 4 * (lane & 15);
    f32x4 v[16];
#pragma unroll
    for (int i = 0; i < 16; ++i) v[i] = *(const f32x4*)(src + (size_t)(4 * i) * N);
#pragma unroll
    for (int i = 0; i < 16; ++i) { LAS float* d = scr + (4 * i + (lane >> 4)) * 65 + 4 * (lane & 15); d[0] = v[i][0]; d[1] = v[i][1]; d[2] = v[i][2]; d[3] = v[i][3]; }
    LDS_WAIT();
    const int c = lane >> 3;
#pragma unroll
    for (int jn = 0; jn < 8; ++jn) { const int n = (lane & 7) + 8 * jn; const LAS float* s = scr + (8 * c) * 65 + n;
        v4u o; o.x = pk2(s[0 * 65], s[1 * 65]); o.y = pk2(s[2 * 65], s[3 * 65]); o.z = pk2(s[4 * 65], s[5 * 65]); o.w = pk2(s[6 * 65], s[7 * 65]);
        *(v4u*)(WT + (size_t)(n0 + n) * K + k0 + 8 * c) = o; }
    LDS_WAIT();
}
__device__ __forceinline__ void p0_transpose8_item(const float* W, int K, int N, unsigned char* WT, LAS float* scr, int item, int lane, float scale) {
    const int nblk = N >> 5, kb = item / nblk, nb = item - kb * nblk, k0 = kb << 7, n0 = nb << 5;
    const float* src = W + (size_t)(k0 + (lane >> 3)) * N + n0 + 4 * (lane & 7);
    f32x4 v[16];
#pragma unroll
    for (int i = 0; i < 16; ++i) v[i] = *(const f32x4*)(src + (size_t)(8 * i) * N);
#pragma unroll
    for (int i = 0; i < 16; ++i) { LAS float* d = scr + (8 * i + (lane >> 3)) * 33 + 4 * (lane & 7); d[0] = v[i][0]; d[1] = v[i][1]; d[2] = v[i][2]; d[3] = v[i][3]; }
    LDS_WAIT();
#pragma unroll
    for (int jn = 0; jn < 2; ++jn)
#pragma unroll
        for (int jc = 0; jc < 2; ++jc) { const int n = (lane & 15) + 16 * jn, c = (lane >> 4) + 4 * jc; const LAS float* s = scr + (16 * c) * 33 + n;
            v4u o;
            o.x = pg8::cvt4_fp8(s[0 * 33] * scale, s[1 * 33] * scale, s[2 * 33] * scale, s[3 * 33] * scale);
            o.y = pg8::cvt4_fp8(s[4 * 33] * scale, s[5 * 33] * scale, s[6 * 33] * scale, s[7 * 33] * scale);
            o.z = pg8::cvt4_fp8(s[8 * 33] * scale, s[9 * 33] * scale, s[10 * 33] * scale, s[11 * 33] * scale);
            o.w = pg8::cvt4_fp8(s[12 * 33] * scale, s[13 * 33] * scale, s[14 * 33] * scale, s[15 * 33] * scale);
            *(v4u*)(WT + (size_t)(n0 + n) * K + k0 + 16 * c) = o; }
    LDS_WAIT();
}
__device__ __forceinline__ void p0_prologue(Frame& F) {
    for (int j = F.vcu; j < 256; j += F.G) p0_mod_item(F, j);
    __syncthreads();
    LAS float* scr = (LAS float*)(F.lds + RING_OFF + F.wave * 16896);
    const int gw = F.vcu * NWAVES + F.wave, NGW = F.G * NWAVES;
    constexpr int I_IN = (D / 64) * (NQKV / 64), I_O = (D / 64) * (D / 64), I_EI1 = (D / 128) * (FF2 / 32), I_EO1 = (FF / 128) * (D / 32);
    constexpr int I_EI = NE * I_EI1, I_EO = NE * I_EO1, NITEMS = I_IN + I_O + I_EI + I_EO;
    for (int it = gw; it < NITEMS; it += NGW) {
        int r = it;
        if (r < I_IN) { p0_transpose_item(F.w_in, D, NQKV, (bf16*)(F.ws + WS_WIN_T), scr, r, F.lane); continue; } r -= I_IN;
        if (r < I_O) { p0_transpose_item(F.w_o, D, D, (bf16*)(F.ws + WS_WO_T), scr, r, F.lane); continue; } r -= I_O;
        if (r < I_EI) { const int e = r / I_EI1; p0_transpose8_item(F.w_e_in + (size_t)e * D * FF2, D, FF2, F.ws + WS_WEI_T + (size_t)e * FF2 * D, scr, r - e * I_EI1, F.lane, WSCALE); continue; } r -= I_EI;
        { const int e = r / I_EO1; p0_transpose8_item(F.w_e_out + (size_t)e * FF * D, FF, D, F.ws + WS_WEO_T + (size_t)e * D * FF, scr, r - e * I_EO1, F.lane, WSCALE); }
    }
}

__device__ __forceinline__ void p1_hmix(Frame& F) {
    LAS float* ta = (LAS float*)(F.lds + RING_OFF);
    LAS float* tb = ta + D;
    for (int rb = F.vcu; rb < T / 32; rb += F.G) {
        const int b = rb >> 6;
        __syncthreads();
        for (int col = F.tid; col < D; col += NWAVES * 64) { ta[col] = F.g_pre_mix[col] * (1.0f + mod_val(F, b, D + col)); tb[col] = mod_val(F, b, col); }
        __syncthreads();
        for (int rr = F.wave; rr < 32; rr += NWAVES) {
            const int row = rb * 32 + rr;
            const f32x4* xr = (const f32x4*)(F.x + (size_t)row * D) + F.lane;
            f32x4 v[8]; float ss = 0.f;
#pragma unroll
            for (int j = 0; j < 8; ++j) { v[j] = xr[64 * j]; ss += (v[j][0] * v[j][0] + v[j][1] * v[j][1]) + (v[j][2] * v[j][2] + v[j][3] * v[j][3]); }
            const float r = 1.0f / sqrtf(wave_sum(ss) * (1.0f / D) + EPS);
            v2u* o8 = (v2u*)((bf16*)(F.ws + WS_HMIX) + (size_t)row * D) + F.lane;
#pragma unroll
            for (int j = 0; j < 8; ++j) { const int col = 4 * F.lane + 256 * j; const f32x4 a = *(LAS f32x4*)(ta + col), s = *(LAS f32x4*)(tb + col);
                v2u w; w.x = pk2(v[j][0] * r * a[0] + s[0], v[j][1] * r * a[1] + s[1]); w.y = pk2(v[j][2] * r * a[2] + s[2], v[j][3] * r * a[3] + s[3]); o8[64 * j] = w; }
        }
    }
}

__device__ __forceinline__ float dot_qk(const LAS float* q, const bf16* krow) {
    float s = 0.f;
#pragma unroll
    for (int ch = 0; ch < 16; ++ch) { const v4u kv = *(const v4u*)(krow + 8 * ch); const LAS float* qq = q + 8 * ch;
        s += qq[0] * bflo(kv.x) + qq[1] * bfhi(kv.x) + qq[2] * bflo(kv.y) + qq[3] * bfhi(kv.y) + qq[4] * bflo(kv.z) + qq[5] * bfhi(kv.z) + qq[6] * bflo(kv.w) + qq[7] * bfhi(kv.w); }
    return s;
}
__device__ __forceinline__ void p3_attn_naive(Frame& F) {
    LAS float* lq = (LAS float*)(F.lds + RING_OFF + F.wave * 2048);
    LAS float* lp = lq + 128;
    const bf16* proj = (const bf16*)(F.ws + WS_PROJ);
    float* ona = (float*)(F.ws + WS_ONA); float* odil = (float*)(F.ws + WS_ODIL); float* lse = (float*)(F.ws + WS_LSE);
    const float scale = 0.08838834764831845f;
    const int gw = F.vcu * NWAVES + F.wave, NGW = F.G * NWAVES, lane = F.lane;
    for (int it = gw; it < T * 16; it += NGW) {
        const int tok = it >> 4, hh = it & 15, b = tok >> 11, pos = tok & 2047;
        const bf16* prow = proj + (size_t)tok * NQKV;
        if (hh < 8) {
            const int h = hh;
            { const unsigned qw = *(const unsigned*)(prow + h * HD + 2 * lane); LDS_WAIT(); lq[2 * lane] = bflo(qw); lq[2 * lane + 1] = bfhi(qw); LDS_WAIT(); }
            const int r = pos >> 6, c = pos & 63; const int rs = min(max(r - 4, 0), 24), cs = min(max(c - 8, 0), 48);
            float lg[2];
#pragma unroll
            for (int jj = 0; jj < 2; ++jj) { const int j = lane + 64 * jj, i = j >> 4, cc = cs + (j & 15), kpos = (rs + i) * 64 + cc;
                const float d = dot_qk(lq, proj + (size_t)(b * SEQ + kpos) * NQKV + GW + h * HD);
                lg[jj] = d * scale + F.rpb[(h * 15 + (rs + i - r + 7)) * 31 + (cc - c + 15)]; }
            const float m = wave_max(fmaxf(lg[0], lg[1]));
            const float p0 = __expf(lg[0] - m), p1 = __expf(lg[1] - m);
            const float inv = 1.0f / wave_sum(p0 + p1);
            lp[lane] = p0 * inv; lp[lane + 64] = p1 * inv; LDS_WAIT();
            float o0 = 0.f, o1 = 0.f;
            for (int j = 0; j < 128; ++j) { const int kpos = (rs + (j >> 4)) * 64 + cs + (j & 15);
                const unsigned vw = *(const unsigned*)(proj + (size_t)(b * SEQ + kpos) * NQKV + 2 * GW + h * HD + 2 * lane); const float p = lp[j]; o0 += p * bflo(vw); o1 += p * bfhi(vw); }
            *(float2*)(ona + (size_t)tok * GW + h * HD + 2 * lane) = make_float2(o0, o1);
        } else {
            const int h = hh - 8;
            { const unsigned qw = *(const unsigned*)(prow + 3 * GW + h * HD + 2 * lane); LDS_WAIT(); lq[2 * lane] = bflo(qw); lq[2 * lane + 1] = bfhi(qw); LDS_WAIT(); }
#pragma unroll
            for (int p = 0; p < 3; ++p) {
                const int dsh = 2 * p, dil = 1 << dsh, sub_len = SEQ >> dsh, rho = pos & (dil - 1), ql = pos >> dsh;
                float lg[3];
#pragma unroll
                for (int jj = 0; jj < 3; ++jj) { const int j = lane + 64 * jj; const int kl = ql + j - 64; const bool valid = (j < 129) && (kl >= 0) && (kl < sub_len);
                    const int kpos = rho + dil * min(max(kl, 0), sub_len - 1);
                    float d = -INFINITY;
                    if (valid) d = dot_qk(lq, proj + (size_t)(b * SEQ + kpos) * NQKV + 4 * GW + h * HD) * scale + F.t5[(int)T5B[p][j] * 8 + h];
                    lg[jj] = d; }
                const float m = wave_max(fmaxf(fmaxf(lg[0], lg[1]), lg[2]));
                const float p0 = __expf(lg[0] - m), p1 = __expf(lg[1] - m), p2 = __expf(lg[2] - m);
                const float den = wave_sum(p0 + p1 + p2), inv = 1.0f / den;
                LDS_WAIT(); lp[lane] = p0 * inv; lp[lane + 64] = p1 * inv; lp[lane + 128] = p2 * inv; LDS_WAIT();
                float o0 = 0.f, o1 = 0.f;
                for (int j = 0; j < 129; ++j) { const int kl = ql + j - 64; const int kpos = rho + dil * min(max(kl, 0), sub_len - 1);
                    const unsigned vw = *(const unsigned*)(proj + (size_t)(b * SEQ + kpos) * NQKV + 5 * GW + h * HD + 2 * lane); const float pp = lp[j]; o0 += pp * bflo(vw); o1 += pp * bfhi(vw); }
                *(float2*)(odil + ((size_t)p * T + tok) * GW + h * HD + 2 * lane) = make_float2(o0, o1);
                if (lane == 0) lse[((size_t)p * T + tok) * 8 + h] = m + __logf(den);
            }
        }
    }
}


typedef short bf16x8v __attribute__((ext_vector_type(8)));
typedef short s16x4v __attribute__((ext_vector_type(4)));
typedef int v4i16_t_ __attribute__((ext_vector_type(2)));
__device__ __forceinline__ unsigned vimg_off(unsigned row, unsigned ch) { return 256u * row + 16u * (ch ^ (((row & 3u) << 2) | ((row >> 2) & 3u))); }
__device__ __forceinline__ s16x4v tr_read16(const LAS unsigned char* p) {
    typedef short v4i16 __attribute__((ext_vector_type(4)));
    return __builtin_bit_cast(s16x4v, __builtin_amdgcn_ds_read_tr16_b64_v4i16((LAS v4i16*)p));
}
struct GeoNA {
    int tok0, qbase, kbase, r, rs, c0, kc0; const float* rpb_h;
    static constexpr int QCOL = 0, KCOL = GW, VCOL = 2 * GW;
    __device__ __forceinline__ int qtok(int n16) const { return qbase + n16; }
    __device__ __forceinline__ int ktok(int c, int slot) const { return kbase + c * 64 + slot; }
    __device__ __forceinline__ float bias(int c, int slot, int n16) const {
        const int qc = c0 + n16, kc = kc0 + slot, cs = min(max(qc - 8, 0), 48);
        const bool valid = (kc >= cs) && (kc < cs + 16);
        const int dc = min(max(kc - qc + 15, 0), 30);
        const float bv = rpb_h[(rs + c - r + 7) * 31 + dc];
        return valid ? bv : -INFINITY;
    }
};
struct GeoDil {
    int tok0, rho, dsh, sub_len, l0, p, h; const float* t5;
    static constexpr int QCOL = 3 * GW, KCOL = 4 * GW, VCOL = 5 * GW;
    __device__ __forceinline__ int qtok(int n16) const { return tok0 + rho + ((l0 + n16) << dsh); }
    __device__ __forceinline__ int ktok(int c, int slot) const { const int l = min(max(l0 - 64 + 32 * c + slot, 0), sub_len - 1); return tok0 + rho + (l << dsh); }
    __device__ __forceinline__ float bias(int c, int slot, int n16) const {
        const int kk = 32 * c + slot, delta = kk - 64 - n16, l = l0 - 64 + kk;
        const bool valid = (delta >= -64) && (delta <= 64) && (l >= 0) && (l < sub_len);
        const int di = min(max(delta + 64, 0), 128);
        const float bv = t5[(int)T5B[p][di] * 8 + h];
        return valid ? bv : -INFINITY;
    }
};
template <int NCH, class Geo>
__device__ __forceinline__ void attn_item(const Geo& G, const bf16* proj, int hcol, LAS unsigned char* vimg, float* out, float* lse_out, int lane) {
    const int n16 = lane & 15, g = lane >> 4;
    const float scale_l2 = 0.08838834764831845f * 1.44269504089f;
    bf16x8v qf[4];
    { const bf16* qp = proj + (size_t)G.qtok(n16) * NQKV + Geo::QCOL + hcol + 8 * g;
#pragma unroll
      for (int s = 0; s < 4; ++s) qf[s] = *(const bf16x8v*)(qp + 32 * s); }
    f32x4 st[NCH][2];
#pragma unroll
    for (int c = 0; c < NCH; ++c)
#pragma unroll
        for (int t2 = 0; t2 < 2; ++t2) {
            const int slot = 8 * (n16 >> 2) + 4 * t2 + (n16 & 3);
            const bf16* kp = proj + (size_t)G.ktok(c, slot) * NQKV + Geo::KCOL + hcol + 8 * g;
            f32x4 acc = (f32x4){0.f, 0.f, 0.f, 0.f};
#pragma unroll
            for (int s = 0; s < 4; ++s) { const bf16x8v kf = *(const bf16x8v*)(kp + 32 * s); acc = __builtin_amdgcn_mfma_f32_16x16x32_bf16(kf, qf[s], acc, 0, 0, 0); }
            st[c][t2] = acc;
        }
    float mx = -INFINITY;
#pragma unroll
    for (int c = 0; c < NCH; ++c)
#pragma unroll
        for (int t2 = 0; t2 < 2; ++t2)
#pragma unroll
            for (int r = 0; r < 4; ++r) { const float bv = G.bias(c, 8 * g + 4 * t2 + r, n16); const float x = st[c][t2][r] * scale_l2 + bv * 1.44269504089f; st[c][t2][r] = x; mx = fmaxf(mx, x); }
    mx = fmaxf(mx, __shfl_xor(mx, 16)); mx = fmaxf(mx, __shfl_xor(mx, 32));
    float sum = 0.f;
    bf16x8v pf[NCH];
#pragma unroll
    for (int c = 0; c < NCH; ++c) {
        float pv[8];
#pragma unroll
        for (int t2 = 0; t2 < 2; ++t2)
#pragma unroll
            for (int r = 0; r < 4; ++r) { const float p = __builtin_amdgcn_exp2f(st[c][t2][r] - mx); pv[4 * t2 + r] = p; sum += p; }
        v4u w; w.x = pk2(pv[0], pv[1]); w.y = pk2(pv[2], pv[3]); w.z = pk2(pv[4], pv[5]); w.w = pk2(pv[6], pv[7]);
        pf[c] = __builtin_bit_cast(bf16x8v, w);
    }
    sum += __shfl_xor(sum, 16); sum += __shfl_xor(sum, 32);
    f32x4 oacc[8];
#pragma unroll
    for (int dt = 0; dt < 8; ++dt) oacc[dt] = (f32x4){0.f, 0.f, 0.f, 0.f};
    const int vr_row = lane >> 4, vr_ch = lane & 15;
    v4u vr[8];
#pragma unroll
    for (int i = 0; i < 8; ++i) vr[i] = *(const v4u*)(proj + (size_t)G.ktok(0, 4 * i + vr_row) * NQKV + Geo::VCOL + hcol + 8 * vr_ch);
    const unsigned q4 = (unsigned)(lane & 15) >> 2, pp = (unsigned)lane & 3u;
#pragma unroll
    for (int c = 0; c < NCH; ++c) {
        asm volatile("" ::: "memory");
#pragma unroll
        for (int i = 0; i < 8; ++i) *(LAS v4u*)(vimg + vimg_off((unsigned)(4 * i + vr_row), (unsigned)vr_ch)) = vr[i];
        asm volatile("" ::: "memory");
        if (c + 1 < NCH) {
#pragma unroll
            for (int i = 0; i < 8; ++i) vr[i] = *(const v4u*)(proj + (size_t)G.ktok(c + 1, 4 * i + vr_row) * NQKV + Geo::VCOL + hcol + 8 * vr_ch);
        }
#pragma unroll
        for (int dt = 0; dt < 8; ++dt) {
            const s16x4v lo = tr_read16(vimg + vimg_off((unsigned)(8 * g) + q4, (unsigned)(2 * dt) + (pp >> 1)) + 8u * (pp & 1u));
            const s16x4v hi = tr_read16(vimg + vimg_off((unsigned)(8 * g + 4) + q4, (unsigned)(2 * dt) + (pp >> 1)) + 8u * (pp & 1u));
            bf16x8v vf; vf[0] = lo[0]; vf[1] = lo[1]; vf[2] = lo[2]; vf[3] = lo[3]; vf[4] = hi[0]; vf[5] = hi[1]; vf[6] = hi[2]; vf[7] = hi[3];
            oacc[dt] = __builtin_amdgcn_mfma_f32_16x16x32_bf16(vf, pf[c], oacc[dt], 0, 0, 0);
        }
        asm volatile("" ::: "memory");
    }
    const float inv = 1.0f / sum;
    float* op = out + (size_t)G.qtok(n16) * GW + hcol + 4 * g;
#pragma unroll
    for (int dt = 0; dt < 8; ++dt) *(f32x4*)(op + 16 * dt) = oacc[dt] * inv;
    if (lse_out != nullptr && g == 0) lse_out[(size_t)G.qtok(n16) * 8 + (hcol >> 7)] = (mx + __builtin_amdgcn_logf(sum)) * 0.69314718056f;
}
__device__ __forceinline__ unsigned kimg_off(unsigned row, unsigned ch) { return 256u * row + 16u * (ch ^ (((row & 3u) << 2) | ((row >> 3) & 3u))); }
__device__ __forceinline__ void attn_dil_units(Frame& F) {
    LAS unsigned char* kimg = F.lds + RING_OFF;
    LAS unsigned char* vimg = F.lds + RING_OFF + 65536;
    LAS float* tb = (LAS float*)(F.lds + RING_OFF + 131072);
    const bf16* proj = (const bf16*)(F.ws + WS_PROJ);
    float* odil = (float*)(F.ws + WS_ODIL); float* lse = (float*)(F.ws + WS_LSE);
    const int lane = F.lane, n16 = lane & 15, g = lane >> 4, w = F.wave;
    const float scale_l2 = 0.08838834764831845f * 1.44269504089f;
    for (int u = F.vcu; u < 3 * NBATCH * 8 * 16; u += F.G) {
        const int p = u >> 9, b = (u >> 7) & 3, h = (u >> 4) & 7, grp = u & 15;
        const int dsh = 2 * p, sub_len = SEQ >> dsh, gpc = sub_len >> 7, rho = grp / gpc, l0g = (grp - rho * gpc) << 7, tok0 = b * SEQ + rho;
        __syncthreads();
        if (F.tid < 129) tb[F.tid] = F.t5[(int)T5B[p][F.tid] * 8 + h] * 1.44269504089f;
        { v4u kr[8], vr[8];
#pragma unroll
          for (int ps = 0; ps < 8; ++ps) { const int row = ps * 32 + (F.tid >> 4), ch = F.tid & 15; const int l = min(max(l0g - 64 + row, 0), sub_len - 1);
              const bf16* src = proj + (size_t)(tok0 + (l << dsh)) * NQKV + h * HD + 8 * ch;
              kr[ps] = *(const v4u*)(src + 4 * GW); vr[ps] = *(const v4u*)(src + 5 * GW); }
#pragma unroll
          for (int ps = 0; ps < 8; ++ps) { const unsigned row = ps * 32 + (F.tid >> 4), ch = F.tid & 15;
              *(LAS v4u*)(kimg + kimg_off(row, ch)) = kr[ps]; *(LAS v4u*)(vimg + vimg_off(row, ch)) = vr[ps]; } }
        __syncthreads();
        const int l0 = l0g + 16 * w, qtok = tok0 + ((l0 + n16) << dsh);
        bf16x8v qf[4];
        { const bf16* qp = proj + (size_t)qtok * NQKV + 3 * GW + h * HD + 8 * g;
#pragma unroll
          for (int s = 0; s < 4; ++s) qf[s] = *(const bf16x8v*)(qp + 32 * s); }
        f32x4 st[5][2];
#pragma unroll
        for (int c = 0; c < 5; ++c)
#pragma unroll
            for (int t2 = 0; t2 < 2; ++t2) {
                const unsigned row = (unsigned)(16 * w + 32 * c + 8 * (n16 >> 2) + 4 * t2 + (n16 & 3)) & 255u;
                f32x4 acc = (f32x4){0.f, 0.f, 0.f, 0.f};
#pragma unroll
                for (int s = 0; s < 4; ++s) { const bf16x8v kf = *(const LAS bf16x8v*)(kimg + kimg_off(row, (unsigned)(4 * s + g))); acc = __builtin_amdgcn_mfma_f32_16x16x32_bf16(kf, qf[s], acc, 0, 0, 0); }
                st[c][t2] = acc;
            }
        float mx = -INFINITY;
#pragma unroll
        for (int c = 0; c < 5; ++c)
#pragma unroll
            for (int t2 = 0; t2 < 2; ++t2)
#pragma unroll
                for (int r = 0; r < 4; ++r) { const int kk = 32 * c + 8 * g + 4 * t2 + r, delta = kk - 64 - n16, l = l0 - 64 + kk;
                    const bool valid = (delta >= -64) && (delta <= 64) && (l >= 0) && (l < sub_len);
                    const float bv = tb[min(max(delta + 64, 0), 128)];
                    const float x = valid ? st[c][t2][r] * scale_l2 + bv : -INFINITY; st[c][t2][r] = x; mx = fmaxf(mx, x); }
        mx = fmaxf(mx, __shfl_xor(mx, 16)); mx = fmaxf(mx, __shfl_xor(mx, 32));
        float sum = 0.f;
        bf16x8v pf[5];
#pragma unroll
        for (int c = 0; c < 5; ++c) {
            float pv[8];
#pragma unroll
            for (int t2 = 0; t2 < 2; ++t2)
#pragma unroll
                for (int r = 0; r < 4; ++r) { const float pe = __builtin_amdgcn_exp2f(st[c][t2][r] - mx); pv[4 * t2 + r] = pe; sum += pe; }
            v4u wv; wv.x = pk2(pv[0], pv[1]); wv.y = pk2(pv[2], pv[3]); wv.z = pk2(pv[4], pv[5]); wv.w = pk2(pv[6], pv[7]);
            pf[c] = __builtin_bit_cast(bf16x8v, wv);
        }
        sum += __shfl_xor(sum, 16); sum += __shfl_xor(sum, 32);
        f32x4 oacc[8];
#pragma unroll
        for (int dt = 0; dt < 8; ++dt) oacc[dt] = (f32x4){0.f, 0.f, 0.f, 0.f};
        const unsigned q4 = (unsigned)(lane & 15) >> 2, pp = (unsigned)lane & 3u;
#pragma unroll
        for (int c = 0; c < 5; ++c)
#pragma unroll
            for (int dt = 0; dt < 8; ++dt) {
                const unsigned rbase = ((unsigned)(16 * w + 32 * c + 8 * g) & 255u) + q4;
                const s16x4v lo = tr_read16(vimg + vimg_off(rbase, (unsigned)(2 * dt) + (pp >> 1)) + 8u * (pp & 1u));
                const s16x4v hi = tr_read16(vimg + vimg_off(rbase + 4u, (unsigned)(2 * dt) + (pp >> 1)) + 8u * (pp & 1u));
                bf16x8v vf; vf[0] = lo[0]; vf[1] = lo[1]; vf[2] = lo[2]; vf[3] = lo[3]; vf[4] = hi[0]; vf[5] = hi[1]; vf[6] = hi[2]; vf[7] = hi[3];
                oacc[dt] = __builtin_amdgcn_mfma_f32_16x16x32_bf16(vf, pf[c], oacc[dt], 0, 0, 0);
            }
        const float inv = 1.0f / sum;
        float* op = odil + ((size_t)p * T + qtok) * GW + h * HD + 4 * g;
#pragma unroll
        for (int dt = 0; dt < 8; ++dt) *(f32x4*)(op + 16 * dt) = oacc[dt] * inv;
        if (g == 0) lse[((size_t)p * T + qtok) * 8 + h] = (mx + __builtin_amdgcn_logf(sum)) * 0.69314718056f;
    }
    __syncthreads();
}
__device__ __forceinline__ void p3_attn_mfma(Frame& F) {
    attn_dil_units(F);
    LAS unsigned char* vimg = F.lds + RING_OFF + F.wave * 8192;
    const bf16* proj = (const bf16*)(F.ws + WS_PROJ);
    float* ona = (float*)(F.ws + WS_ONA);
    const int gw = F.vcu * NWAVES + F.wave, NGW = F.G * NWAVES, lane = F.lane;
    for (int it = gw * 2; it < NBATCH * 32 * 8 * 4; it += NGW * 2) {
#pragma unroll 1
        for (int k = 0; k < 2; ++k) {
            const int id = it + k, qt = id & 3, h = (id >> 2) & 7, r = (id >> 5) & 31, b = id >> 10;
            GeoNA G; G.tok0 = b * SEQ; G.r = r; G.rs = min(max(r - 4, 0), 24); G.c0 = 16 * qt; G.kc0 = (qt == 0) ? 0 : (qt == 1) ? 8 : (qt == 2) ? 24 : 32;
            G.qbase = G.tok0 + r * 64 + G.c0; G.kbase = G.tok0 + G.rs * 64 + G.kc0; G.rpb_h = F.rpb + h * (15 * 31);
            attn_item<8, GeoNA>(G, proj, h * HD, vimg, ona, nullptr, lane);
        }
    }
}

__device__ __forceinline__ void p4_post(Frame& F) {
    const float* ona = (const float*)(F.ws + WS_ONA); const float* odil = (const float*)(F.ws + WS_ODIL); const float* lse = (const float*)(F.ws + WS_LSE);
    bf16* aout = (bf16*)(F.ws + WS_AOUT);
    const int gw = F.vcu * NWAVES + F.wave, NGW = F.G * NWAVES, lane = F.lane;
    for (int tok = gw; tok < T; tok += NGW) {
        f32x4 v[4]; float ss = 0.f;
#pragma unroll
        for (int j = 0; j < 4; ++j) { v[j] = *(const f32x4*)(ona + (size_t)tok * GW + 4 * lane + 256 * j); ss += (v[j][0] * v[j][0] + v[j][1] * v[j][1]) + (v[j][2] * v[j][2] + v[j][3] * v[j][3]); }
        float r = 1.0f / sqrtf(wave_sum(ss) * (1.0f / GW) + EPS);
#pragma unroll
        for (int j = 0; j < 4; ++j) { const int col = 4 * lane + 256 * j; const f32x4 g = *(const f32x4*)(F.g_out_na + col);
            v2u w; w.x = pk2(v[j][0] * r * g[0], v[j][1] * r * g[1]); w.y = pk2(v[j][2] * r * g[2], v[j][3] * r * g[3]); *(v2u*)(aout + (size_t)tok * D + col) = w; }
        ss = 0.f;
#pragma unroll
        for (int j = 0; j < 4; ++j) { const int col = 4 * lane + 256 * j, h = col >> 7;
            const float l0 = lse[((size_t)0 * T + tok) * 8 + h], l1 = lse[((size_t)1 * T + tok) * 8 + h], l2 = lse[((size_t)2 * T + tok) * 8 + h];
            const float mx = fmaxf(fmaxf(l0, l1), l2); const float e0 = __expf(l0 - mx), e1 = __expf(l1 - mx), e2 = __expf(l2 - mx); const float inv = 1.0f / (e0 + e1 + e2);
            const f32x4 a0 = *(const f32x4*)(odil + ((size_t)0 * T + tok) * GW + col), a1 = *(const f32x4*)(odil + ((size_t)1 * T + tok) * GW + col), a2 = *(const f32x4*)(odil + ((size_t)2 * T + tok) * GW + col);
            v[j] = a0 * (e0 * inv) + a1 * (e1 * inv) + a2 * (e2 * inv);
            ss += (v[j][0] * v[j][0] + v[j][1] * v[j][1]) + (v[j][2] * v[j][2] + v[j][3] * v[j][3]); }
        r = 1.0f / sqrtf(wave_sum(ss) * (1.0f / GW) + EPS);
#pragma unroll
        for (int j = 0; j < 4; ++j) { const int col = 4 * lane + 256 * j; const f32x4 g = *(const f32x4*)(F.g_out_dil + col);
            v2u w; w.x = pk2(v[j][0] * r * g[0], v[j][1] * r * g[1]); w.y = pk2(v[j][2] * r * g[2], v[j][3] * r * g[3]); *(v2u*)(aout + (size_t)tok * D + GW + col) = w; }
    }
}

__device__ __forceinline__ void p6_rows(Frame& F) {
    LAS float* t1 = (LAS float*)(F.lds + RING_OFF);
    LAS float* t2 = t1 + D;
    LAS float* t3 = t2 + D;
    LAS unsigned* hb = (LAS unsigned*)(F.lds + RING_OFF + 3 * D * 4) + F.wave * (4 * D / 2);
    const float* mixed = (const float*)(F.ws + WS_MIXED); float* x1 = (float*)(F.ws + WS_X1); unsigned char* hffn8 = F.ws + WS_HFFN;
    int* topi = (int*)(F.ws + WS_TOPI); float* topg = (float*)(F.ws + WS_TOPG); int* trank = (int*)(F.ws + WS_TRANK); unsigned* hist_g = (unsigned*)(F.ws + WS_HIST);
    LAS unsigned* hist = (LAS unsigned*)(F.lds + MISC_OFF) + 224;
    const int lane = F.lane;
    for (int rb = F.vcu; rb < T / 32; rb += F.G) {
        const int b = rb >> 6;
        __syncthreads();
        if (F.tid < 32) hist[F.tid] = 0u;
        for (int col = F.tid; col < D; col += NWAVES * 64) { t1[col] = F.g_post_mix[col] * mod_val(F, b, 2 * D + col); t2[col] = F.g_pre_ffn[col] * (1.0f + mod_val(F, b, 4 * D + col)); t3[col] = mod_val(F, b, 3 * D + col); }
        __syncthreads();
#pragma unroll 1
        for (int rr = 0; rr < 4; ++rr) {
            const int row = rb * 32 + F.wave * 4 + rr;
            f32x4 v[8]; float ss = 0.f;
#pragma unroll
            for (int j = 0; j < 8; ++j) { v[j] = *(const f32x4*)(mixed + (size_t)row * D + 4 * lane + 256 * j); ss += (v[j][0] * v[j][0] + v[j][1] * v[j][1]) + (v[j][2] * v[j][2] + v[j][3] * v[j][3]); }
            float r = 1.0f / sqrtf(wave_sum(ss) * (1.0f / D) + EPS);
            ss = 0.f;
#pragma unroll
            for (int j = 0; j < 8; ++j) { const int col = 4 * lane + 256 * j; const f32x4 xv = *(const f32x4*)(F.x + (size_t)row * D + col); const f32x4 a = *(LAS f32x4*)(t1 + col);
                v[j] = xv + a * (v[j] * r); *(f32x4*)(x1 + (size_t)row * D + col) = v[j];
                ss += (v[j][0] * v[j][0] + v[j][1] * v[j][1]) + (v[j][2] * v[j][2] + v[j][3] * v[j][3]); }
            r = 1.0f / sqrtf(wave_sum(ss) * (1.0f / D) + EPS);
#pragma unroll
            for (int j = 0; j < 8; ++j) { const int col = 4 * lane + 256 * j; const f32x4 a = *(LAS f32x4*)(t2 + col), s = *(LAS f32x4*)(t3 + col);
                const f32x4 hv = v[j] * r * a + s;
                v2u w; w.x = pk2(hv[0], hv[1]); w.y = pk2(hv[2], hv[3]); *(LAS v2u*)(hb + rr * (D / 2) + (col >> 1)) = w;
                *(unsigned*)(hffn8 + (size_t)row * D + col) = pg8::cvt4_fp8(hv[0] * XSCALE, hv[1] * XSCALE, hv[2] * XSCALE, hv[3] * XSCALE); }
        }
        LDS_WAIT();
        const int e = lane & 31, half = lane >> 5;
        float acc[4] = {0.f, 0.f, 0.f, 0.f};
        { const float* wr = F.w_router + (size_t)(half * 1024) * NE + e; const LAS unsigned* hr = hb + half * 512;
#pragma unroll 8
          for (int kp = 0; kp < 512; ++kp) { const float w0 = wr[(size_t)(2 * kp) * NE], w1 = wr[(size_t)(2 * kp + 1) * NE];
#pragma unroll
              for (int rr = 0; rr < 4; ++rr) { const unsigned hw = hr[rr * (D / 2) + kp]; acc[rr] += bflo(hw) * w0 + bfhi(hw) * w1; } } }
        const float br = F.b_router[e];
#pragma unroll
        for (int rr = 0; rr < 4; ++rr) {
            const int row = rb * 32 + F.wave * 4 + rr;
            float a = acc[rr]; a += __shfl_xor(a, 32);
            float lg = (lane < 32) ? a + br : -INFINITY;
            int sel[4]; float val[4];
#pragma unroll
            for (int k = 0; k < 4; ++k) { const float mx = wave_max(lg); const unsigned long long bal = __ballot(lg == mx); const int idx = __ffsll((long long)bal) - 1; sel[k] = idx; val[k] = mx; if (lane == idx) lg = -INFINITY; }
            const float e1 = __expf(val[1] - val[0]), e2 = __expf(val[2] - val[0]), e3 = __expf(val[3] - val[0]); const float inv = 1.0f / (1.0f + e1 + e2 + e3);
            if (lane == 0) {
                *(int4*)(topi + (size_t)row * 4) = make_int4(sel[0], sel[1], sel[2], sel[3]);
                *(float4*)(topg + (size_t)row * 4) = make_float4(inv, e1 * inv, e2 * inv, e3 * inv);
                int rk[4];
#pragma unroll
                for (int k = 0; k < 4; ++k) rk[k] = (int)__hip_atomic_fetch_add(hist + sel[k], 1u, __ATOMIC_RELAXED, __HIP_MEMORY_SCOPE_WORKGROUP);
                *(int4*)(trank + (size_t)row * 4) = make_int4(rk[0], rk[1], rk[2], rk[3]);
            }
        }
        __syncthreads();
        if (F.tid < 32) hist_g[rb * 32 + F.tid] = hist[F.tid];
    }
}

__device__ __forceinline__ void moe_tables(Frame& F, int rb) {
    const unsigned* hist_g = (const unsigned*)(F.ws + WS_HIST);
    LAS unsigned* red = (LAS unsigned*)(F.lds + RING_OFF);
    __syncthreads();
    { const int e = F.tid & 31, part = F.tid >> 5; unsigned tot = 0u, pre = 0u;
#pragma unroll
      for (int i = 0; i < 16; ++i) { const int r2 = part * 16 + i; const unsigned v = hist_g[r2 * 32 + e]; tot += v; pre += (r2 < rb) ? v : 0u; }
      red[(part * 32 + e) * 2] = tot; red[(part * 32 + e) * 2 + 1] = pre; }
    __syncthreads();
    if (F.tid < 32) { unsigned tot = 0u, pre = 0u;
#pragma unroll
        for (int part = 0; part < 16; ++part) { tot += red[(part * 32 + F.tid) * 2]; pre += red[(part * 32 + F.tid) * 2 + 1]; }
        F.MISC[224 + F.tid] = tot; F.MISC[32 + F.tid] = pre; }
    __syncthreads();
    if (F.tid == 0) { int nb = 0;
        for (int e = 0; e < NE; ++e) { const int cnt = (int)F.MISC[224 + e]; const int k = (cnt + 255) >> 8; F.MISC[32 + e] += (unsigned)(nb * 256); for (int j = 0; j < k && nb < MAXBLK; ++j) F.MISC[64 + nb++] = (unsigned)e; }
        F.MISC[16] = (unsigned)nb; }
    __syncthreads();
}
__device__ __forceinline__ void p7_slots(Frame& F) {
    const int* topi = (const int*)(F.ws + WS_TOPI); const int* trank = (const int*)(F.ws + WS_TRANK); int* tslot = (int*)(F.ws + WS_TSLOT);
    const unsigned char* hffn8 = F.ws + WS_HFFN; unsigned char* xg8 = F.ws + WS_XG;
    const int lane = F.lane;
    for (int rb = F.vcu; rb < T / 32; rb += F.G) {
        moe_tables(F, rb);
#pragma unroll 4
        for (int i = 0; i < 16; ++i) {
            const int pid = rb * 128 + F.wave * 16 + i, t = pid >> 2; const int e = topi[pid];
            const int slot = (int)F.MISC[32 + e] + trank[pid];
            if (lane == 0) tslot[pid] = slot;
            const v4u* s = (const v4u*)(hffn8 + (size_t)t * D) + lane; v4u* d = (v4u*)(xg8 + (size_t)slot * D) + lane;
#pragma unroll
            for (int j = 0; j < 2; ++j) d[64 * j] = s[64 * j];
        }
    }
}

__device__ __forceinline__ void p10_final(Frame& F) {
    LAS float* t1 = (LAS float*)(F.lds + RING_OFF);
    const float* x1 = (const float*)(F.ws + WS_X1); const bf16* yb = (const bf16*)(F.ws + WS_YB);
    const int* tslot = (const int*)(F.ws + WS_TSLOT); const float* topg = (const float*)(F.ws + WS_TOPG);
    const int lane = F.lane;
    for (int rb = F.vcu; rb < T / 32; rb += F.G) {
        const int b = rb >> 6;
        __syncthreads();
        for (int col = F.tid; col < D; col += NWAVES * 64) t1[col] = F.g_post_ffn[col] * mod_val(F, b, 5 * D + col);
        __syncthreads();
        for (int rr = F.wave; rr < 32; rr += NWAVES) {
            const int row = rb * 32 + rr;
            const int4 sl = *(const int4*)(tslot + (size_t)row * 4); const float4 gt = *(const float4*)(topg + (size_t)row * 4);
            const int sls[4] = {sl.x, sl.y, sl.z, sl.w}; const float gts[4] = {gt.x, gt.y, gt.z, gt.w};
            float y[4][8]; float ss = 0.f;
#pragma unroll
            for (int j = 0; j < 4; ++j) {
#pragma unroll
                for (int i = 0; i < 8; ++i) y[j][i] = 0.f;
#pragma unroll
                for (int k = 0; k < 4; ++k) { const v4u w = *(const v4u*)(yb + (size_t)sls[k] * D + 8 * lane + 512 * j); const float g = gts[k];
                    y[j][0] += g * bflo(w.x); y[j][1] += g * bfhi(w.x); y[j][2] += g * bflo(w.y); y[j][3] += g * bfhi(w.y); y[j][4] += g * bflo(w.z); y[j][5] += g * bfhi(w.z); y[j][6] += g * bflo(w.w); y[j][7] += g * bfhi(w.w); }
#pragma unroll
                for (int i = 0; i < 8; ++i) ss += y[j][i] * y[j][i];
            }
            const float r = 1.0f / sqrtf(wave_sum(ss) * (1.0f / D) + EPS);
#pragma unroll
            for (int j = 0; j < 4; ++j) { const int col = 8 * lane + 512 * j;
#pragma unroll
                for (int hh = 0; hh < 2; ++hh) { const f32x4 xv = *(const f32x4*)(x1 + (size_t)row * D + col + 4 * hh); const f32x4 a = *(LAS f32x4*)(t1 + col + 4 * hh);
                    f32x4 o; o[0] = xv[0] + a[0] * y[j][4 * hh + 0] * r; o[1] = xv[1] + a[1] * y[j][4 * hh + 1] * r; o[2] = xv[2] + a[2] * y[j][4 * hh + 2] * r; o[3] = xv[3] + a[3] * y[j][4 * hh + 3] * r;
                    *(f32x4*)(F.out + (size_t)row * D + col + 4 * hh) = o; } }
        }
    }
}

struct Args { const float* in[20]; float* out; unsigned char* ws; int ph_lo, ph_hi; };
__global__ void __launch_bounds__(NWAVES * 64, 2) fwd_kernel(Args args) {
    extern __shared__ __attribute__((aligned(16))) unsigned char lds[];
    Frame F;
    F.lds = (LAS unsigned char*)lds;
    F.MISC = (volatile LAS unsigned*)(F.lds + MISC_OFF);
    F.tid = threadIdx.x; F.lane = F.tid & 63; F.wave = __builtin_amdgcn_readfirstlane(F.tid >> 6);
    F.G = gridDim.x; { const int bx = blockIdx.x; F.vcu = (F.G % 8 == 0) ? (bx % 8) * (F.G / 8) + bx / 8 : bx; }
    F.ws = args.ws; F.ctl = (unsigned*)(args.ws + WS_CTL); F.out = args.out;
    F.x = args.in[0]; F.c = args.in[1]; F.w_ada = args.in[2]; F.b_ada = args.in[3]; F.g_pre_mix = args.in[4]; F.g_post_mix = args.in[5]; F.w_in = args.in[6]; F.rpb = args.in[7]; F.t5 = args.in[8];
    F.g_out_na = args.in[9]; F.g_out_dil = args.in[10]; F.w_o = args.in[11]; F.g_pre_ffn = args.in[12]; F.g_post_ffn = args.in[13]; F.w_router = args.in[14]; F.b_router = args.in[15];
    F.w_e_in = args.in[16]; F.b_e_in = args.in[17]; F.w_e_out = args.in[18]; F.b_e_out = args.in[19];
    for (int u = F.tid; u < 256; u += NWAVES * 64) F.MISC[u] = 0u;
    __syncthreads();
    XcdBarrier bar; bar.bar = F.ctl + CW_BAR; bar.x = 0; bar.st = nullptr;
    if (MK_N_LAUNCHES == 1) bar = xcd_barrier_post(F.ctl + CW_BAR, F.MISC + 8);
    const int lo = args.ph_lo, hi = args.ph_hi;
#define IN(k) (lo <= (k) && (k) < hi)
#ifndef PROBE_REPEAT
#define PROBE_REPEAT -1
#endif
#define REP(k) ((PROBE_REPEAT == (k)) ? 2 : 1)
#define SEAM(k) do { if (IN(k) && IN((k) + 1)) xcd_barrier(bar); } while (0)

    if (IN(0)) { for (int rep = 0; rep < REP(0); ++rep) p0_prologue(F); } SEAM(0);
    if (IN(1)) { p1_hmix(F); } SEAM(1);
    if (IN(2)) {
        pg8::Gemm g{(const bf16*)(F.ws + WS_HMIX), (const bf16*)(F.ws + WS_WIN_T), T, NQKV, D}; pg8::StaticOrder S; S.init(T, NQKV, F.G, (int)blockIdx.x);
        pg8::EpiBf16 E{(bf16*)(F.ws + WS_PROJ), NQKV, nullptr, 0};
        __syncthreads();
        for (int rep = 0; rep < REP(2); ++rep) { __syncthreads(); pg8::gemm_phase<pg8::EpiBf16, pg8::StaticOrder, true, true>(F.lds + RING_OFF, g, S, E); }
    } SEAM(2);
    #ifdef ATTN_NAIVE
    if (IN(3)) { p3_attn_naive(F); } SEAM(3);
#else
    if (IN(3)) { for (int rep = 0; rep < REP(3); ++rep) { __syncthreads(); p3_attn_mfma(F); } } SEAM(3);
#endif
    if (IN(4)) { p4_post(F); } SEAM(4);
    if (IN(5)) {
        pg8::Gemm g{(const bf16*)(F.ws + WS_AOUT), (const bf16*)(F.ws + WS_WO_T), T, D, D}; pg8::StaticOrder S; S.init(T, D, F.G, (int)blockIdx.x);
        pg8::EpiF32 E{(float*)(F.ws + WS_MIXED), D};
        __syncthreads();
        pg8::gemm_phase<pg8::EpiF32, pg8::StaticOrder, true, true>(F.lds + RING_OFF, g, S, E);
    } SEAM(5);
    if (IN(6)) { for (int rep = 0; rep < REP(6); ++rep) p6_rows(F); } SEAM(6);
    if (IN(7)) { p7_slots(F); } SEAM(7);
    if (IN(8)) {
        moe_tables(F, -1);
        pg8::Gemm g{(const bf16*)(F.ws + WS_XG), (const bf16*)(F.ws + WS_WEI_T), MAXBLK * 256, FF2, D / 2};
        pg8::MoeOrder<16> S{(const LAS int*)(F.lds + MISC_OFF + 64 * 4), (int)F.MISC[16], F.G, (int)blockIdx.x};
        pg8::EpiSwiglu8 E{F.ws + WS_HB, FF, F.b_e_in, FF2, 1.0f / (WSCALE * XSCALE), HSCALE};
        for (int rep = 0; rep < REP(8); ++rep) { __syncthreads(); pg8::gemm_phase<pg8::EpiSwiglu8, pg8::MoeOrder<16>, true, true, true>(F.lds + RING_OFF, g, S, E); }
    } SEAM(8);
    if (IN(9)) {
        moe_tables(F, -1);
        pg8::Gemm g{(const bf16*)(F.ws + WS_HB), (const bf16*)(F.ws + WS_WEO_T), MAXBLK * 256, D, FF / 2};
        pg8::MoeOrder<8> S{(const LAS int*)(F.lds + MISC_OFF + 64 * 4), (int)F.MISC[16], F.G, (int)blockIdx.x};
        pg8::EpiBf16S E{(bf16*)(F.ws + WS_YB), D, F.b_e_out, D, 1.0f / (WSCALE * HSCALE)};
        for (int rep = 0; rep < REP(9); ++rep) { __syncthreads(); pg8::gemm_phase<pg8::EpiBf16S, pg8::MoeOrder<8>, true, true, true>(F.lds + RING_OFF, g, S, E); }
    } SEAM(9);
    if (IN(10)) { p10_final(F); }
#undef IN
#undef SEAM
}

extern "C" void kernel_launch(void* const* d_in, const int* in_sizes, int n_in, void* d_out, int out_size, void* d_ws, size_t ws_size, hipStream_t stream) {
    static int grid = 0;
    if (grid == 0) {
        if (n_in != 20 || out_size != T * D || ws_size < WS_END) { fprintf(stderr, "kernel_launch: unexpected problem (n_in %d, out %d, ws %zu)\n", n_in, out_size, ws_size); grid = -1; return; }
        int dev = 0, cus = 0, per_cu = 0;
        if (hipGetDevice(&dev) != hipSuccess || hipDeviceGetAttribute(&cus, hipDeviceAttributeMultiprocessorCount, dev) != hipSuccess) { grid = -1; return; }
        if (hipFuncSetAttribute((const void*)fwd_kernel, hipFuncAttributeMaxDynamicSharedMemorySize, LDS_BYTES) != hipSuccess) { fprintf(stderr, "kernel_launch: hipFuncSetAttribute failed\n"); grid = -1; return; }
        if (hipOccupancyMaxActiveBlocksPerMultiprocessor(&per_cu, (const void*)fwd_kernel, NWAVES * 64, LDS_BYTES) != hipSuccess || per_cu < 1) { fprintf(stderr, "kernel_launch: occupancy query reports %d\n", per_cu); }
        (void)hipGetLastError();
        grid = cus;
    }
    if (grid < 0) return;
    if (hipMemsetAsync((char*)d_ws + WS_CTL, 0, CTL_ZERO_BYTES, stream) != hipSuccess) return;
    Args a{};
    for (int i = 0; i < 20; ++i) a.in[i] = (const float*)d_in[i];
    a.out = (float*)d_out; a.ws = (unsigned char*)d_ws;
    if (MK_N_LAUNCHES == 1) {
        a.ph_lo = 0; a.ph_hi = NPHASE;
        hipLaunchKernelGGL(fwd_kernel, dim3(grid), dim3(NWAVES * 64), LDS_BYTES, stream, a);
    } else {
        for (int p = 0; p < NPHASE; ++p) { a.ph_lo = p; a.ph_hi = p + 1; hipLaunchKernelGGL(fwd_kernel, dim3(grid), dim3(NWAVES * 64), LDS_BYTES, stream, a); }
    }
}
```

```cpp
#include <hip/hip_runtime.h>
#include <cstdio>
#include <cstdint>
#include <type_traits>

#ifndef MK_N_LAUNCHES
#define MK_N_LAUNCHES 1
#endif

namespace pg8 {
#define PG8_LAS __attribute__((address_space(3)))
typedef unsigned short bf16_t;
typedef short bf16x8 __attribute__((ext_vector_type(8)));
typedef float f32x4 __attribute__((ext_vector_type(4)));
typedef unsigned u32x4 __attribute__((ext_vector_type(4)));
typedef unsigned u32x2 __attribute__((ext_vector_type(2)));
constexpr int BM = 256, BK = 64, HALF = 128, HTB = HALF * BK * 2  , STAGE_BYTES = 8 * HTB, NXCD = 8, WGM = 8;

__host__ __device__ __forceinline__ int lds_byte(int r, int c) { const int st = (r >> 4) * 2 + (c >> 5), rr = r & 15, cc = c & 31, ob = rr * 64 + cc * 2; return st * 1024 + (ob ^ (((ob >> 9) & 1) << 5)); }
__host__ __device__ __forceinline__ void stage_rc(int b, int& R, int& C) { const int st = b / 1024, sb = b % 1024, swz = sb ^ (((sb >> 9) & 1) << 5); R = (st >> 1) * 16 + swz / 64; C = (st & 1) * 32 + (swz % 64) / 2; }
__host__ __device__ __forceinline__ int perm32(int rho) { const int n = rho >> 4, i = rho & 15; return 8 * (i >> 2) + 4 * n + (i & 3); }

struct Unit { int pm, pn, bt, e; };
struct Gemm { const bf16_t* A; const bf16_t* Bt; int M, N, K; };

struct StaticOrder {
    int nM, nN, nwg, G, c;
    __host__ __device__ void init(int M, int N, int G_, int c_) { nM = M / BM; nN = N / BM; nwg = nM * nN; G = G_; c = c_; }
    __host__ __device__ bool next(int i, Unit& u) const {
        const long L = (long)i * G + c; if (L >= nwg) return false;
        int wgid = (int)L; { const int q = nwg / NXCD, r = nwg % NXCD, xcd = wgid % NXCD, off = wgid / NXCD; wgid = (xcd < r ? xcd * (q + 1) : r * (q + 1) + (xcd - r) * q) + off; }
        const int nig = WGM * nN, gid = wgid / nig, fm = gid * WGM, gsz = (nM - fm) < WGM ? (nM - fm) : WGM;
        u.pm = fm + ((wgid % nig) % gsz); u.pn = (wgid % nig) / gsz; u.bt = u.pn; u.e = 0; return true;
    }
    __device__ __forceinline__ void a_ready(const Unit&) const {}
    __device__ __forceinline__ void done(const Unit&) const {}
};
template <int NPN> struct MoeOrder {
    const PG8_LAS int* blk_e; int nb, G, c;
    __device__ __forceinline__ bool next(int i, Unit& u) const {
        int L = i * G + c;
        if (G == 256) L = ((i * 8 + (c & 7)) << 5) + (c >> 3);
        const int g = L >> 5, r = L & 31;
        int block, pn;
        if (NPN == 16) { block = 4 * (g >> 1) + (r & 3); pn = 8 * (g & 1) + (r >> 2); } else { block = 4 * g + (r & 3); pn = r >> 2; }
        if (block >= nb) return false;
        u.pm = block; u.pn = pn; u.e = blk_e[block]; u.bt = u.e * NPN + pn; return true;
    }
    __device__ __forceinline__ void a_ready(const Unit&) const {}
    __device__ __forceinline__ void done(const Unit&) const {}
};

__device__ __forceinline__ unsigned cvt_pk_bf16(float lo, float hi) { unsigned r; asm volatile("v_cvt_pk_bf16_f32 %0, %1, %2" : "=v"(r) : "v"(lo), "v"(hi)); return r; }

struct EpiF32 {
    static constexpr bool PERM = false, AFTER_DRAIN = false;
    float* C; int ldc;
    __device__ __forceinline__ void operator()(const f32x4 (&acc)[2][2][4][2], const Unit& u, int wr, int wc, int fr, int fq) const {
        const int row0 = u.pm * BM + wr * 64 + fr, col0 = u.pn * BM + wc * 32 + 4 * fq;
#pragma unroll
        for (int ai = 0; ai < 2; ++ai)
#pragma unroll
            for (int m = 0; m < 4; ++m) { float* rowp = C + (size_t)(row0 + ai * HALF + m * 16) * ldc + col0;
#pragma unroll
                for (int bj = 0; bj < 2; ++bj)
#pragma unroll
                    for (int n = 0; n < 2; ++n) *(f32x4*)(rowp + bj * HALF + n * 16) = acc[ai][bj][m][n]; }
    }
};
struct EpiBf16 {
    static constexpr bool PERM = true, AFTER_DRAIN = false;
    bf16_t* O; int ldc; const float* bias; int bias_estride;
    __device__ __forceinline__ void operator()(const f32x4 (&acc)[2][2][4][2], const Unit& u, int wr, int wc, int fr, int fq) const {
        const int row0 = u.pm * BM + wr * 64 + fr; const int col0 = u.pn * BM + wc * 32 + 8 * fq;
        f32x4 bv[2][2];
#pragma unroll
        for (int bj = 0; bj < 2; ++bj)
#pragma unroll
            for (int n = 0; n < 2; ++n) bv[bj][n] = bias ? *(const f32x4*)(bias + (size_t)u.e * bias_estride + col0 + bj * HALF + 4 * n) : (f32x4){0.f, 0.f, 0.f, 0.f};
#pragma unroll
        for (int ai = 0; ai < 2; ++ai)
#pragma unroll
            for (int m = 0; m < 4; ++m) { bf16_t* rowp = O + (size_t)(row0 + ai * HALF + m * 16) * ldc + col0;
#pragma unroll
                for (int bj = 0; bj < 2; ++bj) { const f32x4 v0 = acc[ai][bj][m][0] + bv[bj][0], v1 = acc[ai][bj][m][1] + bv[bj][1];
                    u32x4 w; w.x = cvt_pk_bf16(v0[0], v0[1]); w.y = cvt_pk_bf16(v0[2], v0[3]); w.z = cvt_pk_bf16(v1[0], v1[1]); w.w = cvt_pk_bf16(v1[2], v1[3]);
                    *(u32x4*)(rowp + bj * HALF) = w; } }
    }
};
__device__ __forceinline__ float swiglu1(float g, float u) {
    g = fminf(g, 7.0f); u = fminf(fmaxf(u, -7.0f), 7.0f);
    const float s = __builtin_amdgcn_rcpf(1.0f + __builtin_amdgcn_exp2f(g * (-1.702f * 1.44269504089f)));
    return (u + 1.0f) * (g * s);
}
struct EpiSwiglu {
    static constexpr bool PERM = true, AFTER_DRAIN = false;
    bf16_t* H; int ldh; const float* bias; int bias_estride;
    __device__ __forceinline__ void operator()(const f32x4 (&acc)[2][2][4][2], const Unit& u, int wr, int wc, int fr, int fq) const {
        const int row0 = u.pm * BM + wr * 64 + fr; const int col0 = u.pn * BM + wc * 32 + 8 * fq;
        f32x4 bv[2][2];
#pragma unroll
        for (int bj = 0; bj < 2; ++bj)
#pragma unroll
            for (int n = 0; n < 2; ++n) bv[bj][n] = *(const f32x4*)(bias + (size_t)u.e * bias_estride + col0 + bj * HALF + 4 * n);
#pragma unroll
        for (int ai = 0; ai < 2; ++ai)
#pragma unroll
            for (int m = 0; m < 4; ++m) { bf16_t* rowp = H + (size_t)(row0 + ai * HALF + m * 16) * ldh + (col0 >> 1);
#pragma unroll
                for (int bj = 0; bj < 2; ++bj) { const f32x4 v0 = acc[ai][bj][m][0] + bv[bj][0], v1 = acc[ai][bj][m][1] + bv[bj][1];
                    u32x2 w; w.x = cvt_pk_bf16(swiglu1(v0[0], v0[1]), swiglu1(v0[2], v0[3])); w.y = cvt_pk_bf16(swiglu1(v1[0], v1[1]), swiglu1(v1[2], v1[3]));
                    *(u32x2*)(rowp + bj * (HALF / 2)) = w; } }
    }
};

__device__ __forceinline__ unsigned cvt4_fp8(float a, float b, float c, float d) {
    int r = 0;
    r = __builtin_amdgcn_cvt_pk_fp8_f32(__builtin_amdgcn_fmed3f(a, -448.f, 448.f), __builtin_amdgcn_fmed3f(b, -448.f, 448.f), r, false);
    r = __builtin_amdgcn_cvt_pk_fp8_f32(__builtin_amdgcn_fmed3f(c, -448.f, 448.f), __builtin_amdgcn_fmed3f(d, -448.f, 448.f), r, true);
    return (unsigned)r;
}
struct EpiSwiglu8 {
    static constexpr bool PERM = true, AFTER_DRAIN = false;
    unsigned char* H; int ldh; const float* bias; int bias_estride; float ascale, hscale;
    __device__ __forceinline__ void operator()(const f32x4 (&acc)[2][2][4][2], const Unit& u, int wr, int wc, int fr, int fq) const {
        const int row0 = u.pm * BM + wr * 64 + fr; const int col0 = u.pn * BM + wc * 32 + 8 * fq;
        f32x4 bv[2][2];
#pragma unroll
        for (int bj = 0; bj < 2; ++bj)
#pragma unroll
            for (int n = 0; n < 2; ++n) bv[bj][n] = *(const f32x4*)(bias + (size_t)u.e * bias_estride + col0 + bj * HALF + 4 * n);
#pragma unroll
        for (int ai = 0; ai < 2; ++ai)
#pragma unroll
            for (int m = 0; m < 4; ++m) { unsigned char* rowp = H + (size_t)(row0 + ai * HALF + m * 16) * ldh + (col0 >> 1);
#pragma unroll
                for (int bj = 0; bj < 2; ++bj) { const f32x4 v0 = acc[ai][bj][m][0] * ascale + bv[bj][0], v1 = acc[ai][bj][m][1] * ascale + bv[bj][1];
                    *(unsigned*)(rowp + bj * (HALF / 2)) = cvt4_fp8(hscale * swiglu1(v0[0], v0[1]), hscale * swiglu1(v0[2], v0[3]), hscale * swiglu1(v1[0], v1[1]), hscale * swiglu1(v1[2], v1[3])); } }
    }
};
struct EpiBf16S {
    static constexpr bool PERM = true, AFTER_DRAIN = false;
    bf16_t* O; int ldc; const float* bias; int bias_estride; float ascale;
    __device__ __forceinline__ void operator()(const f32x4 (&acc)[2][2][4][2], const Unit& u, int wr, int wc, int fr, int fq) const {
        const int row0 = u.pm * BM + wr * 64 + fr; const int col0 = u.pn * BM + wc * 32 + 8 * fq;
        f32x4 bv[2][2];
#pragma unroll
        for (int bj = 0; bj < 2; ++bj)
#pragma unroll
            for (int n = 0; n < 2; ++n) bv[bj][n] = *(const f32x4*)(bias + (size_t)u.e * bias_estride + col0 + bj * HALF + 4 * n);
#pragma unroll
        for (int ai = 0; ai < 2; ++ai)
#pragma unroll
            for (int m = 0; m < 4; ++m) { bf16_t* rowp = O + (size_t)(row0 + ai * HALF + m * 16) * ldc + col0;
#pragma unroll
                for (int bj = 0; bj < 2; ++bj) { const f32x4 v0 = acc[ai][bj][m][0] * ascale + bv[bj][0], v1 = acc[ai][bj][m][1] * ascale + bv[bj][1];
                    u32x4 w; w.x = cvt_pk_bf16(v0[0], v0[1]); w.y = cvt_pk_bf16(v0[2], v0[3]); w.z = cvt_pk_bf16(v1[0], v1[1]); w.w = cvt_pk_bf16(v1[2], v1[3]);
                    *(u32x4*)(rowp + bj * HALF) = w; } }
    }
};

typedef int v8i32 __attribute__((ext_vector_type(8)));
typedef short bf16x16 __attribute__((ext_vector_type(16)));
template <class Epi, class Sched, bool ALIGN_EPI = false, bool SP2 = false, bool FP8 = false>
__device__ __forceinline__ void gemm_phase(PG8_LAS unsigned char* lds, const Gemm g, const Sched& S, const Epi& E) {
    const int tid = threadIdx.x, wid = __builtin_amdgcn_readfirstlane(tid >> 6), lane = tid & 63, wr = wid >> 2, wc = wid & 3, fr = lane & 15, fq = lane >> 4;
    const int K = g.K, nt = K / BK;
    unsigned voffA[2], voffB[2];
#pragma unroll
    for (int i = 0; i < 2; ++i) { int R, C; stage_rc(tid * 16 + i * 8192, R, C); const int Rb = Epi::PERM ? ((R & ~31) + perm32(R & 31)) : R;
        voffA[i] = (unsigned)(R * K + C) * 2u; voffB[i] = (unsigned)(Rb * K + C) * 2u; }
    const size_t kstep = (size_t)(BK * 2);
    const size_t hstep = (size_t)HALF * K * 2;
    const size_t tstep = 2 * hstep;
    const unsigned ldsw = (unsigned)wid * 1024u;
    const int fcol = FP8 ? (32 * (fq >> 1) + 16 * (fq & 1)) : fq * 8;
    const int aoff = lds_byte(wr * 64 + fr, fcol), boff = lds_byte(wc * 32 + fr, fcol);
    constexpr int KSTR = FP8 ? 16 : 1024;
#define PG8_SA(b, h) (((b) * 2 + (h)) * HTB)
#define PG8_SB(b, h) ((4 + (b) * 2 + (h)) * HTB)
#define PG8_STAGE(bufoff, gbase, voff) do { _Pragma("unroll") for (int _i = 0; _i < 2; ++_i) \
        __builtin_amdgcn_global_load_lds((const unsigned*)((const char*)(gbase) + (voff)[_i]), (PG8_LAS unsigned*)(lds + (bufoff) + ldsw + _i * 8192), 16, 0, 0); } while (0)
#define PG8_RD(dst, addr) do { if constexpr (FP8) { const u32x4 _lo = *(const PG8_LAS u32x4*)(addr), _hi = *(const PG8_LAS u32x4*)((addr) + 16); \
        (dst)[0] = (frag_t)__builtin_bit_cast(v8i32, __builtin_shufflevector(_lo, _hi, 0, 1, 2, 3, 4, 5, 6, 7)); } \
    else { (dst)[0] = (frag_t)*(const PG8_LAS bf16x8*)(addr); (dst)[NKF - 1] = (frag_t)*(const PG8_LAS bf16x8*)((addr) + 1024); } } while (0)
#define PG8_LDA(dst, b, h) do { _Pragma("unroll") for (int m = 0; m < 4; ++m) PG8_RD(dst[m], lds + PG8_SA(b, h) + aoff + m * 2048); } while (0)
#define PG8_LDB(dst, b, h) do { _Pragma("unroll") for (int n = 0; n < 2; ++n) PG8_RD(dst[n], lds + PG8_SB(b, h) + boff + n * 2048); } while (0)
#define PG8_MMA(ai, bj, At, Bt) do { __builtin_amdgcn_s_setprio(1); _Pragma("unroll") for (int m = 0; m < 4; ++m) _Pragma("unroll") for (int n = 0; n < 2; ++n) { \
        if constexpr (FP8) asm volatile("v_mfma_f32_16x16x128_f8f6f4 %0, %1, %2, %0" : "+v"(acc[ai][bj][m][n]) : "v"(Bt[n][0]), "v"(At[m][0])); \
        else { _Pragma("unroll") for (int k = 0; k < NKF; ++k) acc[ai][bj][m][n] = __builtin_amdgcn_mfma_f32_16x16x32_bf16((bf16x8)Bt[n][k], (bf16x8)At[m][k], acc[ai][bj][m][n], 0, 0, 0); } } \
        __builtin_amdgcn_s_setprio(0); } while (0)
#define PG8_WAIT_V(n) asm volatile("s_waitcnt vmcnt(" #n ")" ::: "memory")
#define PG8_WAIT_L(n) asm volatile("s_waitcnt lgkmcnt(" #n ")" ::: "memory")
#define PG8_BAR __builtin_amdgcn_s_barrier()
#define PG8_SCHED __builtin_amdgcn_sched_barrier(0)
    Unit cur, nxt; int ui = 0;
    if (!S.next(0, cur)) return;
    f32x4 acc[2][2][4][2];
#pragma unroll
    for (int a = 0; a < 2; ++a)
#pragma unroll
        for (int b = 0; b < 2; ++b)
#pragma unroll
            for (int m = 0; m < 4; ++m)
#pragma unroll
                for (int n = 0; n < 2; ++n) acc[a][b][m][n] = (f32x4){0.f, 0.f, 0.f, 0.f};
    typedef typename std::conditional<FP8, v8i32, bf16x8>::type frag_t; constexpr int NKF = FP8 ? 1 : 2;
    frag_t At[4][NKF], B0[2][NKF], B1[2][NKF];
    const char* cA = (const char*)g.A + (size_t)cur.pm * tstep; const char* cB = (const char*)g.Bt + (size_t)cur.bt * tstep;
    S.a_ready(cur);
    if constexpr (SP2) {
        PG8_STAGE(PG8_SB(0, 0), cB, voffB); PG8_STAGE(PG8_SB(0, 1), cB + hstep, voffB); PG8_STAGE(PG8_SA(0, 0), cA, voffA); PG8_STAGE(PG8_SA(0, 1), cA + hstep, voffA);
        if (wr == 1) PG8_BAR;
        PG8_WAIT_V(2); PG8_BAR;
        PG8_STAGE(PG8_SB(1, 0), cB + kstep, voffB); PG8_STAGE(PG8_SA(1, 0), cA + kstep, voffA); PG8_STAGE(PG8_SB(1, 1), cB + hstep + kstep, voffB);
        PG8_WAIT_V(6); PG8_BAR;
    } else {
        PG8_STAGE(PG8_SB(0, 0), cB, voffB); PG8_STAGE(PG8_SA(0, 0), cA, voffA); PG8_STAGE(PG8_SB(0, 1), cB + hstep, voffB); PG8_STAGE(PG8_SA(0, 1), cA + hstep, voffA);
        if (wr == 1) PG8_BAR;
        PG8_WAIT_V(4); PG8_BAR;
        PG8_STAGE(PG8_SB(1, 0), cB + kstep, voffB); PG8_STAGE(PG8_SA(1, 0), cA + kstep, voffA); PG8_STAGE(PG8_SB(1, 1), cB + hstep + kstep, voffB);
        PG8_WAIT_V(6); PG8_BAR;
    }
    for (;;) {
        const bool has_next = S.next(ui + 1, nxt);
        const char* nA = has_next ? (const char*)g.A + (size_t)nxt.pm * tstep : cA; const char* nB = has_next ? (const char*)g.Bt + (size_t)nxt.bt * tstep : cB;
        for (int t = 0; t < nt; t += 2) {
            const bool last = (t == nt - 2);
            const char* a1 = cA + (size_t)(t + 1) * kstep;
            const char* a2 = last ? nA : cA + (size_t)(t + 2) * kstep; const char* b2 = last ? nB : cB + (size_t)(t + 2) * kstep;
            const char* a3 = a2 + kstep; const char* b3 = b2 + kstep;
            if (last && has_next) S.a_ready(nxt);
            if constexpr (SP2) {
            PG8_LDB(B0, 0, 0); PG8_LDB(B1, 0, 1); PG8_SCHED; PG8_LDA(At, 0, 0); PG8_STAGE(PG8_SA(1, 1), a1 + hstep, voffA);
            PG8_WAIT_V(8); PG8_WAIT_L(0); PG8_BAR; PG8_MMA(0, 0, At, B0); PG8_MMA(0, 1, At, B1); PG8_BAR; PG8_SCHED;
            PG8_LDA(At, 0, 1); PG8_STAGE(PG8_SB(0, 0), b2, voffB); PG8_STAGE(PG8_SB(0, 1), b2 + hstep, voffB); PG8_STAGE(PG8_SA(0, 0), a2, voffA);
            PG8_WAIT_V(8); PG8_WAIT_L(0); PG8_BAR; PG8_MMA(1, 0, At, B0); PG8_MMA(1, 1, At, B1); PG8_BAR; PG8_SCHED;
            PG8_LDB(B0, 1, 0); PG8_LDB(B1, 1, 1); PG8_SCHED; PG8_LDA(At, 1, 0); PG8_STAGE(PG8_SA(0, 1), a2 + hstep, voffA);
            PG8_WAIT_V(8); PG8_WAIT_L(0); PG8_BAR; PG8_MMA(0, 0, At, B0); PG8_MMA(0, 1, At, B1); PG8_BAR; PG8_SCHED;
            PG8_LDA(At, 1, 1); PG8_STAGE(PG8_SB(1, 0), b3, voffB); PG8_STAGE(PG8_SB(1, 1), b3 + hstep, voffB); PG8_STAGE(PG8_SA(1, 0), a3, voffA);
            PG8_WAIT_V(8); PG8_WAIT_L(0); PG8_BAR; PG8_MMA(1, 0, At, B0); PG8_MMA(1, 1, At, B1); PG8_BAR; PG8_SCHED;
            } else {
            PG8_LDB(B0, 0, 0); PG8_SCHED; PG8_LDA(At, 0, 0); PG8_STAGE(PG8_SA(1, 1), a1 + hstep, voffA);
            PG8_WAIT_L(8); PG8_BAR; PG8_WAIT_L(0); PG8_MMA(0, 0, At, B0); PG8_BAR; PG8_SCHED;
            PG8_LDB(B1, 0, 1); PG8_STAGE(PG8_SB(0, 0), b2, voffB);
            PG8_BAR; PG8_WAIT_L(0); PG8_MMA(0, 1, At, B1); PG8_BAR;
            PG8_LDA(At, 0, 1); PG8_STAGE(PG8_SA(0, 0), a2, voffA);
            PG8_BAR; PG8_WAIT_L(0); PG8_MMA(1, 0, At, B0); PG8_BAR; PG8_SCHED;
            PG8_STAGE(PG8_SB(0, 1), b2 + hstep, voffB);
            PG8_WAIT_V(6); PG8_BAR; PG8_MMA(1, 1, At, B1); PG8_BAR;
            PG8_LDB(B0, 1, 0); PG8_SCHED; PG8_LDA(At, 1, 0); PG8_STAGE(PG8_SA(0, 1), a2 + hstep, voffA);
            PG8_WAIT_L(8); PG8_BAR; PG8_WAIT_L(0); PG8_MMA(0, 0, At, B0); PG8_BAR; PG8_SCHED;
            PG8_LDB(B1, 1, 1); PG8_STAGE(PG8_SB(1, 0), b3, voffB);
            PG8_BAR; PG8_WAIT_L(0); PG8_MMA(0, 1, At, B1); PG8_BAR;
            PG8_LDA(At, 1, 1); PG8_STAGE(PG8_SA(1, 0), a3, voffA);
            PG8_BAR; PG8_WAIT_L(0); PG8_MMA(1, 0, At, B0); PG8_BAR; PG8_SCHED;
            PG8_STAGE(PG8_SB(1, 1), b3 + hstep, voffB);
            PG8_WAIT_V(6); PG8_BAR; PG8_MMA(1, 1, At, B1); PG8_BAR;
            }
        }
        if constexpr (ALIGN_EPI) { if (wr == 0) PG8_BAR; }
        if constexpr (FP8) asm volatile("s_nop 15\n\ts_nop 15" ::: "memory");
        if constexpr (!Epi::AFTER_DRAIN) { E(acc, cur, wr, wc, fr, fq); S.done(cur); }
        if (!has_next) break;
#pragma unroll
        for (int a = 0; a < 2; ++a)
#pragma unroll
            for (int b = 0; b < 2; ++b)
#pragma unroll
                for (int m = 0; m < 4; ++m)
#pragma unroll
                    for (int n = 0; n < 2; ++n) acc[a][b][m][n] = (f32x4){0.f, 0.f, 0.f, 0.f};
        cur = nxt; cA = nA; cB = nB; ++ui;
        if constexpr (ALIGN_EPI) { if (wr == 1) PG8_BAR; }
    }
    PG8_WAIT_V(0);
    if constexpr (!ALIGN_EPI) { if (wr == 0) PG8_BAR; }
    PG8_BAR;
    if constexpr (Epi::AFTER_DRAIN) { E.fused(acc, cur, wr, wc, fr, fq, lds, wid, lane); S.done(cur); }
#undef PG8_SA
#undef PG8_SB
#undef PG8_STAGE
#undef PG8_LDA
#undef PG8_LDB
#undef PG8_MMA
#undef PG8_RD
#undef PG8_WAIT_V
#undef PG8_WAIT_L
#undef PG8_BAR
#undef PG8_SCHED
}
}

constexpr int NWAVES = 8;
constexpr int NBATCH = 4, SEQ = 2048, T = NBATCH * SEQ, D = 2048, HD = 128, NHG = 8, GW = 1024, NQKV = 6144, NE = 32, TOPK = 4, FF = 2048, FF2 = 4096;
constexpr int MAXBLK = 160;
constexpr float EPS = 1e-6f;
constexpr int NPHASE = 11;
constexpr float WSCALE = 512.0f, XSCALE = 16.0f, HSCALE = 4.0f;

constexpr size_t MiB = 1u << 20;
constexpr size_t WS_CTL = 0, CTL_ZERO_BYTES = 1 * MiB;
constexpr size_t WS_MODP = 1 * MiB;
constexpr size_t WS_TOPI = 5 * MiB, WS_TOPG = WS_TOPI + 131072, WS_TSLOT = WS_TOPG + 131072;
constexpr size_t WS_TRANK = WS_TSLOT + 131072, WS_HIST = WS_TRANK + 131072;
constexpr size_t WS_LSE = 6 * MiB;
constexpr size_t WS_WIN_T = 8 * MiB;
constexpr size_t WS_WO_T = 32 * MiB;
constexpr size_t WS_HMIX = 40 * MiB;
constexpr size_t WS_AOUT = 72 * MiB;
constexpr size_t WS_PROJ = 104 * MiB;
constexpr size_t WS_ONA = 200 * MiB;
constexpr size_t WS_ODIL = 232 * MiB;
constexpr size_t WS_MIXED = 328 * MiB;
constexpr size_t WS_X1 = 392 * MiB;
constexpr size_t WS_HFFN = 456 * MiB;
constexpr size_t WS_XG = 492 * MiB;
constexpr size_t WS_HB = 652 * MiB;
constexpr size_t WS_YB = 812 * MiB;
constexpr size_t WS_WEI_T = 1024 * MiB;
constexpr size_t WS_WEO_T = 1536 * MiB;
constexpr size_t WS_END = 1792 * MiB;
constexpr int CW_TMO = 0, CW_CODE = 1, CW_CNT = 256, CW_CUR = 512, CW_BAR = 4096;

constexpr int RING_OFF = 0, RING_BYTES = 155648;
constexpr int MISC_OFF = RING_BYTES;
constexpr int LDS_BYTES = RING_BYTES + 1024;

#define GAS __attribute__((address_space(1)))
#define LAS __attribute__((address_space(3)))
typedef unsigned short bf16;
typedef unsigned v4u __attribute__((ext_vector_type(4)));
typedef unsigned v2u __attribute__((ext_vector_type(2)));
typedef float f32x4 __attribute__((ext_vector_type(4)));
typedef GAS unsigned gu32;
#define RLX_AGENT __ATOMIC_RELAXED, __HIP_MEMORY_SCOPE_AGENT
#define LDS_WAIT() asm volatile("s_waitcnt lgkmcnt(0)" ::: "memory")
#define VM_WAIT() asm volatile("s_waitcnt vmcnt(0)" ::: "memory")
__device__ __forceinline__ float bf2f(unsigned short h) { return __builtin_bit_cast(float, (unsigned)h << 16); }
__device__ __forceinline__ float bflo(unsigned w) { return __builtin_bit_cast(float, w << 16); }
__device__ __forceinline__ float bfhi(unsigned w) { return __builtin_bit_cast(float, w & 0xffff0000u); }
__device__ __forceinline__ unsigned pk2(float lo, float hi) { return pg8::cvt_pk_bf16(lo, hi); }

#define XB_TMO      128
#define XB_XCNT(j)  (256  + 64 * (j))
#define XB_XSUB(j)  (1280 + 64 * (j))
#define XB_XGEN(j)  (2304 + 64 * (j))
#define XB_TOP      3328
#define XB_TOPGEN   3392
#define XCD_BAR_WORDS 3456
#define XB_SPIN_CAP (1u << 18)
__device__ __forceinline__ unsigned xb_ld(unsigned* p)              { return __hip_atomic_load(p, __ATOMIC_RELAXED, __HIP_MEMORY_SCOPE_AGENT); }
__device__ __forceinline__ unsigned xb_add(unsigned* p, unsigned v) { return __hip_atomic_fetch_add(p, v, __ATOMIC_RELAXED, __HIP_MEMORY_SCOPE_AGENT); }
__device__ __forceinline__ unsigned xb_xcc_id() { return (unsigned)__builtin_amdgcn_s_getreg((3 << 11) | 20) & 0xFu; }
#define XB_SPIN(cond, bar) do { unsigned _sp = 0; while (cond) { __builtin_amdgcn_s_sleep(1); \
    if ((++_sp & 255u) == 0u) { if (xb_ld(&(bar)[XB_TMO])) break; if (_sp > XB_SPIN_CAP) { atomicAdd(&(bar)[XB_TMO], 1u); break; } } } } while (0)
struct XcdBarrier { unsigned* bar; unsigned x; volatile LAS unsigned* st; };
__device__ __forceinline__ XcdBarrier xcd_barrier_post(unsigned* bar, volatile LAS unsigned* st) {
    XcdBarrier b; b.bar = bar; b.x = xb_xcc_id(); b.st = st;
    if (threadIdx.x == 0) (void)xb_add(&bar[XB_XCNT(b.x)], 1u);
    return b;
}
__device__ __forceinline__ void xcd_barrier_complete(unsigned* bar, unsigned x, unsigned& nloc, unsigned& nx) {
    const unsigned G = gridDim.x * gridDim.y * gridDim.z;
    unsigned sum, cnt, mine, sp = 0u;
    for (;;) {
        sum = 0u; cnt = 0u; mine = 0u;
#pragma unroll
        for (unsigned j = 0; j < 16; ++j) { const unsigned c = xb_ld(&bar[XB_XCNT(j)]); sum += c; cnt += (c > 0u) ? 1u : 0u; mine = (j == x) ? c : mine; }
        if (sum == G) break;
        __builtin_amdgcn_s_sleep(1);
        if ((++sp & 255u) == 0u) { if (xb_ld(&bar[XB_TMO])) break; if (sp > XB_SPIN_CAP) { atomicAdd(&bar[XB_TMO], 1u); break; } }
    }
    nloc = mine > 0u ? mine : 1u; nx = cnt > 0u ? cnt : 1u;
}
__device__ __forceinline__ void xcd_barrier(const XcdBarrier& b) {
    asm volatile("s_waitcnt vmcnt(0)" ::: "memory");
    __syncthreads();
    if (threadIdx.x == 0) {
        unsigned* bar = b.bar;
        __builtin_amdgcn_s_waitcnt(0);
        unsigned nloc = b.st[0], nx = b.st[1];
        if (nloc == 0u) { xcd_barrier_complete(bar, b.x, nloc, nx); b.st[0] = nloc; b.st[1] = nx; }
        const unsigned old = xb_add(&bar[XB_XSUB(b.x)], 1u);
        const unsigned gen = old / nloc;
        if (old + 1u == (gen + 1u) * nloc) {
            __builtin_amdgcn_fence(__ATOMIC_RELEASE, "agent");
            asm volatile("s_waitcnt vmcnt(0)" ::: "memory");
            const unsigned og = xb_add(&bar[XB_TOP], 1u);
            const unsigned tg = og / nx;
            if (og + 1u == (tg + 1u) * nx) xb_add(&bar[XB_TOPGEN], 1u);
            else XB_SPIN(xb_ld(&bar[XB_TOPGEN]) == tg, bar);
            __builtin_amdgcn_fence(__ATOMIC_ACQUIRE, "agent");
            xb_add(&bar[XB_XGEN(b.x)], 1u);
            asm volatile("s_waitcnt vmcnt(0)" ::: "memory");
        } else {
            XB_SPIN(xb_ld(&bar[XB_XGEN(b.x)]) == gen, bar);
            __builtin_amdgcn_fence(__ATOMIC_ACQUIRE, "agent");
            asm volatile("s_waitcnt vmcnt(0)" ::: "memory");
        }
    }
    __syncthreads();
}

struct Frame {
    LAS unsigned char* lds;
    volatile LAS unsigned* MISC;
    unsigned* ctl;
    int tid, lane, wave, vcu, G;
    const float *x, *c, *w_ada, *b_ada, *g_pre_mix, *g_post_mix, *w_in, *rpb, *t5, *g_out_na, *g_out_dil, *w_o, *g_pre_ffn, *g_post_ffn, *w_router, *b_router, *w_e_in, *b_e_in, *w_e_out, *b_e_out;
    float* out;
    unsigned char* ws;
};
__device__ __forceinline__ float wave_sum(float v) {
#pragma unroll
    for (int o = 1; o < 64; o <<= 1) v += __shfl_xor(v, o);
    return v;
}
__device__ __forceinline__ float wave_max(float v) {
#pragma unroll
    for (int o = 1; o < 64; o <<= 1) v = fmaxf(v, __shfl_xor(v, o));
    return v;
}
__device__ __forceinline__ float mod_val(const Frame& F, int b, int idx) {
    const float* mp = (const float*)(F.ws + WS_MODP);
    float s = F.b_ada[idx];
#pragma unroll
    for (int ks = 0; ks < 16; ++ks) s += mp[(size_t)(ks * 4 + b) * (6 * D) + idx];
    return s;
}

__constant__ unsigned char T5B[3][132] = {
 {11,11,11,11,11,11,11,11,11,11,11,11,11,11,11,10,10,10,10,10,10,10,10,10,10,10,10,10,10,10,10,10,10,10,10,10,10,10,9,9,9,9,9,9,9,9,9,9,9,9,8,8,8,8,8,8,8,7,6,5,4,3,2,1,0,17,18,19,20,21,22,23,24,24,24,24,24,24,24,25,25,25,25,25,25,25,25,25,25,25,25,26,26,26,26,26,26,26,26,26,26,26,26,26,26,26,26,26,26,26,26,26,26,26,27,27,27,27,27,27,27,27,27,27,27,27,27,27,27,0,0,0},
 {13,13,13,13,13,13,13,13,13,13,13,13,13,13,13,13,13,13,13,13,13,13,13,12,12,12,12,12,12,12,12,12,12,12,12,12,12,12,12,12,12,12,11,11,11,11,11,11,11,11,11,11,10,10,10,10,10,10,9,9,9,8,8,4,0,20,24,24,25,25,25,26,26,26,26,26,26,27,27,27,27,27,27,27,27,27,27,28,28,28,28,28,28,28,28,28,28,28,28,28,28,28,28,28,28,28,29,29,29,29,29,29,29,29,29,29,29,29,29,29,29,29,29,29,29,29,29,29,29,0,0,0},
 {15,15,15,15,15,15,15,15,15,15,15,15,15,15,15,15,15,15,15,15,15,15,15,15,15,15,15,15,15,15,14,14,14,14,14,14,14,14,14,14,14,14,14,14,14,13,13,13,13,13,13,13,13,13,12,12,12,12,12,11,11,10,10,9,0,25,26,26,27,27,28,28,28,28,28,29,29,29,29,29,29,29,29,29,30,30,30,30,30,30,30,30,30,30,30,30,30,30,30,31,31,31,31,31,31,31,31,31,31,31,31,31,31,31,31,31,31,31,31,31,31,31,31,31,31,31,31,31,31,0,0,0}};

__device__ __forceinline__ void p0_mod_item(Frame& F, int j) {
    const int ks = j >> 4, cb = j & 15;
    LAS float* sc = (LAS float*)(F.lds + RING_OFF);
    LAS float* red = (LAS float*)(F.lds + RING_OFF + 4096);
    __syncthreads();
    { const int b = F.tid >> 7, k = F.tid & 127; const float cv = F.c[b * D + ks * 128 + k]; sc[F.tid] = cv / (1.0f + __expf(-cv)); }
    __syncthreads();
    const int cg = F.tid % 192, sub = F.tid / 192;
    f32x4 acc[4];
#pragma unroll
    for (int b = 0; b < 4; ++b) acc[b] = (f32x4){0.f, 0.f, 0.f, 0.f};
    if (sub < 2) {
        const float* wp = F.w_ada + (size_t)(ks * 128 + sub * 64) * (6 * D) + cb * 768 + 4 * cg;
#pragma unroll 8
        for (int i = 0; i < 64; ++i) {
            const f32x4 w = *(const f32x4*)(wp + (size_t)i * (6 * D));
#pragma unroll
            for (int b = 0; b < 4; ++b) { const float s = sc[b * 128 + sub * 64 + i]; acc[b] += w * s; }
        }
        if (sub == 1) {
#pragma unroll
            for (int b = 0; b < 4; ++b) *(LAS f32x4*)(red + cg * 16 + b * 4) = acc[b];
        }
    }
    __syncthreads();
    if (sub == 0) {
        float* mp = (float*)(F.ws + WS_MODP);
#pragma unroll
        for (int b = 0; b < 4; ++b) { const f32x4 o = acc[b] + *(LAS f32x4*)(red + cg * 16 + b * 4); *(f32x4*)(mp + (size_t)(ks * 4 + b) * (6 * D) + cb * 768 + 4 * cg) = o; }
    }
}
__device__ __forceinline__ void p0_transpose_item(const float* W, int K, int N, bf16* WT, LAS float* scr, int item, int lane) {
    const int nblk = N >> 6, kb = item / nblk, nb = item - kb * nblk, k0 = kb << 6, n0 = nb << 6;
    const float* src = W + (size_t)(k0 + (lane >> 4)) * N + n0 + 4 * (lane & 15);
    f32x4 v[16];
#pragma unroll
    for (int i = 0; i < 16; ++i) v[i] = *(const f32x4*)(src + (size_t)(4 * i) * N);
#pragma unroll
    for (int i = 0; i < 16; ++i) { LAS float* d = scr + (4 * i + (lane >> 4)) * 65 + 4 * (lane & 15); d[0] = v[i][0]; d[1] = v[i][1]; d[2] = v[i][2]; d[3] = v[i][3]; }
    LDS_WAIT();
    const int c = lane >> 3;
#pragma unroll
    for (int jn = 0; jn < 8; ++jn) { const int n = (lane & 7) + 8 * jn; const LAS float* s = scr + (8 * c) * 65 + n;
        v4u o; o.x = pk2(s[0 * 65], s[1 * 65]); o.y = pk2(s[2 * 65], s[3 * 65]); o.z = pk2(s[4 * 65], s[5 * 65]); o.w = pk2(s[6 * 65], s[7 * 65]);
        *(v4u*)(WT + (size_t)(n0 + n) * K + k0 + 8 * c) = o; }
    LDS_WAIT();
}
constexpr int I_EI1 = (D / 128) * (FF2 / 32), I_EO1 = (FF / 128) * (D / 32), I_EI = NE * I_EI1, I_EO = NE * I_EO1, CONV8_ITEMS = I_EI + I_EO;
constexpr int CONV_Q = 65536, QKV_GEMM_WGS = 128, CONV_Q5 = 28672, WO_GEMM_WGS = 128;
struct Conv8 { const float* src; unsigned char* dst; int N; };
__device__ __forceinline__ Conv8 conv8_item(const Frame& F, int r, int lane) {
    Conv8 c; const float* W; unsigned char* WT; int it;
    if (r < I_EI) { const int e = r / I_EI1; it = r - e * I_EI1; c.N = FF2; W = F.w_e_in + (size_t)e * D * FF2; WT = F.ws + WS_WEI_T + (size_t)e * FF2 * D; }
    else { r -= I_EI; const int e = r / I_EO1; it = r - e * I_EO1; c.N = D; W = F.w_e_out + (size_t)e * FF * D; WT = F.ws + WS_WEO_T + (size_t)e * D * FF; }
    const int nblk = c.N >> 5, kb = it / nblk, nb = it - kb * nblk, k0 = kb << 7, n0 = nb << 5;
    c.src = W + (size_t)(k0 + (lane >> 3)) * c.N + n0 + 4 * (lane & 7); c.dst = WT + (size_t)n0 * 2048 + k0;
    return c;
}
__device__ __forceinline__ void conv8_load(const Conv8& c, f32x4 (&v)[16]) {
#pragma unroll
    for (int i = 0; i < 16; ++i) v[i] = *(const f32x4*)(c.src + (size_t)(8 * i) * c.N);
}
__device__ __forceinline__ void conv8_finish(const f32x4 (&v)[16], unsigned char* dst, LAS float* scr, int lane) {
#pragma unroll
    for (int i = 0; i < 16; ++i) { LAS float* d = scr + (8 * i + (lane >> 3)) * 33 + 4 * (lane & 7); d[0] = v[i][0]; d[1] = v[i][1]; d[2] = v[i][2]; d[3] = v[i][3]; }
    LDS_WAIT();
#pragma unroll
    for (int jn = 0; jn < 2; ++jn)
#pragma unroll
        for (int jc = 0; jc < 2; ++jc) { const int n = (lane & 15) + 16 * jn, c = (lane >> 4) + 4 * jc; const LAS float* s = scr + (16 * c) * 33 + n;
            v4u o;
            o.x = pg8::cvt4_fp8(s[0 * 33] * WSCALE, s[1 * 33] * WSCALE, s[2 * 33] * WSCALE, s[3 * 33] * WSCALE);
            o.y = pg8::cvt4_fp8(s[4 * 33] * WSCALE, s[5 * 33] * WSCALE, s[6 * 33] * WSCALE, s[7 * 33] * WSCALE);
            o.z = pg8::cvt4_fp8(s[8 * 33] * WSCALE, s[9 * 33] * WSCALE, s[10 * 33] * WSCALE, s[11 * 33] * WSCALE);
            o.w = pg8::cvt4_fp8(s[12 * 33] * WSCALE, s[13 * 33] * WSCALE, s[14 * 33] * WSCALE, s[15 * 33] * WSCALE);
            *(v4u*)(dst + (size_t)n * 2048 + 16 * c) = o; }
    LDS_WAIT();
}
__device__ __forceinline__ void conv8_run(Frame& F, LAS float* scr, int first, int stride, int last) {
    if (first >= last) return;
    f32x4 va[16], vb[16];
    Conv8 ca = conv8_item(F, first, F.lane), cb = ca;
    conv8_load(ca, va);
    for (int it = first; it < last; it += 2 * stride) {
        const bool hb = it + stride < last;
        if (hb) { cb = conv8_item(F, it + stride, F.lane); conv8_load(cb, vb); }
        conv8_finish(va, ca.dst, scr, F.lane);
        if (!hb) break;
        const bool ha = it + 2 * stride < last;
        if (ha) { ca = conv8_item(F, it + 2 * stride, F.lane); conv8_load(ca, va); }
        conv8_finish(vb, cb.dst, scr, F.lane);
        if (!ha) break;
    }
}
__device__ __forceinline__ void p0_prologue(Frame& F) {
    for (int j = F.vcu; j < 256; j += F.G) p0_mod_item(F, j);
    __syncthreads();
    LAS float* scr = (LAS float*)(F.lds + RING_OFF + F.wave * 16896);
    const int gw = F.vcu * NWAVES + F.wave, NGW = F.G * NWAVES;
    constexpr int I_IN = (D / 64) * (NQKV / 64), I_O = (D / 64) * (D / 64);
    for (int it = gw; it < I_IN + I_O; it += NGW) {
        if (it < I_IN) p0_transpose_item(F.w_in, D, NQKV, (bf16*)(F.ws + WS_WIN_T), scr, it, F.lane);
        else p0_transpose_item(F.w_o, D, D, (bf16*)(F.ws + WS_WO_T), scr, it - I_IN, F.lane);
    }
    conv8_run(F, scr, CONV_Q + CONV_Q5 + gw, NGW, CONV8_ITEMS);
}

__device__ __forceinline__ void p1_hmix(Frame& F) {
    LAS float* ta = (LAS float*)(F.lds + RING_OFF);
    LAS float* tb = ta + D;
    for (int rb = F.vcu; rb < T / 32; rb += F.G) {
        const int b = rb >> 6;
        __syncthreads();
        for (int col = F.tid; col < D; col += NWAVES * 64) { ta[col] = F.g_pre_mix[col] * (1.0f + mod_val(F, b, D + col)); tb[col] = mod_val(F, b, col); }
        __syncthreads();
        for (int rr = F.wave; rr < 32; rr += NWAVES) {
            const int row = rb * 32 + rr;
            const f32x4* xr = (const f32x4*)(F.x + (size_t)row * D) + F.lane;
            f32x4 v[8]; float ss = 0.f;
#pragma unroll
            for (int j = 0; j < 8; ++j) { v[j] = xr[64 * j]; ss += (v[j][0] * v[j][0] + v[j][1] * v[j][1]) + (v[j][2] * v[j][2] + v[j][3] * v[j][3]); }
            const float r = 1.0f / sqrtf(wave_sum(ss) * (1.0f / D) + EPS);
            v2u* o8 = (v2u*)((bf16*)(F.ws + WS_HMIX) + (size_t)row * D) + F.lane;
#pragma unroll
            for (int j = 0; j < 8; ++j) { const int col = 4 * F.lane + 256 * j; const f32x4 a = *(LAS f32x4*)(ta + col), s = *(LAS f32x4*)(tb + col);
                v2u w; w.x = pk2(v[j][0] * r * a[0] + s[0], v[j][1] * r * a[1] + s[1]); w.y = pk2(v[j][2] * r * a[2] + s[2], v[j][3] * r * a[3] + s[3]); o8[64 * j] = w; }
        }
    }
}

__device__ __forceinline__ float dot_qk(const LAS float* q, const bf16* krow) {
    float s = 0.f;
#pragma unroll
    for (int ch = 0; ch < 16; ++ch) { const v4u kv = *(const v4u*)(krow + 8 * ch); const LAS float* qq = q + 8 * ch;
        s += qq[0] * bflo(kv.x) + qq[1] * bfhi(kv.x) + qq[2] * bflo(kv.y) + qq[3] * bfhi(kv.y) + qq[4] * bflo(kv.z) + qq[5] * bfhi(kv.z) + qq[6] * bflo(kv.w) + qq[7] * bfhi(kv.w); }
    return s;
}
__device__ __forceinline__ void p3_attn_naive(Frame& F) {
    LAS float* lq = (LAS float*)(F.lds + RING_OFF + F.wave * 2048);
    LAS float* lp = lq + 128;
    const bf16* proj = (const bf16*)(F.ws + WS_PROJ);
    float* ona = (float*)(F.ws + WS_ONA); float* odil = (float*)(F.ws + WS_ODIL); float* lse = (float*)(F.ws + WS_LSE);
    const float scale = 0.08838834764831845f;
    const int gw = F.vcu * NWAVES + F.wave, NGW = F.G * NWAVES, lane = F.lane;
    for (int it = gw; it < T * 16; it += NGW) {
        const int tok = it >> 4, hh = it & 15, b = tok >> 11, pos = tok & 2047;
        const bf16* prow = proj + (size_t)tok * NQKV;
        if (hh < 8) {
            const int h = hh;
            { const unsigned qw = *(const unsigned*)(prow + h * HD + 2 * lane); LDS_WAIT(); lq[2 * lane] = bflo(qw); lq[2 * lane + 1] = bfhi(qw); LDS_WAIT(); }
            const int r = pos >> 6, c = pos & 63; const int rs = min(max(r - 4, 0), 24), cs = min(max(c - 8, 0), 48);
            float lg[2];
#pragma unroll
            for (int jj = 0; jj < 2; ++jj) { const int j = lane + 64 * jj, i = j >> 4, cc = cs + (j & 15), kpos = (rs + i) * 64 + cc;
                const float d = dot_qk(lq, proj + (size_t)(b * SEQ + kpos) * NQKV + GW + h * HD);
                lg[jj] = d * scale + F.rpb[(h * 15 + (rs + i - r + 7)) * 31 + (cc - c + 15)]; }
            const float m = wave_max(fmaxf(lg[0], lg[1]));
            const float p0 = __expf(lg[0] - m), p1 = __expf(lg[1] - m);
            const float inv = 1.0f / wave_sum(p0 + p1);
            lp[lane] = p0 * inv; lp[lane + 64] = p1 * inv; LDS_WAIT();
            float o0 = 0.f, o1 = 0.f;
            for (int j = 0; j < 128; ++j) { const int kpos = (rs + (j >> 4)) * 64 + cs + (j & 15);
                const unsigned vw = *(const unsigned*)(proj + (size_t)(b * SEQ + kpos) * NQKV + 2 * GW + h * HD + 2 * lane); const float p = lp[j]; o0 += p * bflo(vw); o1 += p * bfhi(vw); }
            *(float2*)(ona + (size_t)tok * GW + h * HD + 2 * lane) = make_float2(o0, o1);
        } else {
            const int h = hh - 8;
            { const unsigned qw = *(const unsigned*)(prow + 3 * GW + h * HD + 2 * lane); LDS_WAIT(); lq[2 * lane] = bflo(qw); lq[2 * lane + 1] = bfhi(qw); LDS_WAIT(); }
#pragma unroll
            for (int p = 0; p < 3; ++p) {
                const int dsh = 2 * p, dil = 1 << dsh, sub_len = SEQ >> dsh, rho = pos & (dil - 1), ql = pos >> dsh;
                float lg[3];
#pragma unroll
                for (int jj = 0; jj < 3; ++jj) { const int j = lane + 64 * jj; const int kl = ql + j - 64; const bool valid = (j < 129) && (kl >= 0) && (kl < sub_len);
                    const int kpos = rho + dil * min(max(kl, 0), sub_len - 1);
                    float d = -INFINITY;
                    if (valid) d = dot_qk(lq, proj + (size_t)(b * SEQ + kpos) * NQKV + 4 * GW + h * HD) * scale + F.t5[(int)T5B[p][j] * 8 + h];
                    lg[jj] = d; }
                const float m = wave_max(fmaxf(fmaxf(lg[0], lg[1]), lg[2]));
                const float p0 = __expf(lg[0] - m), p1 = __expf(lg[1] - m), p2 = __expf(lg[2] - m);
                const float den = wave_sum(p0 + p1 + p2), inv = 1.0f / den;
                LDS_WAIT(); lp[lane] = p0 * inv; lp[lane + 64] = p1 * inv; lp[lane + 128] = p2 * inv; LDS_WAIT();
                float o0 = 0.f, o1 = 0.f;
                for (int j = 0; j < 129; ++j) { const int kl = ql + j - 64; const int kpos = rho + dil * min(max(kl, 0), sub_len - 1);
                    const unsigned vw = *(const unsigned*)(proj + (size_t)(b * SEQ + kpos) * NQKV + 5 * GW + h * HD + 2 * lane); const float pp = lp[j]; o0 += pp * bflo(vw); o1 += pp * bfhi(vw); }
                *(float2*)(odil + ((size_t)p * T + tok) * GW + h * HD + 2 * lane) = make_float2(o0, o1);
                if (lane == 0) lse[((size_t)p * T + tok) * 8 + h] = m + __logf(den);
            }
        }
    }
}


typedef short bf16x8v __attribute__((ext_vector_type(8)));
typedef short s16x4v __attribute__((ext_vector_type(4)));
typedef int v4i16_t_ __attribute__((ext_vector_type(2)));
__device__ __forceinline__ unsigned vimg_off(unsigned row, unsigned ch) { return 256u * row + 16u * (ch ^ (((row & 3u) << 2) | ((row >> 2) & 3u))); }
__device__ __forceinline__ s16x4v tr_read16(const LAS unsigned char* p) {
    typedef short v4i16 __attribute__((ext_vector_type(4)));
    return __builtin_bit_cast(s16x4v, __builtin_amdgcn_ds_read_tr16_b64_v4i16((LAS v4i16*)p));
}
struct GeoNA {
    int tok0, qbase, kbase, r, rs, c0, kc0; const float* rpb_h;
    static constexpr int QCOL = 0, KCOL = GW, VCOL = 2 * GW;
    __device__ __forceinline__ int qtok(int n16) const { return qbase + n16; }
    __device__ __forceinline__ int ktok(int c, int slot) const { return kbase + c * 64 + slot; }
    __device__ __forceinline__ float bias(int c, int slot, int n16) const {
        const int qc = c0 + n16, kc = kc0 + slot, cs = min(max(qc - 8, 0), 48);
        const bool valid = (kc >= cs) && (kc < cs + 16);
        const int dc = min(max(kc - qc + 15, 0), 30);
        const float bv = rpb_h[(rs + c - r + 7) * 31 + dc];
        return valid ? bv : -INFINITY;
    }
};
struct GeoDil {
    int tok0, rho, dsh, sub_len, l0, p, h; const float* t5;
    static constexpr int QCOL = 3 * GW, KCOL = 4 * GW, VCOL = 5 * GW;
    __device__ __forceinline__ int qtok(int n16) const { return tok0 + rho + ((l0 + n16) << dsh); }
    __device__ __forceinline__ int ktok(int c, int slot) const { const int l = min(max(l0 - 64 + 32 * c + slot, 0), sub_len - 1); return tok0 + rho + (l << dsh); }
    __device__ __forceinline__ float bias(int c, int slot, int n16) const {
        const int kk = 32 * c + slot, delta = kk - 64 - n16, l = l0 - 64 + kk;
        const bool valid = (delta >= -64) && (delta <= 64) && (l >= 0) && (l < sub_len);
        const int di = min(max(delta + 64, 0), 128);
        const float bv = t5[(int)T5B[p][di] * 8 + h];
        return valid ? bv : -INFINITY;
    }
};
template <int NCH, class Geo>
__device__ __forceinline__ void attn_item(const Geo& G, const bf16* proj, int hcol, LAS unsigned char* vimg, float* out, float* lse_out, int lane) {
    const int n16 = lane & 15, g = lane >> 4;
    const float scale_l2 = 0.08838834764831845f * 1.44269504089f;
    bf16x8v qf[4];
    { const bf16* qp = proj + (size_t)G.qtok(n16) * NQKV + Geo::QCOL + hcol + 8 * g;
#pragma unroll
      for (int s = 0; s < 4; ++s) qf[s] = *(const bf16x8v*)(qp + 32 * s); }
    f32x4 st[NCH][2];
#pragma unroll
    for (int c = 0; c < NCH; ++c)
#pragma unroll
        for (int t2 = 0; t2 < 2; ++t2) {
            const int slot = 8 * (n16 >> 2) + 4 * t2 + (n16 & 3);
            const bf16* kp = proj + (size_t)G.ktok(c, slot) * NQKV + Geo::KCOL + hcol + 8 * g;
            f32x4 acc = (f32x4){0.f, 0.f, 0.f, 0.f};
#pragma unroll
            for (int s = 0; s < 4; ++s) { const bf16x8v kf = *(const bf16x8v*)(kp + 32 * s); acc = __builtin_amdgcn_mfma_f32_16x16x32_bf16(kf, qf[s], acc, 0, 0, 0); }
            st[c][t2] = acc;
        }
    float mx = -INFINITY;
#pragma unroll
    for (int c = 0; c < NCH; ++c)
#pragma unroll
        for (int t2 = 0; t2 < 2; ++t2)
#pragma unroll
            for (int r = 0; r < 4; ++r) { const float bv = G.bias(c, 8 * g + 4 * t2 + r, n16); const float x = st[c][t2][r] * scale_l2 + bv * 1.44269504089f; st[c][t2][r] = x; mx = fmaxf(mx, x); }
    mx = fmaxf(mx, __shfl_xor(mx, 16)); mx = fmaxf(mx, __shfl_xor(mx, 32));
    float sum = 0.f;
    bf16x8v pf[NCH];
#pragma unroll
    for (int c = 0; c < NCH; ++c) {
        float pv[8];
#pragma unroll
        for (int t2 = 0; t2 < 2; ++t2)
#pragma unroll
            for (int r = 0; r < 4; ++r) { const float p = __builtin_amdgcn_exp2f(st[c][t2][r] - mx); pv[4 * t2 + r] = p; sum += p; }
        v4u w; w.x = pk2(pv[0], pv[1]); w.y = pk2(pv[2], pv[3]); w.z = pk2(pv[4], pv[5]); w.w = pk2(pv[6], pv[7]);
        pf[c] = __builtin_bit_cast(bf16x8v, w);
    }
    sum += __shfl_xor(sum, 16); sum += __shfl_xor(sum, 32);
    f32x4 oacc[8];
#pragma unroll
    for (int dt = 0; dt < 8; ++dt) oacc[dt] = (f32x4){0.f, 0.f, 0.f, 0.f};
    const int vr_row = lane >> 4, vr_ch = lane & 15;
    v4u vr[8];
#pragma unroll
    for (int i = 0; i < 8; ++i) vr[i] = *(const v4u*)(proj + (size_t)G.ktok(0, 4 * i + vr_row) * NQKV + Geo::VCOL + hcol + 8 * vr_ch);
    const unsigned q4 = (unsigned)(lane & 15) >> 2, pp = (unsigned)lane & 3u;
#pragma unroll
    for (int c = 0; c < NCH; ++c) {
        asm volatile("" ::: "memory");
#pragma unroll
        for (int i = 0; i < 8; ++i) *(LAS v4u*)(vimg + vimg_off((unsigned)(4 * i + vr_row), (unsigned)vr_ch)) = vr[i];
        asm volatile("" ::: "memory");
        if (c + 1 < NCH) {
#pragma unroll
            for (int i = 0; i < 8; ++i) vr[i] = *(const v4u*)(proj + (size_t)G.ktok(c + 1, 4 * i + vr_row) * NQKV + Geo::VCOL + hcol + 8 * vr_ch);
        }
#pragma unroll
        for (int dt = 0; dt < 8; ++dt) {
            const s16x4v lo = tr_read16(vimg + vimg_off((unsigned)(8 * g) + q4, (unsigned)(2 * dt) + (pp >> 1)) + 8u * (pp & 1u));
            const s16x4v hi = tr_read16(vimg + vimg_off((unsigned)(8 * g + 4) + q4, (unsigned)(2 * dt) + (pp >> 1)) + 8u * (pp & 1u));
            bf16x8v vf; vf[0] = lo[0]; vf[1] = lo[1]; vf[2] = lo[2]; vf[3] = lo[3]; vf[4] = hi[0]; vf[5] = hi[1]; vf[6] = hi[2]; vf[7] = hi[3];
            oacc[dt] = __builtin_amdgcn_mfma_f32_16x16x32_bf16(vf, pf[c], oacc[dt], 0, 0, 0);
        }
        asm volatile("" ::: "memory");
    }
    const float inv = 1.0f / sum;
    float* op = out + (size_t)G.qtok(n16) * GW + hcol + 4 * g;
#pragma unroll
    for (int dt = 0; dt < 8; ++dt) *(f32x4*)(op + 16 * dt) = oacc[dt] * inv;
    if (lse_out != nullptr && g == 0) lse_out[(size_t)G.qtok(n16) * 8 + (hcol >> 7)] = (mx + __builtin_amdgcn_logf(sum)) * 0.69314718056f;
}
__device__ __forceinline__ unsigned kimg_off(unsigned row, unsigned ch) { return 256u * row + 16u * (ch ^ (((row & 3u) << 2) | ((row >> 3) & 3u))); }
__device__ __forceinline__ void attn_dil_units(Frame& F) {
    LAS unsigned char* kimg = F.lds + RING_OFF;
    LAS unsigned char* vimg = F.lds + RING_OFF + 65536;
    LAS float* tb = (LAS float*)(F.lds + RING_OFF + 131072);
    const bf16* proj = (const bf16*)(F.ws + WS_PROJ);
    float* odil = (float*)(F.ws + WS_ODIL); float* lse = (float*)(F.ws + WS_LSE);
    const int lane = F.lane, n16 = lane & 15, g = lane >> 4, w = F.wave;
    const float scale_l2 = 0.08838834764831845f * 1.44269504089f;
    for (int u = F.vcu; u < 3 * NBATCH * 8 * 16; u += F.G) {
        const int p = u >> 9, b = (u >> 7) & 3, h = (u >> 4) & 7, grp = u & 15;
        const int dsh = 2 * p, sub_len = SEQ >> dsh, gpc = sub_len >> 7, rho = grp / gpc, l0g = (grp - rho * gpc) << 7, tok0 = b * SEQ + rho;
        __syncthreads();
        if (F.tid < 129) tb[F.tid] = F.t5[(int)T5B[p][F.tid] * 8 + h] * 1.44269504089f;
        { v4u kr[8], vr[8];
#pragma unroll
          for (int ps = 0; ps < 8; ++ps) { const int row = ps * 32 + (F.tid >> 4), ch = F.tid & 15; const int l = min(max(l0g - 64 + row, 0), sub_len - 1);
              const bf16* src = proj + (size_t)(tok0 + (l << dsh)) * NQKV + h * HD + 8 * ch;
              kr[ps] = *(const v4u*)(src + 4 * GW); vr[ps] = *(const v4u*)(src + 5 * GW); }
#pragma unroll
          for (int ps = 0; ps < 8; ++ps) { const unsigned row = ps * 32 + (F.tid >> 4), ch = F.tid & 15;
              *(LAS v4u*)(kimg + kimg_off(row, ch)) = kr[ps]; *(LAS v4u*)(vimg + vimg_off(row, ch)) = vr[ps]; } }
        __syncthreads();
        const int l0 = l0g + 16 * w, qtok = tok0 + ((l0 + n16) << dsh);
        bf16x8v qf[4];
        { const bf16* qp = proj + (size_t)qtok * NQKV + 3 * GW + h * HD + 8 * g;
#pragma unroll
          for (int s = 0; s < 4; ++s) qf[s] = *(const bf16x8v*)(qp + 32 * s); }
        f32x4 st[5][2];
#pragma unroll
        for (int c = 0; c < 5; ++c)
#pragma unroll
            for (int t2 = 0; t2 < 2; ++t2) {
                const unsigned row = (unsigned)(16 * w + 32 * c + 8 * (n16 >> 2) + 4 * t2 + (n16 & 3)) & 255u;
                f32x4 acc = (f32x4){0.f, 0.f, 0.f, 0.f};
#pragma unroll
                for (int s = 0; s < 4; ++s) { const bf16x8v kf = *(const LAS bf16x8v*)(kimg + kimg_off(row, (unsigned)(4 * s + g))); acc = __builtin_amdgcn_mfma_f32_16x16x32_bf16(kf, qf[s], acc, 0, 0, 0); }
                st[c][t2] = acc;
            }
        float mx = -INFINITY;
#pragma unroll
        for (int c = 0; c < 5; ++c)
#pragma unroll
            for (int t2 = 0; t2 < 2; ++t2)
#pragma unroll
                for (int r = 0; r < 4; ++r) { const int kk = 32 * c + 8 * g + 4 * t2 + r, delta = kk - 64 - n16, l = l0 - 64 + kk;
                    const bool valid = (delta >= -64) && (delta <= 64) && (l >= 0) && (l < sub_len);
                    const float bv = tb[min(max(delta + 64, 0), 128)];
                    const float x = valid ? st[c][t2][r] * scale_l2 + bv : -INFINITY; st[c][t2][r] = x; mx = fmaxf(mx, x); }
        mx = fmaxf(mx, __shfl_xor(mx, 16)); mx = fmaxf(mx, __shfl_xor(mx, 32));
        float sum = 0.f;
        bf16x8v pf[5];
#pragma unroll
        for (int c = 0; c < 5; ++c) {
            float pv[8];
#pragma unroll
            for (int t2 = 0; t2 < 2; ++t2)
#pragma unroll
                for (int r = 0; r < 4; ++r) { const float pe = __builtin_amdgcn_exp2f(st[c][t2][r] - mx); pv[4 * t2 + r] = pe; sum += pe; }
            v4u wv; wv.x = pk2(pv[0], pv[1]); wv.y = pk2(pv[2], pv[3]); wv.z = pk2(pv[4], pv[5]); wv.w = pk2(pv[6], pv[7]);
            pf[c] = __builtin_bit_cast(bf16x8v, wv);
        }
        sum += __shfl_xor(sum, 16); sum += __shfl_xor(sum, 32);
        f32x4 oacc[8];
#pragma unroll
        for (int dt = 0; dt < 8; ++dt) oacc[dt] = (f32x4){0.f, 0.f, 0.f, 0.f};
        const unsigned q4 = (unsigned)(lane & 15) >> 2, pp = (unsigned)lane & 3u;
#pragma unroll
        for (int c = 0; c < 5; ++c)
#pragma unroll
            for (int dt = 0; dt < 8; ++dt) {
                const unsigned rbase = ((unsigned)(16 * w + 32 * c + 8 * g) & 255u) + q4;
                const s16x4v lo = tr_read16(vimg + vimg_off(rbase, (unsigned)(2 * dt) + (pp >> 1)) + 8u * (pp & 1u));
                const s16x4v hi = tr_read16(vimg + vimg_off(rbase + 4u, (unsigned)(2 * dt) + (pp >> 1)) + 8u * (pp & 1u));
                bf16x8v vf; vf[0] = lo[0]; vf[1] = lo[1]; vf[2] = lo[2]; vf[3] = lo[3]; vf[4] = hi[0]; vf[5] = hi[1]; vf[6] = hi[2]; vf[7] = hi[3];
                oacc[dt] = __builtin_amdgcn_mfma_f32_16x16x32_bf16(vf, pf[c], oacc[dt], 0, 0, 0);
            }
        const float inv = 1.0f / sum;
        float* op = odil + ((size_t)p * T + qtok) * GW + h * HD + 4 * g;
#pragma unroll
        for (int dt = 0; dt < 8; ++dt) *(f32x4*)(op + 16 * dt) = oacc[dt] * inv;
        if (g == 0) lse[((size_t)p * T + qtok) * 8 + h] = (mx + __builtin_amdgcn_logf(sum)) * 0.69314718056f;
    }
    __syncthreads();
}
__device__ __forceinline__ void p3_attn_mfma(Frame& F) {
    attn_dil_units(F);
    LAS unsigned char* vimg = F.lds + RING_OFF + F.wave * 8192;
    const bf16* proj = (const bf16*)(F.ws + WS_PROJ);
    float* ona = (float*)(F.ws + WS_ONA);
    int lane = F.lane; asm volatile("" : "+v"(lane));
    const int gw = F.vcu * NWAVES + F.wave, NGW = F.G * NWAVES;
#pragma unroll 1
    for (int id = gw; id < NBATCH * 32 * 8 * 4; id += NGW) {
        const int qt = id & 3, h = (id >> 2) & 7, r = (id >> 5) & 31, b = id >> 10;
        GeoNA G; G.tok0 = b * SEQ; G.r = r; G.rs = min(max(r - 4, 0), 24); G.c0 = 16 * qt; G.kc0 = (qt == 0) ? 0 : (qt == 1) ? 8 : (qt == 2) ? 24 : 32;
        G.qbase = G.tok0 + r * 64 + G.c0; G.kbase = G.tok0 + G.rs * 64 + G.kc0; G.rpb_h = F.rpb + h * (15 * 31);
        attn_item<8, GeoNA>(G, proj, h * HD, vimg, ona, nullptr, lane);
    }
}

__device__ __forceinline__ void p4_post(Frame& F) {
    const float* ona = (const float*)(F.ws + WS_ONA); const float* odil = (const float*)(F.ws + WS_ODIL); const float* lse = (const float*)(F.ws + WS_LSE);
    bf16* aout = (bf16*)(F.ws + WS_AOUT);
    const int gw = F.vcu * NWAVES + F.wave, NGW = F.G * NWAVES, lane = F.lane;
    for (int tok = gw; tok < T; tok += NGW) {
        f32x4 v[4]; float ss = 0.f;
#pragma unroll
        for (int j = 0; j < 4; ++j) { v[j] = *(const f32x4*)(ona + (size_t)tok * GW + 4 * lane + 256 * j); ss += (v[j][0] * v[j][0] + v[j][1] * v[j][1]) + (v[j][2] * v[j][2] + v[j][3] * v[j][3]); }
        float r = 1.0f / sqrtf(wave_sum(ss) * (1.0f / GW) + EPS);
#pragma unroll
        for (int j = 0; j < 4; ++j) { const int col = 4 * lane + 256 * j; const f32x4 g = *(const f32x4*)(F.g_out_na + col);
            v2u w; w.x = pk2(v[j][0] * r * g[0], v[j][1] * r * g[1]); w.y = pk2(v[j][2] * r * g[2], v[j][3] * r * g[3]); *(v2u*)(aout + (size_t)tok * D + col) = w; }
        ss = 0.f;
#pragma unroll
        for (int j = 0; j < 4; ++j) { const int col = 4 * lane + 256 * j, h = col >> 7;
            const float l0 = lse[((size_t)0 * T + tok) * 8 + h], l1 = lse[((size_t)1 * T + tok) * 8 + h], l2 = lse[((size_t)2 * T + tok) * 8 + h];
            const float mx = fmaxf(fmaxf(l0, l1), l2); const float e0 = __expf(l0 - mx), e1 = __expf(l1 - mx), e2 = __expf(l2 - mx); const float inv = 1.0f / (e0 + e1 + e2);
            const f32x4 a0 = *(const f32x4*)(odil + ((size_t)0 * T + tok) * GW + col), a1 = *(const f32x4*)(odil + ((size_t)1 * T + tok) * GW + col), a2 = *(const f32x4*)(odil + ((size_t)2 * T + tok) * GW + col);
            v[j] = a0 * (e0 * inv) + a1 * (e1 * inv) + a2 * (e2 * inv);
            ss += (v[j][0] * v[j][0] + v[j][1] * v[j][1]) + (v[j][2] * v[j][2] + v[j][3] * v[j][3]); }
        r = 1.0f / sqrtf(wave_sum(ss) * (1.0f / GW) + EPS);
#pragma unroll
        for (int j = 0; j < 4; ++j) { const int col = 4 * lane + 256 * j; const f32x4 g = *(const f32x4*)(F.g_out_dil + col);
            v2u w; w.x = pk2(v[j][0] * r * g[0], v[j][1] * r * g[1]); w.y = pk2(v[j][2] * r * g[2], v[j][3] * r * g[3]); *(v2u*)(aout + (size_t)tok * D + GW + col) = w; }
    }
}

__device__ __forceinline__ void p6_rows(Frame& F) {
    LAS float* t1 = (LAS float*)(F.lds + RING_OFF);
    LAS float* t2 = t1 + D;
    LAS float* t3 = t2 + D;
    LAS unsigned* hb = (LAS unsigned*)(F.lds + RING_OFF + 3 * D * 4) + F.wave * (4 * D / 2);
    const float* mixed = (const float*)(F.ws + WS_MIXED); float* x1 = (float*)(F.ws + WS_X1); unsigned char* hffn8 = F.ws + WS_HFFN;
    int* topi = (int*)(F.ws + WS_TOPI); float* topg = (float*)(F.ws + WS_TOPG); int* trank = (int*)(F.ws + WS_TRANK); unsigned* hist_g = (unsigned*)(F.ws + WS_HIST);
    LAS unsigned* hist = (LAS unsigned*)(F.lds + MISC_OFF) + 224;
    const int lane = F.lane;
    for (int rb = F.vcu; rb < T / 32; rb += F.G) {
        const int b = rb >> 6;
        __syncthreads();
        if (F.tid < 32) hist[F.tid] = 0u;
        for (int col = F.tid; col < D; col += NWAVES * 64) { t1[col] = F.g_post_mix[col] * mod_val(F, b, 2 * D + col); t2[col] = F.g_pre_ffn[col] * (1.0f + mod_val(F, b, 4 * D + col)); t3[col] = mod_val(F, b, 3 * D + col); }
        __syncthreads();
#pragma unroll 1
        for (int rr = 0; rr < 4; ++rr) {
            const int row = rb * 32 + F.wave * 4 + rr;
            f32x4 v[8]; float ss = 0.f;
#pragma unroll
            for (int j = 0; j < 8; ++j) { v[j] = *(const f32x4*)(mixed + (size_t)row * D + 4 * lane + 256 * j); ss += (v[j][0] * v[j][0] + v[j][1] * v[j][1]) + (v[j][2] * v[j][2] + v[j][3] * v[j][3]); }
            float r = 1.0f / sqrtf(wave_sum(ss) * (1.0f / D) + EPS);
            ss = 0.f;
#pragma unroll
            for (int j = 0; j < 8; ++j) { const int col = 4 * lane + 256 * j; const f32x4 xv = *(const f32x4*)(F.x + (size_t)row * D + col); const f32x4 a = *(LAS f32x4*)(t1 + col);
                v[j] = xv + a * (v[j] * r); *(f32x4*)(x1 + (size_t)row * D + col) = v[j];
                ss += (v[j][0] * v[j][0] + v[j][1] * v[j][1]) + (v[j][2] * v[j][2] + v[j][3] * v[j][3]); }
            r = 1.0f / sqrtf(wave_sum(ss) * (1.0f / D) + EPS);
#pragma unroll
            for (int j = 0; j < 8; ++j) { const int col = 4 * lane + 256 * j; const f32x4 a = *(LAS f32x4*)(t2 + col), s = *(LAS f32x4*)(t3 + col);
                const f32x4 hv = v[j] * r * a + s;
                v2u w; w.x = pk2(hv[0], hv[1]); w.y = pk2(hv[2], hv[3]); *(LAS v2u*)(hb + rr * (D / 2) + (col >> 1)) = w;
                *(unsigned*)(hffn8 + (size_t)row * D + col) = pg8::cvt4_fp8(hv[0] * XSCALE, hv[1] * XSCALE, hv[2] * XSCALE, hv[3] * XSCALE); }
        }
        LDS_WAIT();
        const int e = lane & 31, half = lane >> 5;
        float acc[4] = {0.f, 0.f, 0.f, 0.f};
        { const float* wr = F.w_router + (size_t)(half * 1024) * NE + e; const LAS unsigned* hr = hb + half * 512;
#pragma unroll 8
          for (int kp = 0; kp < 512; ++kp) { const float w0 = wr[(size_t)(2 * kp) * NE], w1 = wr[(size_t)(2 * kp + 1) * NE];
#pragma unroll
              for (int rr = 0; rr < 4; ++rr) { const unsigned hw = hr[rr * (D / 2) + kp]; acc[rr] += bflo(hw) * w0 + bfhi(hw) * w1; } } }
        const float br = F.b_router[e];
#pragma unroll
        for (int rr = 0; rr < 4; ++rr) {
            const int row = rb * 32 + F.wave * 4 + rr;
            float a = acc[rr]; a += __shfl_xor(a, 32);
            float lg = (lane < 32) ? a + br : -INFINITY;
            int sel[4]; float val[4];
#pragma unroll
            for (int k = 0; k < 4; ++k) { const float mx = wave_max(lg); const unsigned long long bal = __ballot(lg == mx); const int idx = __ffsll((long long)bal) - 1; sel[k] = idx; val[k] = mx; if (lane == idx) lg = -INFINITY; }
            const float e1 = __expf(val[1] - val[0]), e2 = __expf(val[2] - val[0]), e3 = __expf(val[3] - val[0]); const float inv = 1.0f / (1.0f + e1 + e2 + e3);
            if (lane == 0) {
                *(int4*)(topi + (size_t)row * 4) = make_int4(sel[0], sel[1], sel[2], sel[3]);
                *(float4*)(topg + (size_t)row * 4) = make_float4(inv, e1 * inv, e2 * inv, e3 * inv);
                int rk[4];
#pragma unroll
                for (int k = 0; k < 4; ++k) rk[k] = (int)__hip_atomic_fetch_add(hist + sel[k], 1u, __ATOMIC_RELAXED, __HIP_MEMORY_SCOPE_WORKGROUP);
                *(int4*)(trank + (size_t)row * 4) = make_int4(rk[0], rk[1], rk[2], rk[3]);
            }
        }
        __syncthreads();
        if (F.tid < 32) hist_g[rb * 32 + F.tid] = hist[F.tid];
    }
}

__device__ __forceinline__ void moe_tables(Frame& F, int rb) {
    const unsigned* hist_g = (const unsigned*)(F.ws + WS_HIST);
    LAS unsigned* red = (LAS unsigned*)(F.lds + RING_OFF);
    __syncthreads();
    { const int e = F.tid & 31, part = F.tid >> 5; unsigned tot = 0u, pre = 0u;
#pragma unroll
      for (int i = 0; i < 16; ++i) { const int r2 = part * 16 + i; const unsigned v = hist_g[r2 * 32 + e]; tot += v; pre += (r2 < rb) ? v : 0u; }
      red[(part * 32 + e) * 2] = tot; red[(part * 32 + e) * 2 + 1] = pre; }
    __syncthreads();
    if (F.tid < 32) { unsigned tot = 0u, pre = 0u;
#pragma unroll
        for (int part = 0; part < 16; ++part) { tot += red[(part * 32 + F.tid) * 2]; pre += red[(part * 32 + F.tid) * 2 + 1]; }
        F.MISC[224 + F.tid] = tot; F.MISC[32 + F.tid] = pre; }
    __syncthreads();
    if (F.tid == 0) { int nb = 0;
        for (int e = 0; e < NE; ++e) { const int cnt = (int)F.MISC[224 + e]; const int k = (cnt + 255) >> 8; F.MISC[32 + e] += (unsigned)(nb * 256); for (int j = 0; j < k && nb < MAXBLK; ++j) F.MISC[64 + nb++] = (unsigned)e; }
        F.MISC[16] = (unsigned)nb; }
    __syncthreads();
}
__device__ __forceinline__ void p7_slots(Frame& F) {
    const int* topi = (const int*)(F.ws + WS_TOPI); const int* trank = (const int*)(F.ws + WS_TRANK); int* tslot = (int*)(F.ws + WS_TSLOT);
    const unsigned char* hffn8 = F.ws + WS_HFFN; unsigned char* xg8 = F.ws + WS_XG;
    const int lane = F.lane;
    for (int rb = F.vcu; rb < T / 32; rb += F.G) {
        moe_tables(F, rb);
#pragma unroll 4
        for (int i = 0; i < 16; ++i) {
            const int pid = rb * 128 + F.wave * 16 + i, t = pid >> 2; const int e = topi[pid];
            const int slot = (int)F.MISC[32 + e] + trank[pid];
            if (lane == 0) tslot[pid] = slot;
            const v4u* s = (const v4u*)(hffn8 + (size_t)t * D) + lane; v4u* d = (v4u*)(xg8 + (size_t)slot * D) + lane;
#pragma unroll
            for (int j = 0; j < 2; ++j) d[64 * j] = s[64 * j];
        }
    }
}

__device__ __forceinline__ void p10_final(Frame& F) {
    LAS float* t1 = (LAS float*)(F.lds + RING_OFF);
    const float* x1 = (const float*)(F.ws + WS_X1); const bf16* yb = (const bf16*)(F.ws + WS_YB);
    const int* tslot = (const int*)(F.ws + WS_TSLOT); const float* topg = (const float*)(F.ws + WS_TOPG);
    const int lane = F.lane;
    for (int rb = F.vcu; rb < T / 32; rb += F.G) {
        const int b = rb >> 6;
        __syncthreads();
        for (int col = F.tid; col < D; col += NWAVES * 64) t1[col] = F.g_post_ffn[col] * mod_val(F, b, 5 * D + col);
        __syncthreads();
        for (int rr = F.wave; rr < 32; rr += NWAVES) {
            const int row = rb * 32 + rr;
            const int4 sl = *(const int4*)(tslot + (size_t)row * 4); const float4 gt = *(const float4*)(topg + (size_t)row * 4);
            const int sls[4] = {sl.x, sl.y, sl.z, sl.w}; const float gts[4] = {gt.x, gt.y, gt.z, gt.w};
            float y[4][8]; float ss = 0.f;
#pragma unroll
            for (int j = 0; j < 4; ++j) {
#pragma unroll
                for (int i = 0; i < 8; ++i) y[j][i] = 0.f;
#pragma unroll
                for (int k = 0; k < 4; ++k) { const v4u w = *(const v4u*)(yb + (size_t)sls[k] * D + 8 * lane + 512 * j); const float g = gts[k];
                    y[j][0] += g * bflo(w.x); y[j][1] += g * bfhi(w.x); y[j][2] += g * bflo(w.y); y[j][3] += g * bfhi(w.y); y[j][4] += g * bflo(w.z); y[j][5] += g * bfhi(w.z); y[j][6] += g * bflo(w.w); y[j][7] += g * bfhi(w.w); }
#pragma unroll
                for (int i = 0; i < 8; ++i) ss += y[j][i] * y[j][i];
            }
            const float r = 1.0f / sqrtf(wave_sum(ss) * (1.0f / D) + EPS);
#pragma unroll
            for (int j = 0; j < 4; ++j) { const int col = 8 * lane + 512 * j;
#pragma unroll
                for (int hh = 0; hh < 2; ++hh) { const f32x4 xv = *(const f32x4*)(x1 + (size_t)row * D + col + 4 * hh); const f32x4 a = *(LAS f32x4*)(t1 + col + 4 * hh);
                    f32x4 o; o[0] = xv[0] + a[0] * y[j][4 * hh + 0] * r; o[1] = xv[1] + a[1] * y[j][4 * hh + 1] * r; o[2] = xv[2] + a[2] * y[j][4 * hh + 2] * r; o[3] = xv[3] + a[3] * y[j][4 * hh + 3] * r;
                    *(f32x4*)(F.out + (size_t)row * D + col + 4 * hh) = o; } }
        }
    }
}

struct Args { const float* in[20]; float* out; unsigned char* ws; int ph_lo, ph_hi; };
__global__ void __launch_bounds__(NWAVES * 64, 2) fwd_kernel(Args args) {
    extern __shared__ __attribute__((aligned(16))) unsigned char lds[];
    Frame F;
    F.lds = (LAS unsigned char*)lds;
    F.MISC = (volatile LAS unsigned*)(F.lds + MISC_OFF);
    F.tid = threadIdx.x; F.lane = F.tid & 63; F.wave = __builtin_amdgcn_readfirstlane(F.tid >> 6);
    F.G = gridDim.x; { const int bx = blockIdx.x; F.vcu = (F.G % 8 == 0) ? (bx % 8) * (F.G / 8) + bx / 8 : bx; }
    F.ws = args.ws; F.ctl = (unsigned*)(args.ws + WS_CTL); F.out = args.out;
    F.x = args.in[0]; F.c = args.in[1]; F.w_ada = args.in[2]; F.b_ada = args.in[3]; F.g_pre_mix = args.in[4]; F.g_post_mix = args.in[5]; F.w_in = args.in[6]; F.rpb = args.in[7]; F.t5 = args.in[8];
    F.g_out_na = args.in[9]; F.g_out_dil = args.in[10]; F.w_o = args.in[11]; F.g_pre_ffn = args.in[12]; F.g_post_ffn = args.in[13]; F.w_router = args.in[14]; F.b_router = args.in[15];
    F.w_e_in = args.in[16]; F.b_e_in = args.in[17]; F.w_e_out = args.in[18]; F.b_e_out = args.in[19];
    for (int u = F.tid; u < 256; u += NWAVES * 64) F.MISC[u] = 0u;
    __syncthreads();
    XcdBarrier bar; bar.bar = F.ctl + CW_BAR; bar.x = 0; bar.st = nullptr;
    if (MK_N_LAUNCHES == 1) bar = xcd_barrier_post(F.ctl + CW_BAR, F.MISC + 8);
    const int lo = args.ph_lo, hi = args.ph_hi;
#define IN(k) (lo <= (k) && (k) < hi)
#ifndef PROBE_REPEAT
#define PROBE_REPEAT -1
#endif
#define REP(k) ((PROBE_REPEAT == (k)) ? 2 : 1)
#define SEAM(k) do { if (IN(k) && IN((k) + 1)) xcd_barrier(bar); } while (0)

    if (IN(0)) { for (int rep = 0; rep < REP(0); ++rep) p0_prologue(F); } SEAM(0);
    if (IN(1)) { p1_hmix(F); } SEAM(1);
    if (IN(2)) {
        __syncthreads();
        if (F.G == 256 && (int)blockIdx.x >= QKV_GEMM_WGS) {
            conv8_run(F, (LAS float*)(F.lds + RING_OFF + F.wave * 16896), ((int)blockIdx.x - QKV_GEMM_WGS) * NWAVES + F.wave, (256 - QKV_GEMM_WGS) * NWAVES, CONV_Q);
        } else {
            const int gg = (F.G == 256) ? QKV_GEMM_WGS : F.G;
            pg8::Gemm g{(const bf16*)(F.ws + WS_HMIX), (const bf16*)(F.ws + WS_WIN_T), T, NQKV, D}; pg8::StaticOrder S; S.init(T, NQKV, gg, (int)blockIdx.x);
            pg8::EpiBf16 E{(bf16*)(F.ws + WS_PROJ), NQKV, nullptr, 0};
            for (int rep = 0; rep < REP(2); ++rep) { __syncthreads(); pg8::gemm_phase<pg8::EpiBf16, pg8::StaticOrder, true, true>(F.lds + RING_OFF, g, S, E); }
            if (F.G != 256) { __syncthreads(); conv8_run(F, (LAS float*)(F.lds + RING_OFF + F.wave * 16896), F.vcu * NWAVES + F.wave, F.G * NWAVES, CONV_Q); }
        }
    } SEAM(2);
    #ifdef ATTN_NAIVE
    if (IN(3)) { p3_attn_naive(F); } SEAM(3);
#else
    if (IN(3)) { for (int rep = 0; rep < REP(3); ++rep) { __syncthreads(); p3_attn_mfma(F); } } SEAM(3);
#endif
    if (IN(4)) { p4_post(F); } SEAM(4);
    if (IN(5)) {
        __syncthreads();
        if (F.G == 256 && (int)blockIdx.x >= WO_GEMM_WGS) {
            conv8_run(F, (LAS float*)(F.lds + RING_OFF + F.wave * 16896), CONV_Q + ((int)blockIdx.x - WO_GEMM_WGS) * NWAVES + F.wave, (256 - WO_GEMM_WGS) * NWAVES, CONV_Q + CONV_Q5);
        } else {
            const int gg = (F.G == 256) ? WO_GEMM_WGS : F.G;
            pg8::Gemm g{(const bf16*)(F.ws + WS_AOUT), (const bf16*)(F.ws + WS_WO_T), T, D, D}; pg8::StaticOrder S; S.init(T, D, gg, (int)blockIdx.x);
            pg8::EpiF32 E{(float*)(F.ws + WS_MIXED), D};
            __syncthreads();
            pg8::gemm_phase<pg8::EpiF32, pg8::StaticOrder, true, true>(F.lds + RING_OFF, g, S, E);
            if (F.G != 256) { __syncthreads(); conv8_run(F, (LAS float*)(F.lds + RING_OFF + F.wave * 16896), CONV_Q + F.vcu * NWAVES + F.wave, F.G * NWAVES, CONV_Q + CONV_Q5); }
        }
    } SEAM(5);
    if (IN(6)) { for (int rep = 0; rep < REP(6); ++rep) p6_rows(F); } SEAM(6);
    if (IN(7)) { p7_slots(F); } SEAM(7);
    if (IN(8)) {
        moe_tables(F, -1);
        pg8::Gemm g{(const bf16*)(F.ws + WS_XG), (const bf16*)(F.ws + WS_WEI_T), MAXBLK * 256, FF2, D / 2};
        pg8::MoeOrder<16> S{(const LAS int*)(F.lds + MISC_OFF + 64 * 4), (int)F.MISC[16], F.G, (int)blockIdx.x};
        pg8::EpiSwiglu8 E{F.ws + WS_HB, FF, F.b_e_in, FF2, 1.0f / (WSCALE * XSCALE), HSCALE};
        for (int rep = 0; rep < REP(8); ++rep) { __syncthreads(); pg8::gemm_phase<pg8::EpiSwiglu8, pg8::MoeOrder<16>, true, true, true>(F.lds + RING_OFF, g, S, E); }
    } SEAM(8);
    if (IN(9)) {
        moe_tables(F, -1);
        pg8::Gemm g{(const bf16*)(F.ws + WS_HB), (const bf16*)(F.ws + WS_WEO_T), MAXBLK * 256, D, FF / 2};
        pg8::MoeOrder<8> S{(const LAS int*)(F.lds + MISC_OFF + 64 * 4), (int)F.MISC[16], F.G, (int)blockIdx.x};
        pg8::EpiBf16S E{(bf16*)(F.ws + WS_YB), D, F.b_e_out, D, 1.0f / (WSCALE * HSCALE)};
        for (int rep = 0; rep < REP(9); ++rep) { __syncthreads(); pg8::gemm_phase<pg8::EpiBf16S, pg8::MoeOrder<8>, true, true, true>(F.lds + RING_OFF, g, S, E); }
    } SEAM(9);
    if (IN(10)) { p10_final(F); }
#undef IN
#undef SEAM
}

extern "C" void kernel_launch(void* const* d_in, const int* in_sizes, int n_in, void* d_out, int out_size, void* d_ws, size_t ws_size, hipStream_t stream) {
    static int grid = 0;
    if (grid == 0) {
        if (n_in != 20 || out_size != T * D || ws_size < WS_END) { fprintf(stderr, "kernel_launch: unexpected problem (n_in %d, out %d, ws %zu)\n", n_in, out_size, ws_size); grid = -1; return; }
        int dev = 0, cus = 0, per_cu = 0;
        if (hipGetDevice(&dev) != hipSuccess || hipDeviceGetAttribute(&cus, hipDeviceAttributeMultiprocessorCount, dev) != hipSuccess) { grid = -1; return; }
        if (hipFuncSetAttribute((const void*)fwd_kernel, hipFuncAttributeMaxDynamicSharedMemorySize, LDS_BYTES) != hipSuccess) { fprintf(stderr, "kernel_launch: hipFuncSetAttribute failed\n"); grid = -1; return; }
        if (hipOccupancyMaxActiveBlocksPerMultiprocessor(&per_cu, (const void*)fwd_kernel, NWAVES * 64, LDS_BYTES) != hipSuccess || per_cu < 1) { fprintf(stderr, "kernel_launch: occupancy query reports %d\n", per_cu); }
        (void)hipGetLastError();
        grid = cus;
    }
    if (grid < 0) return;
    if (hipMemsetAsync((char*)d_ws + WS_CTL, 0, CTL_ZERO_BYTES, stream) != hipSuccess) return;
    Args a{};
    for (int i = 0; i < 20; ++i) a.in[i] = (const float*)d_in[i];
    a.out = (float*)d_out; a.ws = (unsigned char*)d_ws;
    if (MK_N_LAUNCHES == 1) {
        a.ph_lo = 0; a.ph_hi = NPHASE;
        hipLaunchKernelGGL(fwd_kernel, dim3(grid), dim3(NWAVES * 64), LDS_BYTES, stream, a);
    } else {
        for (int p = 0; p < NPHASE; ++p) { a.ph_lo = p; a.ph_hi = p + 1; hipLaunchKernelGGL(fwd_kernel, dim3(grid), dim3(NWAVES * 64), LDS_BYTES, stream, a); }
    }
}
```

```cpp
#include <hip/hip_runtime.h>
#include <cstdio>
#include <cstdint>
#include <type_traits>

#ifndef MK_N_LAUNCHES
#define MK_N_LAUNCHES 1
#endif

namespace pg8 {
#define PG8_LAS __attribute__((address_space(3)))
typedef unsigned short bf16_t;
typedef short bf16x8 __attribute__((ext_vector_type(8)));
typedef float f32x4 __attribute__((ext_vector_type(4)));
typedef unsigned u32x4 __attribute__((ext_vector_type(4)));
typedef unsigned u32x2 __attribute__((ext_vector_type(2)));
constexpr int BM = 256, BK = 64, HALF = 128, HTB = HALF * BK * 2  , STAGE_BYTES = 8 * HTB, NXCD = 8, WGM = 8;

__host__ __device__ __forceinline__ int lds_byte(int r, int c) { const int st = (r >> 4) * 2 + (c >> 5), rr = r & 15, cc = c & 31, ob = rr * 64 + cc * 2; return st * 1024 + (ob ^ (((ob >> 9) & 1) << 5)); }
__host__ __device__ __forceinline__ void stage_rc(int b, int& R, int& C) { const int st = b / 1024, sb = b % 1024, swz = sb ^ (((sb >> 9) & 1) << 5); R = (st >> 1) * 16 + swz / 64; C = (st & 1) * 32 + (swz % 64) / 2; }
__host__ __device__ __forceinline__ int perm32(int rho) { const int n = rho >> 4, i = rho & 15; return 8 * (i >> 2) + 4 * n + (i & 3); }

struct Unit { int pm, pn, bt, e; };
struct Gemm { const bf16_t* A; const bf16_t* Bt; int M, N, K; };

struct StaticOrder {
    int nM, nN, nwg, G, c;
    __host__ __device__ void init(int M, int N, int G_, int c_) { nM = M / BM; nN = N / BM; nwg = nM * nN; G = G_; c = c_; }
    __host__ __device__ bool next(int i, Unit& u) const {
        const long L = (long)i * G + c; if (L >= nwg) return false;
        int wgid = (int)L; { const int q = nwg / NXCD, r = nwg % NXCD, xcd = wgid % NXCD, off = wgid / NXCD; wgid = (xcd < r ? xcd * (q + 1) : r * (q + 1) + (xcd - r) * q) + off; }
        const int nig = WGM * nN, gid = wgid / nig, fm = gid * WGM, gsz = (nM - fm) < WGM ? (nM - fm) : WGM;
        u.pm = fm + ((wgid % nig) % gsz); u.pn = (wgid % nig) / gsz; u.bt = u.pn; u.e = 0; return true;
    }
    __device__ __forceinline__ void a_ready(const Unit&) const {}
    __device__ __forceinline__ void done(const Unit&) const {}
};
template <int NPN> struct MoeOrder {
    const PG8_LAS int* blk_e; int nb, G, c; const PG8_LAS int* rowtab;
    __device__ __forceinline__ bool next(int i, Unit& u) const {
        int L = i * G + c;
        if (G == 256) L = ((i * 8 + (c & 7)) << 5) + (c >> 3);
        const int g = L >> 5, r = L & 31;
        int block, pn;
        if (NPN == 16) { block = 4 * (g >> 1) + (r & 3); pn = 8 * (g & 1) + (r >> 2); } else { block = 4 * g + (r & 3); pn = r >> 2; }
        if (block >= nb) return false;
        u.pm = block; u.pn = pn; u.e = blk_e[block]; u.bt = u.e * NPN + pn; return true;
    }
    __device__ __forceinline__ void a_ready(const Unit&) const {}
    __device__ __forceinline__ void done(const Unit&) const {}
};

__device__ __forceinline__ unsigned cvt_pk_bf16(float lo, float hi) { unsigned r; asm volatile("v_cvt_pk_bf16_f32 %0, %1, %2" : "=v"(r) : "v"(lo), "v"(hi)); return r; }

struct EpiF32 {
    static constexpr bool PERM = false, AFTER_DRAIN = false;
    float* C; int ldc;
    __device__ __forceinline__ void operator()(const f32x4 (&acc)[2][2][4][2], const Unit& u, int wr, int wc, int fr, int fq) const {
        const int row0 = u.pm * BM + wr * 64 + fr, col0 = u.pn * BM + wc * 32 + 4 * fq;
#pragma unroll
        for (int ai = 0; ai < 2; ++ai)
#pragma unroll
            for (int m = 0; m < 4; ++m) { float* rowp = C + (size_t)(row0 + ai * HALF + m * 16) * ldc + col0;
#pragma unroll
                for (int bj = 0; bj < 2; ++bj)
#pragma unroll
                    for (int n = 0; n < 2; ++n) *(f32x4*)(rowp + bj * HALF + n * 16) = acc[ai][bj][m][n]; }
    }
};
struct EpiBf16 {
    static constexpr bool PERM = true, AFTER_DRAIN = false;
    bf16_t* O; int ldc; const float* bias; int bias_estride;
    __device__ __forceinline__ void operator()(const f32x4 (&acc)[2][2][4][2], const Unit& u, int wr, int wc, int fr, int fq) const {
        const int row0 = u.pm * BM + wr * 64 + fr; const int col0 = u.pn * BM + wc * 32 + 8 * fq;
        f32x4 bv[2][2];
#pragma unroll
        for (int bj = 0; bj < 2; ++bj)
#pragma unroll
            for (int n = 0; n < 2; ++n) bv[bj][n] = bias ? *(const f32x4*)(bias + (size_t)u.e * bias_estride + col0 + bj * HALF + 4 * n) : (f32x4){0.f, 0.f, 0.f, 0.f};
#pragma unroll
        for (int ai = 0; ai < 2; ++ai)
#pragma unroll
            for (int m = 0; m < 4; ++m) { bf16_t* rowp = O + (size_t)(row0 + ai * HALF + m * 16) * ldc + col0;
#pragma unroll
                for (int bj = 0; bj < 2; ++bj) { const f32x4 v0 = acc[ai][bj][m][0] + bv[bj][0], v1 = acc[ai][bj][m][1] + bv[bj][1];
                    u32x4 w; w.x = cvt_pk_bf16(v0[0], v0[1]); w.y = cvt_pk_bf16(v0[2], v0[3]); w.z = cvt_pk_bf16(v1[0], v1[1]); w.w = cvt_pk_bf16(v1[2], v1[3]);
                    *(u32x4*)(rowp + bj * HALF) = w; } }
    }
};
__device__ __forceinline__ float swiglu1(float g, float u) {
    g = fminf(g, 7.0f); u = fminf(fmaxf(u, -7.0f), 7.0f);
    const float s = __builtin_amdgcn_rcpf(1.0f + __builtin_amdgcn_exp2f(g * (-1.702f * 1.44269504089f)));
    return (u + 1.0f) * (g * s);
}
struct EpiSwiglu {
    static constexpr bool PERM = true, AFTER_DRAIN = false;
    bf16_t* H; int ldh; const float* bias; int bias_estride;
    __device__ __forceinline__ void operator()(const f32x4 (&acc)[2][2][4][2], const Unit& u, int wr, int wc, int fr, int fq) const {
        const int row0 = u.pm * BM + wr * 64 + fr; const int col0 = u.pn * BM + wc * 32 + 8 * fq;
        f32x4 bv[2][2];
#pragma unroll
        for (int bj = 0; bj < 2; ++bj)
#pragma unroll
            for (int n = 0; n < 2; ++n) bv[bj][n] = *(const f32x4*)(bias + (size_t)u.e * bias_estride + col0 + bj * HALF + 4 * n);
#pragma unroll
        for (int ai = 0; ai < 2; ++ai)
#pragma unroll
            for (int m = 0; m < 4; ++m) { bf16_t* rowp = H + (size_t)(row0 + ai * HALF + m * 16) * ldh + (col0 >> 1);
#pragma unroll
                for (int bj = 0; bj < 2; ++bj) { const f32x4 v0 = acc[ai][bj][m][0] + bv[bj][0], v1 = acc[ai][bj][m][1] + bv[bj][1];
                    u32x2 w; w.x = cvt_pk_bf16(swiglu1(v0[0], v0[1]), swiglu1(v0[2], v0[3])); w.y = cvt_pk_bf16(swiglu1(v1[0], v1[1]), swiglu1(v1[2], v1[3]));
                    *(u32x2*)(rowp + bj * (HALF / 2)) = w; } }
    }
};

__device__ __forceinline__ unsigned cvt4_fp8(float a, float b, float c, float d) {
    int r = 0;
    r = __builtin_amdgcn_cvt_pk_fp8_f32(__builtin_amdgcn_fmed3f(a, -448.f, 448.f), __builtin_amdgcn_fmed3f(b, -448.f, 448.f), r, false);
    r = __builtin_amdgcn_cvt_pk_fp8_f32(__builtin_amdgcn_fmed3f(c, -448.f, 448.f), __builtin_amdgcn_fmed3f(d, -448.f, 448.f), r, true);
    return (unsigned)r;
}
struct EpiSwiglu8 {
    static constexpr bool PERM = true, AFTER_DRAIN = false;
    unsigned char* H; int ldh; const float* bias; int bias_estride; float ascale, hscale;
    __device__ __forceinline__ void operator()(const f32x4 (&acc)[2][2][4][2], const Unit& u, int wr, int wc, int fr, int fq) const {
        const int row0 = u.pm * BM + wr * 64 + fr; const int col0 = u.pn * BM + wc * 32 + 8 * fq;
        f32x4 bv[2][2];
#pragma unroll
        for (int bj = 0; bj < 2; ++bj)
#pragma unroll
            for (int n = 0; n < 2; ++n) bv[bj][n] = *(const f32x4*)(bias + (size_t)u.e * bias_estride + col0 + bj * HALF + 4 * n);
#pragma unroll
        for (int ai = 0; ai < 2; ++ai)
#pragma unroll
            for (int m = 0; m < 4; ++m) { unsigned char* rowp = H + (size_t)(row0 + ai * HALF + m * 16) * ldh + (col0 >> 1);
#pragma unroll
                for (int bj = 0; bj < 2; ++bj) { const f32x4 v0 = acc[ai][bj][m][0] * ascale + bv[bj][0], v1 = acc[ai][bj][m][1] * ascale + bv[bj][1];
                    *(unsigned*)(rowp + bj * (HALF / 2)) = cvt4_fp8(hscale * swiglu1(v0[0], v0[1]), hscale * swiglu1(v0[2], v0[3]), hscale * swiglu1(v1[0], v1[1]), hscale * swiglu1(v1[2], v1[3])); } }
    }
};
struct EpiBf16S {
    static constexpr bool PERM = true, AFTER_DRAIN = false;
    bf16_t* O; int ldc; const float* bias; int bias_estride; float ascale;
    __device__ __forceinline__ void operator()(const f32x4 (&acc)[2][2][4][2], const Unit& u, int wr, int wc, int fr, int fq) const {
        const int row0 = u.pm * BM + wr * 64 + fr; const int col0 = u.pn * BM + wc * 32 + 8 * fq;
        f32x4 bv[2][2];
#pragma unroll
        for (int bj = 0; bj < 2; ++bj)
#pragma unroll
            for (int n = 0; n < 2; ++n) bv[bj][n] = *(const f32x4*)(bias + (size_t)u.e * bias_estride + col0 + bj * HALF + 4 * n);
#pragma unroll
        for (int ai = 0; ai < 2; ++ai)
#pragma unroll
            for (int m = 0; m < 4; ++m) { bf16_t* rowp = O + (size_t)(row0 + ai * HALF + m * 16) * ldc + col0;
#pragma unroll
                for (int bj = 0; bj < 2; ++bj) { const f32x4 v0 = acc[ai][bj][m][0] * ascale + bv[bj][0], v1 = acc[ai][bj][m][1] * ascale + bv[bj][1];
                    u32x4 w; w.x = cvt_pk_bf16(v0[0], v0[1]); w.y = cvt_pk_bf16(v0[2], v0[3]); w.z = cvt_pk_bf16(v1[0], v1[1]); w.w = cvt_pk_bf16(v1[2], v1[3]);
                    *(u32x4*)(rowp + bj * HALF) = w; } }
    }
};

typedef int v8i32 __attribute__((ext_vector_type(8)));
typedef short bf16x16 __attribute__((ext_vector_type(16)));
template <class Epi, class Sched, bool ALIGN_EPI = false, bool SP2 = false, bool FP8 = false, bool GATHER = false>
__device__ __forceinline__ void gemm_phase(PG8_LAS unsigned char* lds, const Gemm g, const Sched& S, const Epi& E) {
    const int tid = threadIdx.x, wid = __builtin_amdgcn_readfirstlane(tid >> 6), lane = tid & 63, wr = wid >> 2, wc = wid & 3, fr = lane & 15, fq = lane >> 4;
    const int K = g.K, nt = K / BK;
    unsigned voffA[2], voffB[2];
#pragma unroll
    for (int i = 0; i < 2; ++i) { int R, C; stage_rc(tid * 16 + i * 8192, R, C); const int Rb = Epi::PERM ? ((R & ~31) + perm32(R & 31)) : R;
        voffA[i] = (unsigned)(R * K + C) * 2u; voffB[i] = (unsigned)(Rb * K + C) * 2u; }
    unsigned gAc[2][2], gAn[2][2];
#define PG8_GLOAD(dst, uidx) do { _Pragma("unroll") for (int _h = 0; _h < 2; ++_h) _Pragma("unroll") for (int _i = 0; _i < 2; ++_i) { int _R, _C; stage_rc(tid * 16 + _i * 8192, _R, _C); \
        dst[_h][_i] = (unsigned)S.rowtab[(uidx) * 256 + _h * HALF + _R] * (unsigned)(K * 2) + (unsigned)_C * 2u; } } while (0)
    const size_t kstep = (size_t)(BK * 2);
    const size_t hstep = (size_t)HALF * K * 2;
    const size_t tstep = 2 * hstep;
    const unsigned ldsw = (unsigned)wid * 1024u;
    const int fcol = FP8 ? (32 * (fq >> 1) + 16 * (fq & 1)) : fq * 8;
    const int aoff = lds_byte(wr * 64 + fr, fcol), boff = lds_byte(wc * 32 + fr, fcol);
    constexpr int KSTR = FP8 ? 16 : 1024;
#define PG8_SA(b, h) (((b) * 2 + (h)) * HTB)
#define PG8_SB(b, h) ((4 + (b) * 2 + (h)) * HTB)
#define PG8_STAGE(bufoff, gbase, voff) do { _Pragma("unroll") for (int _i = 0; _i < 2; ++_i) \
        __builtin_amdgcn_global_load_lds((const unsigned*)((const char*)(gbase) + (voff)[_i]), (PG8_LAS unsigned*)(lds + (bufoff) + ldsw + _i * 8192), 16, 0, 0); } while (0)
#define PG8_RD(dst, addr) do { if constexpr (FP8) { const u32x4 _lo = *(const PG8_LAS u32x4*)(addr), _hi = *(const PG8_LAS u32x4*)((addr) + 16); \
        (dst)[0] = (frag_t)__builtin_bit_cast(v8i32, __builtin_shufflevector(_lo, _hi, 0, 1, 2, 3, 4, 5, 6, 7)); } \
    else { (dst)[0] = (frag_t)*(const PG8_LAS bf16x8*)(addr); (dst)[NKF - 1] = (frag_t)*(const PG8_LAS bf16x8*)((addr) + 1024); } } while (0)
#define PG8_STAGE_A(bufoff, abase, h, nx) do { if constexpr (GATHER) { unsigned _g[2] = {(nx) ? gAn[h][0] : gAc[h][0], (nx) ? gAn[h][1] : gAc[h][1]}; PG8_STAGE(bufoff, abase, _g); } \
        else { PG8_STAGE(bufoff, (abase) + (h) * hstep, voffA); } } while (0)
#define PG8_LDA(dst, b, h) do { _Pragma("unroll") for (int m = 0; m < 4; ++m) PG8_RD(dst[m], lds + PG8_SA(b, h) + aoff + m * 2048); } while (0)
#define PG8_LDB(dst, b, h) do { _Pragma("unroll") for (int n = 0; n < 2; ++n) PG8_RD(dst[n], lds + PG8_SB(b, h) + boff + n * 2048); } while (0)
#define PG8_MMA(ai, bj, At, Bt) do { __builtin_amdgcn_s_setprio(1); _Pragma("unroll") for (int m = 0; m < 4; ++m) _Pragma("unroll") for (int n = 0; n < 2; ++n) { \
        if constexpr (FP8) asm volatile("v_mfma_f32_16x16x128_f8f6f4 %0, %1, %2, %0" : "+v"(acc[ai][bj][m][n]) : "v"(Bt[n][0]), "v"(At[m][0])); \
        else { _Pragma("unroll") for (int k = 0; k < NKF; ++k) acc[ai][bj][m][n] = __builtin_amdgcn_mfma_f32_16x16x32_bf16((bf16x8)Bt[n][k], (bf16x8)At[m][k], acc[ai][bj][m][n], 0, 0, 0); } } \
        __builtin_amdgcn_s_setprio(0); } while (0)
#define PG8_WAIT_V(n) asm volatile("s_waitcnt vmcnt(" #n ")" ::: "memory")
#define PG8_WAIT_L(n) asm volatile("s_waitcnt lgkmcnt(" #n ")" ::: "memory")
#define PG8_BAR __builtin_amdgcn_s_barrier()
#define PG8_SCHED __builtin_amdgcn_sched_barrier(0)
    Unit cur, nxt; int ui = 0;
    if (!S.next(0, cur)) return;
    f32x4 acc[2][2][4][2];
#pragma unroll
    for (int a = 0; a < 2; ++a)
#pragma unroll
        for (int b = 0; b < 2; ++b)
#pragma unroll
            for (int m = 0; m < 4; ++m)
#pragma unroll
                for (int n = 0; n < 2; ++n) acc[a][b][m][n] = (f32x4){0.f, 0.f, 0.f, 0.f};
    typedef typename std::conditional<FP8, v8i32, bf16x8>::type frag_t; constexpr int NKF = FP8 ? 1 : 2;
    frag_t At[4][NKF], B0[2][NKF], B1[2][NKF];
    const char* cA = (const char*)g.A + (GATHER ? (size_t)0 : (size_t)cur.pm * tstep); const char* cB = (const char*)g.Bt + (size_t)cur.bt * tstep;
    S.a_ready(cur);
    if constexpr (GATHER) { PG8_GLOAD(gAc, 0); }
    if constexpr (SP2) {
        PG8_STAGE(PG8_SB(0, 0), cB, voffB); PG8_STAGE(PG8_SB(0, 1), cB + hstep, voffB); PG8_STAGE_A(PG8_SA(0, 0), cA, 0, false); PG8_STAGE_A(PG8_SA(0, 1), cA, 1, false);
        if (wr == 1) PG8_BAR;
        PG8_WAIT_V(2); PG8_BAR;
        PG8_STAGE(PG8_SB(1, 0), cB + kstep, voffB); PG8_STAGE_A(PG8_SA(1, 0), cA + kstep, 0, false); PG8_STAGE(PG8_SB(1, 1), cB + hstep + kstep, voffB);
        PG8_WAIT_V(6); PG8_BAR;
    } else {
        PG8_STAGE(PG8_SB(0, 0), cB, voffB); PG8_STAGE_A(PG8_SA(0, 0), cA, 0, false); PG8_STAGE(PG8_SB(0, 1), cB + hstep, voffB); PG8_STAGE_A(PG8_SA(0, 1), cA, 1, false);
        if (wr == 1) PG8_BAR;
        PG8_WAIT_V(4); PG8_BAR;
        PG8_STAGE(PG8_SB(1, 0), cB + kstep, voffB); PG8_STAGE_A(PG8_SA(1, 0), cA + kstep, 0, false); PG8_STAGE(PG8_SB(1, 1), cB + hstep + kstep, voffB);
        PG8_WAIT_V(6); PG8_BAR;
    }
    for (;;) {
        const bool has_next = S.next(ui + 1, nxt);
        const char* nA = (has_next && !GATHER) ? (const char*)g.A + (size_t)nxt.pm * tstep : cA;
        if constexpr (GATHER) { if (has_next) { PG8_GLOAD(gAn, ui + 1); } else { gAn[0][0] = gAc[0][0]; gAn[0][1] = gAc[0][1]; gAn[1][0] = gAc[1][0]; gAn[1][1] = gAc[1][1]; } } const char* nB = has_next ? (const char*)g.Bt + (size_t)nxt.bt * tstep : cB;
        for (int t = 0; t < nt; t += 2) {
            const bool last = (t == nt - 2);
            const char* a1 = cA + (size_t)(t + 1) * kstep;
            const char* a2 = last ? nA : cA + (size_t)(t + 2) * kstep; const char* b2 = last ? nB : cB + (size_t)(t + 2) * kstep;
            const char* a3 = a2 + kstep; const char* b3 = b2 + kstep;
            if (last && has_next) S.a_ready(nxt);
            if constexpr (SP2) {
            PG8_LDB(B0, 0, 0); PG8_LDB(B1, 0, 1); PG8_SCHED; PG8_LDA(At, 0, 0); PG8_STAGE_A(PG8_SA(1, 1), a1, 1, false);
            PG8_WAIT_V(8); PG8_WAIT_L(0); PG8_BAR; PG8_MMA(0, 0, At, B0); PG8_MMA(0, 1, At, B1); PG8_BAR; PG8_SCHED;
            PG8_LDA(At, 0, 1); PG8_STAGE(PG8_SB(0, 0), b2, voffB); PG8_STAGE(PG8_SB(0, 1), b2 + hstep, voffB); PG8_STAGE_A(PG8_SA(0, 0), a2, 0, last);
            PG8_WAIT_V(8); PG8_WAIT_L(0); PG8_BAR; PG8_MMA(1, 0, At, B0); PG8_MMA(1, 1, At, B1); PG8_BAR; PG8_SCHED;
            PG8_LDB(B0, 1, 0); PG8_LDB(B1, 1, 1); PG8_SCHED; PG8_LDA(At, 1, 0); PG8_STAGE_A(PG8_SA(0, 1), a2, 1, last);
            PG8_WAIT_V(8); PG8_WAIT_L(0); PG8_BAR; PG8_MMA(0, 0, At, B0); PG8_MMA(0, 1, At, B1); PG8_BAR; PG8_SCHED;
            PG8_LDA(At, 1, 1); PG8_STAGE(PG8_SB(1, 0), b3, voffB); PG8_STAGE(PG8_SB(1, 1), b3 + hstep, voffB); PG8_STAGE_A(PG8_SA(1, 0), a3, 0, last);
            PG8_WAIT_V(8); PG8_WAIT_L(0); PG8_BAR; PG8_MMA(1, 0, At, B0); PG8_MMA(1, 1, At, B1); PG8_BAR; PG8_SCHED;
            } else {
            PG8_LDB(B0, 0, 0); PG8_SCHED; PG8_LDA(At, 0, 0); PG8_STAGE_A(PG8_SA(1, 1), a1, 1, false);
            PG8_WAIT_L(8); PG8_BAR; PG8_WAIT_L(0); PG8_MMA(0, 0, At, B0); PG8_BAR; PG8_SCHED;
            PG8_LDB(B1, 0, 1); PG8_STAGE(PG8_SB(0, 0), b2, voffB);
            PG8_BAR; PG8_WAIT_L(0); PG8_MMA(0, 1, At, B1); PG8_BAR;
            PG8_LDA(At, 0, 1); PG8_STAGE_A(PG8_SA(0, 0), a2, 0, last);
            PG8_BAR; PG8_WAIT_L(0); PG8_MMA(1, 0, At, B0); PG8_BAR; PG8_SCHED;
            PG8_STAGE(PG8_SB(0, 1), b2 + hstep, voffB);
            PG8_WAIT_V(6); PG8_BAR; PG8_MMA(1, 1, At, B1); PG8_BAR;
            PG8_LDB(B0, 1, 0); PG8_SCHED; PG8_LDA(At, 1, 0); PG8_STAGE_A(PG8_SA(0, 1), a2, 1, last);
            PG8_WAIT_L(8); PG8_BAR; PG8_WAIT_L(0); PG8_MMA(0, 0, At, B0); PG8_BAR; PG8_SCHED;
            PG8_LDB(B1, 1, 1); PG8_STAGE(PG8_SB(1, 0), b3, voffB);
            PG8_BAR; PG8_WAIT_L(0); PG8_MMA(0, 1, At, B1); PG8_BAR;
            PG8_LDA(At, 1, 1); PG8_STAGE_A(PG8_SA(1, 0), a3, 0, last);
            PG8_BAR; PG8_WAIT_L(0); PG8_MMA(1, 0, At, B0); PG8_BAR; PG8_SCHED;
            PG8_STAGE(PG8_SB(1, 1), b3 + hstep, voffB);
            PG8_WAIT_V(6); PG8_BAR; PG8_MMA(1, 1, At, B1); PG8_BAR;
            }
        }
        if constexpr (ALIGN_EPI) { if (wr == 0) PG8_BAR; }
        if constexpr (FP8) asm volatile("s_nop 15\n\ts_nop 15" ::: "memory");
        if constexpr (!Epi::AFTER_DRAIN) { E(acc, cur, wr, wc, fr, fq); S.done(cur); }
        if (!has_next) break;
#pragma unroll
        for (int a = 0; a < 2; ++a)
#pragma unroll
            for (int b = 0; b < 2; ++b)
#pragma unroll
                for (int m = 0; m < 4; ++m)
#pragma unroll
                    for (int n = 0; n < 2; ++n) acc[a][b][m][n] = (f32x4){0.f, 0.f, 0.f, 0.f};
        cur = nxt; cA = nA; cB = nB; ++ui;
        if constexpr (GATHER) { gAc[0][0] = gAn[0][0]; gAc[0][1] = gAn[0][1]; gAc[1][0] = gAn[1][0]; gAc[1][1] = gAn[1][1]; }
        if constexpr (ALIGN_EPI) { if (wr == 1) PG8_BAR; }
    }
    PG8_WAIT_V(0);
    if constexpr (!ALIGN_EPI) { if (wr == 0) PG8_BAR; }
    PG8_BAR;
    if constexpr (Epi::AFTER_DRAIN) { E.fused(acc, cur, wr, wc, fr, fq, lds, wid, lane); S.done(cur); }
#undef PG8_SA
#undef PG8_SB
#undef PG8_STAGE
#undef PG8_STAGE_A
#undef PG8_GLOAD
#undef PG8_LDA
#undef PG8_LDB
#undef PG8_MMA
#undef PG8_RD
#undef PG8_WAIT_V
#undef PG8_WAIT_L
#undef PG8_BAR
#undef PG8_SCHED
}
}

constexpr int NWAVES = 8;
constexpr int NBATCH = 4, SEQ = 2048, T = NBATCH * SEQ, D = 2048, HD = 128, NHG = 8, GW = 1024, NQKV = 6144, NE = 32, TOPK = 4, FF = 2048, FF2 = 4096;
constexpr int MAXBLK = 160;
constexpr float EPS = 1e-6f;
constexpr int NPHASE = 11;
constexpr float WSCALE = 512.0f, XSCALE = 16.0f, HSCALE = 4.0f;

constexpr size_t MiB = 1u << 20;
constexpr size_t WS_CTL = 0, CTL_ZERO_BYTES = 1 * MiB;
constexpr size_t WS_SLOTTOK = 512 * 1024;
constexpr size_t WS_MODP = 1 * MiB;
constexpr size_t WS_TOPI = 5 * MiB, WS_TOPG = WS_TOPI + 131072, WS_TSLOT = WS_TOPG + 131072;
constexpr size_t WS_TRANK = WS_TSLOT + 131072, WS_HIST = WS_TRANK + 131072;
constexpr size_t WS_LSE = 6 * MiB;
constexpr size_t WS_WIN_T = 8 * MiB;
constexpr size_t WS_WO_T = 32 * MiB;
constexpr size_t WS_HMIX = 40 * MiB;
constexpr size_t WS_AOUT = 72 * MiB;
constexpr size_t WS_PROJ = 104 * MiB;
constexpr size_t WS_ONA = 200 * MiB;
constexpr size_t WS_ODIL = 232 * MiB;
constexpr size_t WS_MIXED = 328 * MiB;
constexpr size_t WS_X1 = 392 * MiB;
constexpr size_t WS_HFFN = 456 * MiB;
constexpr size_t WS_XG = 492 * MiB;
constexpr size_t WS_HB = 652 * MiB;
constexpr size_t WS_YB = 812 * MiB;
constexpr size_t WS_WEI_T = 1024 * MiB;
constexpr size_t WS_WEO_T = 1536 * MiB;
constexpr size_t WS_END = 1792 * MiB;
constexpr int CW_TMO = 0, CW_CODE = 1, CW_CNT = 256, CW_CUR = 512, CW_BAR = 4096;

constexpr int RING_OFF = 0, RING_BYTES = 155648;
constexpr int MISC_OFF = RING_BYTES;
constexpr int LDS_BYTES = RING_BYTES + 1024;

#define GAS __attribute__((address_space(1)))
#define LAS __attribute__((address_space(3)))
typedef unsigned short bf16;
typedef unsigned v4u __attribute__((ext_vector_type(4)));
typedef unsigned v2u __attribute__((ext_vector_type(2)));
typedef float f32x4 __attribute__((ext_vector_type(4)));
typedef GAS unsigned gu32;
#define RLX_AGENT __ATOMIC_RELAXED, __HIP_MEMORY_SCOPE_AGENT
#define LDS_WAIT() asm volatile("s_waitcnt lgkmcnt(0)" ::: "memory")
#define VM_WAIT() asm volatile("s_waitcnt vmcnt(0)" ::: "memory")
__device__ __forceinline__ float bf2f(unsigned short h) { return __builtin_bit_cast(float, (unsigned)h << 16); }
__device__ __forceinline__ float bflo(unsigned w) { return __builtin_bit_cast(float, w << 16); }
__device__ __forceinline__ float bfhi(unsigned w) { return __builtin_bit_cast(float, w & 0xffff0000u); }
__device__ __forceinline__ unsigned pk2(float lo, float hi) { return pg8::cvt_pk_bf16(lo, hi); }
__device__ __forceinline__ f32x4 ld4bf(const unsigned short* p) { const v2u w = *(const v2u*)p; return (f32x4){bflo(w.x), bfhi(w.x), bflo(w.y), bfhi(w.y)}; }

#define XB_TMO      128
#define XB_XCNT(j)  (256  + 64 * (j))
#define XB_XSUB(j)  (1280 + 64 * (j))
#define XB_XGEN(j)  (2304 + 64 * (j))
#define XB_TOP      3328
#define XB_TOPGEN   3392
#define XCD_BAR_WORDS 3456
#define XB_SPIN_CAP (1u << 18)
__device__ __forceinline__ unsigned xb_ld(unsigned* p)              { return __hip_atomic_load(p, __ATOMIC_RELAXED, __HIP_MEMORY_SCOPE_AGENT); }
__device__ __forceinline__ unsigned xb_add(unsigned* p, unsigned v) { return __hip_atomic_fetch_add(p, v, __ATOMIC_RELAXED, __HIP_MEMORY_SCOPE_AGENT); }
__device__ __forceinline__ unsigned xb_xcc_id() { return (unsigned)__builtin_amdgcn_s_getreg((3 << 11) | 20) & 0xFu; }
#define XB_SPIN(cond, bar) do { unsigned _sp = 0; while (cond) { __builtin_amdgcn_s_sleep(1); \
    if ((++_sp & 255u) == 0u) { if (xb_ld(&(bar)[XB_TMO])) break; if (_sp > XB_SPIN_CAP) { atomicAdd(&(bar)[XB_TMO], 1u); break; } } } } while (0)
struct XcdBarrier { unsigned* bar; unsigned x; volatile LAS unsigned* st; };
__device__ __forceinline__ XcdBarrier xcd_barrier_post(unsigned* bar, volatile LAS unsigned* st) {
    XcdBarrier b; b.bar = bar; b.x = xb_xcc_id(); b.st = st;
    if (threadIdx.x == 0) (void)xb_add(&bar[XB_XCNT(b.x)], 1u);
    return b;
}
__device__ __forceinline__ void xcd_barrier_complete(unsigned* bar, unsigned x, unsigned& nloc, unsigned& nx) {
    const unsigned G = gridDim.x * gridDim.y * gridDim.z;
    unsigned sum, cnt, mine, sp = 0u;
    for (;;) {
        sum = 0u; cnt = 0u; mine = 0u;
#pragma unroll
        for (unsigned j = 0; j < 16; ++j) { const unsigned c = xb_ld(&bar[XB_XCNT(j)]); sum += c; cnt += (c > 0u) ? 1u : 0u; mine = (j == x) ? c : mine; }
        if (sum == G) break;
        __builtin_amdgcn_s_sleep(1);
        if ((++sp & 255u) == 0u) { if (xb_ld(&bar[XB_TMO])) break; if (sp > XB_SPIN_CAP) { atomicAdd(&bar[XB_TMO], 1u); break; } }
    }
    nloc = mine > 0u ? mine : 1u; nx = cnt > 0u ? cnt : 1u;
}
__device__ __forceinline__ void xcd_barrier(const XcdBarrier& b) {
    asm volatile("s_waitcnt vmcnt(0)" ::: "memory");
    __syncthreads();
    if (threadIdx.x == 0) {
        unsigned* bar = b.bar;
        __builtin_amdgcn_s_waitcnt(0);
        unsigned nloc = b.st[0], nx = b.st[1];
        if (nloc == 0u) { xcd_barrier_complete(bar, b.x, nloc, nx); b.st[0] = nloc; b.st[1] = nx; }
        const unsigned old = xb_add(&bar[XB_XSUB(b.x)], 1u);
        const unsigned gen = old / nloc;
        if (old + 1u == (gen + 1u) * nloc) {
            __builtin_amdgcn_fence(__ATOMIC_RELEASE, "agent");
            asm volatile("s_waitcnt vmcnt(0)" ::: "memory");
            const unsigned og = xb_add(&bar[XB_TOP], 1u);
            const unsigned tg = og / nx;
            if (og + 1u == (tg + 1u) * nx) xb_add(&bar[XB_TOPGEN], 1u);
            else XB_SPIN(xb_ld(&bar[XB_TOPGEN]) == tg, bar);
            __builtin_amdgcn_fence(__ATOMIC_ACQUIRE, "agent");
            xb_add(&bar[XB_XGEN(b.x)], 1u);
            asm volatile("s_waitcnt vmcnt(0)" ::: "memory");
        } else {
            XB_SPIN(xb_ld(&bar[XB_XGEN(b.x)]) == gen, bar);
            __builtin_amdgcn_fence(__ATOMIC_ACQUIRE, "agent");
            asm volatile("s_waitcnt vmcnt(0)" ::: "memory");
        }
    }
    __syncthreads();
}

struct Frame {
    LAS unsigned char* lds;
    volatile LAS unsigned* MISC;
    unsigned* ctl;
    int tid, lane, wave, vcu, G;
    const float *x, *c, *w_ada, *b_ada, *g_pre_mix, *g_post_mix, *w_in, *rpb, *t5, *g_out_na, *g_out_dil, *w_o, *g_pre_ffn, *g_post_ffn, *w_router, *b_router, *w_e_in, *b_e_in, *w_e_out, *b_e_out;
    float* out;
    unsigned char* ws;
};
__device__ __forceinline__ float wave_sum(float v) {
#pragma unroll
    for (int o = 1; o < 64; o <<= 1) v += __shfl_xor(v, o);
    return v;
}
__device__ __forceinline__ float wave_max(float v) {
#pragma unroll
    for (int o = 1; o < 64; o <<= 1) v = fmaxf(v, __shfl_xor(v, o));
    return v;
}
__device__ __forceinline__ float mod_val(const Frame& F, int b, int idx) {
    const float* mp = (const float*)(F.ws + WS_MODP);
    float s = F.b_ada[idx];
#pragma unroll
    for (int ks = 0; ks < 16; ++ks) s += mp[(size_t)(ks * 4 + b) * (6 * D) + idx];
    return s;
}

__constant__ unsigned char T5B[3][132] = {
 {11,11,11,11,11,11,11,11,11,11,11,11,11,11,11,10,10,10,10,10,10,10,10,10,10,10,10,10,10,10,10,10,10,10,10,10,10,10,9,9,9,9,9,9,9,9,9,9,9,9,8,8,8,8,8,8,8,7,6,5,4,3,2,1,0,17,18,19,20,21,22,23,24,24,24,24,24,24,24,25,25,25,25,25,25,25,25,25,25,25,25,26,26,26,26,26,26,26,26,26,26,26,26,26,26,26,26,26,26,26,26,26,26,26,27,27,27,27,27,27,27,27,27,27,27,27,27,27,27,0,0,0},
 {13,13,13,13,13,13,13,13,13,13,13,13,13,13,13,13,13,13,13,13,13,13,13,12,12,12,12,12,12,12,12,12,12,12,12,12,12,12,12,12,12,12,11,11,11,11,11,11,11,11,11,11,10,10,10,10,10,10,9,9,9,8,8,4,0,20,24,24,25,25,25,26,26,26,26,26,26,27,27,27,27,27,27,27,27,27,27,28,28,28,28,28,28,28,28,28,28,28,28,28,28,28,28,28,28,28,29,29,29,29,29,29,29,29,29,29,29,29,29,29,29,29,29,29,29,29,29,29,29,0,0,0},
 {15,15,15,15,15,15,15,15,15,15,15,15,15,15,15,15,15,15,15,15,15,15,15,15,15,15,15,15,15,15,14,14,14,14,14,14,14,14,14,14,14,14,14,14,14,13,13,13,13,13,13,13,13,13,12,12,12,12,12,11,11,10,10,9,0,25,26,26,27,27,28,28,28,28,28,29,29,29,29,29,29,29,29,29,30,30,30,30,30,30,30,30,30,30,30,30,30,30,30,31,31,31,31,31,31,31,31,31,31,31,31,31,31,31,31,31,31,31,31,31,31,31,31,31,31,31,31,31,31,0,0,0}};

__device__ __forceinline__ void p0_mod_item(Frame& F, int j) {
    const int ks = j >> 4, cb = j & 15;
    LAS float* sc = (LAS float*)(F.lds + RING_OFF);
    LAS float* red = (LAS float*)(F.lds + RING_OFF + 4096);
    __syncthreads();
    { const int b = F.tid >> 7, k = F.tid & 127; const float cv = F.c[b * D + ks * 128 + k]; sc[F.tid] = cv / (1.0f + __expf(-cv)); }
    __syncthreads();
    const int cg = F.tid % 192, sub = F.tid / 192;
    f32x4 acc[4];
#pragma unroll
    for (int b = 0; b < 4; ++b) acc[b] = (f32x4){0.f, 0.f, 0.f, 0.f};
    if (sub < 2) {
        const float* wp = F.w_ada + (size_t)(ks * 128 + sub * 64) * (6 * D) + cb * 768 + 4 * cg;
#pragma unroll 8
        for (int i = 0; i < 64; ++i) {
            const f32x4 w = *(const f32x4*)(wp + (size_t)i * (6 * D));
#pragma unroll
            for (int b = 0; b < 4; ++b) { const float s = sc[b * 128 + sub * 64 + i]; acc[b] += w * s; }
        }
        if (sub == 1) {
#pragma unroll
            for (int b = 0; b < 4; ++b) *(LAS f32x4*)(red + cg * 16 + b * 4) = acc[b];
        }
    }
    __syncthreads();
    if (sub == 0) {
        float* mp = (float*)(F.ws + WS_MODP);
#pragma unroll
        for (int b = 0; b < 4; ++b) { const f32x4 o = acc[b] + *(LAS f32x4*)(red + cg * 16 + b * 4); *(f32x4*)(mp + (size_t)(ks * 4 + b) * (6 * D) + cb * 768 + 4 * cg) = o; }
    }
}
__device__ __forceinline__ void p0_transpose_item(const float* W, int K, int N, bf16* WT, LAS float* scr, int item, int lane) {
    const int nblk = N >> 6, kb = item / nblk, nb = item - kb * nblk, k0 = kb << 6, n0 = nb << 6;
    const float* src = W + (size_t)(k0 + (lane >> 4)) * N + n0 + 4 * (lane & 15);
    f32x4 v[16];
#pragma unroll
    for (int i = 0; i < 16; ++i) v[i] = *(const f32x4*)(src + (size_t)(4 * i) * N);
#pragma unroll
    for (int i = 0; i < 16; ++i) { LAS float* d = scr + (4 * i + (lane >> 4)) * 65 + 4 * (lane & 15); d[0] = v[i][0]; d[1] = v[i][1]; d[2] = v[i][2]; d[3] = v[i][3]; }
    LDS_WAIT();
    const int c = lane >> 3;
#pragma unroll
    for (int jn = 0; jn < 8; ++jn) { const int n = (lane & 7) + 8 * jn; const LAS float* s = scr + (8 * c) * 65 + n;
        v4u o; o.x = pk2(s[0 * 65], s[1 * 65]); o.y = pk2(s[2 * 65], s[3 * 65]); o.z = pk2(s[4 * 65], s[5 * 65]); o.w = pk2(s[6 * 65], s[7 * 65]);
        *(v4u*)(WT + (size_t)(n0 + n) * K + k0 + 8 * c) = o; }
    LDS_WAIT();
}
constexpr int I_EI1 = (D / 128) * (FF2 / 32), I_EO1 = (FF / 128) * (D / 32), I_EI = NE * I_EI1, I_EO = NE * I_EO1, CONV8_ITEMS = I_EI + I_EO;
constexpr int CONV_Q = 65536, QKV_GEMM_WGS = 128, CONV_Q5 = 28672, WO_GEMM_WGS = 128;
struct Conv8 { const float* src; unsigned char* dst; int N; };
__device__ __forceinline__ Conv8 conv8_item(const Frame& F, int r, int lane) {
    Conv8 c; const float* W; unsigned char* WT; int it;
    if (r < I_EI) { const int e = r / I_EI1; it = r - e * I_EI1; c.N = FF2; W = F.w_e_in + (size_t)e * D * FF2; WT = F.ws + WS_WEI_T + (size_t)e * FF2 * D; }
    else { r -= I_EI; const int e = r / I_EO1; it = r - e * I_EO1; c.N = D; W = F.w_e_out + (size_t)e * FF * D; WT = F.ws + WS_WEO_T + (size_t)e * D * FF; }
    const int nblk = c.N >> 5, kb = it / nblk, nb = it - kb * nblk, k0 = (kb << 7) + 16 * (lane >> 3), n0 = (nb << 5) + 4 * (lane & 7);
    c.src = W + (size_t)k0 * c.N + n0; c.dst = WT + (size_t)n0 * 2048 + k0;
    return c;
}
__device__ __forceinline__ void conv8_load(const Conv8& c, f32x4 (&v)[16]) {
#pragma unroll
    for (int i = 0; i < 16; ++i) v[i] = *(const f32x4*)(c.src + (size_t)i * c.N);
}
__device__ __forceinline__ void conv8_finish(const f32x4 (&v)[16], unsigned char* dst, LAS float*, int) {
#pragma unroll
    for (int e = 0; e < 4; ++e) { v4u o;
        o.x = pg8::cvt4_fp8(v[0][e] * WSCALE, v[1][e] * WSCALE, v[2][e] * WSCALE, v[3][e] * WSCALE);
        o.y = pg8::cvt4_fp8(v[4][e] * WSCALE, v[5][e] * WSCALE, v[6][e] * WSCALE, v[7][e] * WSCALE);
        o.z = pg8::cvt4_fp8(v[8][e] * WSCALE, v[9][e] * WSCALE, v[10][e] * WSCALE, v[11][e] * WSCALE);
        o.w = pg8::cvt4_fp8(v[12][e] * WSCALE, v[13][e] * WSCALE, v[14][e] * WSCALE, v[15][e] * WSCALE);
        *(v4u*)(dst + (size_t)e * 2048) = o; }
}
__device__ __forceinline__ void conv8_run(Frame& F, LAS float* scr, int first, int stride, int last) {
    if (first >= last) return;
    f32x4 va[16], vb[16];
    Conv8 ca = conv8_item(F, first, F.lane), cb = ca;
    conv8_load(ca, va);
    for (int it = first; it < last; it += 2 * stride) {
        const bool hb = it + stride < last;
        if (hb) { cb = conv8_item(F, it + stride, F.lane); conv8_load(cb, vb); }
        conv8_finish(va, ca.dst, scr, F.lane);
        if (!hb) break;
        const bool ha = it + 2 * stride < last;
        if (ha) { ca = conv8_item(F, it + 2 * stride, F.lane); conv8_load(ca, va); }
        conv8_finish(vb, cb.dst, scr, F.lane);
        if (!ha) break;
    }
}
__device__ __forceinline__ void p0_prologue(Frame& F) {
    for (int j = F.vcu; j < 256; j += F.G) p0_mod_item(F, j);
    __syncthreads();
    LAS float* scr = (LAS float*)(F.lds + RING_OFF + F.wave * 16896);
    const int gw = F.vcu * NWAVES + F.wave, NGW = F.G * NWAVES;
    constexpr int I_IN = (D / 64) * (NQKV / 64), I_O = (D / 64) * (D / 64);
    for (int it = gw; it < I_IN + I_O; it += NGW) {
        if (it < I_IN) p0_transpose_item(F.w_in, D, NQKV, (bf16*)(F.ws + WS_WIN_T), scr, it, F.lane);
        else p0_transpose_item(F.w_o, D, D, (bf16*)(F.ws + WS_WO_T), scr, it - I_IN, F.lane);
    }
    conv8_run(F, scr, CONV_Q + CONV_Q5 + gw, NGW, CONV8_ITEMS);
}

__device__ __forceinline__ void p1_hmix(Frame& F) {
    LAS float* ta = (LAS float*)(F.lds + RING_OFF);
    LAS float* tb = ta + D;
    for (int rb = F.vcu; rb < T / 32; rb += F.G) {
        const int b = rb >> 6;
        __syncthreads();
        for (int col = F.tid; col < D; col += NWAVES * 64) { ta[col] = F.g_pre_mix[col] * (1.0f + mod_val(F, b, D + col)); tb[col] = mod_val(F, b, col); }
        __syncthreads();
        for (int rr = F.wave; rr < 32; rr += NWAVES) {
            const int row = rb * 32 + rr;
            const f32x4* xr = (const f32x4*)(F.x + (size_t)row * D) + F.lane;
            f32x4 v[8]; float ss = 0.f;
#pragma unroll
            for (int j = 0; j < 8; ++j) { v[j] = xr[64 * j]; ss += (v[j][0] * v[j][0] + v[j][1] * v[j][1]) + (v[j][2] * v[j][2] + v[j][3] * v[j][3]); }
            const float r = 1.0f / sqrtf(wave_sum(ss) * (1.0f / D) + EPS);
            v2u* o8 = (v2u*)((bf16*)(F.ws + WS_HMIX) + (size_t)row * D) + F.lane;
#pragma unroll
            for (int j = 0; j < 8; ++j) { const int col = 4 * F.lane + 256 * j; const f32x4 a = *(LAS f32x4*)(ta + col), s = *(LAS f32x4*)(tb + col);
                v2u w; w.x = pk2(v[j][0] * r * a[0] + s[0], v[j][1] * r * a[1] + s[1]); w.y = pk2(v[j][2] * r * a[2] + s[2], v[j][3] * r * a[3] + s[3]); o8[64 * j] = w; }
        }
    }
}

typedef short bf16x8v __attribute__((ext_vector_type(8)));
typedef short s16x4v __attribute__((ext_vector_type(4)));
typedef int v4i16_t_ __attribute__((ext_vector_type(2)));
__device__ __forceinline__ unsigned vimg_off(unsigned row, unsigned ch) { return 256u * row + 16u * (ch ^ (((row & 3u) << 2) | ((row >> 2) & 3u))); }
__device__ __forceinline__ s16x4v tr_read16(const LAS unsigned char* p) {
    typedef short v4i16 __attribute__((ext_vector_type(4)));
    return __builtin_bit_cast(s16x4v, __builtin_amdgcn_ds_read_tr16_b64_v4i16((LAS v4i16*)p));
}
struct GeoNA {
    int tok0, qbase, kbase, r, rs, c0, kc0; const float* rpb_h;
    static constexpr int QCOL = 0, KCOL = GW, VCOL = 2 * GW;
    __device__ __forceinline__ int qtok(int n16) const { return qbase + n16; }
    __device__ __forceinline__ int ktok(int c, int slot) const { return kbase + c * 64 + slot; }
    __device__ __forceinline__ float bias(int c, int slot, int n16) const {
        const int qc = c0 + n16, kc = kc0 + slot, cs = min(max(qc - 8, 0), 48);
        const bool valid = (kc >= cs) && (kc < cs + 16);
        const int dc = min(max(kc - qc + 15, 0), 30);
        const float bv = rpb_h[(rs + c - r + 7) * 31 + dc];
        return valid ? bv : -INFINITY;
    }
};
struct GeoDil {
    int tok0, rho, dsh, sub_len, l0, p, h; const float* t5;
    static constexpr int QCOL = 3 * GW, KCOL = 4 * GW, VCOL = 5 * GW;
    __device__ __forceinline__ int qtok(int n16) const { return tok0 + rho + ((l0 + n16) << dsh); }
    __device__ __forceinline__ int ktok(int c, int slot) const { const int l = min(max(l0 - 64 + 32 * c + slot, 0), sub_len - 1); return tok0 + rho + (l << dsh); }
    __device__ __forceinline__ float bias(int c, int slot, int n16) const {
        const int kk = 32 * c + slot, delta = kk - 64 - n16, l = l0 - 64 + kk;
        const bool valid = (delta >= -64) && (delta <= 64) && (l >= 0) && (l < sub_len);
        const int di = min(max(delta + 64, 0), 128);
        const float bv = t5[(int)T5B[p][di] * 8 + h];
        return valid ? bv : -INFINITY;
    }
};
template <int NCH, class Geo>
__device__ __forceinline__ void attn_item(const Geo& G, const bf16* proj, int hcol, LAS unsigned char* vimg, bf16* out, float* lse_out, int lane) {
    const int n16 = lane & 15, g = lane >> 4;
    const float scale_l2 = 0.08838834764831845f * 1.44269504089f;
    bf16x8v qf[4];
    { const bf16* qp = proj + (size_t)G.qtok(n16) * NQKV + Geo::QCOL + hcol + 8 * g;
#pragma unroll
      for (int s = 0; s < 4; ++s) qf[s] = *(const bf16x8v*)(qp + 32 * s); }
    f32x4 st[NCH][2];
#pragma unroll
    for (int c = 0; c < NCH; ++c)
#pragma unroll
        for (int t2 = 0; t2 < 2; ++t2) {
            const int slot = 8 * (n16 >> 2) + 4 * t2 + (n16 & 3);
            const bf16* kp = proj + (size_t)G.ktok(c, slot) * NQKV + Geo::KCOL + hcol + 8 * g;
            f32x4 acc = (f32x4){0.f, 0.f, 0.f, 0.f};
#pragma unroll
            for (int s = 0; s < 4; ++s) { const bf16x8v kf = *(const bf16x8v*)(kp + 32 * s); acc = __builtin_amdgcn_mfma_f32_16x16x32_bf16(kf, qf[s], acc, 0, 0, 0); }
            st[c][t2] = acc;
        }
    float mx = -INFINITY;
#pragma unroll
    for (int c = 0; c < NCH; ++c)
#pragma unroll
        for (int t2 = 0; t2 < 2; ++t2)
#pragma unroll
            for (int r = 0; r < 4; ++r) { const float bv = G.bias(c, 8 * g + 4 * t2 + r, n16); const float x = st[c][t2][r] * scale_l2 + bv * 1.44269504089f; st[c][t2][r] = x; mx = fmaxf(mx, x); }
    mx = fmaxf(mx, __shfl_xor(mx, 16)); mx = fmaxf(mx, __shfl_xor(mx, 32));
    float sum = 0.f;
    bf16x8v pf[NCH];
#pragma unroll
    for (int c = 0; c < NCH; ++c) {
        float pv[8];
#pragma unroll
        for (int t2 = 0; t2 < 2; ++t2)
#pragma unroll
            for (int r = 0; r < 4; ++r) { const float p = __builtin_amdgcn_exp2f(st[c][t2][r] - mx); pv[4 * t2 + r] = p; sum += p; }
        v4u w; w.x = pk2(pv[0], pv[1]); w.y = pk2(pv[2], pv[3]); w.z = pk2(pv[4], pv[5]); w.w = pk2(pv[6], pv[7]);
        pf[c] = __builtin_bit_cast(bf16x8v, w);
    }
    sum += __shfl_xor(sum, 16); sum += __shfl_xor(sum, 32);
    f32x4 oacc[8];
#pragma unroll
    for (int dt = 0; dt < 8; ++dt) oacc[dt] = (f32x4){0.f, 0.f, 0.f, 0.f};
    const int vr_row = lane >> 4, vr_ch = lane & 15;
    v4u vr[8];
#pragma unroll
    for (int i = 0; i < 8; ++i) vr[i] = *(const v4u*)(proj + (size_t)G.ktok(0, 4 * i + vr_row) * NQKV + Geo::VCOL + hcol + 8 * vr_ch);
    const unsigned q4 = (unsigned)(lane & 15) >> 2, pp = (unsigned)lane & 3u;
#pragma unroll
    for (int c = 0; c < NCH; ++c) {
        asm volatile("" ::: "memory");
#pragma unroll
        for (int i = 0; i < 8; ++i) *(LAS v4u*)(vimg + vimg_off((unsigned)(4 * i + vr_row), (unsigned)vr_ch)) = vr[i];
        asm volatile("" ::: "memory");
        if (c + 1 < NCH) {
#pragma unroll
            for (int i = 0; i < 8; ++i) vr[i] = *(const v4u*)(proj + (size_t)G.ktok(c + 1, 4 * i + vr_row) * NQKV + Geo::VCOL + hcol + 8 * vr_ch);
        }
#pragma unroll
        for (int dt = 0; dt < 8; ++dt) {
            const s16x4v lo = tr_read16(vimg + vimg_off((unsigned)(8 * g) + q4, (unsigned)(2 * dt) + (pp >> 1)) + 8u * (pp & 1u));
            const s16x4v hi = tr_read16(vimg + vimg_off((unsigned)(8 * g + 4) + q4, (unsigned)(2 * dt) + (pp >> 1)) + 8u * (pp & 1u));
            bf16x8v vf; vf[0] = lo[0]; vf[1] = lo[1]; vf[2] = lo[2]; vf[3] = lo[3]; vf[4] = hi[0]; vf[5] = hi[1]; vf[6] = hi[2]; vf[7] = hi[3];
            oacc[dt] = __builtin_amdgcn_mfma_f32_16x16x32_bf16(vf, pf[c], oacc[dt], 0, 0, 0);
        }
        asm volatile("" ::: "memory");
    }
    const float inv = 1.0f / sum;
    bf16* op = out + (size_t)G.qtok(n16) * GW + hcol + 4 * g;
#pragma unroll
    for (int dt = 0; dt < 8; ++dt) { const f32x4 o = oacc[dt] * inv; v2u w; w.x = pk2(o[0], o[1]); w.y = pk2(o[2], o[3]); *(v2u*)(op + 16 * dt) = w; }
    if (lse_out != nullptr && g == 0) lse_out[(size_t)G.qtok(n16) * 8 + (hcol >> 7)] = (mx + __builtin_amdgcn_logf(sum)) * 0.69314718056f;
}
__device__ __forceinline__ unsigned kimg_off(unsigned row, unsigned ch) { return 256u * row + 16u * (ch ^ (((row & 3u) << 2) | ((row >> 3) & 3u))); }
__device__ __forceinline__ void attn_dil_units(Frame& F) {
    LAS unsigned char* kimg = F.lds + RING_OFF;
    LAS unsigned char* vimg = F.lds + RING_OFF + 65536;
    LAS float* tb = (LAS float*)(F.lds + RING_OFF + 131072);
    const bf16* proj = (const bf16*)(F.ws + WS_PROJ);
    bf16* odil = (bf16*)(F.ws + WS_ODIL); float* lse = (float*)(F.ws + WS_LSE);
    const int lane = F.lane, n16 = lane & 15, g = lane >> 4, w = F.wave;
    const float scale_l2 = 0.08838834764831845f * 1.44269504089f;
    for (int u = F.vcu; u < 3 * NBATCH * 8 * 16; u += F.G) {
        const int p = u >> 9, b = (u >> 7) & 3, h = (u >> 4) & 7, grp = u & 15;
        const int dsh = 2 * p, sub_len = SEQ >> dsh, gpc = sub_len >> 7, rho = grp / gpc, l0g = (grp - rho * gpc) << 7, tok0 = b * SEQ + rho;
        __syncthreads();
        if (F.tid < 129) tb[F.tid] = F.t5[(int)T5B[p][F.tid] * 8 + h] * 1.44269504089f;
        { v4u kr[8], vr[8];
#pragma unroll
          for (int ps = 0; ps < 8; ++ps) { const int row = ps * 32 + (F.tid >> 4), ch = F.tid & 15; const int l = min(max(l0g - 64 + row, 0), sub_len - 1);
              const bf16* src = proj + (size_t)(tok0 + (l << dsh)) * NQKV + h * HD + 8 * ch;
              kr[ps] = *(const v4u*)(src + 4 * GW); vr[ps] = *(const v4u*)(src + 5 * GW); }
#pragma unroll
          for (int ps = 0; ps < 8; ++ps) { const unsigned row = ps * 32 + (F.tid >> 4), ch = F.tid & 15;
              *(LAS v4u*)(kimg + kimg_off(row, ch)) = kr[ps]; *(LAS v4u*)(vimg + vimg_off(row, ch)) = vr[ps]; } }
        __syncthreads();
        const int l0 = l0g + 16 * w, qtok = tok0 + ((l0 + n16) << dsh);
        bf16x8v qf[4];
        { const bf16* qp = proj + (size_t)qtok * NQKV + 3 * GW + h * HD + 8 * g;
#pragma unroll
          for (int s = 0; s < 4; ++s) qf[s] = *(const bf16x8v*)(qp + 32 * s); }
        f32x4 st[5][2];
#pragma unroll
        for (int c = 0; c < 5; ++c)
#pragma unroll
            for (int t2 = 0; t2 < 2; ++t2) {
                const unsigned row = (unsigned)(16 * w + 32 * c + 8 * (n16 >> 2) + 4 * t2 + (n16 & 3)) & 255u;
                f32x4 acc = (f32x4){0.f, 0.f, 0.f, 0.f};
#pragma unroll
                for (int s = 0; s < 4; ++s) { const bf16x8v kf = *(const LAS bf16x8v*)(kimg + kimg_off(row, (unsigned)(4 * s + g))); acc = __builtin_amdgcn_mfma_f32_16x16x32_bf16(kf, qf[s], acc, 0, 0, 0); }
                st[c][t2] = acc;
            }
        float mx = -INFINITY;
#pragma unroll
        for (int c = 0; c < 5; ++c)
#pragma unroll
            for (int t2 = 0; t2 < 2; ++t2)
#pragma unroll
                for (int r = 0; r < 4; ++r) { const int kk = 32 * c + 8 * g + 4 * t2 + r, delta = kk - 64 - n16, l = l0 - 64 + kk;
                    const bool valid = (delta >= -64) && (delta <= 64) && (l >= 0) && (l < sub_len);
                    const float bv = tb[min(max(delta + 64, 0), 128)];
                    const float x = valid ? st[c][t2][r] * scale_l2 + bv : -INFINITY; st[c][t2][r] = x; mx = fmaxf(mx, x); }
        mx = fmaxf(mx, __shfl_xor(mx, 16)); mx = fmaxf(mx, __shfl_xor(mx, 32));
        float sum = 0.f;
        bf16x8v pf[5];
#pragma unroll
        for (int c = 0; c < 5; ++c) {
            float pv[8];
#pragma unroll
            for (int t2 = 0; t2 < 2; ++t2)
#pragma unroll
                for (int r = 0; r < 4; ++r) { const float pe = __builtin_amdgcn_exp2f(st[c][t2][r] - mx); pv[4 * t2 + r] = pe; sum += pe; }
            v4u wv; wv.x = pk2(pv[0], pv[1]); wv.y = pk2(pv[2], pv[3]); wv.z = pk2(pv[4], pv[5]); wv.w = pk2(pv[6], pv[7]);
            pf[c] = __builtin_bit_cast(bf16x8v, wv);
        }
        sum += __shfl_xor(sum, 16); sum += __shfl_xor(sum, 32);
        f32x4 oacc[8];
#pragma unroll
        for (int dt = 0; dt < 8; ++dt) oacc[dt] = (f32x4){0.f, 0.f, 0.f, 0.f};
        const unsigned q4 = (unsigned)(lane & 15) >> 2, pp = (unsigned)lane & 3u;
#pragma unroll
        for (int c = 0; c < 5; ++c)
#pragma unroll
            for (int dt = 0; dt < 8; ++dt) {
                const unsigned rbase = ((unsigned)(16 * w + 32 * c + 8 * g) & 255u) + q4;
                const s16x4v lo = tr_read16(vimg + vimg_off(rbase, (unsigned)(2 * dt) + (pp >> 1)) + 8u * (pp & 1u));
                const s16x4v hi = tr_read16(vimg + vimg_off(rbase + 4u, (unsigned)(2 * dt) + (pp >> 1)) + 8u * (pp & 1u));
                bf16x8v vf; vf[0] = lo[0]; vf[1] = lo[1]; vf[2] = lo[2]; vf[3] = lo[3]; vf[4] = hi[0]; vf[5] = hi[1]; vf[6] = hi[2]; vf[7] = hi[3];
                oacc[dt] = __builtin_amdgcn_mfma_f32_16x16x32_bf16(vf, pf[c], oacc[dt], 0, 0, 0);
            }
        const float inv = 1.0f / sum;
        bf16* op = odil + ((size_t)p * T + qtok) * GW + h * HD + 4 * g;
#pragma unroll
        for (int dt = 0; dt < 8; ++dt) { const f32x4 o = oacc[dt] * inv; v2u wv; wv.x = pk2(o[0], o[1]); wv.y = pk2(o[2], o[3]); *(v2u*)(op + 16 * dt) = wv; }
        if (g == 0) lse[((size_t)p * T + qtok) * 8 + h] = (mx + __builtin_amdgcn_logf(sum)) * 0.69314718056f;
    }
    __syncthreads();
}
__device__ __forceinline__ void p3_attn_mfma(Frame& F) {
    attn_dil_units(F);
    LAS unsigned char* vimg = F.lds + RING_OFF + F.wave * 8192;
    const bf16* proj = (const bf16*)(F.ws + WS_PROJ);
    bf16* ona = (bf16*)(F.ws + WS_ONA);
    int lane = F.lane; asm volatile("" : "+v"(lane));
    const int gw = F.vcu * NWAVES + F.wave, NGW = F.G * NWAVES;
#pragma unroll 1
    for (int id = gw; id < NBATCH * 32 * 8 * 4; id += NGW) {
        const int qt = id & 3, h = (id >> 2) & 7, r = (id >> 5) & 31, b = id >> 10;
        GeoNA G; G.tok0 = b * SEQ; G.r = r; G.rs = min(max(r - 4, 0), 24); G.c0 = 16 * qt; G.kc0 = (qt == 0) ? 0 : (qt == 1) ? 8 : (qt == 2) ? 24 : 32;
        G.qbase = G.tok0 + r * 64 + G.c0; G.kbase = G.tok0 + G.rs * 64 + G.kc0; G.rpb_h = F.rpb + h * (15 * 31);
        attn_item<8, GeoNA>(G, proj, h * HD, vimg, ona, nullptr, lane);
    }
}

__device__ __forceinline__ void p4_post(Frame& F) {
    const bf16* ona = (const bf16*)(F.ws + WS_ONA); const bf16* odil = (const bf16*)(F.ws + WS_ODIL); const float* lse = (const float*)(F.ws + WS_LSE);
    bf16* aout = (bf16*)(F.ws + WS_AOUT);
    const int gw = F.vcu * NWAVES + F.wave, NGW = F.G * NWAVES, lane = F.lane;
    for (int tok = gw; tok < T; tok += NGW) {
        f32x4 v[4]; float ss = 0.f;
#pragma unroll
        for (int j = 0; j < 4; ++j) { v[j] = ld4bf(ona + (size_t)tok * GW + 4 * lane + 256 * j); ss += (v[j][0] * v[j][0] + v[j][1] * v[j][1]) + (v[j][2] * v[j][2] + v[j][3] * v[j][3]); }
        float r = 1.0f / sqrtf(wave_sum(ss) * (1.0f / GW) + EPS);
#pragma unroll
        for (int j = 0; j < 4; ++j) { const int col = 4 * lane + 256 * j; const f32x4 g = *(const f32x4*)(F.g_out_na + col);
            v2u w; w.x = pk2(v[j][0] * r * g[0], v[j][1] * r * g[1]); w.y = pk2(v[j][2] * r * g[2], v[j][3] * r * g[3]); *(v2u*)(aout + (size_t)tok * D + col) = w; }
        ss = 0.f;
#pragma unroll
        for (int j = 0; j < 4; ++j) { const int col = 4 * lane + 256 * j, h = col >> 7;
            const float l0 = lse[((size_t)0 * T + tok) * 8 + h], l1 = lse[((size_t)1 * T + tok) * 8 + h], l2 = lse[((size_t)2 * T + tok) * 8 + h];
            const float mx = fmaxf(fmaxf(l0, l1), l2); const float e0 = __expf(l0 - mx), e1 = __expf(l1 - mx), e2 = __expf(l2 - mx); const float inv = 1.0f / (e0 + e1 + e2);
            const f32x4 a0 = ld4bf(odil + ((size_t)0 * T + tok) * GW + col), a1 = ld4bf(odil + ((size_t)1 * T + tok) * GW + col), a2 = ld4bf(odil + ((size_t)2 * T + tok) * GW + col);
            v[j] = a0 * (e0 * inv) + a1 * (e1 * inv) + a2 * (e2 * inv);
            ss += (v[j][0] * v[j][0] + v[j][1] * v[j][1]) + (v[j][2] * v[j][2] + v[j][3] * v[j][3]); }
        r = 1.0f / sqrtf(wave_sum(ss) * (1.0f / GW) + EPS);
#pragma unroll
        for (int j = 0; j < 4; ++j) { const int col = 4 * lane + 256 * j; const f32x4 g = *(const f32x4*)(F.g_out_dil + col);
            v2u w; w.x = pk2(v[j][0] * r * g[0], v[j][1] * r * g[1]); w.y = pk2(v[j][2] * r * g[2], v[j][3] * r * g[3]); *(v2u*)(aout + (size_t)tok * D + GW + col) = w; }
    }
}

__device__ __forceinline__ void p6_rows(Frame& F) {
    LAS float* t1 = (LAS float*)(F.lds + RING_OFF);
    LAS float* t2 = t1 + D;
    LAS float* t3 = t2 + D;
    LAS unsigned* hb = (LAS unsigned*)(F.lds + RING_OFF + 3 * D * 4) + F.wave * (4 * D / 2);
    const bf16* mixed = (const bf16*)(F.ws + WS_MIXED); bf16* x1 = (bf16*)(F.ws + WS_X1); unsigned char* hffn8 = F.ws + WS_HFFN;
    int* topi = (int*)(F.ws + WS_TOPI); float* topg = (float*)(F.ws + WS_TOPG); int* trank = (int*)(F.ws + WS_TRANK); unsigned* hist_g = (unsigned*)(F.ws + WS_HIST);
    LAS unsigned* hist = (LAS unsigned*)(F.lds + MISC_OFF) + 224;
    const int lane = F.lane;
    for (int rb = F.vcu; rb < T / 32; rb += F.G) {
        const int b = rb >> 6;
        __syncthreads();
        if (F.tid < 32) hist[F.tid] = 0u;
        for (int col = F.tid; col < D; col += NWAVES * 64) { t1[col] = F.g_post_mix[col] * mod_val(F, b, 2 * D + col); t2[col] = F.g_pre_ffn[col] * (1.0f + mod_val(F, b, 4 * D + col)); t3[col] = mod_val(F, b, 3 * D + col); }
        __syncthreads();
#pragma unroll 1
        for (int rr = 0; rr < 4; ++rr) {
            const int row = rb * 32 + F.wave * 4 + rr;
            f32x4 v[8]; float ss = 0.f;
#pragma unroll
            for (int j = 0; j < 8; ++j) { v[j] = ld4bf(mixed + (size_t)row * D + 4 * lane + 256 * j); ss += (v[j][0] * v[j][0] + v[j][1] * v[j][1]) + (v[j][2] * v[j][2] + v[j][3] * v[j][3]); }
            float r = 1.0f / sqrtf(wave_sum(ss) * (1.0f / D) + EPS);
            ss = 0.f;
#pragma unroll
            for (int j = 0; j < 8; ++j) { const int col = 4 * lane + 256 * j; const f32x4 xv = *(const f32x4*)(F.x + (size_t)row * D + col); const f32x4 a = *(LAS f32x4*)(t1 + col);
                v[j] = xv + a * (v[j] * r); { v2u w; w.x = pk2(v[j][0], v[j][1]); w.y = pk2(v[j][2], v[j][3]); *(v2u*)(x1 + (size_t)row * D + col) = w; }
                ss += (v[j][0] * v[j][0] + v[j][1] * v[j][1]) + (v[j][2] * v[j][2] + v[j][3] * v[j][3]); }
            r = 1.0f / sqrtf(wave_sum(ss) * (1.0f / D) + EPS);
#pragma unroll
            for (int j = 0; j < 8; ++j) { const int col = 4 * lane + 256 * j; const f32x4 a = *(LAS f32x4*)(t2 + col), s = *(LAS f32x4*)(t3 + col);
                const f32x4 hv = v[j] * r * a + s;
                v2u w; w.x = pk2(hv[0], hv[1]); w.y = pk2(hv[2], hv[3]); *(LAS v2u*)(hb + rr * (D / 2) + (col >> 1)) = w;
                *(unsigned*)(hffn8 + (size_t)row * D + col) = pg8::cvt4_fp8(hv[0] * XSCALE, hv[1] * XSCALE, hv[2] * XSCALE, hv[3] * XSCALE); }
        }
        LDS_WAIT();
        const int e = lane & 31, half = lane >> 5;
        float acc[4] = {0.f, 0.f, 0.f, 0.f};
        { const float* wr = F.w_router + (size_t)(half * 1024) * NE + e; const LAS unsigned* hr = hb + half * 512;
#pragma unroll 8
          for (int kp = 0; kp < 512; ++kp) { const float w0 = wr[(size_t)(2 * kp) * NE], w1 = wr[(size_t)(2 * kp + 1) * NE];
#pragma unroll
              for (int rr = 0; rr < 4; ++rr) { const unsigned hw = hr[rr * (D / 2) + kp]; acc[rr] += bflo(hw) * w0 + bfhi(hw) * w1; } } }
        const float br = F.b_router[e];
#pragma unroll
        for (int rr = 0; rr < 4; ++rr) {
            const int row = rb * 32 + F.wave * 4 + rr;
            float a = acc[rr]; a += __shfl_xor(a, 32);
            float lg = (lane < 32) ? a + br : -INFINITY;
            int sel[4]; float val[4];
#pragma unroll
            for (int k = 0; k < 4; ++k) { const float mx = wave_max(lg); const unsigned long long bal = __ballot(lg == mx); const int idx = __ffsll((long long)bal) - 1; sel[k] = idx; val[k] = mx; if (lane == idx) lg = -INFINITY; }
            const float e1 = __expf(val[1] - val[0]), e2 = __expf(val[2] - val[0]), e3 = __expf(val[3] - val[0]); const float inv = 1.0f / (1.0f + e1 + e2 + e3);
            if (lane == 0) {
                *(int4*)(topi + (size_t)row * 4) = make_int4(sel[0], sel[1], sel[2], sel[3]);
                *(float4*)(topg + (size_t)row * 4) = make_float4(inv, e1 * inv, e2 * inv, e3 * inv);
                int rk[4];
#pragma unroll
                for (int k = 0; k < 4; ++k) rk[k] = (int)__hip_atomic_fetch_add(hist + sel[k], 1u, __ATOMIC_RELAXED, __HIP_MEMORY_SCOPE_WORKGROUP);
                *(int4*)(trank + (size_t)row * 4) = make_int4(rk[0], rk[1], rk[2], rk[3]);
            }
        }
        __syncthreads();
        if (F.tid < 32) hist_g[rb * 32 + F.tid] = hist[F.tid];
    }
}

__device__ __forceinline__ void moe_tables(Frame& F, int rb) {
    const unsigned* hist_g = (const unsigned*)(F.ws + WS_HIST);
    LAS unsigned* red = (LAS unsigned*)(F.lds + RING_OFF);
    __syncthreads();
    { const int e = F.tid & 31, part = F.tid >> 5; unsigned tot = 0u, pre = 0u;
#pragma unroll
      for (int i = 0; i < 16; ++i) { const int r2 = part * 16 + i; const unsigned v = hist_g[r2 * 32 + e]; tot += v; pre += (r2 < rb) ? v : 0u; }
      red[(part * 32 + e) * 2] = tot; red[(part * 32 + e) * 2 + 1] = pre; }
    __syncthreads();
    if (F.tid < 32) { unsigned tot = 0u, pre = 0u;
#pragma unroll
        for (int part = 0; part < 16; ++part) { tot += red[(part * 32 + F.tid) * 2]; pre += red[(part * 32 + F.tid) * 2 + 1]; }
        F.MISC[224 + F.tid] = tot; F.MISC[32 + F.tid] = pre; }
    __syncthreads();
    if (F.tid == 0) { int nb = 0;
        for (int e = 0; e < NE; ++e) { const int cnt = (int)F.MISC[224 + e]; const int k = (cnt + 255) >> 8; F.MISC[32 + e] += (unsigned)(nb * 256); for (int j = 0; j < k && nb < MAXBLK; ++j) F.MISC[64 + nb++] = (unsigned)e; }
        F.MISC[16] = (unsigned)nb; }
    __syncthreads();
}
__device__ __forceinline__ void p7_slots(Frame& F) {
    const int* topi = (const int*)(F.ws + WS_TOPI); const int* trank = (const int*)(F.ws + WS_TRANK); int* tslot = (int*)(F.ws + WS_TSLOT); int* slot_tok = (int*)(F.ws + WS_SLOTTOK);
    for (int rb = F.vcu; rb < T / 32; rb += F.G) {
        moe_tables(F, rb);
        if (F.tid < 128) { const int pid = rb * 128 + F.tid; const int slot = (int)F.MISC[32 + topi[pid]] + trank[pid]; tslot[pid] = slot; slot_tok[slot] = pid >> 2; }
    }
}

__device__ __forceinline__ void p10_final(Frame& F) {
    LAS float* t1 = (LAS float*)(F.lds + RING_OFF);
    const bf16* x1 = (const bf16*)(F.ws + WS_X1); const bf16* yb = (const bf16*)(F.ws + WS_YB);
    const int* tslot = (const int*)(F.ws + WS_TSLOT); const float* topg = (const float*)(F.ws + WS_TOPG);
    const int lane = F.lane;
    for (int rb = F.vcu; rb < T / 32; rb += F.G) {
        const int b = rb >> 6;
        __syncthreads();
        for (int col = F.tid; col < D; col += NWAVES * 64) t1[col] = F.g_post_ffn[col] * mod_val(F, b, 5 * D + col);
        __syncthreads();
        for (int rr = F.wave; rr < 32; rr += NWAVES) {
            const int row = rb * 32 + rr;
            const int4 sl = *(const int4*)(tslot + (size_t)row * 4); const float4 gt = *(const float4*)(topg + (size_t)row * 4);
            const int sls[4] = {sl.x, sl.y, sl.z, sl.w}; const float gts[4] = {gt.x, gt.y, gt.z, gt.w};
            float y[4][8]; float ss = 0.f;
#pragma unroll
            for (int j = 0; j < 4; ++j) {
#pragma unroll
                for (int i = 0; i < 8; ++i) y[j][i] = 0.f;
#pragma unroll
                for (int k = 0; k < 4; ++k) { const v4u w = *(const v4u*)(yb + (size_t)sls[k] * D + 8 * lane + 512 * j); const float g = gts[k];
                    y[j][0] += g * bflo(w.x); y[j][1] += g * bfhi(w.x); y[j][2] += g * bflo(w.y); y[j][3] += g * bfhi(w.y); y[j][4] += g * bflo(w.z); y[j][5] += g * bfhi(w.z); y[j][6] += g * bflo(w.w); y[j][7] += g * bfhi(w.w); }
#pragma unroll
                for (int i = 0; i < 8; ++i) ss += y[j][i] * y[j][i];
            }
            const float r = 1.0f / sqrtf(wave_sum(ss) * (1.0f / D) + EPS);
#pragma unroll
            for (int j = 0; j < 4; ++j) { const int col = 8 * lane + 512 * j;
#pragma unroll
                for (int hh = 0; hh < 2; ++hh) { const f32x4 xv = ld4bf(x1 + (size_t)row * D + col + 4 * hh); const f32x4 a = *(LAS f32x4*)(t1 + col + 4 * hh);
                    f32x4 o; o[0] = xv[0] + a[0] * y[j][4 * hh + 0] * r; o[1] = xv[1] + a[1] * y[j][4 * hh + 1] * r; o[2] = xv[2] + a[2] * y[j][4 * hh + 2] * r; o[3] = xv[3] + a[3] * y[j][4 * hh + 3] * r;
                    *(f32x4*)(F.out + (size_t)row * D + col + 4 * hh) = o; } }
        }
    }
}

struct Args { const float* in[20]; float* out; unsigned char* ws; int ph_lo, ph_hi; };
__global__ void __launch_bounds__(NWAVES * 64, 2) fwd_kernel(Args args) {
    extern __shared__ __attribute__((aligned(16))) unsigned char lds[];
    Frame F;
    F.lds = (LAS unsigned char*)lds;
    F.MISC = (volatile LAS unsigned*)(F.lds + MISC_OFF);
    F.tid = threadIdx.x; F.lane = F.tid & 63; F.wave = __builtin_amdgcn_readfirstlane(F.tid >> 6);
    F.G = gridDim.x; { const int bx = blockIdx.x; F.vcu = (F.G % 8 == 0) ? (bx % 8) * (F.G / 8) + bx / 8 : bx; }
    F.ws = args.ws; F.ctl = (unsigned*)(args.ws + WS_CTL); F.out = args.out;
    F.x = args.in[0]; F.c = args.in[1]; F.w_ada = args.in[2]; F.b_ada = args.in[3]; F.g_pre_mix = args.in[4]; F.g_post_mix = args.in[5]; F.w_in = args.in[6]; F.rpb = args.in[7]; F.t5 = args.in[8];
    F.g_out_na = args.in[9]; F.g_out_dil = args.in[10]; F.w_o = args.in[11]; F.g_pre_ffn = args.in[12]; F.g_post_ffn = args.in[13]; F.w_router = args.in[14]; F.b_router = args.in[15];
    F.w_e_in = args.in[16]; F.b_e_in = args.in[17]; F.w_e_out = args.in[18]; F.b_e_out = args.in[19];
    for (int u = F.tid; u < 256; u += NWAVES * 64) F.MISC[u] = 0u;
    __syncthreads();
    XcdBarrier bar; bar.bar = F.ctl + CW_BAR; bar.x = 0; bar.st = nullptr;
    if (MK_N_LAUNCHES == 1) bar = xcd_barrier_post(F.ctl + CW_BAR, F.MISC + 8);
    const int lo = args.ph_lo, hi = args.ph_hi;
#define IN(k) (lo <= (k) && (k) < hi)
#ifndef PROBE_REPEAT
#define PROBE_REPEAT -1
#endif
#define REP(k) ((PROBE_REPEAT == (k)) ? 2 : 1)
#define SEAM(k) do { if (IN(k) && IN((k) + 1)) xcd_barrier(bar); } while (0)

    if (IN(0)) { for (int rep = 0; rep < REP(0); ++rep) p0_prologue(F); } SEAM(0);
    if (IN(1)) { p1_hmix(F); } SEAM(1);
    if (IN(2)) {
        __syncthreads();
        if (F.G == 256 && (int)blockIdx.x >= QKV_GEMM_WGS) {
            conv8_run(F, (LAS float*)(F.lds + RING_OFF + F.wave * 16896), ((int)blockIdx.x - QKV_GEMM_WGS) * NWAVES + F.wave, (256 - QKV_GEMM_WGS) * NWAVES, CONV_Q);
        } else {
            const int gg = (F.G == 256) ? QKV_GEMM_WGS : F.G;
            pg8::Gemm g{(const bf16*)(F.ws + WS_HMIX), (const bf16*)(F.ws + WS_WIN_T), T, NQKV, D}; pg8::StaticOrder S; S.init(T, NQKV, gg, (int)blockIdx.x);
            pg8::EpiBf16 E{(bf16*)(F.ws + WS_PROJ), NQKV, nullptr, 0};
            for (int rep = 0; rep < REP(2); ++rep) { __syncthreads(); pg8::gemm_phase<pg8::EpiBf16, pg8::StaticOrder, true, true>(F.lds + RING_OFF, g, S, E); }
            if (F.G != 256) { __syncthreads(); conv8_run(F, (LAS float*)(F.lds + RING_OFF + F.wave * 16896), F.vcu * NWAVES + F.wave, F.G * NWAVES, CONV_Q); }
        }
    } SEAM(2);
        if (IN(3)) { for (int rep = 0; rep < REP(3); ++rep) { __syncthreads(); p3_attn_mfma(F); } } SEAM(3);
    if (IN(4)) { p4_post(F); } SEAM(4);
    if (IN(5)) {
        __syncthreads();
        if (F.G == 256 && (int)blockIdx.x >= WO_GEMM_WGS) {
            conv8_run(F, (LAS float*)(F.lds + RING_OFF + F.wave * 16896), CONV_Q + ((int)blockIdx.x - WO_GEMM_WGS) * NWAVES + F.wave, (256 - WO_GEMM_WGS) * NWAVES, CONV_Q + CONV_Q5);
        } else {
            const int gg = (F.G == 256) ? WO_GEMM_WGS : F.G;
            pg8::Gemm g{(const bf16*)(F.ws + WS_AOUT), (const bf16*)(F.ws + WS_WO_T), T, D, D}; pg8::StaticOrder S; S.init(T, D, gg, (int)blockIdx.x);
            pg8::EpiBf16 E{(bf16*)(F.ws + WS_MIXED), D, nullptr, 0};
            __syncthreads();
            pg8::gemm_phase<pg8::EpiBf16, pg8::StaticOrder, true, true>(F.lds + RING_OFF, g, S, E);
            if (F.G != 256) { __syncthreads(); conv8_run(F, (LAS float*)(F.lds + RING_OFF + F.wave * 16896), CONV_Q + F.vcu * NWAVES + F.wave, F.G * NWAVES, CONV_Q + CONV_Q5); }
        }
    } SEAM(5);
    if (IN(6)) { for (int rep = 0; rep < REP(6); ++rep) p6_rows(F); } SEAM(6);
    if (IN(7)) { p7_slots(F); } SEAM(7);
    if (IN(8)) {
        moe_tables(F, -1);
        pg8::Gemm g{(const bf16*)(F.ws + WS_HFFN), (const bf16*)(F.ws + WS_WEI_T), MAXBLK * 256, FF2, D / 2};
        LAS int* rowtab = (LAS int*)(F.lds + RING_OFF + 131072);
        pg8::MoeOrder<16> S{(const LAS int*)(F.lds + MISC_OFF + 64 * 4), (int)F.MISC[16], F.G, (int)blockIdx.x, rowtab};
        { const int* slot_tok = (const int*)(F.ws + WS_SLOTTOK); pg8::Unit u;
          for (int i = 0; i < 24 && S.next(i, u); ++i) if (F.tid < 256) rowtab[i * 256 + F.tid] = slot_tok[u.pm * 256 + F.tid]; }
        pg8::EpiSwiglu8 E{F.ws + WS_HB, FF, F.b_e_in, FF2, 1.0f / (WSCALE * XSCALE), HSCALE};
        for (int rep = 0; rep < REP(8); ++rep) { __syncthreads(); pg8::gemm_phase<pg8::EpiSwiglu8, pg8::MoeOrder<16>, true, true, true, true>(F.lds + RING_OFF, g, S, E); }
    } SEAM(8);
    if (IN(9)) {
        moe_tables(F, -1);
        pg8::Gemm g{(const bf16*)(F.ws + WS_HB), (const bf16*)(F.ws + WS_WEO_T), MAXBLK * 256, D, FF / 2};
        pg8::MoeOrder<8> S{(const LAS int*)(F.lds + MISC_OFF + 64 * 4), (int)F.MISC[16], F.G, (int)blockIdx.x, nullptr};
        pg8::EpiBf16S E{(bf16*)(F.ws + WS_YB), D, F.b_e_out, D, 1.0f / (WSCALE * HSCALE)};
        for (int rep = 0; rep < REP(9); ++rep) { __syncthreads(); pg8::gemm_phase<pg8::EpiBf16S, pg8::MoeOrder<8>, true, true, true>(F.lds + RING_OFF, g, S, E); }
    } SEAM(9);
    if (IN(10)) { p10_final(F); }
#undef IN
#undef SEAM
}

extern "C" void kernel_launch(void* const* d_in, const int* in_sizes, int n_in, void* d_out, int out_size, void* d_ws, size_t ws_size, hipStream_t stream) {
    static int grid = 0;
    if (grid == 0) {
        if (n_in != 20 || out_size != T * D || ws_size < WS_END) { fprintf(stderr, "kernel_launch: unexpected problem (n_in %d, out %d, ws %zu)\n", n_in, out_size, ws_size); grid = -1; return; }
        int dev = 0, cus = 0, per_cu = 0;
        if (hipGetDevice(&dev) != hipSuccess || hipDeviceGetAttribute(&cus, hipDeviceAttributeMultiprocessorCount, dev) != hipSuccess) { grid = -1; return; }
        if (hipFuncSetAttribute((const void*)fwd_kernel, hipFuncAttributeMaxDynamicSharedMemorySize, LDS_BYTES) != hipSuccess) { fprintf(stderr, "kernel_launch: hipFuncSetAttribute failed\n"); grid = -1; return; }
        if (hipOccupancyMaxActiveBlocksPerMultiprocessor(&per_cu, (const void*)fwd_kernel, NWAVES * 64, LDS_BYTES) != hipSuccess || per_cu < 1) { fprintf(stderr, "kernel_launch: occupancy query reports %d\n", per_cu); }
        (void)hipGetLastError();
        grid = cus;
    }
    if (grid < 0) return;
    if (hipMemsetAsync((char*)d_ws + WS_CTL, 0, CTL_ZERO_BYTES, stream) != hipSuccess) return;
    Args a{};
    for (int i = 0; i < 20; ++i) a.in[i] = (const float*)d_in[i];
    a.out = (float*)d_out; a.ws = (unsigned char*)d_ws;
    if (MK_N_LAUNCHES == 1) {
        a.ph_lo = 0; a.ph_hi = NPHASE;
        hipLaunchKernelGGL(fwd_kernel, dim3(grid), dim3(NWAVES * 64), LDS_BYTES, stream, a);
    } else {
        for (int p = 0; p < NPHASE; ++p) { a.ph_lo = p; a.ph_hi = p + 1; hipLaunchKernelGGL(fwd_kernel, dim3(grid), dim3(NWAVES * 64), LDS_BYTES, stream, a); }
    }
}
```

```cpp
#include <hip/hip_runtime.h>
#include <cstdio>
#include <cstdint>
#include <type_traits>

#ifndef MK_N_LAUNCHES
#define MK_N_LAUNCHES 1
#endif

namespace pg8 {
#define PG8_LAS __attribute__((address_space(3)))
typedef unsigned short bf16_t;
typedef short bf16x8 __attribute__((ext_vector_type(8)));
typedef float f32x4 __attribute__((ext_vector_type(4)));
typedef unsigned u32x4 __attribute__((ext_vector_type(4)));
typedef unsigned u32x2 __attribute__((ext_vector_type(2)));
constexpr int BM = 256, BK = 64, HALF = 128, HTB = HALF * BK * 2  , STAGE_BYTES = 8 * HTB, NXCD = 8, WGM = 8;

__host__ __device__ __forceinline__ int lds_byte(int r, int c) { const int st = (r >> 4) * 2 + (c >> 5), rr = r & 15, cc = c & 31, ob = rr * 64 + cc * 2; return st * 1024 + (ob ^ (((ob >> 9) & 1) << 5)); }
__host__ __device__ __forceinline__ void stage_rc(int b, int& R, int& C) { const int st = b / 1024, sb = b % 1024, swz = sb ^ (((sb >> 9) & 1) << 5); R = (st >> 1) * 16 + swz / 64; C = (st & 1) * 32 + (swz % 64) / 2; }
__host__ __device__ __forceinline__ int perm32(int rho) { const int n = rho >> 4, i = rho & 15; return 8 * (i >> 2) + 4 * n + (i & 3); }

struct Unit { int pm, pn, bt, e; };
struct Gemm { const bf16_t* A; const bf16_t* Bt; int M, N, K; };

struct StaticOrder {
    int nM, nN, nwg, G, c;
    __host__ __device__ void init(int M, int N, int G_, int c_) { nM = M / BM; nN = N / BM; nwg = nM * nN; G = G_; c = c_; }
    __host__ __device__ bool next(int i, Unit& u) const {
        const long L = (long)i * G + c; if (L >= nwg) return false;
        int wgid = (int)L; { const int q = nwg / NXCD, r = nwg % NXCD, xcd = wgid % NXCD, off = wgid / NXCD; wgid = (xcd < r ? xcd * (q + 1) : r * (q + 1) + (xcd - r) * q) + off; }
        const int nig = WGM * nN, gid = wgid / nig, fm = gid * WGM, gsz = (nM - fm) < WGM ? (nM - fm) : WGM;
        u.pm = fm + ((wgid % nig) % gsz); u.pn = (wgid % nig) / gsz; u.bt = u.pn; u.e = 0; return true;
    }
    __device__ __forceinline__ void a_ready(const Unit&) const {}
    __device__ __forceinline__ void done(const Unit&) const {}
};
template <int NPN> struct MoeOrder {
    const PG8_LAS int* blk_e; int nb, G, c; const PG8_LAS int* rowtab;
    __device__ __forceinline__ bool next(int i, Unit& u) const {
        int L = i * G + c;
        if (G == 256) L = ((i * 8 + (c & 7)) << 5) + (c >> 3);
        const int g = L >> 5, r = L & 31;
        int block, pn;
        if (NPN == 16) { block = 4 * (g >> 1) + (r & 3); pn = 8 * (g & 1) + (r >> 2); } else { block = 4 * g + (r & 3); pn = r >> 2; }
        if (block >= nb) return false;
        u.pm = block; u.pn = pn; u.e = blk_e[block]; u.bt = u.e * NPN + pn; return true;
    }
    __device__ __forceinline__ void a_ready(const Unit&) const {}
    __device__ __forceinline__ void done(const Unit&) const {}
};

__device__ __forceinline__ unsigned cvt_pk_bf16(float lo, float hi) { unsigned r; asm volatile("v_cvt_pk_bf16_f32 %0, %1, %2" : "=v"(r) : "v"(lo), "v"(hi)); return r; }

struct EpiF32 {
    static constexpr bool PERM = false, AFTER_DRAIN = false;
    float* C; int ldc;
    __device__ __forceinline__ void operator()(const f32x4 (&acc)[2][2][4][2], const Unit& u, int wr, int wc, int fr, int fq) const {
        const int row0 = u.pm * BM + wr * 64 + fr, col0 = u.pn * BM + wc * 32 + 4 * fq;
#pragma unroll
        for (int ai = 0; ai < 2; ++ai)
#pragma unroll
            for (int m = 0; m < 4; ++m) { float* rowp = C + (size_t)(row0 + ai * HALF + m * 16) * ldc + col0;
#pragma unroll
                for (int bj = 0; bj < 2; ++bj)
#pragma unroll
                    for (int n = 0; n < 2; ++n) *(f32x4*)(rowp + bj * HALF + n * 16) = acc[ai][bj][m][n]; }
    }
};
struct EpiBf16 {
    static constexpr bool PERM = true, AFTER_DRAIN = false;
    bf16_t* O; int ldc; const float* bias; int bias_estride;
    __device__ __forceinline__ void operator()(const f32x4 (&acc)[2][2][4][2], const Unit& u, int wr, int wc, int fr, int fq) const {
        const int row0 = u.pm * BM + wr * 64 + fr; const int col0 = u.pn * BM + wc * 32 + 8 * fq;
        f32x4 bv[2][2];
#pragma unroll
        for (int bj = 0; bj < 2; ++bj)
#pragma unroll
            for (int n = 0; n < 2; ++n) bv[bj][n] = bias ? *(const f32x4*)(bias + (size_t)u.e * bias_estride + col0 + bj * HALF + 4 * n) : (f32x4){0.f, 0.f, 0.f, 0.f};
#pragma unroll
        for (int ai = 0; ai < 2; ++ai)
#pragma unroll
            for (int m = 0; m < 4; ++m) { bf16_t* rowp = O + (size_t)(row0 + ai * HALF + m * 16) * ldc + col0;
#pragma unroll
                for (int bj = 0; bj < 2; ++bj) { const f32x4 v0 = acc[ai][bj][m][0] + bv[bj][0], v1 = acc[ai][bj][m][1] + bv[bj][1];
                    u32x4 w; w.x = cvt_pk_bf16(v0[0], v0[1]); w.y = cvt_pk_bf16(v0[2], v0[3]); w.z = cvt_pk_bf16(v1[0], v1[1]); w.w = cvt_pk_bf16(v1[2], v1[3]);
                    *(u32x4*)(rowp + bj * HALF) = w; } }
    }
};
__device__ __forceinline__ float swiglu1(float g, float u) {
    g = fminf(g, 7.0f); u = fminf(fmaxf(u, -7.0f), 7.0f);
    const float s = __builtin_amdgcn_rcpf(1.0f + __builtin_amdgcn_exp2f(g * (-1.702f * 1.44269504089f)));
    return (u + 1.0f) * (g * s);
}
struct EpiSwiglu {
    static constexpr bool PERM = true, AFTER_DRAIN = false;
    bf16_t* H; int ldh; const float* bias; int bias_estride;
    __device__ __forceinline__ void operator()(const f32x4 (&acc)[2][2][4][2], const Unit& u, int wr, int wc, int fr, int fq) const {
        const int row0 = u.pm * BM + wr * 64 + fr; const int col0 = u.pn * BM + wc * 32 + 8 * fq;
        f32x4 bv[2][2];
#pragma unroll
        for (int bj = 0; bj < 2; ++bj)
#pragma unroll
            for (int n = 0; n < 2; ++n) bv[bj][n] = *(const f32x4*)(bias + (size_t)u.e * bias_estride + col0 + bj * HALF + 4 * n);
#pragma unroll
        for (int ai = 0; ai < 2; ++ai)
#pragma unroll
            for (int m = 0; m < 4; ++m) { bf16_t* rowp = H + (size_t)(row0 + ai * HALF + m * 16) * ldh + (col0 >> 1);
#pragma unroll
                for (int bj = 0; bj < 2; ++bj) { const f32x4 v0 = acc[ai][bj][m][0] + bv[bj][0], v1 = acc[ai][bj][m][1] + bv[bj][1];
                    u32x2 w; w.x = cvt_pk_bf16(swiglu1(v0[0], v0[1]), swiglu1(v0[2], v0[3])); w.y = cvt_pk_bf16(swiglu1(v1[0], v1[1]), swiglu1(v1[2], v1[3]));
                    *(u32x2*)(rowp + bj * (HALF / 2)) = w; } }
    }
};

__device__ __forceinline__ unsigned cvt4_fp8(float a, float b, float c, float d) {
    int r = 0;
    r = __builtin_amdgcn_cvt_pk_fp8_f32(__builtin_amdgcn_fmed3f(a, -448.f, 448.f), __builtin_amdgcn_fmed3f(b, -448.f, 448.f), r, false);
    r = __builtin_amdgcn_cvt_pk_fp8_f32(__builtin_amdgcn_fmed3f(c, -448.f, 448.f), __builtin_amdgcn_fmed3f(d, -448.f, 448.f), r, true);
    return (unsigned)r;
}
struct EpiSwiglu8 {
    static constexpr bool PERM = true, AFTER_DRAIN = false;
    unsigned char* H; int ldh; const float* bias; int bias_estride; float ascale, hscale;
    __device__ __forceinline__ void operator()(const f32x4 (&acc)[2][2][4][2], const Unit& u, int wr, int wc, int fr, int fq) const {
        const int row0 = u.pm * BM + wr * 64 + fr; const int col0 = u.pn * BM + wc * 32 + 8 * fq;
        f32x4 bv[2][2];
#pragma unroll
        for (int bj = 0; bj < 2; ++bj)
#pragma unroll
            for (int n = 0; n < 2; ++n) bv[bj][n] = *(const f32x4*)(bias + (size_t)u.e * bias_estride + col0 + bj * HALF + 4 * n);
#pragma unroll
        for (int ai = 0; ai < 2; ++ai)
#pragma unroll
            for (int m = 0; m < 4; ++m) { unsigned char* rowp = H + (size_t)(row0 + ai * HALF + m * 16) * ldh + (col0 >> 1);
#pragma unroll
                for (int bj = 0; bj < 2; ++bj) { const f32x4 v0 = acc[ai][bj][m][0] * ascale + bv[bj][0], v1 = acc[ai][bj][m][1] * ascale + bv[bj][1];
                    *(unsigned*)(rowp + bj * (HALF / 2)) = cvt4_fp8(hscale * swiglu1(v0[0], v0[1]), hscale * swiglu1(v0[2], v0[3]), hscale * swiglu1(v1[0], v1[1]), hscale * swiglu1(v1[2], v1[3])); } }
    }
};
struct EpiBf16S {
    static constexpr bool PERM = true, AFTER_DRAIN = false;
    bf16_t* O; int ldc; const float* bias; int bias_estride; float ascale;
    __device__ __forceinline__ void operator()(const f32x4 (&acc)[2][2][4][2], const Unit& u, int wr, int wc, int fr, int fq) const {
        const int row0 = u.pm * BM + wr * 64 + fr; const int col0 = u.pn * BM + wc * 32 + 8 * fq;
        f32x4 bv[2][2];
#pragma unroll
        for (int bj = 0; bj < 2; ++bj)
#pragma unroll
            for (int n = 0; n < 2; ++n) bv[bj][n] = *(const f32x4*)(bias + (size_t)u.e * bias_estride + col0 + bj * HALF + 4 * n);
#pragma unroll
        for (int ai = 0; ai < 2; ++ai)
#pragma unroll
            for (int m = 0; m < 4; ++m) { bf16_t* rowp = O + (size_t)(row0 + ai * HALF + m * 16) * ldc + col0;
#pragma unroll
                for (int bj = 0; bj < 2; ++bj) { const f32x4 v0 = acc[ai][bj][m][0] * ascale + bv[bj][0], v1 = acc[ai][bj][m][1] * ascale + bv[bj][1];
                    u32x4 w; w.x = cvt_pk_bf16(v0[0], v0[1]); w.y = cvt_pk_bf16(v0[2], v0[3]); w.z = cvt_pk_bf16(v1[0], v1[1]); w.w = cvt_pk_bf16(v1[2], v1[3]);
                    *(u32x4*)(rowp + bj * HALF) = w; } }
    }
};

#ifndef FP8_SAME_ADDR
#define FP8_SAME_ADDR 1
#endif
typedef int v8i32 __attribute__((ext_vector_type(8)));
typedef short bf16x16 __attribute__((ext_vector_type(16)));
template <class Epi, class Sched, bool ALIGN_EPI = false, bool SP2 = false, bool FP8 = false, bool GATHER = false>
__device__ __forceinline__ void gemm_phase(PG8_LAS unsigned char* lds, const Gemm g, const Sched& S, const Epi& E) {
    const int tid = threadIdx.x, wid = __builtin_amdgcn_readfirstlane(tid >> 6), lane = tid & 63, wr = wid >> 2, wc = wid & 3, fr = lane & 15, fq = lane >> 4;
    const int K = g.K, nt = K / BK;
    unsigned voffA[2], voffB[2];
#pragma unroll
    for (int i = 0; i < 2; ++i) { int R, C; stage_rc(tid * 16 + i * 8192, R, C); const int Rb = Epi::PERM ? ((R & ~31) + perm32(R & 31)) : R;
        voffA[i] = (unsigned)(R * K + C) * 2u; voffB[i] = (unsigned)(Rb * K + C) * 2u; }
    unsigned gAc[2][2], gAn[2][2];
#define PG8_GLOAD(dst, uidx) do { _Pragma("unroll") for (int _h = 0; _h < 2; ++_h) _Pragma("unroll") for (int _i = 0; _i < 2; ++_i) { int _R, _C; stage_rc(tid * 16 + _i * 8192, _R, _C); \
        dst[_h][_i] = (unsigned)S.rowtab[(uidx) * 256 + _h * HALF + _R] * (unsigned)(K * 2) + (unsigned)_C * 2u; } } while (0)
    const size_t kstep = (size_t)(BK * 2);
    const size_t hstep = (size_t)HALF * K * 2;
    const size_t tstep = 2 * hstep;
    const unsigned ldsw = (unsigned)wid * 1024u;
    const int fcol = (FP8 && !FP8_SAME_ADDR) ? (32 * (fq >> 1) + 16 * (fq & 1)) : fq * 8;
    const int aoff = lds_byte(wr * 64 + fr, fcol), boff = lds_byte(wc * 32 + fr, fcol);
    constexpr int KSTR = (FP8 && !FP8_SAME_ADDR) ? 16 : 1024;
#define PG8_SA(b, h) (((b) * 2 + (h)) * HTB)
#define PG8_SB(b, h) ((4 + (b) * 2 + (h)) * HTB)
#define PG8_STAGE(bufoff, gbase, voff) do { _Pragma("unroll") for (int _i = 0; _i < 2; ++_i) \
        __builtin_amdgcn_global_load_lds((const unsigned*)((const char*)(gbase) + (voff)[_i]), (PG8_LAS unsigned*)(lds + (bufoff) + ldsw + _i * 8192), 16, 0, 0); } while (0)
#define PG8_RD(dst, addr) do { if constexpr (FP8) { const u32x4 _lo = *(const PG8_LAS u32x4*)(addr), _hi = *(const PG8_LAS u32x4*)((addr) + KSTR); \
        (dst)[0] = (frag_t)__builtin_bit_cast(v8i32, __builtin_shufflevector(_lo, _hi, 0, 1, 2, 3, 4, 5, 6, 7)); } \
    else { (dst)[0] = (frag_t)*(const PG8_LAS bf16x8*)(addr); (dst)[NKF - 1] = (frag_t)*(const PG8_LAS bf16x8*)((addr) + 1024); } } while (0)
#define PG8_STAGE_A(bufoff, abase, h, nx) do { if constexpr (GATHER) { unsigned _g[2] = {(nx) ? gAn[h][0] : gAc[h][0], (nx) ? gAn[h][1] : gAc[h][1]}; PG8_STAGE(bufoff, abase, _g); } \
        else { PG8_STAGE(bufoff, (abase) + (h) * hstep, voffA); } } while (0)
#define PG8_LDA(dst, b, h) do { _Pragma("unroll") for (int m = 0; m < 4; ++m) PG8_RD(dst[m], lds + PG8_SA(b, h) + aoff + m * 2048); } while (0)
#define PG8_LDB(dst, b, h) do { _Pragma("unroll") for (int n = 0; n < 2; ++n) PG8_RD(dst[n], lds + PG8_SB(b, h) + boff + n * 2048); } while (0)
#define PG8_MMA(ai, bj, At, Bt) do { __builtin_amdgcn_s_setprio(1); _Pragma("unroll") for (int m = 0; m < 4; ++m) _Pragma("unroll") for (int n = 0; n < 2; ++n) { \
        if constexpr (FP8) asm volatile("v_mfma_f32_16x16x128_f8f6f4 %0, %1, %2, %0" : "+v"(acc[ai][bj][m][n]) : "v"(Bt[n][0]), "v"(At[m][0])); \
        else { _Pragma("unroll") for (int k = 0; k < NKF; ++k) acc[ai][bj][m][n] = __builtin_amdgcn_mfma_f32_16x16x32_bf16((bf16x8)Bt[n][k], (bf16x8)At[m][k], acc[ai][bj][m][n], 0, 0, 0); } } \
        __builtin_amdgcn_s_setprio(0); } while (0)
#define PG8_WAIT_V(n) asm volatile("s_waitcnt vmcnt(" #n ")" ::: "memory")
#define PG8_WAIT_L(n) asm volatile("s_waitcnt lgkmcnt(" #n ")" ::: "memory")
#define PG8_BAR __builtin_amdgcn_s_barrier()
#define PG8_SCHED __builtin_amdgcn_sched_barrier(0)
    Unit cur, nxt; int ui = 0;
    if (!S.next(0, cur)) return;
    f32x4 acc[2][2][4][2];
#pragma unroll
    for (int a = 0; a < 2; ++a)
#pragma unroll
        for (int b = 0; b < 2; ++b)
#pragma unroll
            for (int m = 0; m < 4; ++m)
#pragma unroll
                for (int n = 0; n < 2; ++n) acc[a][b][m][n] = (f32x4){0.f, 0.f, 0.f, 0.f};
    typedef typename std::conditional<FP8, v8i32, bf16x8>::type frag_t; constexpr int NKF = FP8 ? 1 : 2;
    frag_t At[4][NKF], B0[2][NKF], B1[2][NKF];
    const char* cA = (const char*)g.A + (GATHER ? (size_t)0 : (size_t)cur.pm * tstep); const char* cB = (const char*)g.Bt + (size_t)cur.bt * tstep;
    S.a_ready(cur);
    if constexpr (GATHER) { PG8_GLOAD(gAc, 0); }
    if constexpr (SP2) {
        PG8_STAGE(PG8_SB(0, 0), cB, voffB); PG8_STAGE(PG8_SB(0, 1), cB + hstep, voffB); PG8_STAGE_A(PG8_SA(0, 0), cA, 0, false); PG8_STAGE_A(PG8_SA(0, 1), cA, 1, false);
        if (wr == 1) PG8_BAR;
        PG8_WAIT_V(2); PG8_BAR;
        PG8_STAGE(PG8_SB(1, 0), cB + kstep, voffB); PG8_STAGE_A(PG8_SA(1, 0), cA + kstep, 0, false); PG8_STAGE(PG8_SB(1, 1), cB + hstep + kstep, voffB);
        PG8_WAIT_V(6); PG8_BAR;
    } else {
        PG8_STAGE(PG8_SB(0, 0), cB, voffB); PG8_STAGE_A(PG8_SA(0, 0), cA, 0, false); PG8_STAGE(PG8_SB(0, 1), cB + hstep, voffB); PG8_STAGE_A(PG8_SA(0, 1), cA, 1, false);
        if (wr == 1) PG8_BAR;
        PG8_WAIT_V(4); PG8_BAR;
        PG8_STAGE(PG8_SB(1, 0), cB + kstep, voffB); PG8_STAGE_A(PG8_SA(1, 0), cA + kstep, 0, false); PG8_STAGE(PG8_SB(1, 1), cB + hstep + kstep, voffB);
        PG8_WAIT_V(6); PG8_BAR;
    }
    for (;;) {
        const bool has_next = S.next(ui + 1, nxt);
        const char* nA = (has_next && !GATHER) ? (const char*)g.A + (size_t)nxt.pm * tstep : cA;
        if constexpr (GATHER) { if (has_next) { PG8_GLOAD(gAn, ui + 1); } else { gAn[0][0] = gAc[0][0]; gAn[0][1] = gAc[0][1]; gAn[1][0] = gAc[1][0]; gAn[1][1] = gAc[1][1]; } } const char* nB = has_next ? (const char*)g.Bt + (size_t)nxt.bt * tstep : cB;
        for (int t = 0; t < nt; t += 2) {
            const bool last = (t == nt - 2);
            const char* a1 = cA + (size_t)(t + 1) * kstep;
            const char* a2 = last ? nA : cA + (size_t)(t + 2) * kstep; const char* b2 = last ? nB : cB + (size_t)(t + 2) * kstep;
            const char* a3 = a2 + kstep; const char* b3 = b2 + kstep;
            if (last && has_next) S.a_ready(nxt);
            if constexpr (SP2) {
            PG8_LDB(B0, 0, 0); PG8_LDB(B1, 0, 1); PG8_SCHED; PG8_LDA(At, 0, 0); PG8_STAGE_A(PG8_SA(1, 1), a1, 1, false);
            PG8_WAIT_V(8); PG8_WAIT_L(0); PG8_BAR; PG8_MMA(0, 0, At, B0); PG8_MMA(0, 1, At, B1); PG8_BAR; PG8_SCHED;
            PG8_LDA(At, 0, 1); PG8_STAGE(PG8_SB(0, 0), b2, voffB); PG8_STAGE(PG8_SB(0, 1), b2 + hstep, voffB); PG8_STAGE_A(PG8_SA(0, 0), a2, 0, last);
            PG8_WAIT_V(8); PG8_WAIT_L(0); PG8_BAR; PG8_MMA(1, 0, At, B0); PG8_MMA(1, 1, At, B1); PG8_BAR; PG8_SCHED;
            PG8_LDB(B0, 1, 0); PG8_LDB(B1, 1, 1); PG8_SCHED; PG8_LDA(At, 1, 0); PG8_STAGE_A(PG8_SA(0, 1), a2, 1, last);
            PG8_WAIT_V(8); PG8_WAIT_L(0); PG8_BAR; PG8_MMA(0, 0, At, B0); PG8_MMA(0, 1, At, B1); PG8_BAR; PG8_SCHED;
            PG8_LDA(At, 1, 1); PG8_STAGE(PG8_SB(1, 0), b3, voffB); PG8_STAGE(PG8_SB(1, 1), b3 + hstep, voffB); PG8_STAGE_A(PG8_SA(1, 0), a3, 0, last);
            PG8_WAIT_V(8); PG8_WAIT_L(0); PG8_BAR; PG8_MMA(1, 0, At, B0); PG8_MMA(1, 1, At, B1); PG8_BAR; PG8_SCHED;
            } else {
            PG8_LDB(B0, 0, 0); PG8_SCHED; PG8_LDA(At, 0, 0); PG8_STAGE_A(PG8_SA(1, 1), a1, 1, false);
            PG8_WAIT_L(8); PG8_BAR; PG8_WAIT_L(0); PG8_MMA(0, 0, At, B0); PG8_BAR; PG8_SCHED;
            PG8_LDB(B1, 0, 1); PG8_STAGE(PG8_SB(0, 0), b2, voffB);
            PG8_BAR; PG8_WAIT_L(0); PG8_MMA(0, 1, At, B1); PG8_BAR;
            PG8_LDA(At, 0, 1); PG8_STAGE_A(PG8_SA(0, 0), a2, 0, last);
            PG8_BAR; PG8_WAIT_L(0); PG8_MMA(1, 0, At, B0); PG8_BAR; PG8_SCHED;
            PG8_STAGE(PG8_SB(0, 1), b2 + hstep, voffB);
            PG8_WAIT_V(6); PG8_BAR; PG8_MMA(1, 1, At, B1); PG8_BAR;
            PG8_LDB(B0, 1, 0); PG8_SCHED; PG8_LDA(At, 1, 0); PG8_STAGE_A(PG8_SA(0, 1), a2, 1, last);
            PG8_WAIT_L(8); PG8_BAR; PG8_WAIT_L(0); PG8_MMA(0, 0, At, B0); PG8_BAR; PG8_SCHED;
            PG8_LDB(B1, 1, 1); PG8_STAGE(PG8_SB(1, 0), b3, voffB);
            PG8_BAR; PG8_WAIT_L(0); PG8_MMA(0, 1, At, B1); PG8_BAR;
            PG8_LDA(At, 1, 1); PG8_STAGE_A(PG8_SA(1, 0), a3, 0, last);
            PG8_BAR; PG8_WAIT_L(0); PG8_MMA(1, 0, At, B0); PG8_BAR; PG8_SCHED;
            PG8_STAGE(PG8_SB(1, 1), b3 + hstep, voffB);
            PG8_WAIT_V(6); PG8_BAR; PG8_MMA(1, 1, At, B1); PG8_BAR;
            }
        }
        if constexpr (ALIGN_EPI) { if (wr == 0) PG8_BAR; }
        if constexpr (FP8) asm volatile("s_nop 15\n\ts_nop 15" ::: "memory");
        if constexpr (!Epi::AFTER_DRAIN) { E(acc, cur, wr, wc, fr, fq); S.done(cur); }
        if (!has_next) break;
#pragma unroll
        for (int a = 0; a < 2; ++a)
#pragma unroll
            for (int b = 0; b < 2; ++b)
#pragma unroll
                for (int m = 0; m < 4; ++m)
#pragma unroll
                    for (int n = 0; n < 2; ++n) acc[a][b][m][n] = (f32x4){0.f, 0.f, 0.f, 0.f};
        cur = nxt; cA = nA; cB = nB; ++ui;
        if constexpr (GATHER) { gAc[0][0] = gAn[0][0]; gAc[0][1] = gAn[0][1]; gAc[1][0] = gAn[1][0]; gAc[1][1] = gAn[1][1]; }
        if constexpr (ALIGN_EPI) { if (wr == 1) PG8_BAR; }
    }
    PG8_WAIT_V(0);
    if constexpr (!ALIGN_EPI) { if (wr == 0) PG8_BAR; }
    PG8_BAR;
    if constexpr (Epi::AFTER_DRAIN) { E.fused(acc, cur, wr, wc, fr, fq, lds, wid, lane); S.done(cur); }
#undef PG8_SA
#undef PG8_SB
#undef PG8_STAGE
#undef PG8_STAGE_A
#undef PG8_GLOAD
#undef PG8_LDA
#undef PG8_LDB
#undef PG8_MMA
#undef PG8_RD
#undef PG8_WAIT_V
#undef PG8_WAIT_L
#undef PG8_BAR
#undef PG8_SCHED
}
}

#ifndef PROBE_REPEAT
#define PROBE_REPEAT -1
#endif
constexpr int NWAVES = 8;
constexpr int NBATCH = 4, SEQ = 2048, T = NBATCH * SEQ, D = 2048, HD = 128, NHG = 8, GW = 1024, NQKV = 6144, NE = 32, TOPK = 4, FF = 2048, FF2 = 4096;
constexpr int MAXBLK = 160;
constexpr float EPS = 1e-6f;
constexpr int NPHASE = 11;
constexpr float WSCALE = 512.0f, XSCALE = 16.0f, HSCALE = 4.0f;

constexpr size_t MiB = 1u << 20;
constexpr size_t WS_CTL = 0, CTL_ZERO_BYTES = 1 * MiB;
constexpr size_t WS_SLOTTOK = 512 * 1024;
constexpr size_t WS_MODP = 1 * MiB;
constexpr size_t WS_WRT = 4 * MiB + 512 * 1024;
constexpr size_t WS_MOD = 4 * MiB;
constexpr size_t WS_TOPI = 5 * MiB, WS_TOPG = WS_TOPI + 131072, WS_TSLOT = WS_TOPG + 131072;
constexpr size_t WS_BLK = WS_TSLOT + 131072 + 131072 + 32768;
constexpr size_t WS_TRANK = WS_TSLOT + 131072, WS_HIST = WS_TRANK + 131072;
constexpr size_t WS_LSE = 6 * MiB;
constexpr size_t WS_WIN_T = 8 * MiB;
constexpr size_t WS_WO_T = 32 * MiB;
constexpr size_t WS_HMIX = 40 * MiB;
constexpr size_t WS_AOUT = 72 * MiB;
constexpr size_t WS_PROJ = 104 * MiB;
constexpr size_t WS_ONA = 200 * MiB;
constexpr size_t WS_ODIL = 232 * MiB;
constexpr size_t WS_MIXED = 328 * MiB;
constexpr size_t WS_X1 = 392 * MiB;
constexpr size_t WS_HFFN = 456 * MiB;
constexpr size_t WS_XG = 492 * MiB;
constexpr size_t WS_HB = 652 * MiB;
constexpr size_t WS_YB = 812 * MiB;
constexpr size_t WS_WEI_T = 1024 * MiB;
constexpr size_t WS_WEO_T = 1536 * MiB;
constexpr size_t WS_END = 1792 * MiB;
constexpr int CW_TMO = 0, CW_CODE = 1, CW_CNT = 256, CW_CUR = 512, CW_BAR = 4096;

constexpr int RING_OFF = 0, RING_BYTES = 155648;
constexpr int MISC_OFF = RING_BYTES;
constexpr int LDS_BYTES = RING_BYTES + 1024;

#define GAS __attribute__((address_space(1)))
#define LAS __attribute__((address_space(3)))
typedef unsigned short bf16;
typedef unsigned v4u __attribute__((ext_vector_type(4)));
typedef unsigned v2u __attribute__((ext_vector_type(2)));
typedef float f32x4 __attribute__((ext_vector_type(4)));
typedef GAS unsigned gu32;
#define RLX_AGENT __ATOMIC_RELAXED, __HIP_MEMORY_SCOPE_AGENT
#define LDS_WAIT() asm volatile("s_waitcnt lgkmcnt(0)" ::: "memory")
#define VM_WAIT() asm volatile("s_waitcnt vmcnt(0)" ::: "memory")
__device__ __forceinline__ float bf2f(unsigned short h) { return __builtin_bit_cast(float, (unsigned)h << 16); }
__device__ __forceinline__ float bflo(unsigned w) { return __builtin_bit_cast(float, w << 16); }
__device__ __forceinline__ float bfhi(unsigned w) { return __builtin_bit_cast(float, w & 0xffff0000u); }
__device__ __forceinline__ unsigned pk2(float lo, float hi) { return pg8::cvt_pk_bf16(lo, hi); }
__device__ __forceinline__ f32x4 ld4bf(const unsigned short* p) { const v2u w = *(const v2u*)p; return (f32x4){bflo(w.x), bfhi(w.x), bflo(w.y), bfhi(w.y)}; }

#define XB_TMO      128
#define XB_XCNT(j)  (256  + 64 * (j))
#define XB_XSUB(j)  (1280 + 64 * (j))
#define XB_XGEN(j)  (2304 + 64 * (j))
#define XB_TOP      3328
#define XB_TOPGEN   3392
#define XCD_BAR_WORDS 3456
#define XB_SPIN_CAP (1u << 18)
__device__ __forceinline__ unsigned xb_ld(unsigned* p)              { return __hip_atomic_load(p, __ATOMIC_RELAXED, __HIP_MEMORY_SCOPE_AGENT); }
__device__ __forceinline__ unsigned xb_add(unsigned* p, unsigned v) { return __hip_atomic_fetch_add(p, v, __ATOMIC_RELAXED, __HIP_MEMORY_SCOPE_AGENT); }
__device__ __forceinline__ unsigned xb_xcc_id() { return (unsigned)__builtin_amdgcn_s_getreg((3 << 11) | 20) & 0xFu; }
#define XB_SPIN(cond, bar) do { unsigned _sp = 0; while (cond) { __builtin_amdgcn_s_sleep(1); \
    if ((++_sp & 255u) == 0u) { if (xb_ld(&(bar)[XB_TMO])) break; if (_sp > XB_SPIN_CAP) { atomicAdd(&(bar)[XB_TMO], 1u); break; } } } } while (0)
struct XcdBarrier { unsigned* bar; unsigned x; volatile LAS unsigned* st; };
__device__ __forceinline__ XcdBarrier xcd_barrier_post(unsigned* bar, volatile LAS unsigned* st) {
    XcdBarrier b; b.bar = bar; b.x = xb_xcc_id(); b.st = st;
    if (threadIdx.x == 0) (void)xb_add(&bar[XB_XCNT(b.x)], 1u);
    return b;
}
__device__ __forceinline__ void xcd_barrier_complete(unsigned* bar, unsigned x, unsigned& nloc, unsigned& nx) {
    const unsigned G = gridDim.x * gridDim.y * gridDim.z;
    unsigned sum, cnt, mine, sp = 0u;
    for (;;) {
        sum = 0u; cnt = 0u; mine = 0u;
#pragma unroll
        for (unsigned j = 0; j < 16; ++j) { const unsigned c = xb_ld(&bar[XB_XCNT(j)]); sum += c; cnt += (c > 0u) ? 1u : 0u; mine = (j == x) ? c : mine; }
        if (sum == G) break;
        __builtin_amdgcn_s_sleep(1);
        if ((++sp & 255u) == 0u) { if (xb_ld(&bar[XB_TMO])) break; if (sp > XB_SPIN_CAP) { atomicAdd(&bar[XB_TMO], 1u); break; } }
    }
    nloc = mine > 0u ? mine : 1u; nx = cnt > 0u ? cnt : 1u;
}
__device__ __forceinline__ void xcd_barrier(const XcdBarrier& b) {
    asm volatile("s_waitcnt vmcnt(0)" ::: "memory");
    __syncthreads();
    if (threadIdx.x == 0) {
        unsigned* bar = b.bar;
        __builtin_amdgcn_s_waitcnt(0);
        unsigned nloc = b.st[0], nx = b.st[1];
        if (nloc == 0u) { xcd_barrier_complete(bar, b.x, nloc, nx); b.st[0] = nloc; b.st[1] = nx; }
        const unsigned old = xb_add(&bar[XB_XSUB(b.x)], 1u);
        const unsigned gen = old / nloc;
        if (old + 1u == (gen + 1u) * nloc) {
            __builtin_amdgcn_fence(__ATOMIC_RELEASE, "agent");
            asm volatile("s_waitcnt vmcnt(0)" ::: "memory");
            const unsigned og = xb_add(&bar[XB_TOP], 1u);
            const unsigned tg = og / nx;
            if (og + 1u == (tg + 1u) * nx) xb_add(&bar[XB_TOPGEN], 1u);
            else XB_SPIN(xb_ld(&bar[XB_TOPGEN]) == tg, bar);
            __builtin_amdgcn_fence(__ATOMIC_ACQUIRE, "agent");
            xb_add(&bar[XB_XGEN(b.x)], 1u);
            asm volatile("s_waitcnt vmcnt(0)" ::: "memory");
        } else {
            XB_SPIN(xb_ld(&bar[XB_XGEN(b.x)]) == gen, bar);
            __builtin_amdgcn_fence(__ATOMIC_ACQUIRE, "agent");
            asm volatile("s_waitcnt vmcnt(0)" ::: "memory");
        }
    }
    __syncthreads();
}

struct Frame {
    LAS unsigned char* lds;
    volatile LAS unsigned* MISC;
    unsigned* ctl;
    int tid, lane, wave, vcu, G;
    const float *x, *c, *w_ada, *b_ada, *g_pre_mix, *g_post_mix, *w_in, *rpb, *t5, *g_out_na, *g_out_dil, *w_o, *g_pre_ffn, *g_post_ffn, *w_router, *b_router, *w_e_in, *b_e_in, *w_e_out, *b_e_out;
    float* out;
    unsigned char* ws;
};
__device__ __forceinline__ float wave_sum(float v) {
#pragma unroll
    for (int o = 1; o < 64; o <<= 1) v += __shfl_xor(v, o);
    return v;
}
__device__ __forceinline__ float wave_max(float v) {
#pragma unroll
    for (int o = 1; o < 64; o <<= 1) v = fmaxf(v, __shfl_xor(v, o));
    return v;
}
__device__ __forceinline__ float mod_val(const Frame& F, int b, int idx) {
    const float* mp = (const float*)(F.ws + WS_MODP);
    float s = F.b_ada[idx];
#pragma unroll
    for (int ks = 0; ks < 16; ++ks) s += mp[(size_t)(ks * 4 + b) * (6 * D) + idx];
    return s;
}

__constant__ unsigned char T5B[3][132] = {
 {11,11,11,11,11,11,11,11,11,11,11,11,11,11,11,10,10,10,10,10,10,10,10,10,10,10,10,10,10,10,10,10,10,10,10,10,10,10,9,9,9,9,9,9,9,9,9,9,9,9,8,8,8,8,8,8,8,7,6,5,4,3,2,1,0,17,18,19,20,21,22,23,24,24,24,24,24,24,24,25,25,25,25,25,25,25,25,25,25,25,25,26,26,26,26,26,26,26,26,26,26,26,26,26,26,26,26,26,26,26,26,26,26,26,27,27,27,27,27,27,27,27,27,27,27,27,27,27,27,0,0,0},
 {13,13,13,13,13,13,13,13,13,13,13,13,13,13,13,13,13,13,13,13,13,13,13,12,12,12,12,12,12,12,12,12,12,12,12,12,12,12,12,12,12,12,11,11,11,11,11,11,11,11,11,11,10,10,10,10,10,10,9,9,9,8,8,4,0,20,24,24,25,25,25,26,26,26,26,26,26,27,27,27,27,27,27,27,27,27,27,28,28,28,28,28,28,28,28,28,28,28,28,28,28,28,28,28,28,28,29,29,29,29,29,29,29,29,29,29,29,29,29,29,29,29,29,29,29,29,29,29,29,0,0,0},
 {15,15,15,15,15,15,15,15,15,15,15,15,15,15,15,15,15,15,15,15,15,15,15,15,15,15,15,15,15,15,14,14,14,14,14,14,14,14,14,14,14,14,14,14,14,13,13,13,13,13,13,13,13,13,12,12,12,12,12,11,11,10,10,9,0,25,26,26,27,27,28,28,28,28,28,29,29,29,29,29,29,29,29,29,30,30,30,30,30,30,30,30,30,30,30,30,30,30,30,31,31,31,31,31,31,31,31,31,31,31,31,31,31,31,31,31,31,31,31,31,31,31,31,31,31,31,31,31,31,0,0,0}};

__device__ __forceinline__ void p0_mod_item(Frame& F, int j) {
    const int ks = j >> 4, cb = j & 15;
    LAS float* sc = (LAS float*)(F.lds + RING_OFF);
    LAS float* red = (LAS float*)(F.lds + RING_OFF + 4096);
    __syncthreads();
    { const int b = F.tid >> 7, k = F.tid & 127; const float cv = F.c[b * D + ks * 128 + k]; sc[F.tid] = cv / (1.0f + __expf(-cv)); }
    __syncthreads();
    const int cg = F.tid % 192, sub = F.tid / 192;
    f32x4 acc[4];
#pragma unroll
    for (int b = 0; b < 4; ++b) acc[b] = (f32x4){0.f, 0.f, 0.f, 0.f};
    if (sub < 2) {
        const float* wp = F.w_ada + (size_t)(ks * 128 + sub * 64) * (6 * D) + cb * 768 + 4 * cg;
#pragma unroll 8
        for (int i = 0; i < 64; ++i) {
            const f32x4 w = __builtin_nontemporal_load((const f32x4*)(wp + (size_t)i * (6 * D)));
#pragma unroll
            for (int b = 0; b < 4; ++b) { const float s = sc[b * 128 + sub * 64 + i]; acc[b] += w * s; }
        }
        if (sub == 1) {
#pragma unroll
            for (int b = 0; b < 4; ++b) *(LAS f32x4*)(red + cg * 16 + b * 4) = acc[b];
        }
    }
    __syncthreads();
    if (sub == 0) {
        float* mp = (float*)(F.ws + WS_MODP);
#pragma unroll
        for (int b = 0; b < 4; ++b) { const f32x4 o = acc[b] + *(LAS f32x4*)(red + cg * 16 + b * 4); *(f32x4*)(mp + (size_t)(ks * 4 + b) * (6 * D) + cb * 768 + 4 * cg) = o; }
    }
}
__device__ __forceinline__ void p0_transpose_item(const float* W, int K, int N, bf16* WT, int item, int lane) {
    const int nblk = N >> 5, kb = item / nblk, nb = item - kb * nblk, k0 = (kb << 6) + 8 * (lane >> 3), n0 = (nb << 5) + 4 * (lane & 7);
    const float* src = W + (size_t)k0 * N + n0;
    f32x4 v[8];
#pragma unroll
    for (int i = 0; i < 8; ++i) v[i] = __builtin_nontemporal_load((const f32x4*)(src + (size_t)i * N));
#pragma unroll
    for (int e = 0; e < 4; ++e) { v4u o; o.x = pk2(v[0][e], v[1][e]); o.y = pk2(v[2][e], v[3][e]); o.z = pk2(v[4][e], v[5][e]); o.w = pk2(v[6][e], v[7][e]);
        *(v4u*)(WT + (size_t)(n0 + e) * K + k0) = o; }
}
constexpr int I_EI1 = (D / 128) * (FF2 / 32), I_EO1 = (FF / 128) * (D / 32), I_EI = NE * I_EI1, I_EO = NE * I_EO1, CONV8_ITEMS = I_EI + I_EO;
constexpr int CONV_Q = 65536, QKV_GEMM_WGS = 128, CONV_Q5 = 28672, WO_GEMM_WGS = 128;
#ifndef CONV_KG
#define CONV_KG 8
#endif
struct Conv8 { const float* src; unsigned char* dst; int N; };
__device__ __forceinline__ Conv8 conv8_item(const Frame& F, int r, int lane) {
    Conv8 c; const float* W; unsigned char* WT; int it;
    if (r < I_EI) { const int e = r / I_EI1; it = r - e * I_EI1; c.N = FF2; W = F.w_e_in + (size_t)e * D * FF2; WT = F.ws + WS_WEI_T + (size_t)e * FF2 * D; }
    else { r -= I_EI; const int e = r / I_EO1; it = r - e * I_EO1; c.N = D; W = F.w_e_out + (size_t)e * FF * D; WT = F.ws + WS_WEO_T + (size_t)e * D * FF; }
    constexpr int NL = 64 / CONV_KG;
    const int nblk = c.N / (4 * NL), kb = it / nblk, nb = it - kb * nblk, k0 = kb * (16 * CONV_KG) + 16 * (lane / NL), n0 = nb * (4 * NL) + 4 * (lane % NL);
    c.src = W + (size_t)k0 * c.N + n0; c.dst = WT + (size_t)n0 * 2048 + k0;
    return c;
}
__device__ __forceinline__ void conv8_load(const Conv8& c, f32x4 (&v)[16]) {
#pragma unroll
    for (int i = 0; i < 16; ++i) v[i] = __builtin_nontemporal_load((const f32x4*)(c.src + (size_t)i * c.N));
}
__device__ __forceinline__ void conv8_finish(const f32x4 (&v)[16], unsigned char* dst, LAS float*, int) {
#pragma unroll
    for (int e = 0; e < 4; ++e) { v4u o;
        o.x = pg8::cvt4_fp8(v[0][e] * WSCALE, v[1][e] * WSCALE, v[2][e] * WSCALE, v[3][e] * WSCALE);
        o.y = pg8::cvt4_fp8(v[4][e] * WSCALE, v[5][e] * WSCALE, v[6][e] * WSCALE, v[7][e] * WSCALE);
        o.z = pg8::cvt4_fp8(v[8][e] * WSCALE, v[9][e] * WSCALE, v[10][e] * WSCALE, v[11][e] * WSCALE);
        o.w = pg8::cvt4_fp8(v[12][e] * WSCALE, v[13][e] * WSCALE, v[14][e] * WSCALE, v[15][e] * WSCALE);
        __builtin_nontemporal_store(o, (v4u*)(dst + (size_t)e * 2048)); }
}
__device__ __forceinline__ void conv8_run(Frame& F, LAS float* scr, int first, int stride, int last) {
    if (first >= last) return;
    f32x4 va[16], vb[16];
    Conv8 ca = conv8_item(F, first, F.lane), cb = ca;
    conv8_load(ca, va);
    for (int it = first; it < last; it += 2 * stride) {
        const bool hb = it + stride < last;
        if (hb) { cb = conv8_item(F, it + stride, F.lane); conv8_load(cb, vb); }
        conv8_finish(va, ca.dst, scr, F.lane);
        if (!hb) break;
        const bool ha = it + 2 * stride < last;
        if (ha) { ca = conv8_item(F, it + 2 * stride, F.lane); conv8_load(ca, va); }
        conv8_finish(vb, cb.dst, scr, F.lane);
        if (!ha) break;
    }
}
constexpr int IW_EI1 = (D / 128) * (FF2 / 256), IW_EO1 = (FF / 128) * (D / 256), IW_EI = NE * IW_EI1, IW_EO = NE * IW_EO1, CONVW_ITEMS = IW_EI + IW_EO;
constexpr int CONVW_Q2 = IW_EI, CONVW_Q5 = 3584;
struct ConvW { const float* src; unsigned char* dst; int N; };
__device__ __forceinline__ ConvW convw_item(const Frame& F, int r, int wave, int lane) {
    ConvW c; const float* W; unsigned char* WT; int it, nblk;
    if (r < IW_EI) { const int e = r / IW_EI1; it = r - e * IW_EI1; c.N = FF2; nblk = FF2 / 256; W = F.w_e_in + (size_t)e * D * FF2; WT = F.ws + WS_WEI_T + (size_t)e * FF2 * D; }
    else { r -= IW_EI; const int e = r / IW_EO1; it = r - e * IW_EO1; c.N = D; nblk = D / 256; W = F.w_e_out + (size_t)e * FF * D; WT = F.ws + WS_WEO_T + (size_t)e * D * FF; }
    const int kb = it / nblk, nb = it - kb * nblk, k0 = kb << 7, n0 = nb << 8;
    c.src = W + (size_t)(k0 + 16 * wave) * c.N + n0 + 4 * lane; c.dst = WT + (size_t)n0 * 2048 + k0;
    return c;
}
__device__ __forceinline__ void convw_load(const ConvW& c, f32x4 (&v)[16]) {
#pragma unroll
    for (int i = 0; i < 16; ++i) v[i] = __builtin_nontemporal_load((const f32x4*)(c.src + (size_t)i * c.N));
}
__device__ __forceinline__ void convw_finish(const f32x4 (&v)[16], unsigned char* dst, LAS unsigned char* tile, int wave, int lane) {
#pragma unroll
    for (int e = 0; e < 4; ++e) { v4u o;
        o.x = pg8::cvt4_fp8(v[0][e] * WSCALE, v[1][e] * WSCALE, v[2][e] * WSCALE, v[3][e] * WSCALE);
        o.y = pg8::cvt4_fp8(v[4][e] * WSCALE, v[5][e] * WSCALE, v[6][e] * WSCALE, v[7][e] * WSCALE);
        o.z = pg8::cvt4_fp8(v[8][e] * WSCALE, v[9][e] * WSCALE, v[10][e] * WSCALE, v[11][e] * WSCALE);
        o.w = pg8::cvt4_fp8(v[12][e] * WSCALE, v[13][e] * WSCALE, v[14][e] * WSCALE, v[15][e] * WSCALE);
        *(LAS v4u*)(tile + (4 * lane + e) * 128 + 16 * (wave ^ (lane & 7))) = o; }
    __syncthreads();
#pragma unroll
    for (int j = 0; j < 4; ++j) { const int n = 32 * wave + 8 * j + (lane >> 3), c = lane & 7;
        const v4u o = *(const LAS v4u*)(tile + n * 128 + 16 * (c ^ ((n >> 2) & 7)));
        __builtin_nontemporal_store(o, (v4u*)(dst + (size_t)n * 2048 + 16 * c)); }
}
__device__ __forceinline__ void convw_run(Frame& F, int rank, int nwg, int lo, int hi) {
    LAS unsigned char* t0 = F.lds + RING_OFF; LAS unsigned char* t1 = t0 + 32768;
    int wave = F.wave, lane = F.lane; asm volatile("" : "+v"(lane));
    int it = lo + rank; if (it >= hi) return;
    f32x4 va[16], vb[16];
    ConvW ca = convw_item(F, it, wave, lane), cb = ca; convw_load(ca, va);
    for (;;) {
        const bool hb = it + nwg < hi;
        if (hb) { cb = convw_item(F, it + nwg, wave, lane); convw_load(cb, vb); }
        convw_finish(va, ca.dst, t0, wave, lane);
        if (!hb) break;
        const bool ha = it + 2 * nwg < hi;
        if (ha) { ca = convw_item(F, it + 2 * nwg, wave, lane); convw_load(ca, va); }
        convw_finish(vb, cb.dst, t1, wave, lane);
        if (!ha) break;
        it += 2 * nwg;
    }
    __syncthreads();
}
__device__ __forceinline__ void p0_prologue(Frame& F) {
    for (int j = F.vcu; j < 256; j += F.G) p0_mod_item(F, j);
    __syncthreads();
    LAS float* scr = (LAS float*)(F.lds + RING_OFF + F.wave * 16896);
    const int gw = F.vcu * NWAVES + F.wave, NGW = F.G * NWAVES;
    for (int i = F.vcu * NWAVES * 64 + F.tid; i < D * NE; i += F.G * NWAVES * 64) { const float wv = F.w_router[i]; const int k = i >> 5, e = i & 31; const unsigned hi = pk2(wv, 0.f) & 0xffffu;
        bf16* wt = (bf16*)(F.ws + WS_WRT); wt[e * D + k] = (bf16)hi; wt[NE * D + e * D + k] = (bf16)(pk2(wv - bflo(hi), 0.f) & 0xffffu); }
    constexpr int I_IN = (D / 64) * (NQKV / 32), I_O = (D / 64) * (D / 32);
#pragma unroll 2
    for (int it = gw; it < I_IN + I_O; it += NGW) {
        if (it < I_IN) p0_transpose_item(F.w_in, D, NQKV, (bf16*)(F.ws + WS_WIN_T), it, F.lane);
        else p0_transpose_item(F.w_o, D, D, (bf16*)(F.ws + WS_WO_T), it - I_IN, F.lane);
    }
    __syncthreads();
    convw_run(F, F.vcu, F.G, CONVW_Q2 + CONVW_Q5, CONVW_ITEMS);
}

__device__ __forceinline__ void p1_hmix(Frame& F) {
    LAS float* ta = (LAS float*)(F.lds + RING_OFF);
    LAS float* tb = ta + D;
    for (int rb = F.vcu; rb < T / 32; rb += F.G) {
        const int b = rb >> 6;
        __syncthreads();
        if (F.tid < 192) { const int fi = rb * 192 + F.tid; ((float*)(F.ws + WS_MOD))[fi] = mod_val(F, fi / (6 * D), fi % (6 * D)); }
        for (int col = F.tid; col < D; col += NWAVES * 64) { ta[col] = F.g_pre_mix[col] * (1.0f + mod_val(F, b, D + col)); tb[col] = mod_val(F, b, col); }
        __syncthreads();
        for (int rr = F.wave; rr < 32; rr += NWAVES) {
            const int row = rb * 32 + rr;
            const f32x4* xr = (const f32x4*)(F.x + (size_t)row * D) + F.lane;
            f32x4 v[8]; float ss = 0.f;
#pragma unroll
            for (int j = 0; j < 8; ++j) { v[j] = xr[64 * j]; ss += (v[j][0] * v[j][0] + v[j][1] * v[j][1]) + (v[j][2] * v[j][2] + v[j][3] * v[j][3]); }
            const float r = 1.0f / sqrtf(wave_sum(ss) * (1.0f / D) + EPS);
            v2u* o8 = (v2u*)((bf16*)(F.ws + WS_HMIX) + (size_t)row * D) + F.lane;
#pragma unroll
            for (int j = 0; j < 8; ++j) { const int col = 4 * F.lane + 256 * j; const f32x4 a = *(LAS f32x4*)(ta + col), s = *(LAS f32x4*)(tb + col);
                v2u w; w.x = pk2(v[j][0] * r * a[0] + s[0], v[j][1] * r * a[1] + s[1]); w.y = pk2(v[j][2] * r * a[2] + s[2], v[j][3] * r * a[3] + s[3]); o8[64 * j] = w; }
        }
    }
}

typedef short bf16x8v __attribute__((ext_vector_type(8)));
typedef short s16x4v __attribute__((ext_vector_type(4)));
typedef int v4i16_t_ __attribute__((ext_vector_type(2)));
__device__ __forceinline__ unsigned vimg_off(unsigned row, unsigned ch) { return 256u * row + 16u * (ch ^ (((row & 3u) << 2) | ((row >> 2) & 3u))); }
__device__ __forceinline__ unsigned kimg_off(unsigned row, unsigned ch) { return 256u * row + 16u * (ch ^ (((row & 3u) << 2) | ((row >> 3) & 3u))); }
__device__ __forceinline__ s16x4v tr_read16(const LAS unsigned char* p) {
    typedef short v4i16 __attribute__((ext_vector_type(4)));
    return __builtin_bit_cast(s16x4v, __builtin_amdgcn_ds_read_tr16_b64_v4i16((LAS v4i16*)p));
}
struct GeoNA {
    int tok0, qbase, kbase, r, rs, c0, kc0; const LAS float* rpb_h;
    static constexpr int QCOL = 0, KCOL = GW, VCOL = 2 * GW;
    __device__ __forceinline__ int qtok(int n16) const { return qbase + n16; }
    __device__ __forceinline__ int ktok(int c, int slot) const { return kbase + c * 64 + slot; }
    __device__ __forceinline__ float bias(int c, int slot, int n16) const {
        const int qc = c0 + n16, kc = kc0 + slot, cs = min(max(qc - 8, 0), 48);
        const bool valid = (kc >= cs) && (kc < cs + 16);
        const int dc = min(max(kc - qc + 15, 0), 30);
        const float bv = rpb_h[(rs + c - r + 7) * 31 + dc];
        return valid ? bv : -INFINITY;
    }
};
struct GeoDil {
    int tok0, rho, dsh, sub_len, l0, p, h; const float* t5;
    static constexpr int QCOL = 3 * GW, KCOL = 4 * GW, VCOL = 5 * GW;
    __device__ __forceinline__ int qtok(int n16) const { return tok0 + rho + ((l0 + n16) << dsh); }
    __device__ __forceinline__ int ktok(int c, int slot) const { const int l = min(max(l0 - 64 + 32 * c + slot, 0), sub_len - 1); return tok0 + rho + (l << dsh); }
    __device__ __forceinline__ float bias(int c, int slot, int n16) const {
        const int kk = 32 * c + slot, delta = kk - 64 - n16, l = l0 - 64 + kk;
        const bool valid = (delta >= -64) && (delta <= 64) && (l >= 0) && (l < sub_len);
        const int di = min(max(delta + 64, 0), 128);
        const float bv = t5[(int)T5B[p][di] * 8 + h];
        return valid ? bv : -INFINITY;
    }
};
__device__ __forceinline__ void attn_na_item(const GeoNA& G, const bf16* proj, int hcol, LAS unsigned char* kimg, LAS unsigned char* vimg, bf16* out, int lane) {
    constexpr int NCH = 8;
    const int n16 = lane & 15, g = lane >> 4;
    const float scale_l2 = 0.08838834764831845f * 1.44269504089f;
    bf16x8v qf[4];
    { const bf16* qp = proj + (size_t)G.qtok(n16) * NQKV + GeoNA::QCOL + hcol + 8 * g;
#pragma unroll
      for (int s = 0; s < 4; ++s) qf[s] = *(const bf16x8v*)(qp + 32 * s); }
    const int vr_row = lane >> 4, vr_ch = lane & 15;
    const unsigned voff0 = (unsigned)((vr_row * NQKV + 8 * vr_ch) * 2);
    constexpr size_t ISTEP = (size_t)4 * NQKV * 2;
    const char* kb0 = (const char*)(proj + (size_t)G.kbase * NQKV + GeoNA::KCOL + hcol);
    const char* vb0 = (const char*)(proj + (size_t)G.kbase * NQKV + GeoNA::VCOL + hcol);
    constexpr size_t CSTEP = (size_t)64 * NQKV * 2;
    f32x4 st[NCH][2];
    v4u vr[8];
#pragma unroll
    for (int i = 0; i < 8; ++i) vr[i] = *(const v4u*)(kb0 + i * ISTEP + voff0);
#pragma unroll
    for (int c = 0; c < NCH; ++c) {
        asm volatile("" ::: "memory");
#pragma unroll
        for (int i = 0; i < 8; ++i) *(LAS v4u*)(kimg + kimg_off((unsigned)(4 * i + vr_row), (unsigned)vr_ch)) = vr[i];
        asm volatile("" ::: "memory");
        if (c + 1 < NCH) {
#pragma unroll
            for (int i = 0; i < 8; ++i) vr[i] = *(const v4u*)(kb0 + (size_t)(c + 1) * CSTEP + i * ISTEP + voff0);
        } else {
#pragma unroll
            for (int i = 0; i < 8; ++i) vr[i] = *(const v4u*)(vb0 + i * ISTEP + voff0);
        }
#pragma unroll
        for (int t2 = 0; t2 < 2; ++t2) {
            const unsigned row = (unsigned)(8 * (n16 >> 2) + 4 * t2 + (n16 & 3));
            f32x4 acc = (f32x4){0.f, 0.f, 0.f, 0.f};
#pragma unroll
            for (int s = 0; s < 4; ++s) { const bf16x8v kf = *(const LAS bf16x8v*)(kimg + kimg_off(row, (unsigned)(4 * s + g))); acc = __builtin_amdgcn_mfma_f32_16x16x32_bf16(kf, qf[s], acc, 0, 0, 0); }
            st[c][t2] = acc;
        }
        asm volatile("" ::: "memory");
    }
    float mx = -INFINITY;
#pragma unroll
    for (int c = 0; c < NCH; ++c)
#pragma unroll
        for (int t2 = 0; t2 < 2; ++t2)
#pragma unroll
            for (int r = 0; r < 4; ++r) { const float bv = G.bias(c, 8 * g + 4 * t2 + r, n16); const float x = st[c][t2][r] * scale_l2 + bv * 1.44269504089f; st[c][t2][r] = x; mx = fmaxf(mx, x); }
    mx = fmaxf(mx, __shfl_xor(mx, 16)); mx = fmaxf(mx, __shfl_xor(mx, 32));
    float sum = 0.f;
    bf16x8v pf[NCH];
#pragma unroll
    for (int c = 0; c < NCH; ++c) {
        float pv[8];
#pragma unroll
        for (int t2 = 0; t2 < 2; ++t2)
#pragma unroll
            for (int r = 0; r < 4; ++r) { const float p = __builtin_amdgcn_exp2f(st[c][t2][r] - mx); pv[4 * t2 + r] = p; sum += p; }
        v4u w; w.x = pk2(pv[0], pv[1]); w.y = pk2(pv[2], pv[3]); w.z = pk2(pv[4], pv[5]); w.w = pk2(pv[6], pv[7]);
        pf[c] = __builtin_bit_cast(bf16x8v, w);
    }
    sum += __shfl_xor(sum, 16); sum += __shfl_xor(sum, 32);
    f32x4 oacc[8];
#pragma unroll
    for (int dt = 0; dt < 8; ++dt) oacc[dt] = (f32x4){0.f, 0.f, 0.f, 0.f};
    const unsigned q4 = (unsigned)(lane & 15) >> 2, pp = (unsigned)lane & 3u;
#pragma unroll
    for (int c = 0; c < NCH; ++c) {
        asm volatile("" ::: "memory");
#pragma unroll
        for (int i = 0; i < 8; ++i) *(LAS v4u*)(vimg + vimg_off((unsigned)(4 * i + vr_row), (unsigned)vr_ch)) = vr[i];
        asm volatile("" ::: "memory");
        if (c + 1 < NCH) {
#pragma unroll
            for (int i = 0; i < 8; ++i) vr[i] = *(const v4u*)(vb0 + (size_t)(c + 1) * CSTEP + i * ISTEP + voff0);
        }
#pragma unroll
        for (int dt = 0; dt < 8; ++dt) {
            const s16x4v lo = tr_read16(vimg + vimg_off((unsigned)(8 * g) + q4, (unsigned)(2 * dt) + (pp >> 1)) + 8u * (pp & 1u));
            const s16x4v hi = tr_read16(vimg + vimg_off((unsigned)(8 * g + 4) + q4, (unsigned)(2 * dt) + (pp >> 1)) + 8u * (pp & 1u));
            bf16x8v vf; vf[0] = lo[0]; vf[1] = lo[1]; vf[2] = lo[2]; vf[3] = lo[3]; vf[4] = hi[0]; vf[5] = hi[1]; vf[6] = hi[2]; vf[7] = hi[3];
            oacc[dt] = __builtin_amdgcn_mfma_f32_16x16x32_bf16(vf, pf[c], oacc[dt], 0, 0, 0);
        }
        asm volatile("" ::: "memory");
    }
    const float inv = 1.0f / sum;
    bf16* op = out + (size_t)G.qtok(n16) * GW + hcol + 4 * g;
#pragma unroll
    for (int dt = 0; dt < 8; ++dt) { const f32x4 o = oacc[dt] * inv; v2u w; w.x = pk2(o[0], o[1]); w.y = pk2(o[2], o[3]); *(v2u*)(op + 16 * dt) = w; }
}
__device__ __forceinline__ void attn_dil_units(Frame& F) {
    LAS unsigned char* img = F.lds + RING_OFF;
    LAS float* tb = (LAS float*)(F.lds + RING_OFF + 131072);
    const bf16* proj = (const bf16*)(F.ws + WS_PROJ);
    bf16* odil = (bf16*)(F.ws + WS_ODIL); float* lse = (float*)(F.ws + WS_LSE);
    const int lane = F.lane, n16 = lane & 15, g = lane >> 4, w = F.wave;
    const int t4 = F.tid >> 4, ch = F.tid & 15;
    const float scale_l2 = 0.08838834764831845f * 1.44269504089f;
    constexpr int NU = 3 * NBATCH * 8 * 8, NIT = 12;
    v4u sr[NIT];
#define DIL_LOAD(u_, colofs) do { const int p_ = (u_) >> 8, b_ = ((u_) >> 6) & 3, h_ = ((u_) >> 3) & 7, q8_ = (u_) & 7, dsh_ = 2 * p_, sl_ = SEQ >> dsh_; \
        const int rho_ = (p_ == 0) ? 0 : (p_ == 1) ? (q8_ >> 1) : 2 * q8_, lw_ = (p_ == 0) ? 256 * q8_ - 64 : (p_ == 1) ? 256 * (q8_ & 1) - 64 : -64; \
        _Pragma("unroll") for (int it = 0; it < NIT; ++it) { const int row = 32 * it + t4; const int cls = (p_ == 2 && row >= 192) ? 1 : 0; const int l = min(max(lw_ + row - 128 * cls, 0), sl_ - 1); \
            sr[it] = *(const v4u*)(proj + (size_t)(b_ * SEQ + rho_ + cls + (l << dsh_)) * NQKV + (colofs) + h_ * HD + 8 * ch); } } while (0)
    int u = F.vcu;
    if (u < NU) DIL_LOAD(u, 4 * GW);
#pragma unroll 1
    for (; u < NU; u += F.G) {
        const int p = u >> 8, b = (u >> 6) & 3, h = (u >> 3) & 7, q8 = u & 7, dsh = 2 * p, sub_len = SEQ >> dsh;
        const int rho = ((p == 0) ? 0 : (p == 1) ? (q8 >> 1) : 2 * q8) + ((p == 2) ? (w >> 2) : 0);
        const int qb = (p == 0) ? 256 * q8 + 32 * w : (p == 1) ? 256 * (q8 & 1) + 32 * w : 32 * (w & 3);
        const int qtok0 = b * SEQ + rho + ((qb + n16) << dsh), qtok1 = b * SEQ + rho + ((qb + 16 + n16) << dsh);
        bf16x8v qf0[4], qf1[4];
        { const bf16* qp0 = proj + (size_t)qtok0 * NQKV + 3 * GW + h * HD + 8 * g; const bf16* qp1 = proj + (size_t)qtok1 * NQKV + 3 * GW + h * HD + 8 * g;
#pragma unroll
          for (int s = 0; s < 4; ++s) { qf0[s] = *(const bf16x8v*)(qp0 + 32 * s); qf1[s] = *(const bf16x8v*)(qp1 + 32 * s); } }
        __syncthreads();
        if (F.tid < 129) tb[32 + F.tid] = F.t5[(int)T5B[p][F.tid] * 8 + h] * 1.44269504089f;
#pragma unroll
        for (int it = 0; it < NIT; ++it) *(LAS v4u*)(img + kimg_off((unsigned)(32 * it + t4), (unsigned)ch)) = sr[it];
        asm volatile("" ::: "memory");
        DIL_LOAD(u, 5 * GW);
        __syncthreads();
        f32x4 s0[5][2], s1[5][2];
#pragma unroll
        for (int c = 0; c < 5; ++c)
#pragma unroll
            for (int t2 = 0; t2 < 2; ++t2) {
                const unsigned row = (unsigned)(32 * w + 32 * c + 8 * (n16 >> 2) + 4 * t2 + (n16 & 3));
                f32x4 a0 = (f32x4){0.f, 0.f, 0.f, 0.f}, a1 = (f32x4){0.f, 0.f, 0.f, 0.f};
#pragma unroll
                for (int s = 0; s < 4; ++s) { const bf16x8v kf = *(const LAS bf16x8v*)(img + kimg_off(row, (unsigned)(4 * s + g)));
                    a0 = __builtin_amdgcn_mfma_f32_16x16x32_bf16(kf, qf0[s], a0, 0, 0, 0); a1 = __builtin_amdgcn_mfma_f32_16x16x32_bf16(kf, qf1[s], a1, 0, 0, 0); }
                s0[c][t2] = a0; s1[c][t2] = a1;
            }
        bf16x8v pf0[5], pf1[5]; float mx0, mx1, sum0, sum1;
        const int lb = 8 * g - n16, lkb = qb - 64 + 8 * g; const LAS float* tbl = tb + (lb + 16);
#define DIL_SOFTMAX(st, pf, mx, sum, J) do { mx = -INFINITY; \
        _Pragma("unroll") for (int c = 0; c < 5; ++c) _Pragma("unroll") for (int t2 = 0; t2 < 2; ++t2) _Pragma("unroll") for (int r = 0; r < 4; ++r) { \
            const int idx = lb + (32 * c + 4 * t2 + r - 16 * (J)), lk = lkb + (32 * c + 4 * t2 + r);        \
            const bool valid = (idx >= 0) && (idx <= 128) && (lk >= 0) && (lk < sub_len); \
            const float bv = tbl[32 * c + 4 * t2 + r + 16 - 16 * (J)];                                         \
            const float x = valid ? st[c][t2][r] * scale_l2 + bv : -INFINITY; st[c][t2][r] = x; mx = fmaxf(mx, x); } \
        mx = fmaxf(mx, __shfl_xor(mx, 16)); mx = fmaxf(mx, __shfl_xor(mx, 32)); sum = 0.f; \
        _Pragma("unroll") for (int c = 0; c < 5; ++c) { float pv[8]; \
            _Pragma("unroll") for (int t2 = 0; t2 < 2; ++t2) _Pragma("unroll") for (int r = 0; r < 4; ++r) { const float pe = __builtin_amdgcn_exp2f(st[c][t2][r] - mx); pv[4 * t2 + r] = pe; sum += pe; } \
            v4u wv; wv.x = pk2(pv[0], pv[1]); wv.y = pk2(pv[2], pv[3]); wv.z = pk2(pv[4], pv[5]); wv.w = pk2(pv[6], pv[7]); pf[c] = __builtin_bit_cast(bf16x8v, wv); } \
        sum += __shfl_xor(sum, 16); sum += __shfl_xor(sum, 32); } while (0)
        DIL_SOFTMAX(s0, pf0, mx0, sum0, 0);
        DIL_SOFTMAX(s1, pf1, mx1, sum1, 1);
        __syncthreads();
#pragma unroll
        for (int it = 0; it < NIT; ++it) *(LAS v4u*)(img + vimg_off((unsigned)(32 * it + t4), (unsigned)ch)) = sr[it];
        asm volatile("" ::: "memory");
        if (u + F.G < NU) DIL_LOAD(u + F.G, 4 * GW);
        __syncthreads();
        f32x4 o0[8], o1[8];
#pragma unroll
        for (int dt = 0; dt < 8; ++dt) { o0[dt] = (f32x4){0.f, 0.f, 0.f, 0.f}; o1[dt] = (f32x4){0.f, 0.f, 0.f, 0.f}; }
        const unsigned q4 = (unsigned)(lane & 15) >> 2, pp = (unsigned)lane & 3u;
#pragma unroll
        for (int c = 0; c < 5; ++c)
#pragma unroll
            for (int dt = 0; dt < 8; ++dt) {
                const unsigned rbase = (unsigned)(32 * w + 32 * c + 8 * g) + q4;
                const s16x4v lo = tr_read16(img + vimg_off(rbase, (unsigned)(2 * dt) + (pp >> 1)) + 8u * (pp & 1u));
                const s16x4v hi = tr_read16(img + vimg_off(rbase + 4u, (unsigned)(2 * dt) + (pp >> 1)) + 8u * (pp & 1u));
                bf16x8v vf; vf[0] = lo[0]; vf[1] = lo[1]; vf[2] = lo[2]; vf[3] = lo[3]; vf[4] = hi[0]; vf[5] = hi[1]; vf[6] = hi[2]; vf[7] = hi[3];
                o0[dt] = __builtin_amdgcn_mfma_f32_16x16x32_bf16(vf, pf0[c], o0[dt], 0, 0, 0); o1[dt] = __builtin_amdgcn_mfma_f32_16x16x32_bf16(vf, pf1[c], o1[dt], 0, 0, 0);
            }
        { const float inv = 1.0f / sum0; bf16* op = odil + ((size_t)p * T + qtok0) * GW + h * HD + 4 * g;
#pragma unroll
          for (int dt = 0; dt < 8; ++dt) { const f32x4 o = o0[dt] * inv; v2u wv; wv.x = pk2(o[0], o[1]); wv.y = pk2(o[2], o[3]); *(v2u*)(op + 16 * dt) = wv; }
          if (g == 0) lse[((size_t)p * T + qtok0) * 8 + h] = (mx0 + __builtin_amdgcn_logf(sum0)) * 0.69314718056f; }
        { const float inv = 1.0f / sum1; bf16* op = odil + ((size_t)p * T + qtok1) * GW + h * HD + 4 * g;
#pragma unroll
          for (int dt = 0; dt < 8; ++dt) { const f32x4 o = o1[dt] * inv; v2u wv; wv.x = pk2(o[0], o[1]); wv.y = pk2(o[2], o[3]); *(v2u*)(op + 16 * dt) = wv; }
          if (g == 0) lse[((size_t)p * T + qtok1) * 8 + h] = (mx1 + __builtin_amdgcn_logf(sum1)) * 0.69314718056f; }
    }
#undef DIL_LOAD
#undef DIL_SOFTMAX
    __syncthreads();
}
__device__ __forceinline__ void attn_na_items(Frame& F) {
    LAS float* rpbl = (LAS float*)(F.lds + RING_OFF + 131072);
    for (int i = F.tid; i < 8 * 15 * 31; i += NWAVES * 64) rpbl[i] = F.rpb[i];
    LAS unsigned char* img = F.lds + RING_OFF;
    const bf16* proj = (const bf16*)(F.ws + WS_PROJ);
    bf16* ona = (bf16*)(F.ws + WS_ONA);
    int lane = F.lane; asm volatile("" : "+v"(lane));
    const int n16 = lane & 15, g = lane >> 4, w = F.wave;
    int tidv = F.tid; asm volatile("" : "+v"(tidv));
    const int t4 = tidv >> 4, ch = tidv & 15;
    const float scale_l2 = 0.08838834764831845f * 1.44269504089f;
    constexpr int NU = NBATCH * 8 * 8 * 2, NIT = 14;
    v4u sr[NIT];
#define NA_GEO(u) const int half = (u) & 1, r0 = 4 * (((u) >> 1) & 7), h = ((u) >> 4) & 7, b = (u) >> 7; const int rsmin = min(max(r0 - 4, 0), 24), rsmax = min(max(r0 - 1, 0), 24); \
        const int nimg = (rsmax - rsmin + 8) * 40, colbase = 24 * half, tok0 = b * SEQ; const int hcol = h * HD
#define NA_LOAD(colofs, nimg_, tokb_, hcol_) do { _Pragma("unroll") for (int it = 0; it < NIT; ++it) { const int row = 32 * it + t4; if (row < (nimg_)) { const int kr = (row * 205) >> 13, kc = row - 40 * kr; \
        sr[it] = *(const v4u*)(proj + (size_t)((tokb_) + kr * 64 + kc) * NQKV + (colofs) + (hcol_) + 8 * ch); } } } while (0)
    int u = F.vcu;
    if (u < NU) { NA_GEO(u); NA_LOAD(GeoNA::KCOL, nimg, tok0 + rsmin * 64 + colbase, hcol); }
#pragma unroll 1
    for (; u < NU; u += F.G) {
        NA_GEO(u);
        const int r = r0 + (w >> 1), qt = 2 * half + (w & 1), rs = min(max(r - 4, 0), 24), c0 = 16 * qt, kc0 = (qt == 0) ? 0 : (qt == 1) ? 8 : (qt == 2) ? 24 : 32;
        const int qtok = tok0 + r * 64 + c0 + n16;
        const int base0 = (rs - rsmin) * 40 + (kc0 - colbase);
        bf16x8v qf[4];
        { const bf16* qp = proj + (size_t)qtok * NQKV + GeoNA::QCOL + hcol + 8 * g;
#pragma unroll
          for (int s = 0; s < 4; ++s) qf[s] = *(const bf16x8v*)(qp + 32 * s); }
        __syncthreads();
#pragma unroll
        for (int it = 0; it < NIT; ++it) { const int row = 32 * it + t4; if (row < nimg) *(LAS v4u*)(img + kimg_off((unsigned)row, (unsigned)ch)) = sr[it]; }
        asm volatile("" ::: "memory");
        NA_LOAD(GeoNA::VCOL, nimg, tok0 + rsmin * 64 + colbase, hcol);
        __syncthreads();
        f32x4 st[8][2];
#pragma unroll
        for (int c = 0; c < 8; ++c)
#pragma unroll
            for (int t2 = 0; t2 < 2; ++t2) {
                const unsigned row = (unsigned)(base0 + 40 * c + 8 * (n16 >> 2) + 4 * t2 + (n16 & 3));
                f32x4 acc = (f32x4){0.f, 0.f, 0.f, 0.f};
#pragma unroll
                for (int s = 0; s < 4; ++s) { const bf16x8v kf = *(const LAS bf16x8v*)(img + kimg_off(row, (unsigned)(4 * s + g))); acc = __builtin_amdgcn_mfma_f32_16x16x32_bf16(kf, qf[s], acc, 0, 0, 0); }
                st[c][t2] = acc;
            }
        GeoNA G; G.tok0 = tok0; G.r = r; G.rs = rs; G.c0 = c0; G.kc0 = kc0; G.qbase = 0; G.kbase = 0; G.rpb_h = rpbl + h * (15 * 31);
        float mx = -INFINITY;
#pragma unroll
        for (int c = 0; c < 8; ++c)
#pragma unroll
            for (int t2 = 0; t2 < 2; ++t2)
#pragma unroll
                for (int rr = 0; rr < 4; ++rr) { const float bv = G.bias(c, 8 * g + 4 * t2 + rr, n16); const float x = st[c][t2][rr] * scale_l2 + bv * 1.44269504089f; st[c][t2][rr] = x; mx = fmaxf(mx, x); }
        mx = fmaxf(mx, __shfl_xor(mx, 16)); mx = fmaxf(mx, __shfl_xor(mx, 32));
        float sum = 0.f;
        bf16x8v pf[8];
#pragma unroll
        for (int c = 0; c < 8; ++c) {
            float pv[8];
#pragma unroll
            for (int t2 = 0; t2 < 2; ++t2)
#pragma unroll
                for (int rr = 0; rr < 4; ++rr) { const float p = __builtin_amdgcn_exp2f(st[c][t2][rr] - mx); pv[4 * t2 + rr] = p; sum += p; }
            v4u wv; wv.x = pk2(pv[0], pv[1]); wv.y = pk2(pv[2], pv[3]); wv.z = pk2(pv[4], pv[5]); wv.w = pk2(pv[6], pv[7]);
            pf[c] = __builtin_bit_cast(bf16x8v, wv);
        }
        sum += __shfl_xor(sum, 16); sum += __shfl_xor(sum, 32);
        __syncthreads();
#pragma unroll
        for (int it = 0; it < NIT; ++it) { const int row = 32 * it + t4; if (row < nimg) *(LAS v4u*)(img + vimg_off((unsigned)row, (unsigned)ch)) = sr[it]; }
        asm volatile("" ::: "memory");
        { const int un = u + F.G; if (un < NU) { const int half_n = un & 1, r0n = 4 * ((un >> 1) & 7), hn = (un >> 4) & 7, bn = un >> 7; const int rsmin_n = min(max(r0n - 4, 0), 24), rsmax_n = min(max(r0n - 1, 0), 24);
            NA_LOAD(GeoNA::KCOL, (rsmax_n - rsmin_n + 8) * 40, bn * SEQ + rsmin_n * 64 + 24 * half_n, hn * HD); } }
        __syncthreads();
        f32x4 oacc[8];
#pragma unroll
        for (int dt = 0; dt < 8; ++dt) oacc[dt] = (f32x4){0.f, 0.f, 0.f, 0.f};
        const unsigned q4 = (unsigned)(lane & 15) >> 2, pp = (unsigned)lane & 3u;
#pragma unroll
        for (int c = 0; c < 8; ++c)
#pragma unroll
            for (int dt = 0; dt < 8; ++dt) {
                const unsigned rbase = (unsigned)(base0 + 40 * c + 8 * g) + q4;
                const s16x4v lo = tr_read16(img + vimg_off(rbase, (unsigned)(2 * dt) + (pp >> 1)) + 8u * (pp & 1u));
                const s16x4v hi = tr_read16(img + vimg_off(rbase + 4u, (unsigned)(2 * dt) + (pp >> 1)) + 8u * (pp & 1u));
                bf16x8v vf; vf[0] = lo[0]; vf[1] = lo[1]; vf[2] = lo[2]; vf[3] = lo[3]; vf[4] = hi[0]; vf[5] = hi[1]; vf[6] = hi[2]; vf[7] = hi[3];
                oacc[dt] = __builtin_amdgcn_mfma_f32_16x16x32_bf16(vf, pf[c], oacc[dt], 0, 0, 0);
            }
        const float inv = 1.0f / sum;
        bf16* op = ona + (size_t)qtok * GW + hcol + 4 * g;
#pragma unroll
        for (int dt = 0; dt < 8; ++dt) { const f32x4 o = oacc[dt] * inv; v2u wv; wv.x = pk2(o[0], o[1]); wv.y = pk2(o[2], o[3]); *(v2u*)(op + 16 * dt) = wv; }
    }
#undef NA_GEO
#undef NA_LOAD
    __syncthreads();
}

__device__ __forceinline__ void p3_attn_mfma(Frame& F) {
    attn_dil_units(F);
#if PROBE_REPEAT == 31
    attn_dil_units(F);
#endif
    attn_na_items(F);
#if PROBE_REPEAT == 32
    __syncthreads(); attn_na_items(F);
#endif
}

__device__ __forceinline__ void p4_post(Frame& F) {
    const bf16* ona = (const bf16*)(F.ws + WS_ONA); const bf16* odil = (const bf16*)(F.ws + WS_ODIL); const float* lse = (const float*)(F.ws + WS_LSE);
    bf16* aout = (bf16*)(F.ws + WS_AOUT);
    const int gw = F.vcu * NWAVES + F.wave, NGW = F.G * NWAVES, lane = F.lane;
    for (int tok = gw; tok < T; tok += NGW) {
        f32x4 v[4]; float ss = 0.f;
#pragma unroll
        for (int j = 0; j < 4; ++j) { v[j] = ld4bf(ona + (size_t)tok * GW + 4 * lane + 256 * j); ss += (v[j][0] * v[j][0] + v[j][1] * v[j][1]) + (v[j][2] * v[j][2] + v[j][3] * v[j][3]); }
        float r = 1.0f / sqrtf(wave_sum(ss) * (1.0f / GW) + EPS);
#pragma unroll
        for (int j = 0; j < 4; ++j) { const int col = 4 * lane + 256 * j; const f32x4 g = *(const f32x4*)(F.g_out_na + col);
            v2u w; w.x = pk2(v[j][0] * r * g[0], v[j][1] * r * g[1]); w.y = pk2(v[j][2] * r * g[2], v[j][3] * r * g[3]); *(v2u*)(aout + (size_t)tok * D + col) = w; }
        ss = 0.f;
#pragma unroll
        for (int j = 0; j < 4; ++j) { const int col = 4 * lane + 256 * j, h = col >> 7;
            const float l0 = lse[((size_t)0 * T + tok) * 8 + h], l1 = lse[((size_t)1 * T + tok) * 8 + h], l2 = lse[((size_t)2 * T + tok) * 8 + h];
            const float mx = fmaxf(fmaxf(l0, l1), l2); const float e0 = __expf(l0 - mx), e1 = __expf(l1 - mx), e2 = __expf(l2 - mx); const float inv = 1.0f / (e0 + e1 + e2);
            const f32x4 a0 = ld4bf(odil + ((size_t)0 * T + tok) * GW + col), a1 = ld4bf(odil + ((size_t)1 * T + tok) * GW + col), a2 = ld4bf(odil + ((size_t)2 * T + tok) * GW + col);
            v[j] = a0 * (e0 * inv) + a1 * (e1 * inv) + a2 * (e2 * inv);
            ss += (v[j][0] * v[j][0] + v[j][1] * v[j][1]) + (v[j][2] * v[j][2] + v[j][3] * v[j][3]); }
        r = 1.0f / sqrtf(wave_sum(ss) * (1.0f / GW) + EPS);
#pragma unroll
        for (int j = 0; j < 4; ++j) { const int col = 4 * lane + 256 * j; const f32x4 g = *(const f32x4*)(F.g_out_dil + col);
            v2u w; w.x = pk2(v[j][0] * r * g[0], v[j][1] * r * g[1]); w.y = pk2(v[j][2] * r * g[2], v[j][3] * r * g[3]); *(v2u*)(aout + (size_t)tok * D + GW + col) = w; }
    }
}

__device__ __forceinline__ void p6_rows(Frame& F) {
    LAS float* t1 = (LAS float*)(F.lds + RING_OFF);
    LAS float* t2 = t1 + D;
    LAS float* t3 = t2 + D;
    LAS unsigned* hb0 = (LAS unsigned*)(F.lds + RING_OFF + 3 * D * 4);
    LAS unsigned* hb = hb0 + F.wave * (4 * D / 2);
    const bf16* mixed = (const bf16*)(F.ws + WS_MIXED); bf16* x1 = (bf16*)(F.ws + WS_X1); unsigned char* hffn8 = F.ws + WS_HFFN;
    int* topi = (int*)(F.ws + WS_TOPI); float* topg = (float*)(F.ws + WS_TOPG); int* trank = (int*)(F.ws + WS_TRANK); unsigned* hist_g = (unsigned*)(F.ws + WS_HIST);
    LAS unsigned* hist = (LAS unsigned*)(F.lds + MISC_OFF) + 224;
    const int lane = F.lane;
    for (int rb = F.vcu; rb < T / 32; rb += F.G) {
        const int b = rb >> 6;
        __syncthreads();
        if (F.tid < 32) hist[F.tid] = 0u;
        { const float* md = (const float*)(F.ws + WS_MOD) + (size_t)b * (6 * D);
          for (int col = F.tid; col < D; col += NWAVES * 64) { t1[col] = F.g_post_mix[col] * md[2 * D + col]; t2[col] = F.g_pre_ffn[col] * (1.0f + md[4 * D + col]); t3[col] = md[3 * D + col]; } }
        __syncthreads();
#pragma unroll 1
        for (int rr = 0; rr < 4; ++rr) {
            const int row = rb * 32 + F.wave * 4 + rr;
            f32x4 v[8]; float ss = 0.f;
#pragma unroll
            for (int j = 0; j < 8; ++j) { v[j] = ld4bf(mixed + (size_t)row * D + 4 * lane + 256 * j); ss += (v[j][0] * v[j][0] + v[j][1] * v[j][1]) + (v[j][2] * v[j][2] + v[j][3] * v[j][3]); }
            float r = 1.0f / sqrtf(wave_sum(ss) * (1.0f / D) + EPS);
            ss = 0.f;
#pragma unroll
            for (int j = 0; j < 8; ++j) { const int col = 4 * lane + 256 * j; const f32x4 xv = *(const f32x4*)(F.x + (size_t)row * D + col); const f32x4 a = *(LAS f32x4*)(t1 + col);
                v[j] = xv + a * (v[j] * r); { v2u w; w.x = pk2(v[j][0], v[j][1]); w.y = pk2(v[j][2], v[j][3]); *(v2u*)(x1 + (size_t)row * D + col) = w; }
                ss += (v[j][0] * v[j][0] + v[j][1] * v[j][1]) + (v[j][2] * v[j][2] + v[j][3] * v[j][3]); }
            r = 1.0f / sqrtf(wave_sum(ss) * (1.0f / D) + EPS);
#pragma unroll
            for (int j = 0; j < 8; ++j) { const int col = 4 * lane + 256 * j; const f32x4 a = *(LAS f32x4*)(t2 + col), s = *(LAS f32x4*)(t3 + col);
                const f32x4 hv = v[j] * r * a + s;
                v2u w; w.x = pk2(hv[0], hv[1]); w.y = pk2(hv[2], hv[3]); *(LAS v2u*)(hb + rr * (D / 2) + (col >> 1)) = w;
                *(unsigned*)(hffn8 + (size_t)row * D + col) = pg8::cvt4_fp8(hv[0] * XSCALE, hv[1] * XSCALE, hv[2] * XSCALE, hv[3] * XSCALE); }
        }
        __syncthreads();
        typedef short bf16x8r __attribute__((ext_vector_type(8)));
        f32x4 racc[2][2];
#pragma unroll
        for (int rt = 0; rt < 2; ++rt)
#pragma unroll
            for (int et = 0; et < 2; ++et) racc[rt][et] = (f32x4){0.f, 0.f, 0.f, 0.f};
        { const int n16 = lane & 15, g = lane >> 4;
          const LAS unsigned char* ab = (const LAS unsigned char*)hb0 + n16 * 4096 + (256 * F.wave + 8 * g) * 2;
          const bf16* wb = (const bf16*)(F.ws + WS_WRT) + n16 * D + 256 * F.wave + 8 * g;
#pragma unroll
          for (int ks = 0; ks < 8; ++ks) {
              const bf16x8r a0 = *(const LAS bf16x8r*)(ab + 64 * ks), a1 = *(const LAS bf16x8r*)(ab + 16 * 4096 + 64 * ks);
#pragma unroll
              for (int et = 0; et < 2; ++et) {
                  const bf16x8r bh = *(const bf16x8r*)(wb + et * 16 * D + 32 * ks), bl = *(const bf16x8r*)(wb + NE * D + et * 16 * D + 32 * ks);
                  racc[0][et] = __builtin_amdgcn_mfma_f32_16x16x32_bf16(a0, bh, racc[0][et], 0, 0, 0); racc[0][et] = __builtin_amdgcn_mfma_f32_16x16x32_bf16(a0, bl, racc[0][et], 0, 0, 0);
                  racc[1][et] = __builtin_amdgcn_mfma_f32_16x16x32_bf16(a1, bh, racc[1][et], 0, 0, 0); racc[1][et] = __builtin_amdgcn_mfma_f32_16x16x32_bf16(a1, bl, racc[1][et], 0, 0, 0); } } }
        LAS float* part = (LAS float*)(F.lds + RING_OFF);
#pragma unroll
        for (int rt = 0; rt < 2; ++rt) {
            { const int n16 = lane & 15, g = lane >> 4;
#pragma unroll
              for (int et = 0; et < 2; ++et)
#pragma unroll
                  for (int r = 0; r < 4; ++r) part[(F.wave * 16 + 4 * g + r) * 32 + 16 * et + n16] = racc[rt][et][r]; }
            __syncthreads();
            const int e = lane & 31, rl = 2 * F.wave + (lane >> 5), row = rb * 32 + 16 * rt + rl;
            float lg = F.b_router[e];
#pragma unroll
            for (int w2 = 0; w2 < 8; ++w2) lg += part[(w2 * 16 + rl) * 32 + e];
            int sel[4]; float val[4];
#pragma unroll
            for (int k = 0; k < 4; ++k) { float bv = lg; int bi = e;
#pragma unroll
                for (int o = 16; o >= 1; o >>= 1) { const float ov = __shfl_xor(bv, o); const int oi = __shfl_xor(bi, o); const bool take = (ov > bv) || (ov == bv && oi < bi); bv = take ? ov : bv; bi = take ? oi : bi; }
                sel[k] = bi; val[k] = bv; if (e == bi) lg = -INFINITY; }
            const float e1 = __expf(val[1] - val[0]), e2 = __expf(val[2] - val[0]), e3 = __expf(val[3] - val[0]); const float inv = 1.0f / (1.0f + e1 + e2 + e3);
            if (e == 0) {
                *(int4*)(topi + (size_t)row * 4) = make_int4(sel[0], sel[1], sel[2], sel[3]);
                *(float4*)(topg + (size_t)row * 4) = make_float4(inv, e1 * inv, e2 * inv, e3 * inv);
                int rk[4];
#pragma unroll
                for (int k = 0; k < 4; ++k) rk[k] = (int)__hip_atomic_fetch_add(hist + sel[k], 1u, __ATOMIC_RELAXED, __HIP_MEMORY_SCOPE_WORKGROUP);
                *(int4*)(trank + (size_t)row * 4) = make_int4(rk[0], rk[1], rk[2], rk[3]);
            }
            __syncthreads();
        }
        if (F.tid < 32) hist_g[rb * 32 + F.tid] = hist[F.tid];
    }
}

__device__ __forceinline__ void moe_tables(Frame& F, int rb) {
    const unsigned* hist_g = (const unsigned*)(F.ws + WS_HIST);
    LAS unsigned* red = (LAS unsigned*)(F.lds + RING_OFF);
    __syncthreads();
    { const int e = F.tid & 31, part = F.tid >> 5; unsigned tot = 0u, pre = 0u;
#pragma unroll
      for (int i = 0; i < 16; ++i) { const int r2 = part * 16 + i; const unsigned v = hist_g[r2 * 32 + e]; tot += v; pre += (r2 < rb) ? v : 0u; }
      red[(part * 32 + e) * 2] = tot; red[(part * 32 + e) * 2 + 1] = pre; }
    __syncthreads();
    if (F.tid < 32) { unsigned tot = 0u, pre = 0u;
#pragma unroll
        for (int part = 0; part < 16; ++part) { tot += red[(part * 32 + F.tid) * 2]; pre += red[(part * 32 + F.tid) * 2 + 1]; }
        F.MISC[224 + F.tid] = tot; F.MISC[32 + F.tid] = pre; }
    __syncthreads();
    if (F.tid == 0) { int nb = 0;
        for (int e = 0; e < NE; ++e) { const int cnt = (int)F.MISC[224 + e]; const int k = (cnt + 255) >> 8; F.MISC[32 + e] += (unsigned)(nb * 256); for (int j = 0; j < k && nb < MAXBLK; ++j) F.MISC[64 + nb++] = (unsigned)e; }
        F.MISC[16] = (unsigned)nb; }
    __syncthreads();
}
__device__ __forceinline__ void moe_blocks(Frame& F) {
    __syncthreads();
    if (F.tid < 161) { const unsigned v = ((const unsigned*)(F.ws + WS_BLK))[F.tid]; if (F.tid < 160) F.MISC[64 + F.tid] = v; else F.MISC[16] = v; }
    __syncthreads();
}
__device__ __forceinline__ void p7_slots(Frame& F) {
    const int* topi = (const int*)(F.ws + WS_TOPI); const int* trank = (const int*)(F.ws + WS_TRANK); int* tslot = (int*)(F.ws + WS_TSLOT); int* slot_tok = (int*)(F.ws + WS_SLOTTOK);
    for (int rb = F.vcu; rb < T / 32; rb += F.G) {
        moe_tables(F, rb);
        if (rb == 0 && F.tid < 161) ((unsigned*)(F.ws + WS_BLK))[F.tid] = (F.tid < 160) ? F.MISC[64 + F.tid] : F.MISC[16];
        if (F.tid < 128) { const int pid = rb * 128 + F.tid; const int slot = (int)F.MISC[32 + topi[pid]] + trank[pid]; tslot[pid] = slot; slot_tok[slot] = pid >> 2; }
    }
}

__device__ __forceinline__ void p10_final(Frame& F) {
    LAS float* t1 = (LAS float*)(F.lds + RING_OFF);
    const bf16* x1 = (const bf16*)(F.ws + WS_X1); const bf16* yb = (const bf16*)(F.ws + WS_YB);
    const int* tslot = (const int*)(F.ws + WS_TSLOT); const float* topg = (const float*)(F.ws + WS_TOPG);
    const int lane = F.lane;
    for (int rb = F.vcu; rb < T / 32; rb += F.G) {
        const int b = rb >> 6;
        __syncthreads();
        { const float* md = (const float*)(F.ws + WS_MOD) + (size_t)b * (6 * D); for (int col = F.tid; col < D; col += NWAVES * 64) t1[col] = F.g_post_ffn[col] * md[5 * D + col]; }
        __syncthreads();
        for (int rr = F.wave; rr < 32; rr += NWAVES) {
            const int row = rb * 32 + rr;
            const int4 sl = *(const int4*)(tslot + (size_t)row * 4); const float4 gt = *(const float4*)(topg + (size_t)row * 4);
            const int sls[4] = {sl.x, sl.y, sl.z, sl.w}; const float gts[4] = {gt.x, gt.y, gt.z, gt.w};
            float y[4][8]; float ss = 0.f;
#pragma unroll
            for (int j = 0; j < 4; ++j) {
#pragma unroll
                for (int i = 0; i < 8; ++i) y[j][i] = 0.f;
#pragma unroll
                for (int k = 0; k < 4; ++k) { const v4u w = *(const v4u*)(yb + (size_t)sls[k] * D + 8 * lane + 512 * j); const float g = gts[k];
                    y[j][0] += g * bflo(w.x); y[j][1] += g * bfhi(w.x); y[j][2] += g * bflo(w.y); y[j][3] += g * bfhi(w.y); y[j][4] += g * bflo(w.z); y[j][5] += g * bfhi(w.z); y[j][6] += g * bflo(w.w); y[j][7] += g * bfhi(w.w); }
#pragma unroll
                for (int i = 0; i < 8; ++i) ss += y[j][i] * y[j][i];
            }
            const float r = 1.0f / sqrtf(wave_sum(ss) * (1.0f / D) + EPS);
#pragma unroll
            for (int j = 0; j < 4; ++j) { const int col = 8 * lane + 512 * j;
#pragma unroll
                for (int hh = 0; hh < 2; ++hh) { const f32x4 xv = ld4bf(x1 + (size_t)row * D + col + 4 * hh); const f32x4 a = *(LAS f32x4*)(t1 + col + 4 * hh);
                    f32x4 o; o[0] = xv[0] + a[0] * y[j][4 * hh + 0] * r; o[1] = xv[1] + a[1] * y[j][4 * hh + 1] * r; o[2] = xv[2] + a[2] * y[j][4 * hh + 2] * r; o[3] = xv[3] + a[3] * y[j][4 * hh + 3] * r;
                    __builtin_nontemporal_store(o, (f32x4*)(F.out + (size_t)row * D + col + 4 * hh)); } }
        }
    }
}

struct Args { const float* in[20]; float* out; unsigned char* ws; int ph_lo, ph_hi; };
__global__ void __launch_bounds__(NWAVES * 64, 2) fwd_kernel(Args args) {
    extern __shared__ __attribute__((aligned(16))) unsigned char lds[];
    Frame F;
    F.lds = (LAS unsigned char*)lds;
    F.MISC = (volatile LAS unsigned*)(F.lds + MISC_OFF);
    F.tid = threadIdx.x; F.lane = F.tid & 63; F.wave = __builtin_amdgcn_readfirstlane(F.tid >> 6);
    F.G = gridDim.x; { const int bx = blockIdx.x; F.vcu = (F.G % 8 == 0) ? (bx % 8) * (F.G / 8) + bx / 8 : bx; }
    F.ws = args.ws; F.ctl = (unsigned*)(args.ws + WS_CTL); F.out = args.out;
    F.x = args.in[0]; F.c = args.in[1]; F.w_ada = args.in[2]; F.b_ada = args.in[3]; F.g_pre_mix = args.in[4]; F.g_post_mix = args.in[5]; F.w_in = args.in[6]; F.rpb = args.in[7]; F.t5 = args.in[8];
    F.g_out_na = args.in[9]; F.g_out_dil = args.in[10]; F.w_o = args.in[11]; F.g_pre_ffn = args.in[12]; F.g_post_ffn = args.in[13]; F.w_router = args.in[14]; F.b_router = args.in[15];
    F.w_e_in = args.in[16]; F.b_e_in = args.in[17]; F.w_e_out = args.in[18]; F.b_e_out = args.in[19];
    for (int u = F.tid; u < 256; u += NWAVES * 64) F.MISC[u] = 0u;
    __syncthreads();
    XcdBarrier bar; bar.bar = F.ctl + CW_BAR; bar.x = 0; bar.st = nullptr;
    if (MK_N_LAUNCHES == 1) bar = xcd_barrier_post(F.ctl + CW_BAR, F.MISC + 8);
    const int lo = args.ph_lo, hi = args.ph_hi;
#define IN(k) (lo <= (k) && (k) < hi)
#define REP(k) ((PROBE_REPEAT == (k)) ? 2 : 1)
#ifndef PROBE_TIME
#define PROBE_TIME -1
#endif
    unsigned long long pt0 = 0ull, pt1 = 0ull;
#define SEAM(k) do { if (IN(k) && IN((k) + 1)) xcd_barrier(bar); if (PROBE_TIME == (k)) pt1 = __builtin_amdgcn_s_memrealtime(); if (PROBE_TIME == (k) + 1) pt0 = __builtin_amdgcn_s_memrealtime(); } while (0)
    if (PROBE_TIME == 0) pt0 = __builtin_amdgcn_s_memrealtime();

    if (IN(0)) { for (int rep = 0; rep < REP(0); ++rep) p0_prologue(F); } SEAM(0);
    if (IN(1)) { for (int rep = 0; rep < REP(1); ++rep) p1_hmix(F); } SEAM(1);
    if (IN(2)) for (int rep2 = 0; rep2 < REP(2); ++rep2) {
        __syncthreads();
        if (F.G == 256 && (int)blockIdx.x >= QKV_GEMM_WGS) {
            convw_run(F, (int)blockIdx.x - QKV_GEMM_WGS, 256 - QKV_GEMM_WGS, 0, CONVW_Q2);
        } else {
            const int gg = (F.G == 256) ? QKV_GEMM_WGS : F.G;
            pg8::Gemm g{(const bf16*)(F.ws + WS_HMIX), (const bf16*)(F.ws + WS_WIN_T), T, NQKV, D}; pg8::StaticOrder S; S.init(T, NQKV, gg, (int)blockIdx.x);
            pg8::EpiBf16 E{(bf16*)(F.ws + WS_PROJ), NQKV, nullptr, 0};
            __syncthreads(); pg8::gemm_phase<pg8::EpiBf16, pg8::StaticOrder, true, true>(F.lds + RING_OFF, g, S, E);
            if (F.G != 256) { __syncthreads(); convw_run(F, F.vcu, F.G, 0, CONVW_Q2); }
        }
    } SEAM(2);
        if (IN(3)) { for (int rep = 0; rep < REP(3); ++rep) { __syncthreads(); p3_attn_mfma(F); } } SEAM(3);
    if (IN(4)) { for (int rep = 0; rep < REP(4); ++rep) p4_post(F); } SEAM(4);
    if (IN(5)) for (int rep5 = 0; rep5 < REP(5); ++rep5) {
        __syncthreads();
        if (F.G == 256 && (int)blockIdx.x >= WO_GEMM_WGS) {
            convw_run(F, (int)blockIdx.x - WO_GEMM_WGS, 256 - WO_GEMM_WGS, CONVW_Q2, CONVW_Q2 + CONVW_Q5);
        } else {
            const int gg = (F.G == 256) ? WO_GEMM_WGS : F.G;
            pg8::Gemm g{(const bf16*)(F.ws + WS_AOUT), (const bf16*)(F.ws + WS_WO_T), T, D, D}; pg8::StaticOrder S; S.init(T, D, gg, (int)blockIdx.x);
            pg8::EpiBf16 E{(bf16*)(F.ws + WS_MIXED), D, nullptr, 0};
            __syncthreads();
            pg8::gemm_phase<pg8::EpiBf16, pg8::StaticOrder, true, true>(F.lds + RING_OFF, g, S, E);
            if (F.G != 256) { __syncthreads(); convw_run(F, F.vcu, F.G, CONVW_Q2, CONVW_Q2 + CONVW_Q5); }
        }
    } SEAM(5);
    if (IN(6)) { for (int rep = 0; rep < REP(6); ++rep) p6_rows(F); } SEAM(6);
    if (IN(7)) { for (int rep = 0; rep < REP(7); ++rep) p7_slots(F); } SEAM(7);
    if (IN(8)) {
        moe_blocks(F);
        pg8::Gemm g{(const bf16*)(F.ws + WS_HFFN), (const bf16*)(F.ws + WS_WEI_T), MAXBLK * 256, FF2, D / 2};
        LAS int* rowtab = (LAS int*)(F.lds + RING_OFF + 131072);
        pg8::MoeOrder<16> S{(const LAS int*)(F.lds + MISC_OFF + 64 * 4), (int)F.MISC[16], F.G, (int)blockIdx.x, rowtab};
        { const int* slot_tok = (const int*)(F.ws + WS_SLOTTOK); int tk[12];
#pragma unroll
          for (int i = 0; i < 12; ++i) { pg8::Unit u; const bool ok = S.next(i, u); tk[i] = (ok && F.tid < 256) ? slot_tok[u.pm * 256 + F.tid] : -1; }
#pragma unroll
          for (int i = 0; i < 12; ++i) if (tk[i] >= 0) rowtab[i * 256 + F.tid] = tk[i]; }
        pg8::EpiSwiglu8 E{F.ws + WS_HB, FF, F.b_e_in, FF2, 1.0f / (WSCALE * XSCALE), HSCALE};
        for (int rep = 0; rep < REP(8); ++rep) { __syncthreads(); pg8::gemm_phase<pg8::EpiSwiglu8, pg8::MoeOrder<16>, true, true, true, true>(F.lds + RING_OFF, g, S, E); }
    } SEAM(8);
    if (IN(9)) {
        moe_blocks(F);
        pg8::Gemm g{(const bf16*)(F.ws + WS_HB), (const bf16*)(F.ws + WS_WEO_T), MAXBLK * 256, D, FF / 2};
        pg8::MoeOrder<8> S{(const LAS int*)(F.lds + MISC_OFF + 64 * 4), (int)F.MISC[16], F.G, (int)blockIdx.x, nullptr};
        pg8::EpiBf16S E{(bf16*)(F.ws + WS_YB), D, F.b_e_out, D, 1.0f / (WSCALE * HSCALE)};
        for (int rep = 0; rep < REP(9); ++rep) { __syncthreads(); pg8::gemm_phase<pg8::EpiBf16S, pg8::MoeOrder<8>, true, true, true>(F.lds + RING_OFF, g, S, E); }
    } SEAM(9);
    if (IN(10)) { for (int rep = 0; rep < REP(10); ++rep) p10_final(F); }
    if (PROBE_TIME == 10) pt1 = __builtin_amdgcn_s_memrealtime();
    if (PROBE_TIME >= 0 && blockIdx.x == 0) { const unsigned long long te = __builtin_amdgcn_s_memrealtime(), span = (pt1 - pt0) * 8ull; while (__builtin_amdgcn_s_memrealtime() - te < span) __builtin_amdgcn_s_sleep(8); }
#undef IN
#undef SEAM
}

extern "C" void kernel_launch(void* const* d_in, const int* in_sizes, int n_in, void* d_out, int out_size, void* d_ws, size_t ws_size, hipStream_t stream) {
    static int grid = 0;
    if (grid == 0) {
        if (n_in != 20 || out_size != T * D || ws_size < WS_END) { fprintf(stderr, "kernel_launch: unexpected problem (n_in %d, out %d, ws %zu)\n", n_in, out_size, ws_size); grid = -1; return; }
        int dev = 0, cus = 0, per_cu = 0;
        if (hipGetDevice(&dev) != hipSuccess || hipDeviceGetAttribute(&cus, hipDeviceAttributeMultiprocessorCount, dev) != hipSuccess) { grid = -1; return; }
        if (hipFuncSetAttribute((const void*)fwd_kernel, hipFuncAttributeMaxDynamicSharedMemorySize, LDS_BYTES) != hipSuccess) { fprintf(stderr, "kernel_launch: hipFuncSetAttribute failed\n"); grid = -1; return; }
        if (hipOccupancyMaxActiveBlocksPerMultiprocessor(&per_cu, (const void*)fwd_kernel, NWAVES * 64, LDS_BYTES) != hipSuccess || per_cu < 1) { fprintf(stderr, "kernel_launch: occupancy query reports %d\n", per_cu); }
        (void)hipGetLastError();
        grid = cus;
    }
    if (grid < 0) return;
    if (hipMemsetAsync((char*)d_ws + WS_CTL, 0, CTL_ZERO_BYTES, stream) != hipSuccess) return;
    Args a{};
    for (int i = 0; i < 20; ++i) a.in[i] = (const float*)d_in[i];
    a.out = (float*)d_out; a.ws = (unsigned char*)d_ws;
    if (MK_N_LAUNCHES == 1) {
        a.ph_lo = 0; a.ph_hi = NPHASE;
        hipLaunchKernelGGL(fwd_kernel, dim3(grid), dim3(NWAVES * 64), LDS_BYTES, stream, a);
    } else {
        for (int p = 0; p < NPHASE; ++p) { a.ph_lo = p; a.ph_hi = p + 1; hipLaunchKernelGGL(fwd_kernel, dim3(grid), dim3(NWAVES * 64), LDS_BYTES, stream, a); }
    }
}
```

```cpp
#include <hip/hip_runtime.h>
#include <cstdio>
#include <cstdint>
#include <type_traits>

#ifndef MK_N_LAUNCHES
#define MK_N_LAUNCHES 1
#endif

namespace pg8 {
#define PG8_LAS __attribute__((address_space(3)))
typedef unsigned short bf16_t;
typedef short bf16x8 __attribute__((ext_vector_type(8)));
typedef float f32x4 __attribute__((ext_vector_type(4)));
typedef unsigned u32x4 __attribute__((ext_vector_type(4)));
typedef unsigned u32x2 __attribute__((ext_vector_type(2)));
constexpr int BM = 256, BK = 64, HALF = 128, HTB = HALF * BK * 2  , STAGE_BYTES = 8 * HTB, NXCD = 8, WGM = 8;

__host__ __device__ __forceinline__ int lds_byte(int r, int c) { const int st = (r >> 4) * 2 + (c >> 5), rr = r & 15, cc = c & 31, ob = rr * 64 + cc * 2; return st * 1024 + (ob ^ (((ob >> 9) & 1) << 5)); }
__host__ __device__ __forceinline__ void stage_rc(int b, int& R, int& C) { const int st = b / 1024, sb = b % 1024, swz = sb ^ (((sb >> 9) & 1) << 5); R = (st >> 1) * 16 + swz / 64; C = (st & 1) * 32 + (swz % 64) / 2; }
__host__ __device__ __forceinline__ int perm32(int rho) { const int n = rho >> 4, i = rho & 15; return 8 * (i >> 2) + 4 * n + (i & 3); }

struct Unit { int pm, pn, bt, e, half; };
struct Gemm { const bf16_t* A; const bf16_t* Bt; int M, N, K; };

struct StaticOrder {
    int nM, nN, nwg, G, c;
    __host__ __device__ void init(int M, int N, int G_, int c_) { nM = M / BM; nN = N / BM; nwg = nM * nN; G = G_; c = c_; }
    __host__ __device__ bool next(int i, Unit& u) const {
        const long L = (long)i * G + c; if (L >= nwg) return false;
        int wgid = (int)L; { const int q = nwg / NXCD, r = nwg % NXCD, xcd = wgid % NXCD, off = wgid / NXCD; wgid = (xcd < r ? xcd * (q + 1) : r * (q + 1) + (xcd - r) * q) + off; }
        const int nig = WGM * nN, gid = wgid / nig, fm = gid * WGM, gsz = (nM - fm) < WGM ? (nM - fm) : WGM;
        u.pm = fm + ((wgid % nig) % gsz); u.pn = (wgid % nig) / gsz; u.bt = u.pn; u.e = 0; u.half = -1; return true;
    }
    __device__ __forceinline__ void a_ready(const Unit&) const {}
    __device__ __forceinline__ void done(const Unit&) const {}
};
template <int NPN> struct MoeOrder {
    const PG8_LAS int* blk_e; int nb, G, c; const PG8_LAS int* rowtab; bool rev = false, split = false;
    __device__ __forceinline__ bool next(int i, Unit& u) const {
        int L = i * G + c;
        if (G == 256) L = ((i * 8 + (c & 7)) << 5) + (c >> 3);
        const int g = L >> 5, r = L & 31;
        int block, pn, half = -1;
        if (NPN == 16) { block = 4 * (g >> 1) + (r & 3); pn = 8 * (g & 1) + (r >> 2); } else { block = 4 * g + (r & 3); pn = r >> 2; }
        if (split && G == 256 && NPN == 8) {
            const int nfr = nb >> 5, rem = nb - 32 * nfr;
            if (rem > 0 && rem <= 16 && i == nfr) { const int x = c & 7; block = 32 * nfr + 4 * (x >> 1) + (r & 3); half = x & 1; }
        }
        if (block >= nb) return false;
        if (rev) block = nb - 1 - block;
        u.pm = block; u.pn = pn; u.e = blk_e[block]; u.bt = u.e * NPN + pn; u.half = half; return true;
    }
    __device__ __forceinline__ void a_ready(const Unit&) const {}
    __device__ __forceinline__ void done(const Unit&) const {}
};

__device__ __forceinline__ unsigned cvt_pk_bf16(float lo, float hi) { unsigned r; asm volatile("v_cvt_pk_bf16_f32 %0, %1, %2" : "=v"(r) : "v"(lo), "v"(hi)); return r; }

struct EpiF32 {
    static constexpr bool PERM = false, AFTER_DRAIN = false;
    float* C; int ldc;
    __device__ __forceinline__ void operator()(const f32x4 (&acc)[2][2][4][2], const Unit& u, int wr, int wc, int fr, int fq) const {
        const int row0 = u.pm * BM + wr * 64 + fr, col0 = u.pn * BM + wc * 32 + 4 * fq;
#pragma unroll
        for (int ai = 0; ai < 2; ++ai)
#pragma unroll
            for (int m = 0; m < 4; ++m) { float* rowp = C + (size_t)(row0 + ai * HALF + m * 16) * ldc + col0;
#pragma unroll
                for (int bj = 0; bj < 2; ++bj)
#pragma unroll
                    for (int n = 0; n < 2; ++n) *(f32x4*)(rowp + bj * HALF + n * 16) = acc[ai][bj][m][n]; }
    }
};
struct EpiBf16 {
    static constexpr bool PERM = true, AFTER_DRAIN = false;
    bf16_t* O; int ldc; const float* bias; int bias_estride;
    __device__ __forceinline__ void operator()(const f32x4 (&acc)[2][2][4][2], const Unit& u, int wr, int wc, int fr, int fq) const {
        const int row0 = u.pm * BM + wr * 64 + fr; const int col0 = u.pn * BM + wc * 32 + 8 * fq;
        f32x4 bv[2][2];
#pragma unroll
        for (int bj = 0; bj < 2; ++bj)
#pragma unroll
            for (int n = 0; n < 2; ++n) bv[bj][n] = bias ? *(const f32x4*)(bias + (size_t)u.e * bias_estride + col0 + bj * HALF + 4 * n) : (f32x4){0.f, 0.f, 0.f, 0.f};
#pragma unroll
        for (int ai = 0; ai < 2; ++ai)
#pragma unroll
            for (int m = 0; m < 4; ++m) { bf16_t* rowp = O + (size_t)(row0 + ai * HALF + m * 16) * ldc + col0;
#pragma unroll
                for (int bj = 0; bj < 2; ++bj) { const f32x4 v0 = acc[ai][bj][m][0] + bv[bj][0], v1 = acc[ai][bj][m][1] + bv[bj][1];
                    u32x4 w; w.x = cvt_pk_bf16(v0[0], v0[1]); w.y = cvt_pk_bf16(v0[2], v0[3]); w.z = cvt_pk_bf16(v1[0], v1[1]); w.w = cvt_pk_bf16(v1[2], v1[3]);
                    *(u32x4*)(rowp + bj * HALF) = w; } }
    }
};
__device__ __forceinline__ float swiglu1(float g, float u) {
    g = fminf(g, 7.0f); u = fminf(fmaxf(u, -7.0f), 7.0f);
    const float s = __builtin_amdgcn_rcpf(1.0f + __builtin_amdgcn_exp2f(g * (-1.702f * 1.44269504089f)));
    return (u + 1.0f) * (g * s);
}
struct EpiSwiglu {
    static constexpr bool PERM = true, AFTER_DRAIN = false;
    bf16_t* H; int ldh; const float* bias; int bias_estride;
    __device__ __forceinline__ void operator()(const f32x4 (&acc)[2][2][4][2], const Unit& u, int wr, int wc, int fr, int fq) const {
        const int row0 = u.pm * BM + wr * 64 + fr; const int col0 = u.pn * BM + wc * 32 + 8 * fq;
        f32x4 bv[2][2];
#pragma unroll
        for (int bj = 0; bj < 2; ++bj)
#pragma unroll
            for (int n = 0; n < 2; ++n) bv[bj][n] = *(const f32x4*)(bias + (size_t)u.e * bias_estride + col0 + bj * HALF + 4 * n);
#pragma unroll
        for (int ai = 0; ai < 2; ++ai)
#pragma unroll
            for (int m = 0; m < 4; ++m) { bf16_t* rowp = H + (size_t)(row0 + ai * HALF + m * 16) * ldh + (col0 >> 1);
#pragma unroll
                for (int bj = 0; bj < 2; ++bj) { const f32x4 v0 = acc[ai][bj][m][0] + bv[bj][0], v1 = acc[ai][bj][m][1] + bv[bj][1];
                    u32x2 w; w.x = cvt_pk_bf16(swiglu1(v0[0], v0[1]), swiglu1(v0[2], v0[3])); w.y = cvt_pk_bf16(swiglu1(v1[0], v1[1]), swiglu1(v1[2], v1[3]));
                    *(u32x2*)(rowp + bj * (HALF / 2)) = w; } }
    }
};

__device__ __forceinline__ unsigned cvt4_fp8(float a, float b, float c, float d) {
    int r = 0;
    r = __builtin_amdgcn_cvt_pk_fp8_f32(__builtin_amdgcn_fmed3f(a, -448.f, 448.f), __builtin_amdgcn_fmed3f(b, -448.f, 448.f), r, false);
    r = __builtin_amdgcn_cvt_pk_fp8_f32(__builtin_amdgcn_fmed3f(c, -448.f, 448.f), __builtin_amdgcn_fmed3f(d, -448.f, 448.f), r, true);
    return (unsigned)r;
}
struct EpiSwiglu8 {
    static constexpr bool PERM = true, AFTER_DRAIN = false;
    unsigned char* H; int ldh; const float* bias; int bias_estride; float ascale, hscale;
    __device__ __forceinline__ void operator()(const f32x4 (&acc)[2][2][4][2], const Unit& u, int wr, int wc, int fr, int fq) const {
        const int row0 = u.pm * BM + wr * 64 + fr; const int col0 = u.pn * BM + wc * 32 + 8 * fq;
        f32x4 bv[2][2];
#pragma unroll
        for (int bj = 0; bj < 2; ++bj)
#pragma unroll
            for (int n = 0; n < 2; ++n) bv[bj][n] = *(const f32x4*)(bias + (size_t)u.e * bias_estride + col0 + bj * HALF + 4 * n);
#pragma unroll
        for (int ai = 0; ai < 2; ++ai)
#pragma unroll
            for (int m = 0; m < 4; ++m) { unsigned char* rowp = H + (size_t)(row0 + ai * HALF + m * 16) * ldh + (col0 >> 1);
#pragma unroll
                for (int bj = 0; bj < 2; ++bj) { const f32x4 v0 = acc[ai][bj][m][0] * ascale + bv[bj][0], v1 = acc[ai][bj][m][1] * ascale + bv[bj][1];
                    *(unsigned*)(rowp + bj * (HALF / 2)) = cvt4_fp8(hscale * swiglu1(v0[0], v0[1]), hscale * swiglu1(v0[2], v0[3]), hscale * swiglu1(v1[0], v1[1]), hscale * swiglu1(v1[2], v1[3])); } }
    }
};
struct EpiBf16S {
    static constexpr bool PERM = true, AFTER_DRAIN = false;
    bf16_t* O; int ldc; const float* bias; int bias_estride; float ascale;
    __device__ __forceinline__ void operator()(const f32x4 (&acc)[2][2][4][2], const Unit& u, int wr, int wc, int fr, int fq) const {
        const int row0 = u.pm * BM + wr * 64 + fr; const int col0 = u.pn * BM + wc * 32 + 8 * fq;
        f32x4 bv[2][2];
#pragma unroll
        for (int bj = 0; bj < 2; ++bj)
#pragma unroll
            for (int n = 0; n < 2; ++n) bv[bj][n] = *(const f32x4*)(bias + (size_t)u.e * bias_estride + col0 + bj * HALF + 4 * n);
#pragma unroll
        for (int ai = 0; ai < 2; ++ai)
#pragma unroll
            for (int m = 0; m < 4; ++m) { bf16_t* rowp = O + (size_t)(row0 + ai * HALF + m * 16) * ldc + col0;
#pragma unroll
                for (int bj = 0; bj < 2; ++bj) { const f32x4 v0 = acc[ai][bj][m][0] * ascale + bv[bj][0], v1 = acc[ai][bj][m][1] * ascale + bv[bj][1];
                    u32x4 w; w.x = cvt_pk_bf16(v0[0], v0[1]); w.y = cvt_pk_bf16(v0[2], v0[3]); w.z = cvt_pk_bf16(v1[0], v1[1]); w.w = cvt_pk_bf16(v1[2], v1[3]);
                    *(u32x4*)(rowp + bj * HALF) = w; } }
    }
};
struct EpiFp8S {
    static constexpr bool PERM = true, AFTER_DRAIN = false;
    unsigned char* O; int ldc; const float* bias; int bias_estride; float ascale, oscale;
    __device__ __forceinline__ void operator()(const f32x4 (&acc)[2][2][4][2], const Unit& u, int wr, int wc, int fr, int fq) const {
        const int row0 = u.pm * BM + wr * 64 + fr; const int col0 = u.pn * BM + wc * 32 + 8 * fq + (u.half == 1 ? HALF : 0);
        const bool whole = u.half < 0;
        f32x4 bv[2][2];
#pragma unroll
        for (int bj = 0; bj < 2; ++bj)
#pragma unroll
            for (int n = 0; n < 2; ++n) bv[bj][n] = *(const f32x4*)(bias + (size_t)u.e * bias_estride + col0 + (whole ? bj * HALF : 0) + 4 * n) * oscale;
        const float as = ascale * oscale;
#pragma unroll
        for (int ai = 0; ai < 2; ++ai)
#pragma unroll
            for (int m = 0; m < 4; ++m) { unsigned char* rowp = O + (size_t)(row0 + ai * HALF + m * 16) * ldc + col0;
#pragma unroll
                for (int bj = 0; bj < 2; ++bj) { if (bj == 1 && !whole) continue;
                    const f32x4 v0 = acc[ai][bj][m][0] * as + bv[bj][0], v1 = acc[ai][bj][m][1] * as + bv[bj][1];
                    uint2 w; w.x = cvt4_fp8(v0[0], v0[1], v0[2], v0[3]); w.y = cvt4_fp8(v1[0], v1[1], v1[2], v1[3]);
                    *(uint2*)(rowp + bj * HALF) = w; } }
    }
};

#ifndef FP8_SAME_ADDR
#define FP8_SAME_ADDR 1
#endif
typedef int v8i32 __attribute__((ext_vector_type(8)));
typedef short bf16x16 __attribute__((ext_vector_type(16)));
template <class Epi, class Sched, bool ALIGN_EPI = false, bool SP2 = false, bool FP8 = false, bool GATHER = false>
__device__ __forceinline__ void gemm_phase(PG8_LAS unsigned char* lds, const Gemm g, const Sched& S, const Epi& E) {
    const int tid = threadIdx.x, wid = __builtin_amdgcn_readfirstlane(tid >> 6), lane = tid & 63, wr = wid >> 2, wc = wid & 3, fr = lane & 15, fq = lane >> 4;
    const int K = g.K, nt = K / BK;
    unsigned voffA[2], voffB[2];
#pragma unroll
    for (int i = 0; i < 2; ++i) { int R, C; stage_rc(tid * 16 + i * 8192, R, C); const int Rb = Epi::PERM ? ((R & ~31) + perm32(R & 31)) : R;
        voffA[i] = (unsigned)(R * K + C) * 2u; voffB[i] = (unsigned)(Rb * K + C) * 2u; }
    unsigned gAc[2][2], gAn[2][2];
#define PG8_GLOAD(dst, uidx) do { _Pragma("unroll") for (int _h = 0; _h < 2; ++_h) _Pragma("unroll") for (int _i = 0; _i < 2; ++_i) { int _R, _C; stage_rc(tid * 16 + _i * 8192, _R, _C); \
        dst[_h][_i] = (unsigned)S.rowtab[(uidx) * 256 + _h * HALF + _R] * (unsigned)(K * 2) + (unsigned)_C * 2u; } } while (0)
    const size_t kstep = (size_t)(BK * 2);
    const size_t hstep = (size_t)HALF * K * 2;
    const size_t tstep = 2 * hstep;
    const unsigned ldsw = (unsigned)wid * 1024u;
    const int fcol = (FP8 && !FP8_SAME_ADDR) ? (32 * (fq >> 1) + 16 * (fq & 1)) : fq * 8;
    const int aoff = lds_byte(wr * 64 + fr, fcol), boff = lds_byte(wc * 32 + fr, fcol);
    constexpr int KSTR = (FP8 && !FP8_SAME_ADDR) ? 16 : 1024;
#define PG8_SA(b, h) (((b) * 2 + (h)) * HTB)
#define PG8_SB(b, h) ((4 + (b) * 2 + (h)) * HTB)
#define PG8_STAGE(bufoff, gbase, voff) do { _Pragma("unroll") for (int _i = 0; _i < 2; ++_i) \
        __builtin_amdgcn_global_load_lds((const unsigned*)((const char*)(gbase) + (voff)[_i]), (PG8_LAS unsigned*)(lds + (bufoff) + ldsw + _i * 8192), 16, 0, 0); } while (0)
#define PG8_RD(dst, addr) do { if constexpr (FP8) { const u32x4 _lo = *(const PG8_LAS u32x4*)(addr), _hi = *(const PG8_LAS u32x4*)((addr) + KSTR); \
        (dst)[0] = (frag_t)__builtin_bit_cast(v8i32, __builtin_shufflevector(_lo, _hi, 0, 1, 2, 3, 4, 5, 6, 7)); } \
    else { (dst)[0] = (frag_t)*(const PG8_LAS bf16x8*)(addr); (dst)[NKF - 1] = (frag_t)*(const PG8_LAS bf16x8*)((addr) + 1024); } } while (0)
#define PG8_STAGE_A(bufoff, abase, h, nx) do { if constexpr (GATHER) { unsigned _g[2] = {(nx) ? gAn[h][0] : gAc[h][0], (nx) ? gAn[h][1] : gAc[h][1]}; PG8_STAGE(bufoff, abase, _g); } \
        else { PG8_STAGE(bufoff, (abase) + (h) * hstep, voffA); } } while (0)
#define PG8_LDA(dst, b, h) do { _Pragma("unroll") for (int m = 0; m < 4; ++m) PG8_RD(dst[m], lds + PG8_SA(b, h) + aoff + m * 2048); } while (0)
#define PG8_LDB(dst, b, h) do { _Pragma("unroll") for (int n = 0; n < 2; ++n) PG8_RD(dst[n], lds + PG8_SB(b, h) + boff + n * 2048); } while (0)
#define PG8_MMA(ai, bj, At, Bt) do { __builtin_amdgcn_s_setprio(1); _Pragma("unroll") for (int m = 0; m < 4; ++m) _Pragma("unroll") for (int n = 0; n < 2; ++n) { \
        if constexpr (FP8) asm volatile("v_mfma_f32_16x16x128_f8f6f4 %0, %1, %2, %0" : "+v"(acc[ai][bj][m][n]) : "v"(Bt[n][0]), "v"(At[m][0])); \
        else { _Pragma("unroll") for (int k = 0; k < NKF; ++k) acc[ai][bj][m][n] = __builtin_amdgcn_mfma_f32_16x16x32_bf16((bf16x8)Bt[n][k], (bf16x8)At[m][k], acc[ai][bj][m][n], 0, 0, 0); } } \
        __builtin_amdgcn_s_setprio(0); } while (0)
#define PG8_WAIT_V(n) asm volatile("s_waitcnt vmcnt(" #n ")" ::: "memory")
#define PG8_WAIT_L(n) asm volatile("s_waitcnt lgkmcnt(" #n ")" ::: "memory")
#define PG8_BAR __builtin_amdgcn_s_barrier()
#define PG8_SCHED __builtin_amdgcn_sched_barrier(0)
    Unit cur, nxt; int ui = 0;
    if (!S.next(0, cur)) return;
    f32x4 acc[2][2][4][2];
#pragma unroll
    for (int a = 0; a < 2; ++a)
#pragma unroll
        for (int b = 0; b < 2; ++b)
#pragma unroll
            for (int m = 0; m < 4; ++m)
#pragma unroll
                for (int n = 0; n < 2; ++n) acc[a][b][m][n] = (f32x4){0.f, 0.f, 0.f, 0.f};
    typedef typename std::conditional<FP8, v8i32, bf16x8>::type frag_t; constexpr int NKF = FP8 ? 1 : 2;
    frag_t At[4][NKF], B0[2][NKF], B1[2][NKF];
    const char* cA = (const char*)g.A + (GATHER ? (size_t)0 : (size_t)cur.pm * tstep); const char* cB = (const char*)g.Bt + (size_t)cur.bt * tstep + (cur.half == 1 ? hstep : (size_t)0);
    size_t cbh = (cur.half >= 0) ? (size_t)0 : hstep, nbh = cbh;
    S.a_ready(cur);
    if constexpr (GATHER) { PG8_GLOAD(gAc, 0); }
    if constexpr (SP2) {
        PG8_STAGE(PG8_SB(0, 0), cB, voffB); PG8_STAGE(PG8_SB(0, 1), cB + cbh, voffB); PG8_STAGE_A(PG8_SA(0, 0), cA, 0, false); PG8_STAGE_A(PG8_SA(0, 1), cA, 1, false);
        if (wr == 1) PG8_BAR;
        PG8_WAIT_V(2); PG8_BAR;
        PG8_STAGE(PG8_SB(1, 0), cB + kstep, voffB); PG8_STAGE_A(PG8_SA(1, 0), cA + kstep, 0, false); PG8_STAGE(PG8_SB(1, 1), cB + cbh + kstep, voffB);
        PG8_WAIT_V(6); PG8_BAR;
    } else {
        PG8_STAGE(PG8_SB(0, 0), cB, voffB); PG8_STAGE_A(PG8_SA(0, 0), cA, 0, false); PG8_STAGE(PG8_SB(0, 1), cB + cbh, voffB); PG8_STAGE_A(PG8_SA(0, 1), cA, 1, false);
        if (wr == 1) PG8_BAR;
        PG8_WAIT_V(4); PG8_BAR;
        PG8_STAGE(PG8_SB(1, 0), cB + kstep, voffB); PG8_STAGE_A(PG8_SA(1, 0), cA + kstep, 0, false); PG8_STAGE(PG8_SB(1, 1), cB + cbh + kstep, voffB);
        PG8_WAIT_V(6); PG8_BAR;
    }
    for (;;) {
        const bool has_next = S.next(ui + 1, nxt);
        const char* nA = (has_next && !GATHER) ? (const char*)g.A + (size_t)nxt.pm * tstep : cA;
        if constexpr (GATHER) { if (has_next) { PG8_GLOAD(gAn, ui + 1); } else { gAn[0][0] = gAc[0][0]; gAn[0][1] = gAc[0][1]; gAn[1][0] = gAc[1][0]; gAn[1][1] = gAc[1][1]; } } const char* nB = has_next ? (const char*)g.Bt + (size_t)nxt.bt * tstep + (nxt.half == 1 ? hstep : (size_t)0) : cB; nbh = has_next ? ((nxt.half >= 0) ? (size_t)0 : hstep) : cbh;
        const bool cwhole = cur.half < 0;
        for (int t = 0; t < nt; t += 2) {
            const bool last = (t == nt - 2);
            const char* a1 = cA + (size_t)(t + 1) * kstep;
            const char* a2 = last ? nA : cA + (size_t)(t + 2) * kstep; const char* b2 = last ? nB : cB + (size_t)(t + 2) * kstep;
            const char* a3 = a2 + kstep; const char* b3 = b2 + kstep; const size_t bh2 = last ? nbh : cbh;
            if (last && has_next) S.a_ready(nxt);
            if constexpr (SP2) {
            PG8_LDB(B0, 0, 0); PG8_LDB(B1, 0, 1); PG8_SCHED; PG8_LDA(At, 0, 0); PG8_STAGE_A(PG8_SA(1, 1), a1, 1, false);
            PG8_WAIT_V(8); PG8_WAIT_L(0); PG8_BAR; PG8_MMA(0, 0, At, B0); if (cwhole) PG8_MMA(0, 1, At, B1); PG8_BAR; PG8_SCHED;
            PG8_LDA(At, 0, 1); PG8_STAGE(PG8_SB(0, 0), b2, voffB); PG8_STAGE(PG8_SB(0, 1), b2 + bh2, voffB); PG8_STAGE_A(PG8_SA(0, 0), a2, 0, last);
            PG8_WAIT_V(8); PG8_WAIT_L(0); PG8_BAR; PG8_MMA(1, 0, At, B0); if (cwhole) PG8_MMA(1, 1, At, B1); PG8_BAR; PG8_SCHED;
            PG8_LDB(B0, 1, 0); PG8_LDB(B1, 1, 1); PG8_SCHED; PG8_LDA(At, 1, 0); PG8_STAGE_A(PG8_SA(0, 1), a2, 1, last);
            PG8_WAIT_V(8); PG8_WAIT_L(0); PG8_BAR; PG8_MMA(0, 0, At, B0); if (cwhole) PG8_MMA(0, 1, At, B1); PG8_BAR; PG8_SCHED;
            PG8_LDA(At, 1, 1); PG8_STAGE(PG8_SB(1, 0), b3, voffB); PG8_STAGE(PG8_SB(1, 1), b3 + bh2, voffB); PG8_STAGE_A(PG8_SA(1, 0), a3, 0, last);
            PG8_WAIT_V(8); PG8_WAIT_L(0); PG8_BAR; PG8_MMA(1, 0, At, B0); if (cwhole) PG8_MMA(1, 1, At, B1); PG8_BAR; PG8_SCHED;
            } else {
            PG8_LDB(B0, 0, 0); PG8_SCHED; PG8_LDA(At, 0, 0); PG8_STAGE_A(PG8_SA(1, 1), a1, 1, false);
            PG8_WAIT_L(8); PG8_BAR; PG8_WAIT_L(0); PG8_MMA(0, 0, At, B0); PG8_BAR; PG8_SCHED;
            PG8_LDB(B1, 0, 1); PG8_STAGE(PG8_SB(0, 0), b2, voffB);
            PG8_BAR; PG8_WAIT_L(0); PG8_MMA(0, 1, At, B1); PG8_BAR;
            PG8_LDA(At, 0, 1); PG8_STAGE_A(PG8_SA(0, 0), a2, 0, last);
            PG8_BAR; PG8_WAIT_L(0); PG8_MMA(1, 0, At, B0); PG8_BAR; PG8_SCHED;
            PG8_STAGE(PG8_SB(0, 1), b2 + bh2, voffB);
            PG8_WAIT_V(6); PG8_BAR; PG8_MMA(1, 1, At, B1); PG8_BAR;
            PG8_LDB(B0, 1, 0); PG8_SCHED; PG8_LDA(At, 1, 0); PG8_STAGE_A(PG8_SA(0, 1), a2, 1, last);
            PG8_WAIT_L(8); PG8_BAR; PG8_WAIT_L(0); PG8_MMA(0, 0, At, B0); PG8_BAR; PG8_SCHED;
            PG8_LDB(B1, 1, 1); PG8_STAGE(PG8_SB(1, 0), b3, voffB);
            PG8_BAR; PG8_WAIT_L(0); PG8_MMA(0, 1, At, B1); PG8_BAR;
            PG8_LDA(At, 1, 1); PG8_STAGE_A(PG8_SA(1, 0), a3, 0, last);
            PG8_BAR; PG8_WAIT_L(0); PG8_MMA(1, 0, At, B0); PG8_BAR; PG8_SCHED;
            PG8_STAGE(PG8_SB(1, 1), b3 + bh2, voffB);
            PG8_WAIT_V(6); PG8_BAR; PG8_MMA(1, 1, At, B1); PG8_BAR;
            }
        }
        if constexpr (ALIGN_EPI) { if (wr == 0) PG8_BAR; }
        if constexpr (FP8) asm volatile("s_nop 15\n\ts_nop 15" ::: "memory");
        if constexpr (!Epi::AFTER_DRAIN) { E(acc, cur, wr, wc, fr, fq); S.done(cur); }
        if (!has_next) break;
#pragma unroll
        for (int a = 0; a < 2; ++a)
#pragma unroll
            for (int b = 0; b < 2; ++b)
#pragma unroll
                for (int m = 0; m < 4; ++m)
#pragma unroll
                    for (int n = 0; n < 2; ++n) acc[a][b][m][n] = (f32x4){0.f, 0.f, 0.f, 0.f};
        cur = nxt; cA = nA; cB = nB; cbh = nbh; ++ui;
        if constexpr (GATHER) { gAc[0][0] = gAn[0][0]; gAc[0][1] = gAn[0][1]; gAc[1][0] = gAn[1][0]; gAc[1][1] = gAn[1][1]; }
        if constexpr (ALIGN_EPI) { if (wr == 1) PG8_BAR; }
    }
    PG8_WAIT_V(0);
    if constexpr (!ALIGN_EPI) { if (wr == 0) PG8_BAR; }
    PG8_BAR;
    if constexpr (Epi::AFTER_DRAIN) { E.fused(acc, cur, wr, wc, fr, fq, lds, wid, lane); S.done(cur); }
#undef PG8_SA
#undef PG8_SB
#undef PG8_STAGE
#undef PG8_STAGE_A
#undef PG8_GLOAD
#undef PG8_LDA
#undef PG8_LDB
#undef PG8_MMA
#undef PG8_RD
#undef PG8_WAIT_V
#undef PG8_WAIT_L
#undef PG8_BAR
#undef PG8_SCHED
}
}

#ifndef PROBE_REPEAT
#define PROBE_REPEAT -1
#endif
constexpr int NWAVES = 8;
constexpr int NBATCH = 4, SEQ = 2048, T = NBATCH * SEQ, D = 2048, HD = 128, NHG = 8, GW = 1024, NQKV = 6144, NE = 32, TOPK = 4, FF = 2048, FF2 = 4096;
constexpr int MAXBLK = 160;
constexpr float EPS = 1e-6f;
constexpr int NPHASE = 11;
constexpr float WSCALE = 512.0f, XSCALE = 16.0f, HSCALE = 4.0f;

constexpr size_t MiB = 1u << 20;
constexpr size_t WS_CTL = 0, CTL_ZERO_BYTES = 1 * MiB;
constexpr size_t WS_SLOTTOK = 512 * 1024;
constexpr size_t WS_MODP = 1 * MiB;
constexpr size_t WS_WRT = 4 * MiB + 512 * 1024;
constexpr size_t WS_MOD = 4 * MiB;
constexpr size_t WS_TOPI = 5 * MiB, WS_TOPG = WS_TOPI + 131072, WS_TSLOT = WS_TOPG + 131072;
constexpr size_t WS_BLK = WS_TSLOT + 131072 + 131072 + 32768;
constexpr size_t WS_TRANK = WS_TSLOT + 131072, WS_HIST = WS_TRANK + 131072;
constexpr size_t WS_LSE = 6 * MiB;
constexpr size_t WS_WIN_T = 8 * MiB;
constexpr size_t WS_WO_T = 32 * MiB;
constexpr size_t WS_HMIX = 40 * MiB;
constexpr size_t WS_AOUT = 72 * MiB;
constexpr size_t WS_PROJ = 104 * MiB;
constexpr size_t WS_ONA = 200 * MiB;
constexpr size_t WS_ODIL = 232 * MiB;
constexpr size_t WS_MIXED = 328 * MiB;
constexpr size_t WS_X1 = 392 * MiB;
constexpr size_t WS_HFFN = 456 * MiB;
constexpr size_t WS_XG = 492 * MiB;
constexpr size_t WS_HB = 652 * MiB;
constexpr size_t WS_YB = 812 * MiB;
constexpr float YSCALE = 16.0f;
constexpr size_t WS_WEI_T = 1024 * MiB;
constexpr size_t WS_WEO_T = 1536 * MiB;
constexpr size_t WS_END = 1792 * MiB;
constexpr int CW_TMO = 0, CW_CODE = 1, CW_CNT = 256, CW_CUR = 512, CW_BAR = 4096;

constexpr int RING_OFF = 0, RING_BYTES = 155648;
constexpr int MISC_OFF = RING_BYTES;
constexpr int LDS_BYTES = RING_BYTES + 1024;

#define GAS __attribute__((address_space(1)))
#define LAS __attribute__((address_space(3)))
typedef unsigned short bf16;
typedef unsigned v4u __attribute__((ext_vector_type(4)));
typedef unsigned v2u __attribute__((ext_vector_type(2)));
typedef float f32x4 __attribute__((ext_vector_type(4)));
typedef GAS unsigned gu32;
#define RLX_AGENT __ATOMIC_RELAXED, __HIP_MEMORY_SCOPE_AGENT
#define LDS_WAIT() asm volatile("s_waitcnt lgkmcnt(0)" ::: "memory")
#define VM_WAIT() asm volatile("s_waitcnt vmcnt(0)" ::: "memory")
__device__ __forceinline__ float bf2f(unsigned short h) { return __builtin_bit_cast(float, (unsigned)h << 16); }
__device__ __forceinline__ float bflo(unsigned w) { return __builtin_bit_cast(float, w << 16); }
__device__ __forceinline__ float bfhi(unsigned w) { return __builtin_bit_cast(float, w & 0xffff0000u); }
__device__ __forceinline__ unsigned pk2(float lo, float hi) { return pg8::cvt_pk_bf16(lo, hi); }
__device__ __forceinline__ f32x4 ld4bf(const unsigned short* p) { const v2u w = *(const v2u*)p; return (f32x4){bflo(w.x), bfhi(w.x), bflo(w.y), bfhi(w.y)}; }

#define XB_TMO      128
#define XB_XCNT(j)  (256  + 64 * (j))
#define XB_XSUB(j)  (1280 + 64 * (j))
#define XB_XGEN(j)  (2304 + 64 * (j))
#define XB_TOP      3328
#define XB_TOPGEN   3392
#define XCD_BAR_WORDS 3456
#define XB_SPIN_CAP (1u << 18)
__device__ __forceinline__ unsigned xb_ld(unsigned* p)              { return __hip_atomic_load(p, __ATOMIC_RELAXED, __HIP_MEMORY_SCOPE_AGENT); }
__device__ __forceinline__ unsigned xb_add(unsigned* p, unsigned v) { return __hip_atomic_fetch_add(p, v, __ATOMIC_RELAXED, __HIP_MEMORY_SCOPE_AGENT); }
__device__ __forceinline__ unsigned xb_xcc_id() { return (unsigned)__builtin_amdgcn_s_getreg((3 << 11) | 20) & 0xFu; }
#define XB_SPIN(cond, bar) do { unsigned _sp = 0; while (cond) { __builtin_amdgcn_s_sleep(1); \
    if ((++_sp & 255u) == 0u) { if (xb_ld(&(bar)[XB_TMO])) break; if (_sp > XB_SPIN_CAP) { atomicAdd(&(bar)[XB_TMO], 1u); break; } } } } while (0)
struct XcdBarrier { unsigned* bar; unsigned x; volatile LAS unsigned* st; };
__device__ __forceinline__ XcdBarrier xcd_barrier_post(unsigned* bar, volatile LAS unsigned* st) {
    XcdBarrier b; b.bar = bar; b.x = xb_xcc_id(); b.st = st;
    if (threadIdx.x == 0) (void)xb_add(&bar[XB_XCNT(b.x)], 1u);
    return b;
}
__device__ __forceinline__ void xcd_barrier_complete(unsigned* bar, unsigned x, unsigned& nloc, unsigned& nx) {
    const unsigned G = gridDim.x * gridDim.y * gridDim.z;
    unsigned sum, cnt, mine, sp = 0u;
    for (;;) {
        sum = 0u; cnt = 0u; mine = 0u;
#pragma unroll
        for (unsigned j = 0; j < 16; ++j) { const unsigned c = xb_ld(&bar[XB_XCNT(j)]); sum += c; cnt += (c > 0u) ? 1u : 0u; mine = (j == x) ? c : mine; }
        if (sum == G) break;
        __builtin_amdgcn_s_sleep(1);
        if ((++sp & 255u) == 0u) { if (xb_ld(&bar[XB_TMO])) break; if (sp > XB_SPIN_CAP) { atomicAdd(&bar[XB_TMO], 1u); break; } }
    }
    nloc = mine > 0u ? mine : 1u; nx = cnt > 0u ? cnt : 1u;
}
__device__ __forceinline__ void xcd_barrier(const XcdBarrier& b) {
    asm volatile("s_waitcnt vmcnt(0)" ::: "memory");
    __syncthreads();
    if (threadIdx.x == 0) {
        unsigned* bar = b.bar;
        __builtin_amdgcn_s_waitcnt(0);
        unsigned nloc = b.st[0], nx = b.st[1];
        if (nloc == 0u) { xcd_barrier_complete(bar, b.x, nloc, nx); b.st[0] = nloc; b.st[1] = nx; }
        const unsigned old = xb_add(&bar[XB_XSUB(b.x)], 1u);
        const unsigned gen = old / nloc;
        if (old + 1u == (gen + 1u) * nloc) {
            __builtin_amdgcn_fence(__ATOMIC_RELEASE, "agent");
            asm volatile("s_waitcnt vmcnt(0)" ::: "memory");
            const unsigned og = xb_add(&bar[XB_TOP], 1u);
            const unsigned tg = og / nx;
            if (og + 1u == (tg + 1u) * nx) xb_add(&bar[XB_TOPGEN], 1u);
            else XB_SPIN(xb_ld(&bar[XB_TOPGEN]) == tg, bar);
            __builtin_amdgcn_fence(__ATOMIC_ACQUIRE, "agent");
            xb_add(&bar[XB_XGEN(b.x)], 1u);
            asm volatile("s_waitcnt vmcnt(0)" ::: "memory");
        } else {
            XB_SPIN(xb_ld(&bar[XB_XGEN(b.x)]) == gen, bar);
            __builtin_amdgcn_fence(__ATOMIC_ACQUIRE, "agent");
            asm volatile("s_waitcnt vmcnt(0)" ::: "memory");
        }
    }
    __syncthreads();
}

struct Frame {
    LAS unsigned char* lds;
    volatile LAS unsigned* MISC;
    unsigned* ctl;
    int tid, lane, wave, vcu, G;
    const float *x, *c, *w_ada, *b_ada, *g_pre_mix, *g_post_mix, *w_in, *rpb, *t5, *g_out_na, *g_out_dil, *w_o, *g_pre_ffn, *g_post_ffn, *w_router, *b_router, *w_e_in, *b_e_in, *w_e_out, *b_e_out;
    float* out;
    unsigned char* ws;
};
__device__ __forceinline__ float wave_sum(float v) {
#pragma unroll
    for (int o = 1; o < 64; o <<= 1) v += __shfl_xor(v, o);
    return v;
}
__device__ __forceinline__ float wave_max(float v) {
#pragma unroll
    for (int o = 1; o < 64; o <<= 1) v = fmaxf(v, __shfl_xor(v, o));
    return v;
}
__device__ __forceinline__ float mod_val(const Frame& F, int b, int idx) {
    const float* mp = (const float*)(F.ws + WS_MODP);
    float s = F.b_ada[idx];
#pragma unroll
    for (int ks = 0; ks < 16; ++ks) s += mp[(size_t)(ks * 4 + b) * (6 * D) + idx];
    return s;
}

__constant__ unsigned char T5B[3][132] = {
 {11,11,11,11,11,11,11,11,11,11,11,11,11,11,11,10,10,10,10,10,10,10,10,10,10,10,10,10,10,10,10,10,10,10,10,10,10,10,9,9,9,9,9,9,9,9,9,9,9,9,8,8,8,8,8,8,8,7,6,5,4,3,2,1,0,17,18,19,20,21,22,23,24,24,24,24,24,24,24,25,25,25,25,25,25,25,25,25,25,25,25,26,26,26,26,26,26,26,26,26,26,26,26,26,26,26,26,26,26,26,26,26,26,26,27,27,27,27,27,27,27,27,27,27,27,27,27,27,27,0,0,0},
 {13,13,13,13,13,13,13,13,13,13,13,13,13,13,13,13,13,13,13,13,13,13,13,12,12,12,12,12,12,12,12,12,12,12,12,12,12,12,12,12,12,12,11,11,11,11,11,11,11,11,11,11,10,10,10,10,10,10,9,9,9,8,8,4,0,20,24,24,25,25,25,26,26,26,26,26,26,27,27,27,27,27,27,27,27,27,27,28,28,28,28,28,28,28,28,28,28,28,28,28,28,28,28,28,28,28,29,29,29,29,29,29,29,29,29,29,29,29,29,29,29,29,29,29,29,29,29,29,29,0,0,0},
 {15,15,15,15,15,15,15,15,15,15,15,15,15,15,15,15,15,15,15,15,15,15,15,15,15,15,15,15,15,15,14,14,14,14,14,14,14,14,14,14,14,14,14,14,14,13,13,13,13,13,13,13,13,13,12,12,12,12,12,11,11,10,10,9,0,25,26,26,27,27,28,28,28,28,28,29,29,29,29,29,29,29,29,29,30,30,30,30,30,30,30,30,30,30,30,30,30,30,30,31,31,31,31,31,31,31,31,31,31,31,31,31,31,31,31,31,31,31,31,31,31,31,31,31,31,31,31,31,31,0,0,0}};

__device__ __forceinline__ void p0_mod_item(Frame& F, int j) {
    const int ks = j >> 4, cb = j & 15;
    LAS float* sc = (LAS float*)(F.lds + RING_OFF);
    LAS float* red = (LAS float*)(F.lds + RING_OFF + 4096);
    __syncthreads();
    { const int b = F.tid >> 7, k = F.tid & 127; const float cv = F.c[b * D + ks * 128 + k]; sc[F.tid] = cv / (1.0f + __expf(-cv)); }
    __syncthreads();
    const int cg = F.tid % 192, sub = F.tid / 192;
    f32x4 acc[4];
#pragma unroll
    for (int b = 0; b < 4; ++b) acc[b] = (f32x4){0.f, 0.f, 0.f, 0.f};
    if (sub < 2) {
        const float* wp = F.w_ada + (size_t)(ks * 128 + sub * 64) * (6 * D) + cb * 768 + 4 * cg;
#pragma unroll 8
        for (int i = 0; i < 64; ++i) {
            const f32x4 w = __builtin_nontemporal_load((const f32x4*)(wp + (size_t)i * (6 * D)));
#pragma unroll
            for (int b = 0; b < 4; ++b) { const float s = sc[b * 128 + sub * 64 + i]; acc[b] += w * s; }
        }
        if (sub == 1) {
#pragma unroll
            for (int b = 0; b < 4; ++b) *(LAS f32x4*)(red + cg * 16 + b * 4) = acc[b];
        }
    }
    __syncthreads();
    if (sub == 0) {
        float* mp = (float*)(F.ws + WS_MODP);
#pragma unroll
        for (int b = 0; b < 4; ++b) { const f32x4 o = acc[b] + *(LAS f32x4*)(red + cg * 16 + b * 4); *(f32x4*)(mp + (size_t)(ks * 4 + b) * (6 * D) + cb * 768 + 4 * cg) = o; }
    }
}
__device__ __forceinline__ void p0_transpose_item(const float* W, int K, int N, bf16* WT, int item, int lane) {
    const int nblk = N >> 5, kb = item / nblk, nb = item - kb * nblk, k0 = (kb << 6) + 8 * (lane >> 3), n0 = (nb << 5) + 4 * (lane & 7);
    const float* src = W + (size_t)k0 * N + n0;
    f32x4 v[8];
#pragma unroll
    for (int i = 0; i < 8; ++i) v[i] = __builtin_nontemporal_load((const f32x4*)(src + (size_t)i * N));
#pragma unroll
    for (int e = 0; e < 4; ++e) { v4u o; o.x = pk2(v[0][e], v[1][e]); o.y = pk2(v[2][e], v[3][e]); o.z = pk2(v[4][e], v[5][e]); o.w = pk2(v[6][e], v[7][e]);
        *(v4u*)(WT + (size_t)(n0 + e) * K + k0) = o; }
}
constexpr int I_EI1 = (D / 128) * (FF2 / 32), I_EO1 = (FF / 128) * (D / 32), I_EI = NE * I_EI1, I_EO = NE * I_EO1, CONV8_ITEMS = I_EI + I_EO;
constexpr int CONV_Q = 65536, QKV_GEMM_WGS = 128, CONV_Q5 = 28672, WO_GEMM_WGS = 128;
#ifndef CONV_KG
#define CONV_KG 8
#endif
struct Conv8 { const float* src; unsigned char* dst; int N; };
__device__ __forceinline__ Conv8 conv8_item(const Frame& F, int r, int lane) {
    Conv8 c; const float* W; unsigned char* WT; int it;
    if (r < I_EI) { const int e = r / I_EI1; it = r - e * I_EI1; c.N = FF2; W = F.w_e_in + (size_t)e * D * FF2; WT = F.ws + WS_WEI_T + (size_t)e * FF2 * D; }
    else { r -= I_EI; const int e = r / I_EO1; it = r - e * I_EO1; c.N = D; W = F.w_e_out + (size_t)e * FF * D; WT = F.ws + WS_WEO_T + (size_t)e * D * FF; }
    constexpr int NL = 64 / CONV_KG;
    const int nblk = c.N / (4 * NL), kb = it / nblk, nb = it - kb * nblk, k0 = kb * (16 * CONV_KG) + 16 * (lane / NL), n0 = nb * (4 * NL) + 4 * (lane % NL);
    c.src = W + (size_t)k0 * c.N + n0; c.dst = WT + (size_t)n0 * 2048 + k0;
    return c;
}
__device__ __forceinline__ void conv8_load(const Conv8& c, f32x4 (&v)[16]) {
#pragma unroll
    for (int i = 0; i < 16; ++i) v[i] = __builtin_nontemporal_load((const f32x4*)(c.src + (size_t)i * c.N));
}
__device__ __forceinline__ void conv8_finish(const f32x4 (&v)[16], unsigned char* dst, LAS float*, int) {
#pragma unroll
    for (int e = 0; e < 4; ++e) { v4u o;
        o.x = pg8::cvt4_fp8(v[0][e] * WSCALE, v[1][e] * WSCALE, v[2][e] * WSCALE, v[3][e] * WSCALE);
        o.y = pg8::cvt4_fp8(v[4][e] * WSCALE, v[5][e] * WSCALE, v[6][e] * WSCALE, v[7][e] * WSCALE);
        o.z = pg8::cvt4_fp8(v[8][e] * WSCALE, v[9][e] * WSCALE, v[10][e] * WSCALE, v[11][e] * WSCALE);
        o.w = pg8::cvt4_fp8(v[12][e] * WSCALE, v[13][e] * WSCALE, v[14][e] * WSCALE, v[15][e] * WSCALE);
        __builtin_nontemporal_store(o, (v4u*)(dst + (size_t)e * 2048)); }
}
__device__ __forceinline__ void conv8_run(Frame& F, LAS float* scr, int first, int stride, int last) {
    if (first >= last) return;
    f32x4 va[16], vb[16];
    Conv8 ca = conv8_item(F, first, F.lane), cb = ca;
    conv8_load(ca, va);
    for (int it = first; it < last; it += 2 * stride) {
        const bool hb = it + stride < last;
        if (hb) { cb = conv8_item(F, it + stride, F.lane); conv8_load(cb, vb); }
        conv8_finish(va, ca.dst, scr, F.lane);
        if (!hb) break;
        const bool ha = it + 2 * stride < last;
        if (ha) { ca = conv8_item(F, it + 2 * stride, F.lane); conv8_load(ca, va); }
        conv8_finish(vb, cb.dst, scr, F.lane);
        if (!ha) break;
    }
}
constexpr int IW_EI1 = (D / 128) * (FF2 / 256), IW_EO1 = (FF / 128) * (D / 256), IW_EI = NE * IW_EI1, IW_EO = NE * IW_EO1, CONVW_ITEMS = IW_EI + IW_EO;
constexpr int CONVW_Q2 = IW_EI, CONVW_Q5 = 3584;
struct ConvW { const float* src; unsigned char* dst; int N; };
__device__ __forceinline__ ConvW convw_item(const Frame& F, int r, int wave, int lane) {
    ConvW c; const float* W; unsigned char* WT; int it, nblk;
    if (r < IW_EI) { const int e = r / IW_EI1; it = r - e * IW_EI1; c.N = FF2; nblk = FF2 / 256; W = F.w_e_in + (size_t)e * D * FF2; WT = F.ws + WS_WEI_T + (size_t)e * FF2 * D; }
    else { r -= IW_EI; const int e = r / IW_EO1; it = r - e * IW_EO1; c.N = D; nblk = D / 256; W = F.w_e_out + (size_t)e * FF * D; WT = F.ws + WS_WEO_T + (size_t)e * D * FF; }
    const int kb = it / nblk, nb = it - kb * nblk, k0 = kb << 7, n0 = nb << 8;
    c.src = W + (size_t)(k0 + 16 * wave) * c.N + n0 + 4 * lane; c.dst = WT + (size_t)n0 * 2048 + k0;
    return c;
}
__device__ __forceinline__ void convw_load(const ConvW& c, f32x4 (&v)[16]) {
#pragma unroll
    for (int i = 0; i < 16; ++i) v[i] = __builtin_nontemporal_load((const f32x4*)(c.src + (size_t)i * c.N));
}
__device__ __forceinline__ void convw_finish(const f32x4 (&v)[16], unsigned char* dst, LAS unsigned char* tile, int wave, int lane) {
#pragma unroll
    for (int e = 0; e < 4; ++e) { v4u o;
        o.x = pg8::cvt4_fp8(v[0][e] * WSCALE, v[1][e] * WSCALE, v[2][e] * WSCALE, v[3][e] * WSCALE);
        o.y = pg8::cvt4_fp8(v[4][e] * WSCALE, v[5][e] * WSCALE, v[6][e] * WSCALE, v[7][e] * WSCALE);
        o.z = pg8::cvt4_fp8(v[8][e] * WSCALE, v[9][e] * WSCALE, v[10][e] * WSCALE, v[11][e] * WSCALE);
        o.w = pg8::cvt4_fp8(v[12][e] * WSCALE, v[13][e] * WSCALE, v[14][e] * WSCALE, v[15][e] * WSCALE);
        *(LAS v4u*)(tile + (4 * lane + e) * 128 + 16 * (wave ^ (lane & 7))) = o; }
    __syncthreads();
#pragma unroll
    for (int j = 0; j < 4; ++j) { const int n = 32 * wave + 8 * j + (lane >> 3), c = lane & 7;
        const v4u o = *(const LAS v4u*)(tile + n * 128 + 16 * (c ^ ((n >> 2) & 7)));
        __builtin_nontemporal_store(o, (v4u*)(dst + (size_t)n * 2048 + 16 * c)); }
}
__device__ __forceinline__ void convw_run(Frame& F, int rank, int nwg, int lo, int hi) {
    LAS unsigned char* t0 = F.lds + RING_OFF; LAS unsigned char* t1 = t0 + 32768;
    int wave = F.wave, lane = F.lane; asm volatile("" : "+v"(lane));
    int it = lo + rank; if (it >= hi) return;
    f32x4 va[16], vb[16];
    ConvW ca = convw_item(F, it, wave, lane), cb = ca; convw_load(ca, va);
    for (;;) {
        const bool hb = it + nwg < hi;
        if (hb) { cb = convw_item(F, it + nwg, wave, lane); convw_load(cb, vb); }
        convw_finish(va, ca.dst, t0, wave, lane);
        if (!hb) break;
        const bool ha = it + 2 * nwg < hi;
        if (ha) { ca = convw_item(F, it + 2 * nwg, wave, lane); convw_load(ca, va); }
        convw_finish(vb, cb.dst, t1, wave, lane);
        if (!ha) break;
        it += 2 * nwg;
    }
    __syncthreads();
}
__device__ __forceinline__ void p0_prologue(Frame& F) {
    for (int j = F.vcu; j < 256; j += F.G) p0_mod_item(F, j);
    __syncthreads();
    LAS float* scr = (LAS float*)(F.lds + RING_OFF + F.wave * 16896);
    const int gw = F.vcu * NWAVES + F.wave, NGW = F.G * NWAVES;
    for (int i = F.vcu * NWAVES * 64 + F.tid; i < D * NE; i += F.G * NWAVES * 64) { const float wv = F.w_router[i]; const int k = i >> 5, e = i & 31; const unsigned hi = pk2(wv, 0.f) & 0xffffu;
        bf16* wt = (bf16*)(F.ws + WS_WRT); wt[e * D + k] = (bf16)hi; wt[NE * D + e * D + k] = (bf16)(pk2(wv - bflo(hi), 0.f) & 0xffffu); }
    constexpr int I_IN = (D / 64) * (NQKV / 32), I_O = (D / 64) * (D / 32);
#pragma unroll 2
    for (int it = gw; it < I_IN + I_O; it += NGW) {
        if (it < I_IN) p0_transpose_item(F.w_in, D, NQKV, (bf16*)(F.ws + WS_WIN_T), it, F.lane);
        else p0_transpose_item(F.w_o, D, D, (bf16*)(F.ws + WS_WO_T), it - I_IN, F.lane);
    }
    __syncthreads();
    convw_run(F, F.vcu, F.G, CONVW_Q2 + CONVW_Q5, CONVW_ITEMS);
}

__device__ __forceinline__ void p1_hmix(Frame& F) {
    LAS float* ta = (LAS float*)(F.lds + RING_OFF);
    LAS float* tb = ta + D;
    for (int rb = F.vcu; rb < T / 32; rb += F.G) {
        const int b = rb >> 6;
        f32x4 va[8], vb[8];
#define P1_LOAD(dst, rr) do { const f32x4* xr = (const f32x4*)(F.x + (size_t)(rb * 32 + (rr)) * D) + F.lane; _Pragma("unroll") for (int j = 0; j < 8; ++j) dst[j] = xr[64 * j]; } while (0)
#define P1_ROW(v, rr) do { float ss = 0.f; _Pragma("unroll") for (int j = 0; j < 8; ++j) ss += (v[j][0] * v[j][0] + v[j][1] * v[j][1]) + (v[j][2] * v[j][2] + v[j][3] * v[j][3]); \
            const float r = 1.0f / sqrtf(wave_sum(ss) * (1.0f / D) + EPS); \
            v2u* o8 = (v2u*)((bf16*)(F.ws + WS_HMIX) + (size_t)(rb * 32 + (rr)) * D) + F.lane; \
            _Pragma("unroll") for (int j = 0; j < 8; ++j) { const int col = 4 * F.lane + 256 * j; const f32x4 a = *(LAS f32x4*)(ta + col), s = *(LAS f32x4*)(tb + col); \
                v2u w; w.x = pk2(v[j][0] * r * a[0] + s[0], v[j][1] * r * a[1] + s[1]); w.y = pk2(v[j][2] * r * a[2] + s[2], v[j][3] * r * a[3] + s[3]); o8[64 * j] = w; } } while (0)
        { const float* mp = (const float*)(F.ws + WS_MODP); const int c4 = 4 * F.tid;
          f32x4 sa = *(const f32x4*)(F.b_ada + D + c4), sb = *(const f32x4*)(F.b_ada + c4), pa[16], pb[16];
#pragma unroll
          for (int ks = 0; ks < 16; ++ks) { pa[ks] = *(const f32x4*)(mp + (size_t)(ks * 4 + b) * (6 * D) + D + c4); pb[ks] = *(const f32x4*)(mp + (size_t)(ks * 4 + b) * (6 * D) + c4); }
          const f32x4 gpm = *(const f32x4*)(F.g_pre_mix + c4);
          P1_LOAD(va, F.wave); P1_LOAD(vb, F.wave + 8);
          __syncthreads();
#pragma unroll
          for (int ks = 0; ks < 16; ++ks) { sa += pa[ks]; sb += pb[ks]; }
          *(LAS f32x4*)(ta + c4) = gpm * (sa + 1.0f); *(LAS f32x4*)(tb + c4) = sb; }
        __syncthreads();
        P1_ROW(va, F.wave); P1_LOAD(va, F.wave + 16);
        P1_ROW(vb, F.wave + 8); P1_LOAD(vb, F.wave + 24);
        P1_ROW(va, F.wave + 16);
        P1_ROW(vb, F.wave + 24);
        if (F.tid < 48) {
            const float* mp = (const float*)(F.ws + WS_MODP); const int fi = rb * 192 + 4 * F.tid, fb = fi / (6 * D), fx = fi % (6 * D);
            f32x4 ss = *(const f32x4*)(F.b_ada + fx);
#pragma unroll
            for (int ks = 0; ks < 16; ++ks) ss += *(const f32x4*)(mp + (size_t)(ks * 4 + fb) * (6 * D) + fx);
            *(f32x4*)((float*)(F.ws + WS_MOD) + fi) = ss; }
#undef P1_LOAD
#undef P1_ROW
    }
}

typedef short bf16x8v __attribute__((ext_vector_type(8)));
typedef short s16x4v __attribute__((ext_vector_type(4)));
typedef int v4i16_t_ __attribute__((ext_vector_type(2)));
__device__ __forceinline__ unsigned vimg_off(unsigned row, unsigned ch) { return 256u * row + 16u * (ch ^ (((row & 3u) << 2) | ((row >> 2) & 3u))); }
__device__ __forceinline__ unsigned kimg_off(unsigned row, unsigned ch) { return 256u * row + 16u * (ch ^ (((row & 3u) << 2) | ((row >> 3) & 3u))); }
__device__ __forceinline__ s16x4v tr_read16(const LAS unsigned char* p) {
    typedef short v4i16 __attribute__((ext_vector_type(4)));
    return __builtin_bit_cast(s16x4v, __builtin_amdgcn_ds_read_tr16_b64_v4i16((LAS v4i16*)p));
}
struct GeoNA {
    int tok0, qbase, kbase, r, rs, c0, kc0; const LAS float* rpb_h;
    static constexpr int QCOL = 0, KCOL = GW, VCOL = 2 * GW;
    __device__ __forceinline__ int qtok(int n16) const { return qbase + n16; }
    __device__ __forceinline__ int ktok(int c, int slot) const { return kbase + c * 64 + slot; }
    __device__ __forceinline__ float bias(int c, int slot, int n16) const {
        const int qc = c0 + n16, kc = kc0 + slot, cs = min(max(qc - 8, 0), 48);
        const bool valid = (kc >= cs) && (kc < cs + 16);
        const int dc = min(max(kc - qc + 15, 0), 30);
        const float bv = rpb_h[(rs + c - r + 7) * 31 + dc];
        return valid ? bv : -INFINITY;
    }
};
struct GeoDil {
    int tok0, rho, dsh, sub_len, l0, p, h; const float* t5;
    static constexpr int QCOL = 3 * GW, KCOL = 4 * GW, VCOL = 5 * GW;
    __device__ __forceinline__ int qtok(int n16) const { return tok0 + rho + ((l0 + n16) << dsh); }
    __device__ __forceinline__ int ktok(int c, int slot) const { const int l = min(max(l0 - 64 + 32 * c + slot, 0), sub_len - 1); return tok0 + rho + (l << dsh); }
    __device__ __forceinline__ float bias(int c, int slot, int n16) const {
        const int kk = 32 * c + slot, delta = kk - 64 - n16, l = l0 - 64 + kk;
        const bool valid = (delta >= -64) && (delta <= 64) && (l >= 0) && (l < sub_len);
        const int di = min(max(delta + 64, 0), 128);
        const float bv = t5[(int)T5B[p][di] * 8 + h];
        return valid ? bv : -INFINITY;
    }
};
__device__ __forceinline__ void attn_na_item(const GeoNA& G, const bf16* proj, int hcol, LAS unsigned char* kimg, LAS unsigned char* vimg, bf16* out, int lane) {
    constexpr int NCH = 8;
    const int n16 = lane & 15, g = lane >> 4;
    const float scale_l2 = 0.08838834764831845f * 1.44269504089f;
    bf16x8v qf[4];
    { const bf16* qp = proj + (size_t)G.qtok(n16) * NQKV + GeoNA::QCOL + hcol + 8 * g;
#pragma unroll
      for (int s = 0; s < 4; ++s) qf[s] = *(const bf16x8v*)(qp + 32 * s); }
    const int vr_row = lane >> 4, vr_ch = lane & 15;
    const unsigned voff0 = (unsigned)((vr_row * NQKV + 8 * vr_ch) * 2);
    constexpr size_t ISTEP = (size_t)4 * NQKV * 2;
    const char* kb0 = (const char*)(proj + (size_t)G.kbase * NQKV + GeoNA::KCOL + hcol);
    const char* vb0 = (const char*)(proj + (size_t)G.kbase * NQKV + GeoNA::VCOL + hcol);
    constexpr size_t CSTEP = (size_t)64 * NQKV * 2;
    f32x4 st[NCH][2];
    v4u vr[8];
#pragma unroll
    for (int i = 0; i < 8; ++i) vr[i] = *(const v4u*)(kb0 + i * ISTEP + voff0);
#pragma unroll
    for (int c = 0; c < NCH; ++c) {
        asm volatile("" ::: "memory");
#pragma unroll
        for (int i = 0; i < 8; ++i) *(LAS v4u*)(kimg + kimg_off((unsigned)(4 * i + vr_row), (unsigned)vr_ch)) = vr[i];
        asm volatile("" ::: "memory");
        if (c + 1 < NCH) {
#pragma unroll
            for (int i = 0; i < 8; ++i) vr[i] = *(const v4u*)(kb0 + (size_t)(c + 1) * CSTEP + i * ISTEP + voff0);
        } else {
#pragma unroll
            for (int i = 0; i < 8; ++i) vr[i] = *(const v4u*)(vb0 + i * ISTEP + voff0);
        }
#pragma unroll
        for (int t2 = 0; t2 < 2; ++t2) {
            const unsigned row = (unsigned)(8 * (n16 >> 2) + 4 * t2 + (n16 & 3));
            f32x4 acc = (f32x4){0.f, 0.f, 0.f, 0.f};
#pragma unroll
            for (int s = 0; s < 4; ++s) { const bf16x8v kf = *(const LAS bf16x8v*)(kimg + kimg_off(row, (unsigned)(4 * s + g))); acc = __builtin_amdgcn_mfma_f32_16x16x32_bf16(kf, qf[s], acc, 0, 0, 0); }
            st[c][t2] = acc;
        }
        asm volatile("" ::: "memory");
    }
    float mx = -INFINITY;
#pragma unroll
    for (int c = 0; c < NCH; ++c)
#pragma unroll
        for (int t2 = 0; t2 < 2; ++t2)
#pragma unroll
            for (int r = 0; r < 4; ++r) { const float bv = G.bias(c, 8 * g + 4 * t2 + r, n16); const float x = st[c][t2][r] * scale_l2 + bv * 1.44269504089f; st[c][t2][r] = x; mx = fmaxf(mx, x); }
    mx = fmaxf(mx, __shfl_xor(mx, 16)); mx = fmaxf(mx, __shfl_xor(mx, 32));
    float sum = 0.f;
    bf16x8v pf[NCH];
#pragma unroll
    for (int c = 0; c < NCH; ++c) {
        float pv[8];
#pragma unroll
        for (int t2 = 0; t2 < 2; ++t2)
#pragma unroll
            for (int r = 0; r < 4; ++r) { const float p = __builtin_amdgcn_exp2f(st[c][t2][r] - mx); pv[4 * t2 + r] = p; sum += p; }
        v4u w; w.x = pk2(pv[0], pv[1]); w.y = pk2(pv[2], pv[3]); w.z = pk2(pv[4], pv[5]); w.w = pk2(pv[6], pv[7]);
        pf[c] = __builtin_bit_cast(bf16x8v, w);
    }
    sum += __shfl_xor(sum, 16); sum += __shfl_xor(sum, 32);
    f32x4 oacc[8];
#pragma unroll
    for (int dt = 0; dt < 8; ++dt) oacc[dt] = (f32x4){0.f, 0.f, 0.f, 0.f};
    const unsigned q4 = (unsigned)(lane & 15) >> 2, pp = (unsigned)lane & 3u;
#pragma unroll
    for (int c = 0; c < NCH; ++c) {
        asm volatile("" ::: "memory");
#pragma unroll
        for (int i = 0; i < 8; ++i) *(LAS v4u*)(vimg + vimg_off((unsigned)(4 * i + vr_row), (unsigned)vr_ch)) = vr[i];
        asm volatile("" ::: "memory");
        if (c + 1 < NCH) {
#pragma unroll
            for (int i = 0; i < 8; ++i) vr[i] = *(const v4u*)(vb0 + (size_t)(c + 1) * CSTEP + i * ISTEP + voff0);
        }
#pragma unroll
        for (int dt = 0; dt < 8; ++dt) {
            const s16x4v lo = tr_read16(vimg + vimg_off((unsigned)(8 * g) + q4, (unsigned)(2 * dt) + (pp >> 1)) + 8u * (pp & 1u));
            const s16x4v hi = tr_read16(vimg + vimg_off((unsigned)(8 * g + 4) + q4, (unsigned)(2 * dt) + (pp >> 1)) + 8u * (pp & 1u));
            bf16x8v vf; vf[0] = lo[0]; vf[1] = lo[1]; vf[2] = lo[2]; vf[3] = lo[3]; vf[4] = hi[0]; vf[5] = hi[1]; vf[6] = hi[2]; vf[7] = hi[3];
            oacc[dt] = __builtin_amdgcn_mfma_f32_16x16x32_bf16(vf, pf[c], oacc[dt], 0, 0, 0);
        }
        asm volatile("" ::: "memory");
    }
    const float inv = 1.0f / sum;
    bf16* op = out + (size_t)G.qtok(n16) * GW + hcol + 4 * g;
#pragma unroll
    for (int dt = 0; dt < 8; ++dt) { const f32x4 o = oacc[dt] * inv; v2u w; w.x = pk2(o[0], o[1]); w.y = pk2(o[2], o[3]); *(v2u*)(op + 16 * dt) = w; }
}
__device__ __forceinline__ void na_stage_load(const bf16* proj, int u, int colofs, int tid, v4u (&sr)[14]) {
    const int half = u & 1, r0 = 4 * ((u >> 1) & 7), h = (u >> 4) & 7, b = u >> 7; const int rsmin = min(max(r0 - 4, 0), 24), rsmax = min(max(r0 - 1, 0), 24);
    const int nimg = (rsmax - rsmin + 8) * 40, tokb = b * SEQ + rsmin * 64 + 24 * half;
    int tq = tid; asm volatile("" : "+v"(tq)); const int t4 = tq >> 4, ch = tq & 15;
#pragma unroll
    for (int it = 0; it < 14; ++it) { const int row = 32 * it + t4; if (row < nimg) { const int kr = (row * 205) >> 13, kc = row - 40 * kr;
        sr[it] = *(const v4u*)(proj + (size_t)(tokb + kr * 64 + kc) * NQKV + colofs + h * HD + 8 * ch); } }
}
__device__ __forceinline__ bool attn_dil_units(Frame& F, v4u (&sr)[14]) {
    LAS unsigned char* img = F.lds + RING_OFF;
    LAS float* tb = (LAS float*)(F.lds + RING_OFF + 131072);
    const bf16* proj = (const bf16*)(F.ws + WS_PROJ);
    bf16* odil = (bf16*)(F.ws + WS_ODIL); float* lse = (float*)(F.ws + WS_LSE);
    const int lane = F.lane, n16 = lane & 15, g = lane >> 4, w = F.wave;
    const float scale_l2 = 0.08838834764831845f * 1.44269504089f;
    constexpr int NU = 3 * NBATCH * 8 * 8, NIT = 12;
    bool na_pre = false;
    { LAS float* rpbl = (LAS float*)(F.lds + RING_OFF + 131072 + 1024);
      for (int i = F.tid; i < 8 * 15 * 31; i += NWAVES * 64) rpbl[i] = F.rpb[i] * 1.44269504089f; }
#define DIL_LOAD(u_, colofs) do { const int p_ = (u_) >> 8, b_ = ((u_) >> 6) & 3, h_ = ((u_) >> 3) & 7, q8_ = (u_) & 7, dsh_ = 2 * p_, sl_ = SEQ >> dsh_; \
        const int rho_ = (p_ == 0) ? 0 : (p_ == 1) ? (q8_ >> 1) : 2 * q8_, lw_ = (p_ == 0) ? 256 * q8_ - 64 : (p_ == 1) ? 256 * (q8_ & 1) - 64 : -64; \
        int tq_ = F.tid; asm volatile("" : "+v"(tq_)); const int t4 = tq_ >> 4, ch = tq_ & 15;        \
        _Pragma("unroll") for (int it = 0; it < NIT; ++it) { const int row = 32 * it + t4; const int cls = (p_ == 2 && row >= 192) ? 1 : 0; const int l = min(max(lw_ + row - 128 * cls, 0), sl_ - 1); \
            sr[it] = *(const v4u*)(proj + (size_t)(b_ * SEQ + rho_ + cls + (l << dsh_)) * NQKV + (colofs) + h_ * HD + 8 * ch); } } while (0)
    int u = F.vcu;
    float tbn = -INFINITY;
#define DIL_TB(u_) do { if (F.tid < 129) tbn = F.t5[(int)T5B[(u_) >> 8][F.tid] * 8 + (((u_) >> 3) & 7)] * 1.44269504089f; } while (0)
    if (u < NU) { DIL_LOAD(u, 4 * GW); DIL_TB(u); }
    if (F.tid >= 129 && F.tid < 192) { const int j = F.tid - 129; tb[(j < 32) ? j : 129 + j] = -INFINITY; }
#pragma unroll 1
    for (; u < NU; u += F.G) {
        const int p = u >> 8, b = (u >> 6) & 3, h = (u >> 3) & 7, q8 = u & 7, dsh = 2 * p, sub_len = SEQ >> dsh;
        const int rho = ((p == 0) ? 0 : (p == 1) ? (q8 >> 1) : 2 * q8) + ((p == 2) ? (w >> 2) : 0);
        const int qb = (p == 0) ? 256 * q8 + 32 * w : (p == 1) ? 256 * (q8 & 1) + 32 * w : 32 * (w & 3);
        const int qtok0 = b * SEQ + rho + ((qb + n16) << dsh), qtok1 = b * SEQ + rho + ((qb + 16 + n16) << dsh);
        bf16x8v qf0[4], qf1[4];
        { const bf16* qp0 = proj + (size_t)qtok0 * NQKV + 3 * GW + h * HD + 8 * g; const bf16* qp1 = proj + (size_t)qtok1 * NQKV + 3 * GW + h * HD + 8 * g;
#pragma unroll
          for (int s = 0; s < 4; ++s) { qf0[s] = *(const bf16x8v*)(qp0 + 32 * s); qf1[s] = *(const bf16x8v*)(qp1 + 32 * s); } }
        __syncthreads();
        if (F.tid < 129) tb[32 + F.tid] = tbn;
        { int tq = F.tid; asm volatile("" : "+v"(tq)); const int t4 = tq >> 4, ch = tq & 15;
#pragma unroll
        for (int it = 0; it < NIT; ++it) *(LAS v4u*)(img + kimg_off((unsigned)(32 * it + t4), (unsigned)ch)) = sr[it]; }
        __syncthreads();
        f32x4 s0[5][2], s1[5][2];
#pragma unroll
        for (int c = 0; c < 5; ++c)
#pragma unroll
            for (int t2 = 0; t2 < 2; ++t2) {
                const unsigned row = (unsigned)(32 * w + 32 * c + 8 * (n16 >> 2) + 4 * t2 + (n16 & 3));
                f32x4 a0 = (f32x4){0.f, 0.f, 0.f, 0.f}, a1 = (f32x4){0.f, 0.f, 0.f, 0.f};
#pragma unroll
                for (int s = 0; s < 4; ++s) { const bf16x8v kf = *(const LAS bf16x8v*)(img + kimg_off(row, (unsigned)(4 * s + g)));
                    a0 = __builtin_amdgcn_mfma_f32_16x16x32_bf16(kf, qf0[s], a0, 0, 0, 0); a1 = __builtin_amdgcn_mfma_f32_16x16x32_bf16(kf, qf1[s], a1, 0, 0, 0); }
                s0[c][t2] = a0; s1[c][t2] = a1;
            }
        DIL_LOAD(u, 5 * GW);
        bf16x8v pf0[5], pf1[5]; float mx0, mx1, sum0, sum1;
        const int lb = 8 * g - n16, lkb = qb - 64 + 8 * g; const LAS float* tbl = tb + (lb + 16);
        const bool edge = (qb - 64 < 0) || (qb + 96 > sub_len);
#define DIL_SOFTMAX(st, pf, mx, sum, J) do { mx = -INFINITY; \
        _Pragma("unroll") for (int c = 0; c < 5; ++c) _Pragma("unroll") for (int t2 = 0; t2 < 2; ++t2) _Pragma("unroll") for (int r = 0; r < 4; ++r) \
            st[c][t2][r] = fmaf(st[c][t2][r], scale_l2, tbl[32 * c + 4 * t2 + r + 16 - 16 * (J)]);              \
        if (edge) { _Pragma("unroll") for (int c = 0; c < 5; ++c) _Pragma("unroll") for (int t2 = 0; t2 < 2; ++t2) _Pragma("unroll") for (int r = 0; r < 4; ++r) { \
            const int lk = lkb + (32 * c + 4 * t2 + r); st[c][t2][r] = (lk >= 0 && lk < sub_len) ? st[c][t2][r] : -INFINITY; } } \
        _Pragma("unroll") for (int c = 0; c < 5; ++c) _Pragma("unroll") for (int t2 = 0; t2 < 2; ++t2) _Pragma("unroll") for (int r = 0; r < 4; ++r) mx = fmaxf(mx, st[c][t2][r]); \
        mx = fmaxf(mx, __shfl_xor(mx, 16)); mx = fmaxf(mx, __shfl_xor(mx, 32)); sum = 0.f; \
        _Pragma("unroll") for (int c = 0; c < 5; ++c) { float pv[8]; \
            _Pragma("unroll") for (int t2 = 0; t2 < 2; ++t2) _Pragma("unroll") for (int r = 0; r < 4; ++r) { const float pe = __builtin_amdgcn_exp2f(st[c][t2][r] - mx); pv[4 * t2 + r] = pe; sum += pe; } \
            v4u wv; wv.x = pk2(pv[0], pv[1]); wv.y = pk2(pv[2], pv[3]); wv.z = pk2(pv[4], pv[5]); wv.w = pk2(pv[6], pv[7]); pf[c] = __builtin_bit_cast(bf16x8v, wv); } \
        sum += __shfl_xor(sum, 16); sum += __shfl_xor(sum, 32); } while (0)
        DIL_SOFTMAX(s0, pf0, mx0, sum0, 0);
        DIL_SOFTMAX(s1, pf1, mx1, sum1, 1);
        __syncthreads();
        { int tq = F.tid; asm volatile("" : "+v"(tq)); const int t4 = tq >> 4, ch = tq & 15;
#pragma unroll
        for (int it = 0; it < NIT; ++it) *(LAS v4u*)(img + vimg_off((unsigned)(32 * it + t4), (unsigned)ch)) = sr[it]; }
        asm volatile("" ::: "memory");
        if (u + F.G < NU) { DIL_LOAD(u + F.G, 4 * GW); DIL_TB(u + F.G); }
        else if (F.vcu < NBATCH * 8 * 8 * 2) { na_stage_load(proj, F.vcu, GeoNA::KCOL, F.tid, sr); na_pre = true; }
        __syncthreads();
        f32x4 o0[8], o1[8];
#pragma unroll
        for (int dt = 0; dt < 8; ++dt) { o0[dt] = (f32x4){0.f, 0.f, 0.f, 0.f}; o1[dt] = (f32x4){0.f, 0.f, 0.f, 0.f}; }
        unsigned lq = (unsigned)lane; asm volatile("" : "+v"(lq)); const unsigned q4 = (lq & 15u) >> 2, pp = lq & 3u, gq = lq >> 4;
#pragma unroll
        for (int c = 0; c < 5; ++c)
#pragma unroll
            for (int dt = 0; dt < 8; ++dt) {
                const unsigned rbase = (unsigned)(32 * w + 32 * c) + 8u * gq + q4;
                const s16x4v lo = tr_read16(img + vimg_off(rbase, (unsigned)(2 * dt) + (pp >> 1)) + 8u * (pp & 1u));
                const s16x4v hi = tr_read16(img + vimg_off(rbase + 4u, (unsigned)(2 * dt) + (pp >> 1)) + 8u * (pp & 1u));
                bf16x8v vf; vf[0] = lo[0]; vf[1] = lo[1]; vf[2] = lo[2]; vf[3] = lo[3]; vf[4] = hi[0]; vf[5] = hi[1]; vf[6] = hi[2]; vf[7] = hi[3];
                o0[dt] = __builtin_amdgcn_mfma_f32_16x16x32_bf16(vf, pf0[c], o0[dt], 0, 0, 0); o1[dt] = __builtin_amdgcn_mfma_f32_16x16x32_bf16(vf, pf1[c], o1[dt], 0, 0, 0);
            }
        { const float inv = 1.0f / sum0; bf16* op = odil + ((size_t)p * T + qtok0) * GW + h * HD + 4 * g;
#pragma unroll
          for (int dt = 0; dt < 8; ++dt) { const f32x4 o = o0[dt] * inv; v2u wv; wv.x = pk2(o[0], o[1]); wv.y = pk2(o[2], o[3]); *(v2u*)(op + 16 * dt) = wv; }
          if (g == 0) lse[((size_t)p * T + qtok0) * 8 + h] = (mx0 + __builtin_amdgcn_logf(sum0)) * 0.69314718056f; }
        { const float inv = 1.0f / sum1; bf16* op = odil + ((size_t)p * T + qtok1) * GW + h * HD + 4 * g;
#pragma unroll
          for (int dt = 0; dt < 8; ++dt) { const f32x4 o = o1[dt] * inv; v2u wv; wv.x = pk2(o[0], o[1]); wv.y = pk2(o[2], o[3]); *(v2u*)(op + 16 * dt) = wv; }
          if (g == 0) lse[((size_t)p * T + qtok1) * 8 + h] = (mx1 + __builtin_amdgcn_logf(sum1)) * 0.69314718056f; }
    }
#undef DIL_LOAD
#undef DIL_TB
#undef DIL_SOFTMAX
    __syncthreads();
    return na_pre;
}
__device__ __forceinline__ void attn_na_items(Frame& F, v4u (&sr)[14], bool pre) {
    LAS float* rpbl = (LAS float*)(F.lds + RING_OFF + 131072 + 1024);
    LAS unsigned char* img = F.lds + RING_OFF;
    const bf16* proj = (const bf16*)(F.ws + WS_PROJ);
    bf16* ona = (bf16*)(F.ws + WS_ONA);
    int lane = F.lane; asm volatile("" : "+v"(lane));
    const int n16 = lane & 15, g = lane >> 4, w = F.wave;
    int tidv = F.tid; asm volatile("" : "+v"(tidv));
    const int t4 = tidv >> 4, ch = tidv & 15;
    const float scale_l2 = 0.08838834764831845f * 1.44269504089f;
    constexpr int NU = NBATCH * 8 * 8 * 2, NIT = 14;
#define NA_GEO(u) const int half = (u) & 1, r0 = 4 * (((u) >> 1) & 7), h = ((u) >> 4) & 7, b = (u) >> 7; const int rsmin = min(max(r0 - 4, 0), 24), rsmax = min(max(r0 - 1, 0), 24); \
        const int nimg = (rsmax - rsmin + 8) * 40, colbase = 24 * half, tok0 = b * SEQ; const int hcol = h * HD
    int u = F.vcu;
    if (u < NU && !pre) na_stage_load(proj, u, GeoNA::KCOL, F.tid, sr);
#pragma unroll 1
    for (; u < NU; u += F.G) {
        NA_GEO(u);
        const int r = r0 + (w >> 1), qt = 2 * half + (w & 1), rs = min(max(r - 4, 0), 24), c0 = 16 * qt, kc0 = (qt == 0) ? 0 : (qt == 1) ? 8 : (qt == 2) ? 24 : 32;
        const int qtok = tok0 + r * 64 + c0 + n16;
        const int base0 = (rs - rsmin) * 40 + (kc0 - colbase);
        bf16x8v qf[4];
        { const bf16* qp = proj + (size_t)qtok * NQKV + GeoNA::QCOL + hcol + 8 * g;
#pragma unroll
          for (int s = 0; s < 4; ++s) qf[s] = *(const bf16x8v*)(qp + 32 * s); }
        __syncthreads();
#pragma unroll
        for (int it = 0; it < NIT; ++it) { const int row = 32 * it + t4; if (row < nimg) *(LAS v4u*)(img + kimg_off((unsigned)row, (unsigned)ch)) = sr[it]; }
        asm volatile("" ::: "memory");
        na_stage_load(proj, u, GeoNA::VCOL, F.tid, sr);
        __syncthreads();
        f32x4 st[8][2];
#pragma unroll
        for (int c = 0; c < 8; ++c)
#pragma unroll
            for (int t2 = 0; t2 < 2; ++t2) {
                const unsigned row = (unsigned)(base0 + 40 * c + 8 * (n16 >> 2) + 4 * t2 + (n16 & 3));
                f32x4 acc = (f32x4){0.f, 0.f, 0.f, 0.f};
#pragma unroll
                for (int s = 0; s < 4; ++s) { const bf16x8v kf = *(const LAS bf16x8v*)(img + kimg_off(row, (unsigned)(4 * s + g))); acc = __builtin_amdgcn_mfma_f32_16x16x32_bf16(kf, qf[s], acc, 0, 0, 0); }
                st[c][t2] = acc;
            }
        GeoNA G; G.tok0 = tok0; G.r = r; G.rs = rs; G.c0 = c0; G.kc0 = kc0; G.qbase = 0; G.kbase = 0; G.rpb_h = rpbl + h * (15 * 31);
        float mx = -INFINITY;
#pragma unroll
        for (int c = 0; c < 8; ++c)
#pragma unroll
            for (int t2 = 0; t2 < 2; ++t2)
#pragma unroll
                for (int rr = 0; rr < 4; ++rr) { const float bv = G.bias(c, 8 * g + 4 * t2 + rr, n16); const float x = st[c][t2][rr] * scale_l2 + bv; st[c][t2][rr] = x; mx = fmaxf(mx, x); }
        mx = fmaxf(mx, __shfl_xor(mx, 16)); mx = fmaxf(mx, __shfl_xor(mx, 32));
        float sum = 0.f;
        bf16x8v pf[8];
#pragma unroll
        for (int c = 0; c < 8; ++c) {
            float pv[8];
#pragma unroll
            for (int t2 = 0; t2 < 2; ++t2)
#pragma unroll
                for (int rr = 0; rr < 4; ++rr) { const float p = __builtin_amdgcn_exp2f(st[c][t2][rr] - mx); pv[4 * t2 + rr] = p; sum += p; }
            v4u wv; wv.x = pk2(pv[0], pv[1]); wv.y = pk2(pv[2], pv[3]); wv.z = pk2(pv[4], pv[5]); wv.w = pk2(pv[6], pv[7]);
            pf[c] = __builtin_bit_cast(bf16x8v, wv);
        }
        sum += __shfl_xor(sum, 16); sum += __shfl_xor(sum, 32);
        __syncthreads();
#pragma unroll
        for (int it = 0; it < NIT; ++it) { const int row = 32 * it + t4; if (row < nimg) *(LAS v4u*)(img + vimg_off((unsigned)row, (unsigned)ch)) = sr[it]; }
        asm volatile("" ::: "memory");
        if (u + F.G < NU) na_stage_load(proj, u + F.G, GeoNA::KCOL, F.tid, sr);
        __syncthreads();
        f32x4 oacc[8];
#pragma unroll
        for (int dt = 0; dt < 8; ++dt) oacc[dt] = (f32x4){0.f, 0.f, 0.f, 0.f};
        const unsigned q4 = (unsigned)(lane & 15) >> 2, pp = (unsigned)lane & 3u;
#pragma unroll
        for (int c = 0; c < 8; ++c)
#pragma unroll
            for (int dt = 0; dt < 8; ++dt) {
                const unsigned rbase = (unsigned)(base0 + 40 * c + 8 * g) + q4;
                const s16x4v lo = tr_read16(img + vimg_off(rbase, (unsigned)(2 * dt) + (pp >> 1)) + 8u * (pp & 1u));
                const s16x4v hi = tr_read16(img + vimg_off(rbase + 4u, (unsigned)(2 * dt) + (pp >> 1)) + 8u * (pp & 1u));
                bf16x8v vf; vf[0] = lo[0]; vf[1] = lo[1]; vf[2] = lo[2]; vf[3] = lo[3]; vf[4] = hi[0]; vf[5] = hi[1]; vf[6] = hi[2]; vf[7] = hi[3];
                oacc[dt] = __builtin_amdgcn_mfma_f32_16x16x32_bf16(vf, pf[c], oacc[dt], 0, 0, 0);
            }
        const float inv = 1.0f / sum;
        bf16* op = ona + (size_t)qtok * GW + hcol + 4 * g;
#pragma unroll
        for (int dt = 0; dt < 8; ++dt) { const f32x4 o = oacc[dt] * inv; v2u wv; wv.x = pk2(o[0], o[1]); wv.y = pk2(o[2], o[3]); *(v2u*)(op + 16 * dt) = wv; }
    }
#undef NA_GEO
    __syncthreads();
}

__device__ __forceinline__ void p3_attn_mfma(Frame& F) {
    v4u sr[14];
    const bool pre = attn_dil_units(F, sr);
    attn_na_items(F, sr, pre);
}

__device__ __forceinline__ void p4_post(Frame& F) {
    const bf16* ona = (const bf16*)(F.ws + WS_ONA); const bf16* odil = (const bf16*)(F.ws + WS_ODIL); const float* lse = (const float*)(F.ws + WS_LSE);
    bf16* aout = (bf16*)(F.ws + WS_AOUT);
    const int gw = F.vcu * NWAVES + F.wave, NGW = F.G * NWAVES, lane = F.lane;
    struct Tok { v2u o[4]; v2u d[4][3]; float l[4][3]; };
#define P4_LOAD(S, tok) do { _Pragma("unroll") for (int j = 0; j < 4; ++j) { const int col = 4 * lane + 256 * j, h = col >> 7; S.o[j] = *(const v2u*)(ona + (size_t)(tok) * GW + col); \
        _Pragma("unroll") for (int q = 0; q < 3; ++q) { S.l[j][q] = lse[((size_t)q * T + (tok)) * 8 + h]; S.d[j][q] = *(const v2u*)(odil + ((size_t)q * T + (tok)) * GW + col); } } } while (0)
#define P4_CV(w) ((f32x4){bflo((w).x), bfhi((w).x), bflo((w).y), bfhi((w).y)})
#define P4_DO(S, tok) do { f32x4 v[4]; float ss = 0.f; \
        _Pragma("unroll") for (int j = 0; j < 4; ++j) { v[j] = P4_CV(S.o[j]); ss += (v[j][0] * v[j][0] + v[j][1] * v[j][1]) + (v[j][2] * v[j][2] + v[j][3] * v[j][3]); } \
        float r = 1.0f / sqrtf(wave_sum(ss) * (1.0f / GW) + EPS); \
        _Pragma("unroll") for (int j = 0; j < 4; ++j) { const int col = 4 * lane + 256 * j; const f32x4 g = *(const f32x4*)(F.g_out_na + col); \
            v2u w; w.x = pk2(v[j][0] * r * g[0], v[j][1] * r * g[1]); w.y = pk2(v[j][2] * r * g[2], v[j][3] * r * g[3]); *(v2u*)(aout + (size_t)(tok) * D + col) = w; } \
        ss = 0.f; \
        _Pragma("unroll") for (int j = 0; j < 4; ++j) { const float l0 = S.l[j][0], l1 = S.l[j][1], l2 = S.l[j][2]; \
            const float mx = fmaxf(fmaxf(l0, l1), l2); const float e0 = __expf(l0 - mx), e1 = __expf(l1 - mx), e2 = __expf(l2 - mx); const float inv = 1.0f / (e0 + e1 + e2); \
            v[j] = P4_CV(S.d[j][0]) * (e0 * inv) + P4_CV(S.d[j][1]) * (e1 * inv) + P4_CV(S.d[j][2]) * (e2 * inv); \
            ss += (v[j][0] * v[j][0] + v[j][1] * v[j][1]) + (v[j][2] * v[j][2] + v[j][3] * v[j][3]); } \
        r = 1.0f / sqrtf(wave_sum(ss) * (1.0f / GW) + EPS); \
        _Pragma("unroll") for (int j = 0; j < 4; ++j) { const int col = 4 * lane + 256 * j; const f32x4 g = *(const f32x4*)(F.g_out_dil + col); \
            v2u w; w.x = pk2(v[j][0] * r * g[0], v[j][1] * r * g[1]); w.y = pk2(v[j][2] * r * g[2], v[j][3] * r * g[3]); *(v2u*)(aout + (size_t)(tok) * D + GW + col) = w; } } while (0)
    Tok A, B;
    int tok = gw;
    if (tok < T) P4_LOAD(A, tok);
    if (tok + NGW < T) P4_LOAD(B, tok + NGW);
#pragma unroll 1
    for (; tok < T; tok += 2 * NGW) {
        P4_DO(A, tok);
        if (tok + 2 * NGW < T) P4_LOAD(A, tok + 2 * NGW);
        if (tok + NGW < T) { P4_DO(B, tok + NGW); if (tok + 3 * NGW < T) P4_LOAD(B, tok + 3 * NGW); }
    }
#undef P4_LOAD
#undef P4_CV
#undef P4_DO
}

__device__ __forceinline__ void p6_tables(Frame& F, int rb) {
    LAS float* t1 = (LAS float*)(F.lds + RING_OFF + 131072); LAS float* t2 = t1 + D; LAS float* t3 = t2 + D;
    const float* md = (const float*)(F.ws + WS_MOD) + (size_t)(rb >> 6) * (6 * D);
    for (int col = F.tid; col < D; col += NWAVES * 64) { t1[col] = F.g_post_mix[col] * md[2 * D + col]; t2[col] = F.g_pre_ffn[col] * (1.0f + md[4 * D + col]); t3[col] = md[3 * D + col]; }
}
__device__ __forceinline__ void p6_rows(Frame& F, bool pre) {
    LAS float* t1 = (LAS float*)(F.lds + RING_OFF + 131072);
    LAS float* t2 = t1 + D;
    LAS float* t3 = t2 + D;
    LAS unsigned* hb0 = (LAS unsigned*)(F.lds + RING_OFF);
    LAS unsigned* hb = hb0 + F.wave * (4 * D / 2);
    const bf16* mixed = (const bf16*)(F.ws + WS_MIXED); bf16* x1 = (bf16*)(F.ws + WS_X1); unsigned char* hffn8 = F.ws + WS_HFFN;
    int* topi = (int*)(F.ws + WS_TOPI); float* topg = (float*)(F.ws + WS_TOPG); int* trank = (int*)(F.ws + WS_TRANK); unsigned* hist_g = (unsigned*)(F.ws + WS_HIST);
    LAS unsigned* hist = (LAS unsigned*)(F.lds + MISC_OFF) + 224;
    const int lane = F.lane;
#define P6_LOAD(m, xv, rr) do { const int row_ = rb * 32 + F.wave * 4 + (rr); _Pragma("unroll") for (int j = 0; j < 8; ++j) { const int col = 4 * lane + 256 * j; \
            m[j] = *(const v2u*)(mixed + (size_t)row_ * D + col); xv[j] = *(const f32x4*)(F.x + (size_t)row_ * D + col); } } while (0)
#define P6_ROW(m, xv, rr) do { const int row = rb * 32 + F.wave * 4 + (rr); f32x4 v[8]; float ss = 0.f; \
            _Pragma("unroll") for (int j = 0; j < 8; ++j) { v[j] = (f32x4){bflo(m[j].x), bfhi(m[j].x), bflo(m[j].y), bfhi(m[j].y)}; ss += (v[j][0] * v[j][0] + v[j][1] * v[j][1]) + (v[j][2] * v[j][2] + v[j][3] * v[j][3]); } \
            float r = 1.0f / sqrtf(wave_sum(ss) * (1.0f / D) + EPS); \
            ss = 0.f; \
            _Pragma("unroll") for (int j = 0; j < 8; ++j) { const int col = 4 * lane + 256 * j; const f32x4 a = *(LAS f32x4*)(t1 + col); \
                v[j] = xv[j] + a * (v[j] * r); { v2u w; w.x = pk2(v[j][0], v[j][1]); w.y = pk2(v[j][2], v[j][3]); *(v2u*)(x1 + (size_t)row * D + col) = w; } \
                ss += (v[j][0] * v[j][0] + v[j][1] * v[j][1]) + (v[j][2] * v[j][2] + v[j][3] * v[j][3]); } \
            r = 1.0f / sqrtf(wave_sum(ss) * (1.0f / D) + EPS); \
            _Pragma("unroll") for (int j = 0; j < 8; ++j) { const int col = 4 * lane + 256 * j; const f32x4 a = *(LAS f32x4*)(t2 + col), s = *(LAS f32x4*)(t3 + col); \
                const f32x4 hv = v[j] * r * a + s; \
                v2u w; w.x = pk2(hv[0], hv[1]); w.y = pk2(hv[2], hv[3]); *(LAS v2u*)(hb + (rr) * (D / 2) + (col >> 1)) = w; \
                *(unsigned*)(hffn8 + (size_t)row * D + col) = pg8::cvt4_fp8(hv[0] * XSCALE, hv[1] * XSCALE, hv[2] * XSCALE, hv[3] * XSCALE); } } while (0)
    for (int rb = F.vcu; rb < T / 32; rb += F.G) {
        const int b = rb >> 6;
        v2u ma[8], mb[8]; f32x4 xa[8], xb[8];
        P6_LOAD(ma, xa, 0); P6_LOAD(mb, xb, 1);
        if (pre && rb == F.vcu) { if (F.tid < 32) hist[F.tid] = 0u; }
        else { __syncthreads(); if (F.tid < 32) hist[F.tid] = 0u; p6_tables(F, rb); __syncthreads(); }
        { P6_ROW(ma, xa, 0); P6_LOAD(ma, xa, 2);
          P6_ROW(mb, xb, 1); P6_LOAD(mb, xb, 3);
          P6_ROW(ma, xa, 2);
          P6_ROW(mb, xb, 3); }
#undef P6_LOAD
#undef P6_ROW
        __syncthreads();
        typedef short bf16x8r __attribute__((ext_vector_type(8)));
        f32x4 racc[2][2];
#pragma unroll
        for (int rt = 0; rt < 2; ++rt)
#pragma unroll
            for (int et = 0; et < 2; ++et) racc[rt][et] = (f32x4){0.f, 0.f, 0.f, 0.f};
        { const int n16 = lane & 15, g = lane >> 4;
          const LAS unsigned char* ab = (const LAS unsigned char*)hb0 + n16 * 4096 + (256 * F.wave + 8 * g) * 2;
          const bf16* wb = (const bf16*)(F.ws + WS_WRT) + n16 * D + 256 * F.wave + 8 * g;
#pragma unroll
          for (int ks = 0; ks < 8; ++ks) {
              const bf16x8r a0 = *(const LAS bf16x8r*)(ab + 64 * ks), a1 = *(const LAS bf16x8r*)(ab + 16 * 4096 + 64 * ks);
#pragma unroll
              for (int et = 0; et < 2; ++et) {
                  const bf16x8r bh = *(const bf16x8r*)(wb + et * 16 * D + 32 * ks), bl = *(const bf16x8r*)(wb + NE * D + et * 16 * D + 32 * ks);
                  racc[0][et] = __builtin_amdgcn_mfma_f32_16x16x32_bf16(a0, bh, racc[0][et], 0, 0, 0); racc[0][et] = __builtin_amdgcn_mfma_f32_16x16x32_bf16(a0, bl, racc[0][et], 0, 0, 0);
                  racc[1][et] = __builtin_amdgcn_mfma_f32_16x16x32_bf16(a1, bh, racc[1][et], 0, 0, 0); racc[1][et] = __builtin_amdgcn_mfma_f32_16x16x32_bf16(a1, bl, racc[1][et], 0, 0, 0); } } }
        LAS float* part = (LAS float*)(F.lds + RING_OFF);
        __syncthreads();
        { const int n16 = lane & 15, g = lane >> 4;
#pragma unroll
          for (int rt = 0; rt < 2; ++rt)
#pragma unroll
              for (int et = 0; et < 2; ++et)
#pragma unroll
                  for (int r = 0; r < 4; ++r) part[(F.wave * 32 + 16 * rt + 4 * g + r) * 32 + 16 * et + n16] = racc[rt][et][r]; }
        __syncthreads();
#pragma unroll
        for (int rt = 0; rt < 2; ++rt) {
            const int e = lane & 31, rl = 2 * F.wave + (lane >> 5), row = rb * 32 + 16 * rt + rl;
            float lg = F.b_router[e];
#pragma unroll
            for (int w2 = 0; w2 < 8; ++w2) lg += part[(w2 * 32 + 16 * rt + rl) * 32 + e];
            int sel[4]; float val[4];
#pragma unroll
            for (int k = 0; k < 4; ++k) { float bv = lg; int bi = e;
#pragma unroll
                for (int o = 16; o >= 1; o >>= 1) { const float ov = __shfl_xor(bv, o); const int oi = __shfl_xor(bi, o); const bool take = (ov > bv) || (ov == bv && oi < bi); bv = take ? ov : bv; bi = take ? oi : bi; }
                sel[k] = bi; val[k] = bv; if (e == bi) lg = -INFINITY; }
            const float e1 = __expf(val[1] - val[0]), e2 = __expf(val[2] - val[0]), e3 = __expf(val[3] - val[0]); const float inv = 1.0f / (1.0f + e1 + e2 + e3);
            if (e == 0) {
                *(int4*)(topi + (size_t)row * 4) = make_int4(sel[0], sel[1], sel[2], sel[3]);
                *(float4*)(topg + (size_t)row * 4) = make_float4(inv, e1 * inv, e2 * inv, e3 * inv);
                int rk[4];
#pragma unroll
                for (int k = 0; k < 4; ++k) rk[k] = (int)__hip_atomic_fetch_add(hist + sel[k], 1u, __ATOMIC_RELAXED, __HIP_MEMORY_SCOPE_WORKGROUP);
                *(int4*)(trank + (size_t)row * 4) = make_int4(rk[0], rk[1], rk[2], rk[3]);
            }
        }
        __syncthreads();
        if (F.tid < 32) hist_g[rb * 32 + F.tid] = hist[F.tid];
    }
}

__device__ __forceinline__ void moe_tables(Frame& F, int rb) {
    const unsigned* hist_g = (const unsigned*)(F.ws + WS_HIST);
    LAS unsigned* red = (LAS unsigned*)(F.lds + RING_OFF);
    __syncthreads();
    { const int e = F.tid & 31, part = F.tid >> 5; unsigned tot = 0u, pre = 0u;
#pragma unroll
      for (int i = 0; i < 16; ++i) { const int r2 = part * 16 + i; const unsigned v = hist_g[r2 * 32 + e]; tot += v; pre += (r2 < rb) ? v : 0u; }
      red[(part * 32 + e) * 2] = tot; red[(part * 32 + e) * 2 + 1] = pre; }
    __syncthreads();
    if (F.tid < 32) { unsigned tot = 0u, pre = 0u;
#pragma unroll
        for (int part = 0; part < 16; ++part) { tot += red[(part * 32 + F.tid) * 2]; pre += red[(part * 32 + F.tid) * 2 + 1]; }
        const int k = (int)((tot + 255u) >> 8); int inc = k;
#pragma unroll
        for (int o = 1; o < 32; o <<= 1) { const int v = __shfl_up(inc, o); inc += (F.tid >= o) ? v : 0; }
        const int nb0 = inc - k, nbt = __shfl(inc, 31);
        F.MISC[224 + F.tid] = tot; F.MISC[32 + F.tid] = pre + (unsigned)(nb0 * 256);
        for (int j = 0; j < k; ++j) { const int q = nb0 + j; if (q < MAXBLK) F.MISC[64 + q] = (unsigned)F.tid; }
        if (F.tid == 0) F.MISC[16] = (unsigned)min(nbt, MAXBLK); }
    __syncthreads();
}
__device__ __forceinline__ void moe_blocks(Frame& F) {
    __syncthreads();
    if (F.tid < 161) { const unsigned v = ((const unsigned*)(F.ws + WS_BLK))[F.tid]; if (F.tid < 160) F.MISC[64 + F.tid] = v; else F.MISC[16] = v; }
    __syncthreads();
}
__device__ __forceinline__ void p7_slots(Frame& F) {
    const int* topi = (const int*)(F.ws + WS_TOPI); const int* trank = (const int*)(F.ws + WS_TRANK); int* tslot = (int*)(F.ws + WS_TSLOT); int* slot_tok = (int*)(F.ws + WS_SLOTTOK);
    for (int rb = F.vcu; rb < T / 32; rb += F.G) {
        int p_topi = 0, p_trank = 0; if (F.tid < 128) { p_topi = topi[rb * 128 + F.tid]; p_trank = trank[rb * 128 + F.tid]; }
        moe_tables(F, rb);
        if (rb == 0 && F.tid < 161) ((unsigned*)(F.ws + WS_BLK))[F.tid] = (F.tid < 160) ? F.MISC[64 + F.tid] : F.MISC[16];
        if (F.tid < 128) { const int pid = rb * 128 + F.tid; const int slot = (int)F.MISC[32 + p_topi] + p_trank; tslot[pid] = slot; slot_tok[slot] = pid >> 2; }
    }
}

__device__ __forceinline__ void p10_table(Frame& F, int rb) {
    LAS float* t1 = (LAS float*)(F.lds + RING_OFF + 131072);
    const float* md = (const float*)(F.ws + WS_MOD) + (size_t)(rb >> 6) * (6 * D); for (int col = F.tid; col < D; col += NWAVES * 64) t1[col] = F.g_post_ffn[col] * md[5 * D + col];
}
__device__ __forceinline__ void p10_final(Frame& F, bool pre) {
    LAS float* t1 = (LAS float*)(F.lds + RING_OFF + 131072);
    const bf16* x1 = (const bf16*)(F.ws + WS_X1); const unsigned char* yb = F.ws + WS_YB;
    const int* tslot = (const int*)(F.ws + WS_TSLOT); const float* topg = (const float*)(F.ws + WS_TOPG);
    const int lane = F.lane;
    for (int rb = F.vcu; rb < T / 32; rb += F.G) {
        const int b = rb >> 6;
        int4 sl[4]; float4 gt[4];
#pragma unroll
        for (int i = 0; i < 4; ++i) { const int row_ = rb * 32 + F.wave + 8 * i; sl[i] = *(const int4*)(tslot + (size_t)row_ * 4); gt[i] = *(const float4*)(topg + (size_t)row_ * 4); }
        if (!(pre && rb == F.vcu)) { __syncthreads(); p10_table(F, rb); __syncthreads(); }
        struct Row { v2u yr[4][4]; };
#define P10_LOAD(R, i) do { const int row_ = rb * 32 + F.wave + 8 * (i); const int s0_ = sl[i].x, s1_ = sl[i].y, s2_ = sl[i].z, s3_ = sl[i].w; \
            _Pragma("unroll") for (int j = 0; j < 4; ++j) { const int co = 8 * lane + 512 * j; \
                R.yr[j][0] = *(const v2u*)(yb + (size_t)s0_ * D + co); R.yr[j][1] = *(const v2u*)(yb + (size_t)s1_ * D + co); R.yr[j][2] = *(const v2u*)(yb + (size_t)s2_ * D + co); R.yr[j][3] = *(const v2u*)(yb + (size_t)s3_ * D + co); } (void)row_; } while (0)
#define P10_DO(R, i) do { const int row = rb * 32 + F.wave + 8 * (i); const float gts[4] = {gt[i].x * (1.0f / YSCALE), gt[i].y * (1.0f / YSCALE), gt[i].z * (1.0f / YSCALE), gt[i].w * (1.0f / YSCALE)}; \
            v4u xr[4]; _Pragma("unroll") for (int q = 0; q < 4; ++q) xr[q] = *(const v4u*)(x1 + (size_t)row * D + 8 * lane + 512 * q);         \
            float y[4][8]; float ss = 0.f; \
            _Pragma("unroll") for (int j = 0; j < 4; ++j) { \
                _Pragma("unroll") for (int q = 0; q < 8; ++q) y[j][q] = 0.f; \
                _Pragma("unroll") for (int k = 0; k < 4; ++k) { const v2u w = R.yr[j][k]; const float g = gts[k]; \
                    const auto f0 = __builtin_amdgcn_cvt_pk_f32_fp8((int)w.x, false), f1 = __builtin_amdgcn_cvt_pk_f32_fp8((int)w.x, true), f2 = __builtin_amdgcn_cvt_pk_f32_fp8((int)w.y, false), f3 = __builtin_amdgcn_cvt_pk_f32_fp8((int)w.y, true); \
                    y[j][0] += g * f0[0]; y[j][1] += g * f0[1]; y[j][2] += g * f1[0]; y[j][3] += g * f1[1]; y[j][4] += g * f2[0]; y[j][5] += g * f2[1]; y[j][6] += g * f3[0]; y[j][7] += g * f3[1]; } \
                _Pragma("unroll") for (int q = 0; q < 8; ++q) ss += y[j][q] * y[j][q]; } \
            const float r = 1.0f / sqrtf(wave_sum(ss) * (1.0f / D) + EPS); \
            _Pragma("unroll") for (int j = 0; j < 4; ++j) { const int col = 8 * lane + 512 * j; \
                _Pragma("unroll") for (int hh = 0; hh < 2; ++hh) { v2u xw; xw.x = hh ? xr[j].z : xr[j].x; xw.y = hh ? xr[j].w : xr[j].y; const f32x4 xv = (f32x4){bflo(xw.x), bfhi(xw.x), bflo(xw.y), bfhi(xw.y)}; const f32x4 a = *(LAS f32x4*)(t1 + col + 4 * hh); \
                    f32x4 o; o[0] = xv[0] + a[0] * y[j][4 * hh + 0] * r; o[1] = xv[1] + a[1] * y[j][4 * hh + 1] * r; o[2] = xv[2] + a[2] * y[j][4 * hh + 2] * r; o[3] = xv[3] + a[3] * y[j][4 * hh + 3] * r; \
                    *(f32x4*)(F.out + (size_t)row * D + col + 4 * hh) = o; } } } while (0)
        { Row A, B;
          P10_LOAD(A, 0); P10_LOAD(B, 1);
          P10_DO(A, 0); P10_LOAD(A, 2);
          P10_DO(B, 1); P10_LOAD(B, 3);
          P10_DO(A, 2);
          P10_DO(B, 3); }
#undef P10_LOAD
#undef P10_DO
    }
}

struct Args { const float* in[20]; float* out; unsigned char* ws; int ph_lo, ph_hi; };
__global__ void __launch_bounds__(NWAVES * 64, 2) fwd_kernel(Args args) {
    extern __shared__ __attribute__((aligned(16))) unsigned char lds[];
    Frame F;
    F.lds = (LAS unsigned char*)lds;
    F.MISC = (volatile LAS unsigned*)(F.lds + MISC_OFF);
    F.tid = threadIdx.x; F.lane = F.tid & 63; F.wave = __builtin_amdgcn_readfirstlane(F.tid >> 6);
    F.G = gridDim.x; { const int bx = blockIdx.x; F.vcu = (F.G % 8 == 0) ? (bx % 8) * (F.G / 8) + bx / 8 : bx; }
    F.ws = args.ws; F.ctl = (unsigned*)(args.ws + WS_CTL); F.out = args.out;
    F.x = args.in[0]; F.c = args.in[1]; F.w_ada = args.in[2]; F.b_ada = args.in[3]; F.g_pre_mix = args.in[4]; F.g_post_mix = args.in[5]; F.w_in = args.in[6]; F.rpb = args.in[7]; F.t5 = args.in[8];
    F.g_out_na = args.in[9]; F.g_out_dil = args.in[10]; F.w_o = args.in[11]; F.g_pre_ffn = args.in[12]; F.g_post_ffn = args.in[13]; F.w_router = args.in[14]; F.b_router = args.in[15];
    F.w_e_in = args.in[16]; F.b_e_in = args.in[17]; F.w_e_out = args.in[18]; F.b_e_out = args.in[19];
    for (int u = F.tid; u < 256; u += NWAVES * 64) F.MISC[u] = 0u;
    __syncthreads();
    XcdBarrier bar; bar.bar = F.ctl + CW_BAR; bar.x = 0; bar.st = nullptr;
    if (MK_N_LAUNCHES == 1) bar = xcd_barrier_post(F.ctl + CW_BAR, F.MISC + 8);
    const int lo = args.ph_lo, hi = args.ph_hi;
#define IN(k) (lo <= (k) && (k) < hi)
#define REP(k) ((PROBE_REPEAT == (k)) ? 2 : 1)
#ifndef PROBE_TIME
#define PROBE_TIME -1
#endif
    unsigned long long pt0 = 0ull, pt1 = 0ull;
#define SEAM(k) do { if (IN(k) && IN((k) + 1)) xcd_barrier(bar); if (PROBE_TIME == (k)) pt1 = __builtin_amdgcn_s_memrealtime(); if (PROBE_TIME == (k) + 1) pt0 = __builtin_amdgcn_s_memrealtime(); } while (0)
    if (PROBE_TIME == 0) pt0 = __builtin_amdgcn_s_memrealtime();

    if (IN(0)) { for (int rep = 0; rep < REP(0); ++rep) p0_prologue(F); } SEAM(0);
    if (IN(1)) { for (int rep = 0; rep < REP(1); ++rep) p1_hmix(F); } SEAM(1);
    if (IN(2)) for (int rep2 = 0; rep2 < REP(2); ++rep2) {
        __syncthreads();
        if (F.G == 256 && (int)blockIdx.x >= QKV_GEMM_WGS) {
            convw_run(F, (int)blockIdx.x - QKV_GEMM_WGS, 256 - QKV_GEMM_WGS, 0, CONVW_Q2);
        } else {
            const int gg = (F.G == 256) ? QKV_GEMM_WGS : F.G;
            pg8::Gemm g{(const bf16*)(F.ws + WS_HMIX), (const bf16*)(F.ws + WS_WIN_T), T, NQKV, D}; pg8::StaticOrder S; S.init(T, NQKV, gg, (int)blockIdx.x);
            pg8::EpiBf16 E{(bf16*)(F.ws + WS_PROJ), NQKV, nullptr, 0};
            __syncthreads(); pg8::gemm_phase<pg8::EpiBf16, pg8::StaticOrder, true, true>(F.lds + RING_OFF, g, S, E);
            if (F.G != 256) { __syncthreads(); convw_run(F, F.vcu, F.G, 0, CONVW_Q2); }
        }
    } SEAM(2);
        if (IN(3)) { for (int rep = 0; rep < REP(3); ++rep) { __syncthreads(); p3_attn_mfma(F); } } SEAM(3);
    if (IN(4)) { for (int rep = 0; rep < REP(4); ++rep) p4_post(F); } SEAM(4);
    if (IN(5)) for (int rep5 = 0; rep5 < REP(5); ++rep5) {
        __syncthreads();
        if (F.G == 256 && (int)blockIdx.x >= WO_GEMM_WGS) {
            convw_run(F, (int)blockIdx.x - WO_GEMM_WGS, 256 - WO_GEMM_WGS, CONVW_Q2, CONVW_Q2 + CONVW_Q5);
        } else {
            const int gg = (F.G == 256) ? WO_GEMM_WGS : F.G;
            pg8::Gemm g{(const bf16*)(F.ws + WS_AOUT), (const bf16*)(F.ws + WS_WO_T), T, D, D}; pg8::StaticOrder S; S.init(T, D, gg, (int)blockIdx.x);
            pg8::EpiBf16 E{(bf16*)(F.ws + WS_MIXED), D, nullptr, 0};
            __syncthreads();
            pg8::gemm_phase<pg8::EpiBf16, pg8::StaticOrder, true, true>(F.lds + RING_OFF, g, S, E);
            if (F.G != 256) { __syncthreads(); convw_run(F, F.vcu, F.G, CONVW_Q2, CONVW_Q2 + CONVW_Q5); }
        }
    }
    bool p6pre = false;
    if (IN(5) && IN(6) && F.vcu < T / 32) { p6_tables(F, F.vcu); p6pre = true; }
    SEAM(5);
    if (IN(6)) { for (int rep = 0; rep < REP(6); ++rep) p6_rows(F, p6pre && rep == 0); } SEAM(6);
    if (IN(7)) { for (int rep = 0; rep < REP(7); ++rep) p7_slots(F); } SEAM(7);
    if (IN(8)) {
        if (!IN(7) || F.vcu >= T / 32) moe_blocks(F);
        pg8::Gemm g{(const bf16*)(F.ws + WS_HFFN), (const bf16*)(F.ws + WS_WEI_T), MAXBLK * 256, FF2, D / 2};
        LAS int* rowtab = (LAS int*)(F.lds + RING_OFF + 131072);
        pg8::MoeOrder<16> S{(const LAS int*)(F.lds + MISC_OFF + 64 * 4), (int)F.MISC[16], F.G, (int)blockIdx.x, rowtab};
        { const int* slot_tok = (const int*)(F.ws + WS_SLOTTOK); int tk[12];
#pragma unroll
          for (int i = 0; i < 12; ++i) { pg8::Unit u; const bool ok = S.next(i, u); tk[i] = (ok && F.tid < 256) ? slot_tok[u.pm * 256 + F.tid] : -1; }
#pragma unroll
          for (int i = 0; i < 12; ++i) if (tk[i] >= 0) rowtab[i * 256 + F.tid] = tk[i]; }
        pg8::EpiSwiglu8 E{F.ws + WS_HB, FF, F.b_e_in, FF2, 1.0f / (WSCALE * XSCALE), HSCALE};
        for (int rep = 0; rep < REP(8); ++rep) { __syncthreads(); pg8::gemm_phase<pg8::EpiSwiglu8, pg8::MoeOrder<16>, true, true, true, true>(F.lds + RING_OFF, g, S, E); }
    } SEAM(8);
    if (IN(9)) {
        if (!IN(7) || F.vcu >= T / 32) moe_blocks(F);
        pg8::Gemm g{(const bf16*)(F.ws + WS_HB), (const bf16*)(F.ws + WS_WEO_T), MAXBLK * 256, D, FF / 2};
        pg8::MoeOrder<8> S{(const LAS int*)(F.lds + MISC_OFF + 64 * 4), (int)F.MISC[16], F.G, (int)blockIdx.x, nullptr, true, true};
        pg8::EpiFp8S E{F.ws + WS_YB, D, F.b_e_out, D, 1.0f / (WSCALE * HSCALE), YSCALE};
        for (int rep = 0; rep < REP(9); ++rep) { __syncthreads(); pg8::gemm_phase<pg8::EpiFp8S, pg8::MoeOrder<8>, true, true, true>(F.lds + RING_OFF, g, S, E); }
    }
    bool p10pre = false;
    if (IN(9) && IN(10) && F.vcu < T / 32) { p10_table(F, F.vcu); p10pre = true; }
    SEAM(9);
    if (IN(10)) { for (int rep = 0; rep < REP(10); ++rep) p10_final(F, p10pre && rep == 0); }
    if (PROBE_TIME == 10) pt1 = __builtin_amdgcn_s_memrealtime();
    if (PROBE_TIME >= 0 && blockIdx.x == 0) { const unsigned long long te = __builtin_amdgcn_s_memrealtime(), span = (pt1 - pt0) * 8ull; while (__builtin_amdgcn_s_memrealtime() - te < span) __builtin_amdgcn_s_sleep(8); }
#undef IN
#undef SEAM
}

extern "C" void kernel_launch(void* const* d_in, const int* in_sizes, int n_in, void* d_out, int out_size, void* d_ws, size_t ws_size, hipStream_t stream) {
    static int grid = 0;
    if (grid == 0) {
        if (n_in != 20 || out_size != T * D || ws_size < WS_END) { fprintf(stderr, "kernel_launch: unexpected problem (n_in %d, out %d, ws %zu)\n", n_in, out_size, ws_size); grid = -1; return; }
        int dev = 0, cus = 0, per_cu = 0;
        if (hipGetDevice(&dev) != hipSuccess || hipDeviceGetAttribute(&cus, hipDeviceAttributeMultiprocessorCount, dev) != hipSuccess) { grid = -1; return; }
        if (hipFuncSetAttribute((const void*)fwd_kernel, hipFuncAttributeMaxDynamicSharedMemorySize, LDS_BYTES) != hipSuccess) { fprintf(stderr, "kernel_launch: hipFuncSetAttribute failed\n"); grid = -1; return; }
        if (hipOccupancyMaxActiveBlocksPerMultiprocessor(&per_cu, (const void*)fwd_kernel, NWAVES * 64, LDS_BYTES) != hipSuccess || per_cu < 1) { fprintf(stderr, "kernel_launch: occupancy query reports %d\n", per_cu); }
        (void)hipGetLastError();
        grid = cus;
    }
    if (grid < 0) return;
    if (hipMemsetAsync((char*)d_ws + WS_CTL, 0, CTL_ZERO_BYTES, stream) != hipSuccess) return;
    Args a{};
    for (int i = 0; i < 20; ++i) a.in[i] = (const float*)d_in[i];
    a.out = (float*)d_out; a.ws = (unsigned char*)d_ws;
    if (MK_N_LAUNCHES == 1) {
        a.ph_lo = 0; a.ph_hi = NPHASE;
        hipLaunchKernelGGL(fwd_kernel, dim3(grid), dim3(NWAVES * 64), LDS_BYTES, stream, a);
    } else {
        for (int p = 0; p < NPHASE; ++p) { a.ph_lo = p; a.ph_hi = p + 1; hipLaunchKernelGGL(fwd_kernel, dim3(grid), dim3(NWAVES * 64), LDS_BYTES, stream, a); }
    }
}
```
